# Optimizing an MI355X kernel written in HIP

```python
import jax, jax.numpy as jnp
from jax import lax
import numpy as np

D_MODEL = 1024
BATCH = 8
SEQ = 4096
DEPTH = 2

GRID_W = 64
CTX_LEN = 256
N_MOD = 6
EPS = 1e-6
N_EVEN = (DEPTH + 1) // 2
N_ODD = DEPTH // 2
D_CONV = 512
CONV_WIDTH = 31
CONV_GROUPS = 8
NA_HEADS = 8
HEAD_DIM = 64
D_ATTN = NA_HEADS * HEAD_DIM
NA_ROWS_MAX = 8
NA_COLS = 16
NA_COL_BLOCK = 16
NA_BAND = NA_COL_BLOCK + NA_COLS
D_AB_IN = 2 * D_CONV + 3 * D_ATTN
CHUNK = 128
SGU_GROUPS = 8
D_SGU = 1024
PEER_HEADS = 8
N_KEYS = 128
N_EXPERTS = N_KEYS * N_KEYS
PEER_TOPK = 16
D_KEY = 128
PEER_BLOCK = 128

kernel_name = 'hybrid_conv_natten_sgu_peer_dit'


def rms_norm(x, g):
    xf = x.astype(jnp.float32)
    y = xf * lax.rsqrt(jnp.mean(xf * xf, -1, keepdims=True) + EPS)
    return y.astype(x.dtype) * g


def standardize(x, groups):
    xf = x.astype(jnp.float32).reshape(x.shape[:-1] + (groups, -1))
    mu = jnp.mean(xf, -1, keepdims=True)
    var = jnp.mean(jnp.square(xf - mu), -1, keepdims=True)
    return ((xf - mu) * lax.rsqrt(var + EPS)).reshape(x.shape).astype(x.dtype)


def ada_modulation(cvec, w, b):
    m = jax.nn.silu(cvec) @ w + b
    return m.reshape(m.shape[:-1] + (N_MOD, D_MODEL))


def modulate(x, g, shift, scale):
    return rms_norm(x, g) * (1 + scale[:, None]) + shift[:, None]


def conformer_conv(u, conv_w, conv_b, gn_g, gn_b):
    a, gate = jnp.split(u, 2, axis=-1)
    h = a * jax.nn.sigmoid(gate)
    h = lax.conv_general_dilated(
        h, conv_w[:, None, :].astype(h.dtype), window_strides=(1,),
        padding=[(CONV_WIDTH // 2, CONV_WIDTH // 2)],
        dimension_numbers=('NWC', 'WIO', 'NWC'), feature_group_count=D_CONV) + conv_b
    h = standardize(h, CONV_GROUPS) * gn_g + gn_b
    return jax.nn.silu(h)


def neighbourhood_attention(q, k, v, k_c, v_c, rpb):
    B, S, H, Dh = q.shape
    rows = S // GRID_W
    wh = min(NA_ROWS_MAX, rows)
    ncb = GRID_W // NA_COL_BLOCK
    r = jnp.arange(rows)
    key_rows = jnp.clip(r - wh // 2, 0, rows - wh)[:, None] + jnp.arange(wh)
    band_start = jnp.clip(jnp.arange(ncb) * NA_COL_BLOCK - NA_COLS // 2, 0, GRID_W - NA_BAND)
    key_cols = band_start[:, None] + jnp.arange(NA_BAND)
    q_cols = jnp.arange(GRID_W).reshape(ncb, NA_COL_BLOCK)
    col_start = jnp.clip(q_cols - NA_COLS // 2, 0, GRID_W - NA_COLS)
    valid = (key_cols[:, None, :] >= col_start[..., None]) & (key_cols[:, None, :] < col_start[..., None] + NA_COLS)
    dr_idx = key_rows - r[:, None] + (NA_ROWS_MAX - 1)
    dc_idx = jnp.clip(key_cols[:, None, :] - q_cols[..., None] + (NA_COLS - 1), 0, 2 * NA_COLS - 2)
    bias = rpb.astype(jnp.float32)[:, dr_idx[:, None, None, :, None], dc_idx[None, :, :, None, :]]
    bias = jnp.moveaxis(bias, 0, 2)
    bias = jnp.where(valid[None, :, None, :, None, :], bias, jnp.float32(-1e30))
    ridx = key_rows[:, None, :, None]
    cidx = key_cols[None, :, None, :]
    scale = HEAD_DIM ** -0.5
    nwin = wh * NA_BAND

    def one_sample(args):
        qs, ks, vs, kcs, vcs = args
        qb = qs.reshape(rows, ncb, NA_COL_BLOCK, H, Dh)
        kg = ks.reshape(rows, GRID_W, H, Dh)[ridx, cidx]
        vg = vs.reshape(rows, GRID_W, H, Dh)[ridx, cidx]
        s_win = jnp.einsum('rjqhd,rjwbhd->rjhqwb', qb, kg).astype(jnp.float32) * scale + bias
        s_ctx = jnp.einsum('rjqhd,chd->rjhqc', qb, kcs).astype(jnp.float32) * scale
        s = jnp.concatenate([s_win.reshape(rows, ncb, H, NA_COL_BLOCK, nwin), s_ctx], axis=-1)
        p = jax.nn.softmax(s, axis=-1).astype(vs.dtype)
        p_win = p[..., :nwin].reshape(rows, ncb, H, NA_COL_BLOCK, wh, NA_BAND)
        o = (jnp.einsum('rjhqwb,rjwbhd->rjqhd', p_win, vg)
             + jnp.einsum('rjhqc,chd->rjqhd', p[..., nwin:], vcs))
        return o.reshape(S, H * Dh)

    return lax.map(one_sample, (q, k, v, k_c, v_c))


def context_attention(q, k, v):
    B, L, H, Dh = q.shape
    s = jnp.einsum('bqhd,bkhd->bhqk', q, k).astype(jnp.float32) * HEAD_DIM ** -0.5
    p = jax.nn.softmax(s, axis=-1).astype(v.dtype)
    return jnp.einsum('bhqk,bkhd->bqhd', p, v).reshape(B, L, H * Dh)


def heads(t):
    return t.reshape(t.shape[:-1] + (NA_HEADS, HEAD_DIM))


def mixer_conv_na(hm, hcm, w_in, conv_w, conv_b, gn_g, gn_b, rpb, w_out, ctx_out):
    proj = hm @ w_in
    q, k, v = jnp.split(proj[..., 2 * D_CONV:], 3, axis=-1)
    kv_c = hcm @ w_in[:, 2 * D_CONV + D_ATTN:]
    k_c, v_c = jnp.split(kv_c, 2, axis=-1)
    y_a = conformer_conv(proj[..., :2 * D_CONV], conv_w, conv_b, gn_g, gn_b)
    y_b = neighbourhood_attention(heads(q), heads(k), heads(v), heads(k_c), heads(v_c), rpb)
    out = jnp.concatenate([y_a, y_b], axis=-1) @ w_out
    if not ctx_out:
        return out, None
    proj_c = hcm @ w_in[:, :2 * D_CONV + D_ATTN]
    yc_a = conformer_conv(proj_c[..., :2 * D_CONV], conv_w, conv_b, gn_g, gn_b)
    yc_b = context_attention(heads(proj_c[..., 2 * D_CONV:]), heads(k_c), heads(v_c))
    return out, jnp.concatenate([yc_a, yc_b], axis=-1) @ w_out


def mixer_sgu(hm, w_in, ln_g, ln_b, w_s, b_s, w_out):
    B, L, _ = hm.shape
    z = jax.nn.gelu(hm @ w_in, approximate=False)
    u, vv = jnp.split(z, 2, axis=-1)
    vv = standardize(vv, 1) * ln_g + ln_b
    vv = vv.reshape(B, L // CHUNK, CHUNK, SGU_GROUPS, D_SGU // SGU_GROUPS)
    mixed = jnp.einsum('gpq,bnqgc->bnpgc', w_s, vv) + b_s.T[None, None, :, :, None]
    return (u * mixed.reshape(B, L, D_SGU)) @ w_out


def peer(h, wq, keys, u_tab, v_tab):
    B, L, D = h.shape
    blocks = h.reshape(-1, PEER_BLOCK, D)

    def one_block(xb):
        T = xb.shape[0]
        q = (xb @ wq).reshape(T, PEER_HEADS, 2, D_KEY)
        s = jnp.einsum('thpd,hpkd->thpk', q, keys).astype(jnp.float32)
        s1, i1 = lax.top_k(s[:, :, 0], PEER_TOPK)
        s2, i2 = lax.top_k(s[:, :, 1], PEER_TOPK)
        cand = (s1[..., :, None] + s2[..., None, :]).reshape(T, PEER_HEADS, PEER_TOPK * PEER_TOPK)
        cidx = (i1[..., :, None] * N_KEYS + i2[..., None, :]).reshape(T, PEER_HEADS, PEER_TOPK * PEER_TOPK)
        top_s, pos = lax.top_k(cand, PEER_TOPK)
        idx = jnp.take_along_axis(cidx, pos, axis=-1)
        g = jax.nn.softmax(top_s, axis=-1).astype(xb.dtype)
        ue = u_tab[idx]
        ve = v_tab[idx]
        act = jax.nn.gelu(jnp.einsum('td,thkd->thk', xb, ue), approximate=False)
        return jnp.einsum('thk,thkd->td', g * act, ve)

    return lax.map(one_block, blocks).reshape(B, L, D)


def setup_inputs(seed: int = 0) -> dict:
    key = jax.random.key(seed)
    ks = iter(jax.random.split(key, 32))
    D = D_MODEL

    def nrm(shape, s):
        return jax.random.normal(next(ks), shape, jnp.float32) * s

    return {
        'x': nrm((BATCH, SEQ, D), 1.0),
        'c': nrm((BATCH, D), 1.0),
        'ctx': nrm((BATCH, CTX_LEN, D), 1.0),
        'c_ctx': nrm((D,), 1.0),
        'norm1_g': 1.0 + nrm((DEPTH, D), 0.02),
        'norm2_g': 1.0 + nrm((DEPTH, D), 0.02),
        'ada_w': nrm((DEPTH, D, N_MOD * D), 0.5 * D ** -0.5),
        'ada_b': nrm((DEPTH, N_MOD * D), 0.02),
        'ab_w_in': nrm((N_EVEN, D, D_AB_IN), D ** -0.5),
        'conv_w': nrm((N_EVEN, CONV_WIDTH, D_CONV), CONV_WIDTH ** -0.5),
        'conv_b': nrm((N_EVEN, D_CONV), 0.02),
        'conv_gn_g': 1.0 + nrm((N_EVEN, D_CONV), 0.02),
        'conv_gn_b': nrm((N_EVEN, D_CONV), 0.02),
        'na_rpb': nrm((N_EVEN, NA_HEADS, 2 * NA_ROWS_MAX - 1, 2 * NA_COLS - 1), 0.5),
        'ab_w_out': nrm((N_EVEN, D_CONV + D_ATTN, D), (D_CONV + D_ATTN) ** -0.5),
        'sgu_w_in': nrm((N_ODD, D, 2 * D_SGU), D ** -0.5),
        'sgu_ln_g': 1.0 + nrm((N_ODD, D_SGU), 0.02),
        'sgu_ln_b': nrm((N_ODD, D_SGU), 0.02),
        'sgu_w_s': nrm((N_ODD, SGU_GROUPS, CHUNK, CHUNK), CHUNK ** -0.5),
        'sgu_b_s': 1.0 + nrm((N_ODD, SGU_GROUPS, CHUNK), 0.02),
        'sgu_w_out': nrm((N_ODD, D_SGU, D), D_SGU ** -0.5),
        'peer_wq': nrm((DEPTH, D, PEER_HEADS * 2 * D_KEY), D ** -0.5),
        'peer_keys': nrm((DEPTH, PEER_HEADS, 2, N_KEYS, D_KEY), D_KEY ** -0.5),
        'peer_u': nrm((DEPTH, N_EXPERTS, D), D ** -0.5),
        'peer_v': nrm((DEPTH, N_EXPERTS, D), 1.0),
        'norm_f_g': 1.0 + nrm((D,), 0.02),
    }


def reference(x, c, ctx, c_ctx, norm1_g, norm2_g, ada_w, ada_b, ab_w_in, conv_w, conv_b,
              conv_gn_g, conv_gn_b, na_rpb, ab_w_out, sgu_w_in, sgu_ln_g, sgu_ln_b, sgu_w_s,
              sgu_b_s, sgu_w_out, peer_wq, peer_keys, peer_u, peer_v, norm_f_g):
    h, hc = x, ctx
    for i in range(DEPTH):
        ctx_carried = any(j % 2 == 0 for j in range(i + 1, DEPTH))
        mod = ada_modulation(c, ada_w[i], ada_b[i])
        hm = modulate(h, norm1_g[i], mod[:, 0], mod[:, 1])
        if i % 2 == 0 or ctx_carried:
            mod_c = ada_modulation(c_ctx[None], ada_w[i], ada_b[i])
            hcm = modulate(hc, norm1_g[i], mod_c[:, 0], mod_c[:, 1])
        if i % 2 == 0:
            e = i // 2
            mix, mix_c = mixer_conv_na(hm, hcm, ab_w_in[e], conv_w[e], conv_b[e], conv_gn_g[e],
                                       conv_gn_b[e], na_rpb[e], ab_w_out[e], ctx_carried)
        else:
            o = i // 2
            sgu_args = (sgu_w_in[o], sgu_ln_g[o], sgu_ln_b[o], sgu_w_s[o], sgu_b_s[o], sgu_w_out[o])
            mix = mixer_sgu(hm, *sgu_args)
            mix_c = mixer_sgu(hcm, *sgu_args) if ctx_carried else None
        peer_args = (peer_wq[i], peer_keys[i], peer_u[i], peer_v[i])
        h = h + mod[:, 2, None] * mix
        h = h + mod[:, 5, None] * peer(modulate(h, norm2_g[i], mod[:, 3], mod[:, 4]), *peer_args)
        if ctx_carried:
            hc = hc + mod_c[:, 2, None] * mix_c
            hc = hc + mod_c[:, 5, None] * peer(modulate(hc, norm2_g[i], mod_c[:, 3], mod_c[:, 4]), *peer_args)
    return rms_norm(h, norm_f_g)
```

```cpp
#include <hip/hip_runtime.h>
#include <cstdio>
#include <cstdint>

#ifndef DBG_LEVEL
#define DBG_LEVEL 4
#endif
#ifndef DBG_SHIFT
#define DBG_SHIFT 6
#endif
#ifndef ONE_LAUNCH
#define ONE_LAUNCH 0
#endif

#define LAS __attribute__((address_space(3)))
typedef unsigned short bf16_t;
typedef short bf16x8 __attribute__((ext_vector_type(8)));
typedef float f32x4 __attribute__((ext_vector_type(4)));
typedef float f32x16 __attribute__((ext_vector_type(16)));
typedef float f32x2 __attribute__((ext_vector_type(2)));
typedef unsigned u32x4 __attribute__((ext_vector_type(4)));
typedef unsigned u32x2 __attribute__((ext_vector_type(2)));
typedef __bf16 bf2v __attribute__((ext_vector_type(2)));

constexpr int D = 1024, NBATCH = 8, SEQ = 4096, M = NBATCH * SEQ, CTXL = 256, MC = NBATCH * CTXL, MA = M + MC;
constexpr int NEXP = 16384;
constexpr float EPS = 1e-6f;
enum { I_X = 0, I_C, I_CTX, I_CCTX, I_N1G, I_N2G, I_ADAW, I_ADAB, I_WIN, I_CONVW, I_CONVB, I_GNG, I_GNB, I_RPB, I_WOUT, I_SGUIN, I_LNG, I_LNB, I_WS, I_BS, I_SGUOUT,
       I_WQ, I_KEYS, I_PU, I_PV, I_NFG, N_IN };

constexpr size_t WS_CTL  = 0;
constexpr size_t CTL_BYTES = 65536;
constexpr size_t WS_MODP = WS_CTL + CTL_BYTES;
constexpr size_t WS_MODF = WS_MODP + (size_t)2 * 8 * 9 * 6144 * 4;
constexpr size_t WS_W1T  = WS_MODF + (size_t)2 * 9 * 6144 * 4;
constexpr size_t WS_W2T  = WS_W1T + (size_t)2560 * 1024 * 2;
constexpr size_t WS_WSI  = WS_W2T + (size_t)1024 * 1024 * 2;
constexpr size_t WS_WSO  = WS_WSI + (size_t)2048 * 1024 * 2;
constexpr size_t WS_WQ   = WS_WSO + (size_t)1024 * 1024 * 2;
constexpr size_t WS_KEYS = WS_WQ + (size_t)2 * 2048 * 1024 * 2;
constexpr size_t WS_WSP  = WS_KEYS + (size_t)2 * 8 * 2 * 128 * 128 * 2;
constexpr size_t WS_TU   = WS_WSP + (size_t)8 * 128 * 128 * 2;
constexpr size_t WS_TV   = WS_TU + (size_t)2 * NEXP * 1024 * 2;
constexpr size_t WS_A    = WS_TV + (size_t)2 * NEXP * 1024 * 2;
constexpr size_t WS_B    = WS_A + (size_t)MA * 1024 * 2;
constexpr size_t WS_GLU  = WS_B;
constexpr size_t WS_Q    = WS_GLU + (size_t)M * 512 * 2;
constexpr size_t WS_K    = WS_Q + (size_t)M * 512 * 2;
constexpr size_t WS_V    = WS_K + (size_t)MA * 512 * 2;
constexpr size_t WS_QP   = WS_B;
constexpr size_t WS_U    = WS_B;
constexpr size_t WS_VV   = WS_B + (size_t)M * 1024 * 2;
constexpr size_t WS_IDX  = WS_V + (size_t)MA * 512 * 2;
constexpr size_t WS_WT   = WS_IDX + (size_t)M * 128 * 2;
constexpr size_t WS_REF  = WS_WT + (size_t)M * 128 * 4;
constexpr size_t WS_END  = WS_REF + (size_t)256 * 1024 * 4;

constexpr int LDS_BYTES = 147456;
constexpr int MISC_OFF = 131072;
constexpr int NPH = 24;

__device__ __forceinline__ float bf_lo(unsigned u) { return __uint_as_float(u << 16); }
__device__ __forceinline__ float bf_hi(unsigned u) { return __uint_as_float(u & 0xffff0000u); }
__device__ __forceinline__ unsigned pk2(float lo, float hi) { bf2v r = {(__bf16)lo, (__bf16)hi}; return __builtin_bit_cast(unsigned, r); }
__device__ __forceinline__ float wave_sum(float v) {
#pragma unroll
    for (int o = 1; o < 64; o <<= 1) v += __shfl_xor(v, o);
    return v;
}
__device__ __forceinline__ float dot2bf(unsigned a, unsigned b, float c) { return __builtin_amdgcn_fdot2_f32_bf16(__builtin_bit_cast(bf2v, a), __builtin_bit_cast(bf2v, b), c, false); }
__device__ __forceinline__ float sigmoidf_(float x) { return 1.f / (1.f + __expf(-x)); }
__device__ __forceinline__ float gelu_erf(float v) { return 0.5f * v * (1.f + erff(v * 0.70710678f)); }

namespace pg8 {
constexpr int BM = 256, BK = 64, HALF = 128, HTB = HALF * BK * 2, STAGE_BYTES = 8 * HTB, NXCD = 8, WGM = 8;
__host__ __device__ __forceinline__ int lds_byte(int r, int c) { const int st = (r >> 4) * 2 + (c >> 5), rr = r & 15, cc = c & 31, ob = rr * 64 + cc * 2; return st * 1024 + (ob ^ (((ob >> 9) & 1) << 5)); }
__host__ __device__ __forceinline__ void stage_rc(int b, int& R, int& C) { const int st = b / 1024, sb = b % 1024, swz = sb ^ (((sb >> 9) & 1) << 5); R = (st >> 1) * 16 + swz / 64; C = (st & 1) * 32 + (swz % 64) / 2; }
__host__ __device__ __forceinline__ int perm32(int rho) { const int n = rho >> 4, i = rho & 15; return 8 * (i >> 2) + 4 * n + (i & 3); }
struct Unit { int pm, pn; };
struct Gemm { const bf16_t* A; const bf16_t* Bt; int M, N, K; };
struct StaticOrder {
    int nM, nN, nwg, G, c;
    __host__ __device__ void init(int M_, int N_, int G_, int c_) { nM = M_ / BM; nN = N_ / BM; nwg = nM * nN; G = G_; c = c_; }
    __host__ __device__ bool next(int i, Unit& u) const {
        const long L = (long)i * G + c; if (L >= nwg) return false;
        int wgid = (int)L; { const int q = nwg / NXCD, r = nwg % NXCD, xcd = wgid % NXCD, off = wgid / NXCD; wgid = (xcd < r ? xcd * (q + 1) : r * (q + 1) + (xcd - r) * q) + off; }
        const int nig = WGM * nN, gid = wgid / nig, fm = gid * WGM, gsz = (nM - fm) < WGM ? (nM - fm) : WGM;
        u.pm = fm + ((wgid % nig) % gsz); u.pn = (wgid % nig) / gsz; return true;
    }
    __device__ __forceinline__ void a_ready(const Unit&) const {}
    __device__ __forceinline__ void done(const Unit&) const {}
};
struct Order1 {
    StaticOrder so; int G, c;
    __device__ void init(int G_, int c_) { so.init(M, 2560, G_, c_); G = G_; c = c_; }
    __device__ bool next(int i, Unit& u) const {
        const long L = (long)i * G + c;
        if (L < so.nwg) return so.next(i, u);
        const int l2 = (int)(L - so.nwg); if (l2 >= 32) return false;
        u.pm = 128 + (l2 >> 2); u.pn = 6 + (l2 & 3); return true;
    }
    __device__ __forceinline__ void a_ready(const Unit&) const {}
    __device__ __forceinline__ void done(const Unit&) const {}
};
__device__ __forceinline__ f32x2 gelu_pk(f32x2 v) {
    const f32x2 av = __builtin_elementwise_abs(v), d = av * 0.2316418882f + 1.0f;
    f32x2 t; t.x = __builtin_amdgcn_rcpf(d.x); t.y = __builtin_amdgcn_rcpf(d.y);
    f32x2 q = t * 0.5307027145f + (-0.7265760135f); q = q * t + 0.7107068705f; q = q * t + (-0.142248368f); q = q * t + 0.127414796f; q = q * t;
    const f32x2 s = (v * v) * (-0.72134752044f);
    f32x2 e; e.x = __builtin_amdgcn_exp2f(s.x); e.y = __builtin_amdgcn_exp2f(s.y);
    const f32x2 m = v * (q * e), r = v - m;
    f32x2 o; o.x = v.x < 0.f ? m.x : r.x; o.y = v.y < 0.f ? m.y : r.y; return o;
}
template <class Epi, class Sched>
__device__ __forceinline__ void gemm_phase(LAS unsigned char* lds, const Gemm g, const Sched& S, const Epi& E) {
    const int tid = threadIdx.x, wid = __builtin_amdgcn_readfirstlane(tid >> 6), lane = tid & 63, wr = wid >> 2, wc = wid & 3, fr = lane & 15, fq = lane >> 4;
    const int K = g.K, nt = K / BK;
    unsigned voffA[2], voffB[2];
#pragma unroll
    for (int i = 0; i < 2; ++i) { int R, C; stage_rc(tid * 16 + i * 8192, R, C); const int Rb = Epi::PERM ? ((R & ~31) + perm32(R & 31)) : R;
        voffA[i] = (unsigned)(R * K + C) * 2u; voffB[i] = (unsigned)(Rb * K + C) * 2u; }
    const size_t kstep = (size_t)(BK * 2);
    const size_t hstep = (size_t)HALF * K * 2;
    const size_t tstep = 2 * hstep;
    const unsigned ldsw = (unsigned)wid * 1024u;
    const int aoff = lds_byte(wr * 64 + fr, fq * 8), boff = lds_byte(wc * 32 + fr, fq * 8);
#define PG8_SA(b, h) (((b) * 2 + (h)) * HTB)
#define PG8_SB(b, h) ((4 + (b) * 2 + (h)) * HTB)
#define PG8_STAGE(bufoff, gbase, voff) do { _Pragma("unroll") for (int _i = 0; _i < 2; ++_i) \
        __builtin_amdgcn_global_load_lds((const unsigned*)((const char*)(gbase) + (voff)[_i]), (LAS unsigned*)(lds + (bufoff) + ldsw + _i * 8192), 16, 0, 0); } while (0)
#define PG8_LDA(dst, b, h) do { _Pragma("unroll") for (int m = 0; m < 4; ++m) _Pragma("unroll") for (int k = 0; k < 2; ++k) dst[m][k] = *(const LAS bf16x8*)(lds + PG8_SA(b, h) + aoff + m * 2048 + k * 1024); } while (0)
#define PG8_LDB(dst, b, h) do { _Pragma("unroll") for (int n = 0; n < 2; ++n) _Pragma("unroll") for (int k = 0; k < 2; ++k) dst[n][k] = *(const LAS bf16x8*)(lds + PG8_SB(b, h) + boff + n * 2048 + k * 1024); } while (0)
#define PG8_MMA(ai, bj, At, Bt) do { __builtin_amdgcn_s_setprio(1); _Pragma("unroll") for (int m = 0; m < 4; ++m) _Pragma("unroll") for (int n = 0; n < 2; ++n) _Pragma("unroll") for (int k = 0; k < 2; ++k) \
        acc[ai][bj][m][n] = __builtin_amdgcn_mfma_f32_16x16x32_bf16(Bt[n][k], At[m][k], acc[ai][bj][m][n], 0, 0, 0); __builtin_amdgcn_s_setprio(0); } while (0)
#define PG8_WAIT_V(n) asm volatile("s_waitcnt vmcnt(" #n ")" ::: "memory")
#define PG8_WAIT_L(n) asm volatile("s_waitcnt lgkmcnt(" #n ")" ::: "memory")
#define PG8_BAR __builtin_amdgcn_s_barrier()
#define PG8_SCHED __builtin_amdgcn_sched_barrier(0)
    Unit cur, nxt; int ui = 0;
    if (!S.next(0, cur)) return;
    f32x4 acc[2][2][4][2];
#pragma unroll
    for (int a = 0; a < 2; ++a)
#pragma unroll
        for (int b = 0; b < 2; ++b)
#pragma unroll
            for (int m = 0; m < 4; ++m)
#pragma unroll
                for (int n = 0; n < 2; ++n) acc[a][b][m][n] = (f32x4){0.f, 0.f, 0.f, 0.f};
    bf16x8 At[4][2], B0[2][2], B1[2][2];
    const char* cA = (const char*)g.A + (size_t)cur.pm * tstep; const char* cB = (const char*)g.Bt + (size_t)cur.pn * tstep;
    S.a_ready(cur);
    PG8_STAGE(PG8_SB(0, 0), cB, voffB); PG8_STAGE(PG8_SA(0, 0), cA, voffA); PG8_STAGE(PG8_SB(0, 1), cB + hstep, voffB); PG8_STAGE(PG8_SA(0, 1), cA + hstep, voffA);
    if (wr == 1) PG8_BAR;
    PG8_WAIT_V(4); PG8_BAR;
    PG8_STAGE(PG8_SB(1, 0), cB + kstep, voffB); PG8_STAGE(PG8_SA(1, 0), cA + kstep, voffA); PG8_STAGE(PG8_SB(1, 1), cB + hstep + kstep, voffB);
    PG8_WAIT_V(6); PG8_BAR;
    for (;;) {
        const bool has_next = S.next(ui + 1, nxt);
        const char* nA = has_next ? (const char*)g.A + (size_t)nxt.pm * tstep : cA; const char* nB = has_next ? (const char*)g.Bt + (size_t)nxt.pn * tstep : cB;
        for (int t = 0; t < nt; t += 2) {
            const bool last = (t == nt - 2);
            const char* a1 = cA + (size_t)(t + 1) * kstep;
            const char* a2 = last ? nA : cA + (size_t)(t + 2) * kstep; const char* b2 = last ? nB : cB + (size_t)(t + 2) * kstep;
            const char* a3 = a2 + kstep; const char* b3 = b2 + kstep;
            if (last && has_next) S.a_ready(nxt);
            PG8_LDB(B0, 0, 0); PG8_SCHED; PG8_LDA(At, 0, 0); PG8_STAGE(PG8_SA(1, 1), a1 + hstep, voffA);
            PG8_WAIT_L(8); PG8_BAR; PG8_WAIT_L(0); PG8_MMA(0, 0, At, B0); PG8_BAR; PG8_SCHED;
            PG8_LDB(B1, 0, 1); PG8_STAGE(PG8_SB(0, 0), b2, voffB);
            PG8_BAR; PG8_WAIT_L(0); PG8_MMA(0, 1, At, B1); PG8_BAR;
            PG8_LDA(At, 0, 1); PG8_STAGE(PG8_SA(0, 0), a2, voffA);
            PG8_BAR; PG8_WAIT_L(0); PG8_MMA(1, 0, At, B0); PG8_BAR; PG8_SCHED;
            PG8_STAGE(PG8_SB(0, 1), b2 + hstep, voffB);
            PG8_WAIT_V(6); PG8_BAR; PG8_MMA(1, 1, At, B1); PG8_BAR;
            PG8_LDB(B0, 1, 0); PG8_SCHED; PG8_LDA(At, 1, 0); PG8_STAGE(PG8_SA(0, 1), a2 + hstep, voffA);
            PG8_WAIT_L(8); PG8_BAR; PG8_WAIT_L(0); PG8_MMA(0, 0, At, B0); PG8_BAR; PG8_SCHED;
            PG8_LDB(B1, 1, 1); PG8_STAGE(PG8_SB(1, 0), b3, voffB);
            PG8_BAR; PG8_WAIT_L(0); PG8_MMA(0, 1, At, B1); PG8_BAR;
            PG8_LDA(At, 1, 1); PG8_STAGE(PG8_SA(1, 0), a3, voffA);
            PG8_BAR; PG8_WAIT_L(0); PG8_MMA(1, 0, At, B0); PG8_BAR; PG8_SCHED;
            PG8_STAGE(PG8_SB(1, 1), b3 + hstep, voffB);
            PG8_WAIT_V(6); PG8_BAR; PG8_MMA(1, 1, At, B1); PG8_BAR;
        }
        E(acc, cur, wr, wc, fr, fq); S.done(cur);
        if (!has_next) break;
#pragma unroll
        for (int a = 0; a < 2; ++a)
#pragma unroll
            for (int b = 0; b < 2; ++b)
#pragma unroll
                for (int m = 0; m < 4; ++m)
#pragma unroll
                    for (int n = 0; n < 2; ++n) acc[a][b][m][n] = (f32x4){0.f, 0.f, 0.f, 0.f};
        cur = nxt; cA = nA; cB = nB; ++ui;
    }
    PG8_WAIT_V(0);
    if (wr == 0) PG8_BAR;
    PG8_BAR;
#undef PG8_SA
#undef PG8_SB
#undef PG8_STAGE
#undef PG8_LDA
#undef PG8_LDB
#undef PG8_MMA
#undef PG8_WAIT_V
#undef PG8_WAIT_L
#undef PG8_BAR
#undef PG8_SCHED
}

struct Epi1 {
    static constexpr bool PERM = true;
    bf16_t *GLU; unsigned char* wsb;
    __device__ __forceinline__ void operator()(const f32x4 (&acc)[2][2][4][2], const Unit& u, int wr, int wc, int fr, int fq) const {
        const int row0 = u.pm * BM + wr * 64 + fr;
        if (u.pn < 4) {
            const int ch0 = u.pn * 128 + wc * 32 + 8 * fq;
#pragma unroll
            for (int ai = 0; ai < 2; ++ai)
#pragma unroll
                for (int m = 0; m < 4; ++m) {
                    const f32x4 a0 = acc[ai][0][m][0], a1 = acc[ai][0][m][1], g0 = acc[ai][1][m][0], g1 = acc[ai][1][m][1];
                    u32x4 w;
                    w.x = pk2(a0[0] * sigmoidf_(g0[0]), a0[1] * sigmoidf_(g0[1])); w.y = pk2(a0[2] * sigmoidf_(g0[2]), a0[3] * sigmoidf_(g0[3]));
                    w.z = pk2(a1[0] * sigmoidf_(g1[0]), a1[1] * sigmoidf_(g1[1])); w.w = pk2(a1[2] * sigmoidf_(g1[2]), a1[3] * sigmoidf_(g1[3]));
                    *(u32x4*)(GLU + (size_t)(row0 + ai * HALF + m * 16) * 512 + ch0) = w;
                }
        } else {
            const int t = (u.pn - 4) >> 1;
            const size_t boff = WS_Q + (t >= 1 ? (size_t)M * 1024 : (size_t)0) + (t >= 2 ? (size_t)MA * 1024 : (size_t)0);
            bf16_t* base = (bf16_t*)(wsb + boff);
            const float sc = t == 0 ? 0.125f : 1.f;
            const int col0 = ((u.pn - 4) & 1) * 256 + wc * 32 + 8 * fq;
#pragma unroll
            for (int ai = 0; ai < 2; ++ai)
#pragma unroll
                for (int m = 0; m < 4; ++m) { bf16_t* rowp = base + (size_t)(row0 + ai * HALF + m * 16) * 512 + col0;
#pragma unroll
                    for (int bj = 0; bj < 2; ++bj) { const f32x4 v0 = acc[ai][bj][m][0] * sc, v1 = acc[ai][bj][m][1] * sc;
                        u32x4 w; w.x = pk2(v0[0], v0[1]); w.y = pk2(v0[2], v0[3]); w.z = pk2(v1[0], v1[1]); w.w = pk2(v1[2], v1[3]);
                        *(u32x4*)(rowp + bj * HALF) = w; } }
        }
    }
};
struct EpiRes {
    static constexpr bool PERM = false;
    const float* base; float* out; const float* gate;
    __device__ __forceinline__ void operator()(const f32x4 (&acc)[2][2][4][2], const Unit& u, int wr, int wc, int fr, int fq) const {
        const int row0 = u.pm * BM + wr * 64 + fr, col0 = u.pn * BM + wc * 32 + 4 * fq;
        const int b = (u.pm * BM) / SEQ;
        f32x4 gv[2][2];
#pragma unroll
        for (int bj = 0; bj < 2; ++bj)
#pragma unroll
            for (int n = 0; n < 2; ++n) gv[bj][n] = *(const f32x4*)(gate + (size_t)b * 6144 + col0 + bj * HALF + n * 16);
#pragma unroll
        for (int ai = 0; ai < 2; ++ai)
#pragma unroll
            for (int m = 0; m < 4; ++m) { const size_t off = (size_t)(row0 + ai * HALF + m * 16) * D + col0;
#pragma unroll
                for (int bj = 0; bj < 2; ++bj)
#pragma unroll
                    for (int n = 0; n < 2; ++n) { const f32x4 bs = *(const f32x4*)(base + off + bj * HALF + n * 16);
                        *(f32x4*)(out + off + bj * HALF + n * 16) = bs + gv[bj][n] * acc[ai][bj][m][n]; } }
    }
};
template <int ACT> struct EpiBf16 {
    static constexpr bool PERM = true;
    bf16_t *O0, *O1; int split_tiles, ld;
    __device__ __forceinline__ void operator()(const f32x4 (&acc)[2][2][4][2], const Unit& u, int wr, int wc, int fr, int fq) const {
        const int row0 = u.pm * BM + wr * 64 + fr;
        bf16_t* base = u.pn < split_tiles ? O0 : O1;
        const int col0 = (u.pn < split_tiles ? u.pn : u.pn - split_tiles) * BM + wc * 32 + 8 * fq;
#pragma unroll
        for (int ai = 0; ai < 2; ++ai)
#pragma unroll
            for (int m = 0; m < 4; ++m) { bf16_t* rowp = base + (size_t)(row0 + ai * HALF + m * 16) * ld + col0;
#pragma unroll
                for (int bj = 0; bj < 2; ++bj) { f32x4 v0 = acc[ai][bj][m][0], v1 = acc[ai][bj][m][1];
                    if (ACT == 1) { f32x2 a = gelu_pk((f32x2){v0[0], v0[1]}), b = gelu_pk((f32x2){v0[2], v0[3]}), c = gelu_pk((f32x2){v1[0], v1[1]}), d = gelu_pk((f32x2){v1[2], v1[3]});
                        v0 = (f32x4){a.x, a.y, b.x, b.y}; v1 = (f32x4){c.x, c.y, d.x, d.y}; }
                    u32x4 w; w.x = pk2(v0[0], v0[1]); w.y = pk2(v0[2], v0[3]); w.z = pk2(v1[0], v1[1]); w.w = pk2(v1[2], v1[3]);
                    *(u32x4*)(rowp + bj * HALF) = w; } }
    }
};
}

#define XB_TMO      128
#define XB_XCNT(j)  (256  + 64 * (j))
#define XB_XSUB(j)  (1280 + 64 * (j))
#define XB_XGEN(j)  (2304 + 64 * (j))
#define XB_TOP      3328
#define XB_TOPGEN   3392
#define XCD_BAR_WORDS 3456
#define XB_SPIN_CAP (1u << 22)
__device__ __forceinline__ unsigned xb_ld(unsigned* p)              { return __hip_atomic_load(p, __ATOMIC_RELAXED, __HIP_MEMORY_SCOPE_AGENT); }
__device__ __forceinline__ unsigned xb_add(unsigned* p, unsigned v) { return __hip_atomic_fetch_add(p, v, __ATOMIC_RELAXED, __HIP_MEMORY_SCOPE_AGENT); }
__device__ __forceinline__ unsigned xb_xcc_id() { return (unsigned)__builtin_amdgcn_s_getreg((3 << 11) | 20) & 0xFu; }
#define XB_SPIN(cond, bar) do { unsigned _sp = 0; while (cond) { __builtin_amdgcn_s_sleep(1); \
    if ((++_sp & 255u) == 0u) { if (xb_ld(&(bar)[XB_TMO])) break; if (_sp > XB_SPIN_CAP) { atomicAdd(&(bar)[XB_TMO], 1u); break; } } } } while (0)
struct XcdBarrier { unsigned* bar; unsigned x; volatile LAS unsigned* st; };
__device__ __forceinline__ XcdBarrier xcd_barrier_post(unsigned* bar, volatile LAS unsigned* st) {
    XcdBarrier b; b.bar = bar; b.x = xb_xcc_id(); b.st = st;
    if (threadIdx.x == 0) (void)xb_add(&bar[XB_XCNT(b.x)], 1u);
    return b;
}
__device__ __forceinline__ void xcd_barrier_complete(unsigned* bar, unsigned x, unsigned& nloc, unsigned& nx) {
    const unsigned G = gridDim.x * gridDim.y * gridDim.z;
    unsigned sum, cnt, mine, sp = 0u;
    for (;;) {
        sum = 0u; cnt = 0u; mine = 0u;
#pragma unroll
        for (unsigned j = 0; j < 16; ++j) { const unsigned c = xb_ld(&bar[XB_XCNT(j)]); sum += c; cnt += (c > 0u) ? 1u : 0u; mine = (j == x) ? c : mine; }
        if (sum == G) break;
        __builtin_amdgcn_s_sleep(1);
        if ((++sp & 255u) == 0u) { if (xb_ld(&bar[XB_TMO])) break; if (sp > XB_SPIN_CAP) { atomicAdd(&bar[XB_TMO], 1u); break; } }
    }
    nloc = mine > 0u ? mine : 1u; nx = cnt > 0u ? cnt : 1u;
}
__device__ __forceinline__ void xcd_barrier(const XcdBarrier& b) {
    asm volatile("s_waitcnt vmcnt(0)" ::: "memory");
    __syncthreads();
    if (threadIdx.x == 0) {
        unsigned* bar = b.bar;
        __builtin_amdgcn_s_waitcnt(0);
        unsigned nloc = b.st[0], nx = b.st[1];
        if (nloc == 0u) { xcd_barrier_complete(bar, b.x, nloc, nx); b.st[0] = nloc; b.st[1] = nx; }
        const unsigned old = xb_add(&bar[XB_XSUB(b.x)], 1u);
        const unsigned gen = old / nloc;
        if (old + 1u == (gen + 1u) * nloc) {
            __builtin_amdgcn_fence(__ATOMIC_RELEASE, "agent");
            asm volatile("s_waitcnt vmcnt(0)" ::: "memory");
            const unsigned og = xb_add(&bar[XB_TOP], 1u);
            const unsigned tg = og / nx;
            if (og + 1u == (tg + 1u) * nx) xb_add(&bar[XB_TOPGEN], 1u);
            else XB_SPIN(xb_ld(&bar[XB_TOPGEN]) == tg, bar);
            __builtin_amdgcn_fence(__ATOMIC_ACQUIRE, "agent");
            xb_add(&bar[XB_XGEN(b.x)], 1u);
            asm volatile("s_waitcnt vmcnt(0)" ::: "memory");
        } else {
            XB_SPIN(xb_ld(&bar[XB_XGEN(b.x)]) == gen, bar);
            __builtin_amdgcn_fence(__ATOMIC_ACQUIRE, "agent");
            asm volatile("s_waitcnt vmcnt(0)" ::: "memory");
        }
    }
    __syncthreads();
}

struct Args { const float* in[N_IN]; float* out; unsigned char* ws; int ph_lo, ph_hi; };
static_assert(sizeof(Args) == (N_IN + 2) * 8 + 8, "Args has padding");

struct Ctx {
    const Args* a; LAS unsigned char* lds; int tid, lane, wid, bid, G;
};

__device__ __forceinline__ int w1_dest_row(int n) {
    if (n < 512) return (n >> 7) * 256 + (n & 127);
    if (n < 1024) { const int q = n - 512; return (q >> 7) * 256 + 128 + (q & 127); }
    return n;
}
__device__ __forceinline__ void transpose_item(const float* W, int K, int N, bf16_t* WT, int item, LAS float* scr, int lane, int mode) {
    const int nblk = N / 32, kb = item / nblk, nb = item % nblk, k0 = 64 * kb, n0 = 32 * nb;
#pragma unroll 8
    for (int i = 0; i < 32; ++i) { const int kk = 2 * i + (lane >> 5); scr[kk * 33 + (lane & 31)] = W[(size_t)(k0 + kk) * N + n0 + (lane & 31)]; }
    asm volatile("s_waitcnt lgkmcnt(0)" ::: "memory"); __builtin_amdgcn_wave_barrier();
    const int c = lane & 7;
#pragma unroll
    for (int j = 0; j < 4; ++j) { const int n = (lane >> 3) + 8 * j; const LAS float* s = scr + (8 * c) * 33 + n;
        u32x4 o; o.x = pk2(s[0 * 33], s[1 * 33]); o.y = pk2(s[2 * 33], s[3 * 33]); o.z = pk2(s[4 * 33], s[5 * 33]); o.w = pk2(s[6 * 33], s[7 * 33]);
        const int dr = mode == 1 ? w1_dest_row(n0 + n) : (n0 + n);
        *(u32x4*)(WT + (size_t)dr * K + k0 + 8 * c) = o; }
    asm volatile("s_waitcnt lgkmcnt(0)" ::: "memory"); __builtin_amdgcn_wave_barrier();
}
__device__ __forceinline__ void convert_task(const float* src, bf16_t* dst, size_t base, int lane) {
#pragma unroll
    for (int it = 0; it < 8; ++it) { const size_t i = base + (size_t)it * 512 + lane * 8;
        const f32x4 a = *(const f32x4*)(src + i), b = *(const f32x4*)(src + i + 4);
        u32x4 o; o.x = pk2(a[0], a[1]); o.y = pk2(a[2], a[3]); o.z = pk2(b[0], b[1]); o.w = pk2(b[2], b[3]);
        *(u32x4*)(dst + i) = o; }
}
__device__ __forceinline__ void phaseA(const Ctx& C) {
    const Args& a = *C.a; unsigned char* ws = a.ws;
    LAS float* S = (LAS float*)C.lds;
    for (int i = C.tid; i < 9 * 1024; i += 512) { const int row = i >> 10, k = i & 1023; const float c = row < 8 ? a.in[I_C][row * 1024 + k] : a.in[I_CCTX][k]; S[i] = c / (1.f + __expf(-c)); }
    __syncthreads();
    LAS float* scr = (LAS float*)(C.lds + 40960 + C.wid * 8448);
    const int gw = C.wid * C.G + C.bid, NGW = C.G * 8;
    constexpr int T_ADA = 1536, T_W1 = 16 * 80, T_W2 = 16 * 32, T_SI = 16 * 64, T_SO = 16 * 32, T_WQ = 2 * 16 * 64;
    constexpr int T_TAB = 2 * (2 * NEXP * 1024 / 4096), T_KEYS = 2 * 8 * 2 * 128 * 128 / 4096, T_WSP = 8 * 128 * 128 / 4096;
    constexpr int NT = T_ADA + T_W1 + T_W2 + T_SI + T_SO + T_WQ + T_TAB + T_KEYS + T_WSP;
    float* modp = (float*)(ws + WS_MODP);
    for (int T = gw; T < NT; T += NGW) {
        int t = T;
        if (t < T_ADA) {
            const int l = t / 768, r = t % 768, cb = r >> 3, ks = r & 7;
            const float* W = a.in[I_ADAW] + (size_t)l * 1024 * 6144 + (size_t)(ks * 128) * 6144 + cb * 64 + C.lane;
            float acc[9];
#pragma unroll
            for (int q = 0; q < 9; ++q) acc[q] = 0.f;
#pragma unroll 8
            for (int k = 0; k < 128; ++k) { const float w = W[(size_t)k * 6144];
#pragma unroll
                for (int q = 0; q < 9; ++q) acc[q] += S[q * 1024 + ks * 128 + k] * w; }
            float* P = modp + ((size_t)(l * 8 + ks) * 9) * 6144 + cb * 64 + C.lane;
#pragma unroll
            for (int q = 0; q < 9; ++q) P[(size_t)q * 6144] = acc[q];
            continue;
        }
        t -= T_ADA;
        if (t < T_W1) { transpose_item(a.in[I_WIN], 1024, 2560, (bf16_t*)(ws + WS_W1T), t, scr, C.lane, 1); continue; } t -= T_W1;
        if (t < T_W2) { transpose_item(a.in[I_WOUT], 1024, 1024, (bf16_t*)(ws + WS_W2T), t, scr, C.lane, 0); continue; } t -= T_W2;
        if (t < T_SI) { transpose_item(a.in[I_SGUIN], 1024, 2048, (bf16_t*)(ws + WS_WSI), t, scr, C.lane, 0); continue; } t -= T_SI;
        if (t < T_SO) { transpose_item(a.in[I_SGUOUT], 1024, 1024, (bf16_t*)(ws + WS_WSO), t, scr, C.lane, 0); continue; } t -= T_SO;
        if (t < T_WQ) { const int l = t / 1024; transpose_item(a.in[I_WQ] + (size_t)l * 1024 * 2048, 1024, 2048, (bf16_t*)(ws + WS_WQ) + (size_t)l * 2048 * 1024, t % 1024, scr, C.lane, 0); continue; } t -= T_WQ;
        if (t < T_TAB) { const int half = T_TAB / 2;
            if (t < half) convert_task(a.in[I_PU], (bf16_t*)(ws + WS_TU), (size_t)t * 4096, C.lane);
            else convert_task(a.in[I_PV], (bf16_t*)(ws + WS_TV), (size_t)(t - half) * 4096, C.lane);
            continue; } t -= T_TAB;
        if (t < T_KEYS) { convert_task(a.in[I_KEYS], (bf16_t*)(ws + WS_KEYS), (size_t)t * 4096, C.lane); continue; } t -= T_KEYS;
        convert_task(a.in[I_WS], (bf16_t*)(ws + WS_WSP), (size_t)t * 4096, C.lane);
    }
}

__device__ __forceinline__ void modulate_row(const float* xrow, bf16_t* orow, const LAS float* GS, const LAS float* SH, int lane) {
    const f32x4* xr = (const f32x4*)xrow + lane;
    f32x4 v[4]; float s = 0.f;
#pragma unroll
    for (int j = 0; j < 4; ++j) { v[j] = xr[64 * j]; s += (v[j].x * v[j].x + v[j].y * v[j].y) + (v[j].z * v[j].z + v[j].w * v[j].w); }
    const float rinv = rsqrtf(wave_sum(s) * (1.f / D) + EPS);
    u32x2* o8 = (u32x2*)orow + lane;
#pragma unroll
    for (int j = 0; j < 4; ++j) { const f32x4 g = *(const LAS f32x4*)(GS + 4 * lane + 256 * j), h = *(const LAS f32x4*)(SH + 4 * lane + 256 * j);
        const f32x4 y = v[j] * rinv * g + h;
        u32x2 w; w.x = pk2(y.x, y.y); w.y = pk2(y.z, y.w); o8[64 * j] = w; }
}

__device__ __forceinline__ void phaseB(const Ctx& C) {
    const Args& a = *C.a; unsigned char* ws = a.ws;
    const float* modp = (const float*)(ws + WS_MODP); float* modf = (float*)(ws + WS_MODF);
    {
        const int e = C.bid * 512 + C.tid;
        if (e < 2 * 9 * 6144) { const int l = e / (9 * 6144), rem = e % (9 * 6144), row = rem / 6144, j = rem % 6144;
            float v = a.in[I_ADAB][l * 6144 + j];
#pragma unroll
            for (int ks = 0; ks < 8; ++ks) v += modp[((size_t)(l * 8 + ks) * 9 + row) * 6144 + j];
            modf[e] = v; }
    }
    LAS float* GS = (LAS float*)C.lds; LAS float* SH = GS + 1024;
    bf16_t* A = (bf16_t*)(ws + WS_A);
    for (int part = 0; part < 2; ++part) {
        const int rb = part == 0 ? (C.bid * 128) / SEQ : 8;
        __syncthreads();
        for (int c = C.tid; c < 1024; c += 512) {
            float sh = a.in[I_ADAB][c], sc = a.in[I_ADAB][1024 + c];
#pragma unroll
            for (int ks = 0; ks < 8; ++ks) { sh += modp[((size_t)(0 * 8 + ks) * 9 + rb) * 6144 + c]; sc += modp[((size_t)(0 * 8 + ks) * 9 + rb) * 6144 + 1024 + c]; }
            GS[c] = a.in[I_N1G][c] * (1.f + sc); SH[c] = sh;
        }
        __syncthreads();
        if (part == 0) { for (int i = 0; i < 16; ++i) { const int r = C.bid * 128 + C.wid * 16 + i; modulate_row(a.in[I_X] + (size_t)r * D, A + (size_t)r * D, GS, SH, C.lane); } }
        else { const int r = C.bid * 8 + C.wid; modulate_row(a.in[I_CTX] + (size_t)r * D, A + (size_t)(M + r) * D, GS, SH, C.lane); }
    }
}

__device__ __forceinline__ void conv_tile(const Ctx& C, int tile) {
    const Args& a = *C.a; unsigned char* ws = a.ws;
    const bf16_t* GLU = (const bf16_t*)(ws + WS_GLU); bf16_t* Y = (bf16_t*)(ws + WS_A);
    const int b = tile >> 6, t0 = (tile & 63) * 64;
    __syncthreads();
    for (int i = C.tid; i < 94 * 64; i += 512) { const int row = i >> 6, ch = i & 63, t = t0 - 15 + row;
        u32x4 v = (u32x4){0u, 0u, 0u, 0u};
        if (t >= 0 && t < SEQ) v = *(const u32x4*)(GLU + ((size_t)(b * SEQ + t)) * 512 + ch * 8);
        *(LAS u32x4*)(C.lds + (size_t)i * 16) = v; }
    __syncthreads();
    const int half = C.tid >> 8, cp = C.tid & 255;
    float w0[31], w1[31];
#pragma unroll
    for (int j = 0; j < 31; ++j) { const f32x2 w = *(const f32x2*)(a.in[I_CONVW] + j * 512 + 2 * cp); w0[j] = w.x; w1[j] = w.y; }
    const f32x2 cb = *(const f32x2*)(a.in[I_CONVB] + 2 * cp), gg = *(const f32x2*)(a.in[I_GNG] + 2 * cp), gb = *(const f32x2*)(a.in[I_GNB] + 2 * cp);
    const LAS unsigned* L = (const LAS unsigned*)C.lds;
#pragma unroll 1
    for (int sb = 0; sb < 2; ++sb) {
        const int ob = 32 * half + 16 * sb;
        float a0[16], a1[16];
#pragma unroll
        for (int o = 0; o < 16; ++o) { a0[o] = cb.x; a1[o] = cb.y; }
#pragma unroll
        for (int i = 0; i < 46; ++i) { const unsigned u = L[(ob + i) * 256 + cp]; const float x0 = bf_lo(u), x1 = bf_hi(u);
#pragma unroll
            for (int j = 0; j < 31; ++j) { const int o = i - j; if (o >= 0 && o < 16) { a0[o] += w0[j] * x0; a1[o] += w1[j] * x1; } } }
#pragma unroll
        for (int o = 0; o < 16; ++o) {
            float s = a0[o] + a1[o];
#pragma unroll
            for (int k = 1; k < 32; k <<= 1) s += __shfl_xor(s, k);
            const float mu = s * (1.f / 64.f), d0 = a0[o] - mu, d1 = a1[o] - mu;
            float q = d0 * d0 + d1 * d1;
#pragma unroll
            for (int k = 1; k < 32; k <<= 1) q += __shfl_xor(q, k);
            const float rstd = rsqrtf(q * (1.f / 64.f) + EPS);
            const float y0 = d0 * rstd * gg.x + gb.x, y1 = d1 * rstd * gg.y + gb.y;
            *(unsigned*)(Y + ((size_t)(b * SEQ + t0 + ob + o)) * D + 2 * cp) = pk2(y0 * sigmoidf_(y0), y1 * sigmoidf_(y1));
        }
    }
}

__device__ __forceinline__ void attn_task(const Ctx& C, int task) {
    const Args& a = *C.a; unsigned char* ws = a.ws;
    const bf16_t* Qb = (const bf16_t*)(ws + WS_Q); const bf16_t* Kb = (const bf16_t*)(ws + WS_K); const bf16_t* Vb = (const bf16_t*)(ws + WS_V);
    bf16_t* Y = (bf16_t*)(ws + WS_A);
    const int h = task & 7, r = (task >> 3) & 63, b = task >> 9;
    const int lane = C.lane, n = lane & 31, hh = lane >> 5;
    const int kr0 = r - 4 < 0 ? 0 : (r - 4 > 56 ? 56 : r - 4);
    LAS unsigned char* lw = C.lds + C.wid * 8192;
    LAS bf16_t* Vt = (LAS bf16_t*)lw;
    LAS float* RP = (LAS float*)(lw + 4608);
    for (int i = lane; i < 465; i += 64) RP[i] = a.in[I_RPB][h * 465 + i];
    const int qtok0 = b * SEQ + r * 64;
    bf16x8 bq[2][4];
#pragma unroll
    for (int qb = 0; qb < 2; ++qb)
#pragma unroll
        for (int s = 0; s < 4; ++s) bq[qb][s] = *(const bf16x8*)(Qb + (size_t)(qtok0 + 32 * qb + n) * 512 + h * 64 + 16 * s + 8 * hh);
    f32x16 O[2][2];
#pragma unroll
    for (int i = 0; i < 2; ++i)
#pragma unroll
        for (int j = 0; j < 2; ++j)
#pragma unroll
            for (int e = 0; e < 16; ++e) O[i][j][e] = 0.f;
    float mrun[2] = {-1e30f, -1e30f}, lrun[2] = {0.f, 0.f};
#pragma unroll 1
    for (int kt = 0; kt < 24; ++kt) {
        const bool win = kt < 16;
        const int kri = kt >> 1, kc0 = 32 * (kt & 1);
        const size_t tokk = win ? (size_t)(b * SEQ + (kr0 + kri) * 64 + kc0 + n) : (size_t)(M + b * CTXL + 32 * (kt - 16) + n);
        bf16x8 kf[4], vf[4];
#pragma unroll
        for (int s = 0; s < 4; ++s) { kf[s] = *(const bf16x8*)(Kb + tokk * 512 + h * 64 + 16 * s + 8 * hh); vf[s] = *(const bf16x8*)(Vb + tokk * 512 + h * 64 + 16 * s + 8 * hh); }
#pragma unroll
        for (int s = 0; s < 4; ++s)
#pragma unroll
            for (int e = 0; e < 8; ++e) Vt[(16 * s + 8 * hh + e) * 36 + n] = (bf16_t)vf[s][e];
        bf16x8 pb[2][2];
#pragma unroll
        for (int qb = 0; qb < 2; ++qb) {
            f32x16 S;
#pragma unroll
            for (int e = 0; e < 16; ++e) S[e] = 0.f;
#pragma unroll
            for (int s = 0; s < 4; ++s) S = __builtin_amdgcn_mfma_f32_32x32x16_bf16(kf[s], bq[qb][s], S, 0, 0, 0);
            const int qc = 32 * qb + n;
            const int cs = qc - 8 < 0 ? 0 : (qc - 8 > 48 ? 48 : qc - 8);
            bool valid[16];
            float mt = -1e30f;
#pragma unroll
            for (int e = 0; e < 16; ++e) {
                const int ki = (e & 3) + 8 * (e >> 2) + 4 * hh;
                if (win) { const int kc = kc0 + ki; valid[e] = (kc >= cs) && (kc < cs + 16);
                    const int dc = kc - qc + 15; const int dcc = dc < 0 ? 0 : (dc > 30 ? 30 : dc);
                    const float bias = RP[(kr0 + kri - r + 7) * 31 + dcc];
                    S[e] = valid[e] ? S[e] + bias : -1e30f; }
                else valid[e] = true;
                mt = fmaxf(mt, S[e]);
            }
            mt = fmaxf(mt, __shfl_xor(mt, 32));
            const float mn = fmaxf(mrun[qb], mt), alpha = __expf(mrun[qb] - mn);
            mrun[qb] = mn;
            float ps = 0.f; float p[16];
#pragma unroll
            for (int e = 0; e < 16; ++e) { p[e] = valid[e] ? __expf(S[e] - mn) : 0.f; ps += p[e]; }
            lrun[qb] = lrun[qb] * alpha + ps;
#pragma unroll
            for (int db = 0; db < 2; ++db)
#pragma unroll
                for (int e = 0; e < 16; ++e) O[db][qb][e] *= alpha;
#pragma unroll
            for (int s2 = 0; s2 < 2; ++s2) { u32x4 w; w.x = pk2(p[8 * s2 + 0], p[8 * s2 + 1]); w.y = pk2(p[8 * s2 + 2], p[8 * s2 + 3]); w.z = pk2(p[8 * s2 + 4], p[8 * s2 + 5]); w.w = pk2(p[8 * s2 + 6], p[8 * s2 + 7]);
                pb[qb][s2] = __builtin_bit_cast(bf16x8, w); }
        }
#pragma unroll
        for (int db = 0; db < 2; ++db)
#pragma unroll
            for (int s2 = 0; s2 < 2; ++s2) {
                const LAS bf16_t* vp = Vt + (32 * db + n) * 36 + 16 * s2 + 4 * hh;
                const u32x2 lo = *(const LAS u32x2*)vp, hi = *(const LAS u32x2*)(vp + 8);
                u32x4 w; w.x = lo.x; w.y = lo.y; w.z = hi.x; w.w = hi.y;
                const bf16x8 va = __builtin_bit_cast(bf16x8, w);
#pragma unroll
                for (int qb = 0; qb < 2; ++qb) O[db][qb] = __builtin_amdgcn_mfma_f32_32x32x16_bf16(va, pb[qb][s2], O[db][qb], 0, 0, 0);
            }
    }
#pragma unroll
    for (int qb = 0; qb < 2; ++qb) {
        const float lt = lrun[qb] + __shfl_xor(lrun[qb], 32), inv = 1.f / lt;
        bf16_t* yrow = Y + (size_t)(qtok0 + 32 * qb + n) * D + 512 + h * 64;
#pragma unroll
        for (int db = 0; db < 2; ++db)
#pragma unroll
            for (int g = 0; g < 4; ++g) { u32x2 w; w.x = pk2(O[db][qb][4 * g] * inv, O[db][qb][4 * g + 1] * inv); w.y = pk2(O[db][qb][4 * g + 2] * inv, O[db][qb][4 * g + 3] * inv);
                *(u32x2*)(yrow + 32 * db + 8 * g + 4 * hh) = w; }
    }
}

__device__ __forceinline__ void phaseNorm2(const Ctx& C, int l) {
    const Args& a = *C.a; unsigned char* ws = a.ws;
    const float* modf = (const float*)(ws + WS_MODF) + (size_t)l * 9 * 6144;
    LAS float* GS = (LAS float*)C.lds; LAS float* SH = GS + 1024;
    const int b = (C.bid * 128) / SEQ;
    for (int c = C.tid; c < 1024; c += 512) { GS[c] = a.in[I_N2G][l * 1024 + c] * (1.f + modf[b * 6144 + 4 * 1024 + c]); SH[c] = modf[b * 6144 + 3 * 1024 + c]; }
    __syncthreads();
    bf16_t* A = (bf16_t*)(ws + WS_A);
    for (int i = 0; i < 16; ++i) { const int r = C.bid * 128 + C.wid * 16 + i; modulate_row(a.out + (size_t)r * D, A + (size_t)r * D, GS, SH, C.lane); }
}

__device__ __forceinline__ void ce_desc(float& x, float& y) { const float hi = fmaxf(x, y), lo = fminf(x, y); x = hi; y = lo; }
__device__ __forceinline__ void ce_asc(float& x, float& y) { const float hi = fmaxf(x, y), lo = fminf(x, y); x = lo; y = hi; }
__device__ __forceinline__ void sort16_desc(float (&v)[16]) {
#pragma unroll
    for (int k = 2; k <= 16; k <<= 1)
#pragma unroll
        for (int j = k >> 1; j > 0; j >>= 1)
#pragma unroll
            for (int i = 0; i < 16; ++i) { const int l = i ^ j; if (l > i) { if ((i & k) == 0) ce_desc(v[i], v[l]); else ce_asc(v[i], v[l]); } }
}
__device__ __forceinline__ void merge16_desc(float (&A)[16], const float (&B)[16]) {
#pragma unroll
    for (int i = 0; i < 16; ++i) A[i] = fmaxf(A[i], B[15 - i]);
#pragma unroll
    for (int j = 8; j > 0; j >>= 1)
#pragma unroll
        for (int i = 0; i < 16; ++i) { const int l = i ^ j; if (l > i) ce_desc(A[i], A[l]); }
}
__device__ __forceinline__ void topk_task(const Ctx& C, int l, int tt, int h) {
    const Args& a = *C.a; unsigned char* ws = a.ws;
    const bf16_t* QP = (const bf16_t*)(ws + WS_QP); const bf16_t* KEYS = (const bf16_t*)(ws + WS_KEYS);
    unsigned short* IDX = (unsigned short*)(ws + WS_IDX); float* WT = (float*)(ws + WS_WT);
    const int lane = C.lane, n = lane & 31, hh = lane >> 5;
    const int tok = tt * 32 + n;
    float sp[2][16];
#pragma unroll
    for (int p = 0; p < 2; ++p) {
        bf16x8 bq[8];
#pragma unroll
        for (int s = 0; s < 8; ++s) bq[s] = *(const bf16x8*)(QP + (size_t)tok * 2048 + h * 256 + p * 128 + 16 * s + 8 * hh);
        const bf16_t* kbase = KEYS + ((size_t)((l * 8 + h) * 2 + p)) * 128 * 128;
        float top[16];
#pragma unroll
        for (int kb = 0; kb < 4; ++kb) {
            f32x16 S;
#pragma unroll
            for (int e = 0; e < 16; ++e) S[e] = 0.f;
#pragma unroll
            for (int s = 0; s < 8; ++s) { const bf16x8 kf = *(const bf16x8*)(kbase + (size_t)(32 * kb + n) * 128 + 16 * s + 8 * hh);
                S = __builtin_amdgcn_mfma_f32_32x32x16_bf16(kf, bq[s], S, 0, 0, 0); }
            float ch[16];
#pragma unroll
            for (int e = 0; e < 16; ++e) { const unsigned key = 32 * kb + (e & 3) + 8 * (e >> 2) + 4 * hh; ch[e] = __uint_as_float((__float_as_uint(S[e]) & ~0x7Fu) | key); }
            sort16_desc(ch);
            if (kb == 0) {
#pragma unroll
                for (int e = 0; e < 16; ++e) top[e] = ch[e];
            } else merge16_desc(top, ch);
        }
        float oth[16];
#pragma unroll
        for (int e = 0; e < 16; ++e) oth[e] = __shfl_xor(top[e], 32);
        merge16_desc(top, oth);
#pragma unroll
        for (int e = 0; e < 16; ++e) sp[p][e] = top[e];
    }
    const float NEG = -3.0e38f;
    auto cand = [&](int ia, int ib) -> float { const float s = sp[0][ia] + sp[1][ib]; return __uint_as_float((__float_as_uint(s) & ~0xFFu) | (unsigned)((ia << 4) | ib)); };
    float L1[16], L2[16], L3[16], L4[16];
#pragma unroll
    for (int i = 0; i < 16; ++i) { L1[i] = cand(0, i); L2[i] = i < 15 ? cand(i + 1, 0) : NEG; L4[i] = NEG; }
#pragma unroll
    for (int i = 0; i < 7; ++i) L3[i] = cand(1, i + 1);
#pragma unroll
    for (int i = 0; i < 6; ++i) L3[7 + i] = cand(i + 2, 1);
#pragma unroll
    for (int i = 0; i < 3; ++i) L3[13 + i] = cand(2, i + 2);
    L4[0] = cand(3, 2); L4[1] = cand(4, 2); L4[2] = cand(3, 3);
    sort16_desc(L3);
    ce_desc(L4[0], L4[1]); ce_desc(L4[1], L4[2]); ce_desc(L4[0], L4[1]);
    merge16_desc(L1, L2); merge16_desc(L3, L4); merge16_desc(L1, L3);
    float e16[16], se = 0.f;
#pragma unroll
    for (int i = 0; i < 16; ++i) { e16[i] = __expf(L1[i] - L1[0]); se += e16[i]; }
    const float inv = 1.f / se;
    LAS unsigned* tb = (LAS unsigned*)(C.lds + C.wid * 8448) + lane * 33;
#pragma unroll
    for (int i = 0; i < 16; ++i) { tb[i] = __float_as_uint(sp[0][i]) & 0x7Fu; tb[16 + i] = __float_as_uint(sp[1][i]) & 0x7Fu; }
    unsigned ids[16];
#pragma unroll
    for (int i = 0; i < 16; ++i) { const unsigned code = __float_as_uint(L1[i]) & 0xFFu; ids[i] = tb[code >> 4] * 128u + tb[16 + (code & 15u)]; }
    if (hh == 0) {
        u32x4 w0, w1;
        w0.x = ids[0] | (ids[1] << 16); w0.y = ids[2] | (ids[3] << 16); w0.z = ids[4] | (ids[5] << 16); w0.w = ids[6] | (ids[7] << 16);
        w1.x = ids[8] | (ids[9] << 16); w1.y = ids[10] | (ids[11] << 16); w1.z = ids[12] | (ids[13] << 16); w1.w = ids[14] | (ids[15] << 16);
        u32x4* ip = (u32x4*)(IDX + (size_t)tok * 128 + h * 16); ip[0] = w0; ip[1] = w1;
        f32x4* wp = (f32x4*)(WT + (size_t)tok * 128 + h * 16);
#pragma unroll
        for (int i = 0; i < 4; ++i) wp[i] = (f32x4){e16[4 * i] * inv, e16[4 * i + 1] * inv, e16[4 * i + 2] * inv, e16[4 * i + 3] * inv};
    }
}

__device__ __forceinline__ void phasePeer(const Ctx& C, int l) {
    const Args& a = *C.a; unsigned char* ws = a.ws;
    const bool last = (l == 1);
    const float* modf = (const float*)(ws + WS_MODF);
    const int b = (C.bid * 128) / SEQ;
    LAS float* G5 = (LAS float*)C.lds; LAS float* GS = G5 + 1024; LAS float* SH = GS + 1024;
    for (int c = C.tid; c < 1024; c += 512) {
        G5[c] = modf[(size_t)l * 9 * 6144 + b * 6144 + 5 * 1024 + c];
        if (!last) { GS[c] = a.in[I_N1G][1024 + c] * (1.f + modf[(size_t)9 * 6144 + b * 6144 + 1024 + c]); SH[c] = modf[(size_t)9 * 6144 + b * 6144 + c]; }
        else { GS[c] = a.in[I_NFG][c]; SH[c] = 0.f; }
    }
    __syncthreads();
    bf16_t* A = (bf16_t*)(ws + WS_A);
    const bf16_t* TU = (const bf16_t*)(ws + WS_TU) + (size_t)l * NEXP * 1024; const bf16_t* TV = (const bf16_t*)(ws + WS_TV) + (size_t)l * NEXP * 1024;
    const unsigned short* IDX = (const unsigned short*)(ws + WS_IDX); const float* WT = (const float*)(ws + WS_WT);
    const int lane = C.lane;
#pragma unroll 1
    for (int i = 0; i < 16; ++i) {
        const int tok = C.bid * 128 + C.wid * 16 + i;
        u32x4 xf[2];
#pragma unroll
        for (int j = 0; j < 2; ++j) xf[j] = *(const u32x4*)(A + (size_t)tok * D + 512 * j + 8 * lane);
        const unsigned id0 = IDX[(size_t)tok * 128 + lane], id1 = IDX[(size_t)tok * 128 + 64 + lane];
        const float wt0 = WT[(size_t)tok * 128 + lane], wt1 = WT[(size_t)tok * 128 + 64 + lane];
        float acc[16];
#pragma unroll
        for (int e = 0; e < 16; ++e) acc[e] = 0.f;
#pragma unroll 1
        for (int g = 0; g < 16; ++g) {
            const unsigned idv = g < 8 ? id0 : id1; const float wtv = g < 8 ? wt0 : wt1;
            const int lb = (g & 7) * 8;
            u32x4 uf[8][2], vf[8][2];
#pragma unroll
            for (int k = 0; k < 8; ++k) { const unsigned e = __shfl(idv, lb + k);
                const bf16_t* ur = TU + (size_t)e * 1024 + 8 * lane; const bf16_t* vr = TV + (size_t)e * 1024 + 8 * lane;
                uf[k][0] = *(const u32x4*)ur; uf[k][1] = *(const u32x4*)(ur + 512); vf[k][0] = *(const u32x4*)vr; vf[k][1] = *(const u32x4*)(vr + 512); }
            float dt[8];
#pragma unroll
            for (int k = 0; k < 8; ++k) { float d = 0.f;
#pragma unroll
                for (int j = 0; j < 2; ++j)
#pragma unroll
                    for (int q = 0; q < 4; ++q) {
#ifdef DBG_CHECK
                        if (C.bid & 2) d += bf_lo(xf[j][q]) * bf_lo(uf[k][j][q]) + bf_hi(xf[j][q]) * bf_hi(uf[k][j][q]); else
#endif
                        d = dot2bf(xf[j][q], uf[k][j][q], d); }
                dt[k] = d; }
            float r4[4], r2[2], r1;
            { const bool up = (lane & 32) != 0;
#pragma unroll
              for (int k = 0; k < 4; ++k) { const float keep = up ? dt[k + 4] : dt[k], send = up ? dt[k] : dt[k + 4]; r4[k] = keep + __shfl_xor(send, 32); } }
            { const bool up = (lane & 16) != 0;
#pragma unroll
              for (int k = 0; k < 2; ++k) { const float keep = up ? r4[k + 2] : r4[k], send = up ? r4[k] : r4[k + 2]; r2[k] = keep + __shfl_xor(send, 16); } }
            { const bool up = (lane & 8) != 0; const float keep = up ? r2[1] : r2[0], send = up ? r2[0] : r2[1]; r1 = keep + __shfl_xor(send, 8); }
            r1 += __shfl_xor(r1, 4); r1 += __shfl_xor(r1, 2); r1 += __shfl_xor(r1, 1);
            const int myk = ((lane >> 5) & 1) * 4 + ((lane >> 4) & 1) * 2 + ((lane >> 3) & 1);
#ifdef DBG_CHECK
            if (C.bid & 1) { float tot[8];
#pragma unroll
                for (int k = 0; k < 8; ++k) tot[k] = wave_sum(dt[k]);
                r1 = tot[0];
#pragma unroll
                for (int k = 1; k < 8; ++k) r1 = (myk == k) ? tot[k] : r1; }
#endif
            const float coef = gelu_erf(r1) * __shfl(wtv, lb + myk);
#pragma unroll
            for (int k = 0; k < 8; ++k) {
                const int src = ((k >> 2) & 1) * 32 + ((k >> 1) & 1) * 16 + (k & 1) * 8;
                const float ck = __shfl(coef, src);
#pragma unroll
                for (int j = 0; j < 2; ++j)
#pragma unroll
                    for (int q = 0; q < 4; ++q) { acc[8 * j + 2 * q] += ck * bf_lo(vf[k][j][q]); acc[8 * j + 2 * q + 1] += ck * bf_hi(vf[k][j][q]); }
            }
        }
        float* hrow = a.out + (size_t)tok * D;
        float hv[16]; float ss = 0.f;
#pragma unroll
        for (int j = 0; j < 2; ++j)
#pragma unroll
            for (int q = 0; q < 2; ++q) { const int c0 = 512 * j + 8 * lane + 4 * q; const f32x4 hx = *(const f32x4*)(hrow + c0); const f32x4 g5 = *(const LAS f32x4*)(G5 + c0);
#pragma unroll
                for (int e = 0; e < 4; ++e) { const float v = hx[e] + g5[e] * acc[8 * j + 4 * q + e]; hv[8 * j + 4 * q + e] = v; ss += v * v; } }
        const float rinv = rsqrtf(wave_sum(ss) * (1.f / D) + EPS);
        if (!last) {
#pragma unroll
            for (int j = 0; j < 2; ++j) {
#pragma unroll
                for (int q = 0; q < 2; ++q) { const int c0 = 512 * j + 8 * lane + 4 * q; *(f32x4*)(hrow + c0) = (f32x4){hv[8 * j + 4 * q], hv[8 * j + 4 * q + 1], hv[8 * j + 4 * q + 2], hv[8 * j + 4 * q + 3]}; }
                float y[8];
#pragma unroll
                for (int e = 0; e < 8; ++e) { const int c = 512 * j + 8 * lane + e; y[e] = hv[8 * j + e] * rinv * GS[c] + SH[c]; }
                u32x4 w; w.x = pk2(y[0], y[1]); w.y = pk2(y[2], y[3]); w.z = pk2(y[4], y[5]); w.w = pk2(y[6], y[7]);
                *(u32x4*)(A + (size_t)tok * D + 512 * j + 8 * lane) = w;
            }
        } else {
#pragma unroll
            for (int j = 0; j < 2; ++j)
#pragma unroll
                for (int q = 0; q < 2; ++q) { const int c0 = 512 * j + 8 * lane + 4 * q; const f32x4 g = *(const LAS f32x4*)(GS + c0);
                    *(f32x4*)(hrow + c0) = (f32x4){hv[8 * j + 4 * q] * rinv * g[0], hv[8 * j + 4 * q + 1] * rinv * g[1], hv[8 * j + 4 * q + 2] * rinv * g[2], hv[8 * j + 4 * q + 3] * rinv * g[3]}; }
        }
    }
}

__device__ __forceinline__ void phaseSgu(const Ctx& C) {
    const Args& a = *C.a; unsigned char* ws = a.ws;
    const bf16_t* U = (const bf16_t*)(ws + WS_U); const bf16_t* VV = (const bf16_t*)(ws + WS_VV); const bf16_t* WSP = (const bf16_t*)(ws + WS_WSP);
    bf16_t* A = (bf16_t*)(ws + WS_A);
    LAS float* ST = (LAS float*)(C.lds + 65536);
    LAS bf16_t* VT = (LAS bf16_t*)C.lds;
    const int lane = C.lane, n = lane & 31, hh = lane >> 5;
    for (int chunk = C.bid; chunk < M / 128; chunk += C.G) {
        const int tok0 = chunk * 128;
        __syncthreads();
        for (int i = 0; i < 16; ++i) {
            const int q = C.wid * 16 + i;
            const u32x4 v0 = *(const u32x4*)(VV + (size_t)(tok0 + q) * D + 8 * lane), v1 = *(const u32x4*)(VV + (size_t)(tok0 + q) * D + 512 + 8 * lane);
            float x[16];
#pragma unroll
            for (int e = 0; e < 4; ++e) { x[2 * e] = bf_lo(v0[e]); x[2 * e + 1] = bf_hi(v0[e]); x[8 + 2 * e] = bf_lo(v1[e]); x[8 + 2 * e + 1] = bf_hi(v1[e]); }
            float s = 0.f;
#pragma unroll
            for (int e = 0; e < 16; ++e) s += x[e];
            const float mu = wave_sum(s) * (1.f / D); float qq = 0.f;
#pragma unroll
            for (int e = 0; e < 16; ++e) { const float d = x[e] - mu; qq += d * d; }
            const float rstd = rsqrtf(wave_sum(qq) * (1.f / D) + EPS);
            if (lane == 0) { ST[2 * q] = mu; ST[2 * q + 1] = rstd; }
        }
        __syncthreads();
#pragma unroll 1
        for (int g = 0; g < 8; ++g) {
            { const int q = C.tid & 127; const float mu = ST[2 * q], rstd = ST[2 * q + 1];
#pragma unroll
              for (int i = 0; i < 4; ++i) { const int cb = (C.tid >> 7) + 4 * i;
                const u32x4 v = *(const u32x4*)(VV + (size_t)(tok0 + q) * D + g * 128 + cb * 8);
#pragma unroll
                for (int e = 0; e < 4; ++e) { const int c = cb * 8 + 2 * e;
                    const float y0 = (bf_lo(v[e]) - mu) * rstd * a.in[I_LNG][g * 128 + c] + a.in[I_LNB][g * 128 + c];
                    const float y1 = (bf_hi(v[e]) - mu) * rstd * a.in[I_LNG][g * 128 + c + 1] + a.in[I_LNB][g * 128 + c + 1];
                    const unsigned w = pk2(y0, y1);
                    VT[c * 136 + q] = (bf16_t)(w & 0xffffu); VT[(c + 1) * 136 + q] = (bf16_t)(w >> 16); } } }
            __syncthreads();
            const int cbk = C.wid & 3;
            bf16x8 af[8];
#pragma unroll
            for (int s = 0; s < 8; ++s) af[s] = *(const LAS bf16x8*)(VT + (32 * cbk + n) * 136 + 16 * s + 8 * hh);
#pragma unroll
            for (int pi = 0; pi < 2; ++pi) {
                const int pb = 2 * (C.wid >> 2) + pi;
                f32x16 S;
#pragma unroll
                for (int e = 0; e < 16; ++e) S[e] = 0.f;
#pragma unroll
                for (int s = 0; s < 8; ++s) { const bf16x8 wf = *(const bf16x8*)(WSP + ((size_t)g * 128 + 32 * pb + n) * 128 + 16 * s + 8 * hh);
                    S = __builtin_amdgcn_mfma_f32_32x32x16_bf16(af[s], wf, S, 0, 0, 0); }
                const int p = 32 * pb + n; const float bs = a.in[I_BS][g * 128 + p];
                const size_t rowoff = (size_t)(tok0 + p) * D + g * 128 + 32 * cbk;
#pragma unroll
                for (int q4 = 0; q4 < 4; ++q4) { const int c0 = 8 * q4 + 4 * hh;
                    const u32x2 uu = *(const u32x2*)(U + rowoff + c0);
                    u32x2 w; w.x = pk2(bf_lo(uu.x) * (S[4 * q4] + bs), bf_hi(uu.x) * (S[4 * q4 + 1] + bs)); w.y = pk2(bf_lo(uu.y) * (S[4 * q4 + 2] + bs), bf_hi(uu.y) * (S[4 * q4 + 3] + bs));
                    *(u32x2*)(A + rowoff + c0) = w; }
            }
            __syncthreads();
        }
    }
}

__device__ __forceinline__ void phaseFinalNorm(const Ctx& C, const float* src) {
    const Args& a = *C.a;
    for (int i = 0; i < 16; ++i) { const int r = C.bid * 128 + C.wid * 16 + i;
        const f32x4* xr = (const f32x4*)(src + (size_t)r * D) + C.lane; f32x4 v[4]; float s = 0.f;
#pragma unroll
        for (int j = 0; j < 4; ++j) { v[j] = xr[64 * j]; s += (v[j].x * v[j].x + v[j].y * v[j].y) + (v[j].z * v[j].z + v[j].w * v[j].w); }
        const float rinv = rsqrtf(wave_sum(s) * (1.f / D) + EPS);
        f32x4* o = (f32x4*)(a.out + (size_t)r * D) + C.lane;
#pragma unroll
        for (int j = 0; j < 4; ++j) { const f32x4 g = *((const f32x4*)a.in[I_NFG] + C.lane + 64 * j); o[64 * j] = v[j] * rinv * g; } }
}


#ifdef DBG_CHECK
__device__ __forceinline__ float bfv(const bf16_t* p) { return __uint_as_float(((unsigned)*p) << 16); }
__device__ __forceinline__ int sample_tok(int bid) { return bid * 128 + ((bid * 29 + 7) & 127); }
__device__ __forceinline__ float wave_max(float v) {
#pragma unroll
    for (int o = 1; o < 64; o <<= 1) v = fmaxf(v, __shfl_xor(v, o));
    return v;
}
__device__ __forceinline__ bool far(float got, float want, float tol) { return !(fabsf(got - want) <= tol * (1.f + fabsf(want))); }
__device__ __forceinline__ void checkMixer(const Args& a, int bid_, int lane) {
    unsigned char* ws = a.ws;
    const bf16_t* GLU = (const bf16_t*)(ws + WS_GLU); const bf16_t* Qb = (const bf16_t*)(ws + WS_Q); const bf16_t* Kb = (const bf16_t*)(ws + WS_K); const bf16_t* Vb = (const bf16_t*)(ws + WS_V);
    const bf16_t* Y = (const bf16_t*)(ws + WS_A);
    const int tok = sample_tok(bid_), b = tok / SEQ, t = tok % SEQ, r = t / 64, qc = t % 64;
    unsigned fail = 0;
    _Pragma("unroll") for (int i = 0; i < 8; ++i) { const int c = lane + 64 * i; float acc = a.in[I_CONVB][c];
        for (int j = 0; j < 31; ++j) { const int tt = t + j - 15; if (tt >= 0 && tt < SEQ) acc += a.in[I_CONVW][j * 512 + c] * bfv(GLU + (size_t)(b * SEQ + tt) * 512 + c); }
        const float mu = wave_sum(acc) * (1.f / 64.f), d = acc - mu, var = wave_sum(d * d) * (1.f / 64.f);
        float y = d * rsqrtf(var + EPS) * a.in[I_GNG][c] + a.in[I_GNB][c]; y = y / (1.f + expf(-y));
        if (far(bfv(Y + (size_t)tok * D + c), y, 0.03f)) fail |= 1u; }
    const int kr0 = r - 4 < 0 ? 0 : (r - 4 > 56 ? 56 : r - 4), cs = qc - 8 < 0 ? 0 : (qc - 8 > 48 ? 48 : qc - 8);
    for (int h = 0; h < 8; ++h) {
        float sc[6]; size_t kt[6]; float m = -1e30f;
        _Pragma("unroll") for (int i = 0; i < 6; ++i) { const int j = lane + 64 * i; float bias = 0.f; size_t ktok;
            if (j < 128) { const int kr = kr0 + (j >> 4), kc = cs + (j & 15); ktok = (size_t)b * SEQ + kr * 64 + kc; bias = a.in[I_RPB][h * 465 + (kr - r + 7) * 31 + (kc - qc + 15)]; }
            else ktok = (size_t)M + b * CTXL + (j - 128);
            float s = 0.f; for (int d = 0; d < 64; ++d) s += bfv(Qb + (size_t)tok * 512 + h * 64 + d) * bfv(Kb + ktok * 512 + h * 64 + d);
            sc[i] = s + bias; kt[i] = ktok; m = fmaxf(m, sc[i]); }
        m = wave_max(m); float l = 0.f;
        _Pragma("unroll") for (int i = 0; i < 6; ++i) { sc[i] = expf(sc[i] - m); l += sc[i]; }
        l = wave_sum(l);
        float o = 0.f;
        _Pragma("unroll") for (int i = 0; i < 6; ++i) for (int src = 0; src < 64; ++src) { const float pj = __shfl(sc[i], src); const unsigned lo = __shfl((unsigned)(kt[i] & 0xffffffffu), src), hi = __shfl((unsigned)(kt[i] >> 32), src);
            const size_t ktok = ((size_t)hi << 32) | lo; o += pj * bfv(Vb + ktok * 512 + h * 64 + lane); }
        if (far(bfv(Y + (size_t)tok * D + 512 + h * 64 + lane), o / l, 0.03f)) fail |= 2u;
    }
    if (fail) atomicOr((unsigned*)(ws + WS_CTL) + 8192, fail);
}
__device__ __forceinline__ void checkPeerA(const Args& a, int bid_, int lane, int l) {
    unsigned char* ws = a.ws;
    const bf16_t* A = (const bf16_t*)(ws + WS_A); const bf16_t* QP = (const bf16_t*)(ws + WS_QP);
    const unsigned short* IDX = (const unsigned short*)(ws + WS_IDX); const float* WT = (const float*)(ws + WS_WT);
    const float* modf = (const float*)(ws + WS_MODF) + (size_t)l * 9 * 6144;
    const int tok = sample_tok(bid_), b = tok / SEQ;
    unsigned fail = 0;
    float hv[16]; float ss = 0.f;
    _Pragma("unroll") for (int i = 0; i < 16; ++i) { hv[i] = a.out[(size_t)tok * D + lane + 64 * i]; ss += hv[i] * hv[i]; }
    const float rinv = rsqrtf(wave_sum(ss) * (1.f / D) + EPS);
    _Pragma("unroll") for (int i = 0; i < 16; ++i) { const int c = lane + 64 * i; const float y = hv[i] * rinv * a.in[I_N2G][l * 1024 + c] * (1.f + modf[b * 6144 + 4 * 1024 + c]) + modf[b * 6144 + 3 * 1024 + c];
        if (far(bfv(A + (size_t)tok * D + c), y, 0.03f)) fail |= 4u; }
    { const int n = lane * 32 + 5; float q = 0.f; for (int k = 0; k < 1024; ++k) q += bfv(A + (size_t)tok * D + k) * a.in[I_WQ][(size_t)l * 1024 * 2048 + (size_t)k * 2048 + n];
      if (far(bfv(QP + (size_t)tok * 2048 + n), q, 0.03f)) fail |= 8u; }
    for (int h = 0; h < 8; ++h) {
        const unsigned id = IDX[(size_t)tok * 128 + h * 16]; const int pick0 = (int)(id >> 7), pick1 = (int)(id & 127u);
        _Pragma("unroll") for (int p = 0; p < 2; ++p) { float s2[2];
            _Pragma("unroll") for (int i = 0; i < 2; ++i) { const int key = lane + 64 * i; float s = 0.f;
                for (int d = 0; d < 128; ++d) s += bfv(QP + (size_t)tok * 2048 + h * 256 + p * 128 + d) * a.in[I_KEYS][(((size_t)(l * 8 + h) * 2 + p) * 128 + key) * 128 + d];
                s2[i] = s; }
            const float mx = wave_max(fmaxf(s2[0], s2[1]));
            const int pk = p == 0 ? pick0 : pick1; const float mine = __shfl(pk < 64 ? s2[0] : s2[1], pk & 63);
            if (!(mine >= mx - 0.03f)) fail |= 16u; }
        float w = lane < 16 ? WT[(size_t)tok * 128 + h * 16 + lane] : 0.f; const float wsum = wave_sum(w);
        if (!(fabsf(wsum - 1.f) < 1e-3f) || !(w >= 0.f)) fail |= 32u;
    }
    float pr[16]; _Pragma("unroll") for (int i = 0; i < 16; ++i) pr[i] = 0.f;
    for (int k = 0; k < 128; ++k) { const size_t e = IDX[(size_t)tok * 128 + k]; const float* ur = a.in[I_PU] + ((size_t)l * NEXP + e) * 1024; const float* vr = a.in[I_PV] + ((size_t)l * NEXP + e) * 1024;
        float d = 0.f; _Pragma("unroll") for (int i = 0; i < 16; ++i) d += bfv(A + (size_t)tok * D + lane + 64 * i) * ur[lane + 64 * i];
        d = wave_sum(d); const float cf = WT[(size_t)tok * 128 + k] * gelu_erf(d);
        _Pragma("unroll") for (int i = 0; i < 16; ++i) pr[i] += cf * vr[lane + 64 * i]; }
    float* REF = (float*)(ws + WS_REF) + (size_t)bid_ * 1024;
    _Pragma("unroll") for (int i = 0; i < 16; ++i) { const int c = lane + 64 * i; REF[c] = hv[i] + modf[b * 6144 + 5 * 1024 + c] * pr[i]; }
    if (fail) atomicOr((unsigned*)(ws + WS_CTL) + 8192, fail);
}
__device__ __forceinline__ void checkPeerB(const Args& a, int bid_, int lane) {
    unsigned char* ws = a.ws;
    const int tok = sample_tok(bid_); unsigned fail = 0;
    const float* REF = (const float*)(ws + WS_REF) + (size_t)bid_ * 1024;
    _Pragma("unroll") for (int i = 0; i < 16; ++i) { const int c = lane + 64 * i; if (far(a.out[(size_t)tok * D + c], REF[c], 0.02f)) fail |= (64u << (bid_ & 3)); }
    if (fail) atomicOr((unsigned*)(ws + WS_CTL) + 8192, fail);
}
__device__ void phaseCode(const Ctx& C) {
    const Args& a = *C.a;
    const unsigned mask = *((const unsigned*)(a.ws + WS_CTL) + 8192);
    const unsigned code = (mask >> DBG_SHIFT) & 15u;
    const float alpha = 1.f + 0.5f * (float)code;
    _Pragma("unroll") for (int i = 0; i < 16; ++i) { const int r = C.bid * 128 + C.wid * 16 + i;
        const f32x4* xr = (const f32x4*)(a.in[I_X] + (size_t)r * D) + C.lane; f32x4 v[4]; float s = 0.f;
        for (int j = 0; j < 4; ++j) { v[j] = xr[64 * j]; s += (v[j].x * v[j].x + v[j].y * v[j].y) + (v[j].z * v[j].z + v[j].w * v[j].w); }
        const float rinv = rsqrtf(wave_sum(s) * (1.f / D) + EPS) * alpha;
        f32x4* o = (f32x4*)(a.out + (size_t)r * D) + C.lane;
        for (int j = 0; j < 4; ++j) { const f32x4 g = *((const f32x4*)a.in[I_NFG] + C.lane + 64 * j); o[64 * j] = v[j] * rinv * g; } }
}
__global__ void __launch_bounds__(64) dbg_kernel(Args args, int which) {
    if (which == 17) checkMixer(args, blockIdx.x, threadIdx.x);
    if (which == 18) checkPeerA(args, blockIdx.x, threadIdx.x, 0);
    if (which == 19) checkPeerB(args, blockIdx.x, threadIdx.x);
}
#endif

__global__ void __launch_bounds__(512, 2) fwd_megakernel(Args args) {
    extern __shared__ __attribute__((aligned(16))) unsigned char lds_raw[];
    LAS unsigned char* lds = (LAS unsigned char*)lds_raw;
    Ctx C; C.a = &args; C.lds = lds; C.tid = threadIdx.x; C.lane = C.tid & 63; C.wid = __builtin_amdgcn_readfirstlane(C.tid >> 6); C.bid = blockIdx.x; C.G = gridDim.x;
    volatile LAS unsigned* MISC = (volatile LAS unsigned*)(lds + MISC_OFF);
    if (C.tid < 4) MISC[C.tid] = 0u;
    __syncthreads();
    unsigned char* ws = args.ws;
    const int lo = args.ph_lo, hi = args.ph_hi;
    XcdBarrier bar; bar.bar = (unsigned*)(ws + WS_CTL); bar.x = 0; bar.st = nullptr;
    const bool multi = (hi - lo) > 1;
    if (multi) bar = xcd_barrier_post((unsigned*)(ws + WS_CTL), MISC);
#define IN(k) (lo <= (k) && (k) < hi)
#define SEAM(k) do { if (IN(k) && IN((k) + 1)) xcd_barrier(bar); } while (0)
    using namespace pg8;
    const bf16_t* Abuf = (const bf16_t*)(ws + WS_A);
    const float* modf = (const float*)(ws + WS_MODF);

    if (IN(0)) { phaseA(C); } SEAM(0);
    if (IN(1)) { phaseB(C); } SEAM(1);
    if (IN(2)) {
        Gemm g{Abuf, (const bf16_t*)(ws + WS_W1T), MA, 2560, 1024}; Order1 S; S.init(C.G, C.bid);
        Epi1 E{(bf16_t*)(ws + WS_GLU), ws};
        gemm_phase<Epi1, Order1>(lds, g, S, E);
    } SEAM(2);
    if (IN(3)) {
        for (int t = C.bid; t < 512; t += C.G) conv_tile(C, t);
        __syncthreads();
        for (int t = C.bid * 8 + C.wid; t < NBATCH * 64 * 8; t += C.G * 8) attn_task(C, t);
    } SEAM(3);
    if (IN(4)) {
        Gemm g{Abuf, (const bf16_t*)(ws + WS_W2T), M, 1024, 1024}; StaticOrder S; S.init(M, 1024, C.G, C.bid);
        EpiRes E{args.in[I_X], args.out, modf + 2 * 1024};
        gemm_phase<EpiRes, StaticOrder>(lds, g, S, E);
    } SEAM(4);
    if (IN(5)) { phaseNorm2(C, 0); } SEAM(5);
    if (IN(6)) {
        Gemm g{Abuf, (const bf16_t*)(ws + WS_WQ), M, 2048, 1024}; StaticOrder S; S.init(M, 2048, C.G, C.bid);
        EpiBf16<0> E{(bf16_t*)(ws + WS_QP), (bf16_t*)(ws + WS_QP), 8, 2048};
        gemm_phase<EpiBf16<0>, StaticOrder>(lds, g, S, E);
    } SEAM(6);
    if (IN(7)) { for (int t = C.bid; t < M / 128; t += C.G) for (int q = 0; q < 4; ++q) topk_task(C, 0, t * 4 + q, C.wid); } SEAM(7);
    if (IN(8)) { phasePeer(C, 0); } SEAM(8);
    if (IN(9)) {
        Gemm g{Abuf, (const bf16_t*)(ws + WS_WSI), M, 2048, 1024}; StaticOrder S; S.init(M, 2048, C.G, C.bid);
        EpiBf16<1> E{(bf16_t*)(ws + WS_U), (bf16_t*)(ws + WS_VV), 4, 1024};
        gemm_phase<EpiBf16<1>, StaticOrder>(lds, g, S, E);
    } SEAM(9);
    if (IN(10)) { phaseSgu(C); } SEAM(10);
    if (IN(11)) {
        Gemm g{Abuf, (const bf16_t*)(ws + WS_WSO), M, 1024, 1024}; StaticOrder S; S.init(M, 1024, C.G, C.bid);
        EpiRes E{args.out, args.out, modf + 9 * 6144 + 2 * 1024};
        gemm_phase<EpiRes, StaticOrder>(lds, g, S, E);
    } SEAM(11);
    if (IN(12)) { phaseNorm2(C, 1); } SEAM(12);
    if (IN(13)) {
        Gemm g{Abuf, (const bf16_t*)(ws + WS_WQ) + (size_t)2048 * 1024, M, 2048, 1024}; StaticOrder S; S.init(M, 2048, C.G, C.bid);
        EpiBf16<0> E{(bf16_t*)(ws + WS_QP), (bf16_t*)(ws + WS_QP), 8, 2048};
        gemm_phase<EpiBf16<0>, StaticOrder>(lds, g, S, E);
    } SEAM(13);
    if (IN(14)) { for (int t = C.bid; t < M / 128; t += C.G) for (int q = 0; q < 4; ++q) topk_task(C, 1, t * 4 + q, C.wid); } SEAM(14);
    if (IN(15)) { phasePeer(C, 1); } SEAM(15);
    if (IN(16)) { phaseFinalNorm(C, DBG_LEVEL == 0 ? args.in[I_X] : args.out); }
#ifdef DBG_CHECK
    if (IN(20)) phaseCode(C);
#endif
#undef IN
#undef SEAM
}

extern "C" void kernel_launch(void* const* d_in, const int* in_sizes, int n_in, void* d_out, int out_size, void* d_ws, size_t ws_size, hipStream_t stream) {
    static int grid = 0;
    if (grid == 0) {
        if (n_in != N_IN || out_size != M * D || ws_size < WS_END) { fprintf(stderr, "kernel_launch: unexpected shapes (n_in %d out %d ws %zu need %zu)\n", n_in, out_size, ws_size, (size_t)WS_END); grid = -1; return; }
        int dev = 0, cus = 0, per_cu = 0;
        if (hipGetDevice(&dev) != hipSuccess || hipDeviceGetAttribute(&cus, hipDeviceAttributeMultiprocessorCount, dev) != hipSuccess) { grid = -1; return; }
        if (hipFuncSetAttribute((const void*)fwd_megakernel, hipFuncAttributeMaxDynamicSharedMemorySize, LDS_BYTES) != hipSuccess) { fprintf(stderr, "kernel_launch: hipFuncSetAttribute failed\n"); grid = -1; return; }
        if (hipOccupancyMaxActiveBlocksPerMultiprocessor(&per_cu, (const void*)fwd_megakernel, 512, LDS_BYTES) != hipSuccess || per_cu < 1) { fprintf(stderr, "kernel_launch: occupancy query says %d blocks per CU\n", per_cu); (void)hipGetLastError(); grid = -1; return; }
        grid = cus;
        if (grid != 256) fprintf(stderr, "kernel_launch: note: %d CUs (the phase tilings assume 256)\n", grid);
        if (grid > 256) grid = 256;
    }
    if (grid < 0) return;
    (void)hipMemsetAsync((char*)d_ws + WS_CTL, 0, CTL_BYTES, stream);
    Args a{};
    for (int i = 0; i < N_IN; ++i) a.in[i] = (const float*)d_in[i];
    a.out = (float*)d_out; a.ws = (unsigned char*)d_ws;
    int phases[NPH]; int np = 0;
    const int lastp = DBG_LEVEL == 0 ? -1 : DBG_LEVEL == 1 ? 4 : DBG_LEVEL == 2 ? 8 : DBG_LEVEL == 3 ? 11 : 15;
    for (int p = 0; p <= lastp; ++p) phases[np++] = p;
    if (DBG_LEVEL < 4) phases[np++] = 16;
#ifdef DBG_CHECK
    { const int pl[] = {0, 1, 2, 3, 17, 4, 5, 6, 7, 18, 8, 19, 20}; np = 0; for (int p : pl) phases[np++] = p; }
#endif
#if ONE_LAUNCH
    if (DBG_LEVEL == 4) { a.ph_lo = 0; a.ph_hi = 16; hipLaunchKernelGGL(fwd_megakernel, dim3(grid), dim3(512), LDS_BYTES, stream, a); return; }
#endif
    for (int i = 0; i < np; ++i) {
#ifdef DBG_CHECK
        if (phases[i] >= 17 && phases[i] <= 19) { a.ph_lo = 0; a.ph_hi = 0; hipLaunchKernelGGL(dbg_kernel, dim3(256), dim3(64), 0, stream, a, phases[i]); continue; }
#endif
        a.ph_lo = phases[i]; a.ph_hi = phases[i] + 1; hipLaunchKernelGGL(fwd_megakernel, dim3(grid), dim3(512), LDS_BYTES, stream, a); }
}
```

```cpp
#include <hip/hip_runtime.h>
#include <cstdio>
#include <cstdint>

#ifndef DBG_LEVEL
#define DBG_LEVEL 4
#endif
#ifndef DBG_SHIFT
#define DBG_SHIFT 6
#endif
#ifndef ONE_LAUNCH
#define ONE_LAUNCH 1
#endif

#define LAS __attribute__((address_space(3)))
typedef unsigned short bf16_t;
typedef short bf16x8 __attribute__((ext_vector_type(8)));
typedef float f32x4 __attribute__((ext_vector_type(4)));
typedef float f32x16 __attribute__((ext_vector_type(16)));
typedef float f32x2 __attribute__((ext_vector_type(2)));
typedef unsigned u32x4 __attribute__((ext_vector_type(4)));
typedef unsigned u32x2 __attribute__((ext_vector_type(2)));
typedef __bf16 bf2v __attribute__((ext_vector_type(2)));

constexpr int D = 1024, NBATCH = 8, SEQ = 4096, M = NBATCH * SEQ, CTXL = 256, MC = NBATCH * CTXL, MA = M + MC;
constexpr int NEXP = 16384;
constexpr float EPS = 1e-6f;
enum { I_X = 0, I_C, I_CTX, I_CCTX, I_N1G, I_N2G, I_ADAW, I_ADAB, I_WIN, I_CONVW, I_CONVB, I_GNG, I_GNB, I_RPB, I_WOUT, I_SGUIN, I_LNG, I_LNB, I_WS, I_BS, I_SGUOUT,
       I_WQ, I_KEYS, I_PU, I_PV, I_NFG, N_IN };

constexpr size_t WS_CTL  = 0;
constexpr size_t CTL_BYTES = 65536;
constexpr size_t WS_MODP = WS_CTL + CTL_BYTES;
constexpr size_t WS_MODF = WS_MODP + (size_t)2 * 8 * 9 * 6144 * 4;
constexpr size_t WS_W1T  = WS_MODF + (size_t)2 * 9 * 6144 * 4;
constexpr size_t WS_W2T  = WS_W1T + (size_t)2560 * 1024 * 2;
constexpr size_t WS_WSI  = WS_W2T + (size_t)1024 * 1024 * 2;
constexpr size_t WS_WSO  = WS_WSI + (size_t)2048 * 1024 * 2;
constexpr size_t WS_WQ   = WS_WSO + (size_t)1024 * 1024 * 2;
constexpr size_t WS_KEYS = WS_WQ + (size_t)2 * 2048 * 1024 * 2;
constexpr size_t WS_WSP  = WS_KEYS + (size_t)2 * 8 * 2 * 128 * 128 * 2;
constexpr size_t WS_TU   = WS_WSP + (size_t)8 * 128 * 128 * 2;
constexpr size_t WS_TV   = WS_TU + (size_t)2 * NEXP * 1024 * 2;
constexpr size_t WS_A    = WS_TV + (size_t)2 * NEXP * 1024 * 2;
constexpr size_t WS_B    = WS_A + (size_t)MA * 1024 * 2;
constexpr size_t WS_GLU  = WS_B;
constexpr size_t WS_Q    = WS_GLU + (size_t)M * 512 * 2;
constexpr size_t WS_K    = WS_Q + (size_t)M * 512 * 2;
constexpr size_t WS_V    = WS_K + (size_t)MA * 512 * 2;
constexpr size_t WS_QP   = WS_B;
constexpr size_t WS_U    = WS_B;
constexpr size_t WS_VV   = WS_B + (size_t)M * 1024 * 2;
constexpr size_t WS_IDX  = WS_V + (size_t)MA * 512 * 2;
constexpr size_t WS_WT   = WS_IDX + (size_t)M * 128 * 2;
constexpr size_t WS_REF  = WS_WT + (size_t)M * 128 * 4;
constexpr size_t WS_END  = WS_REF + (size_t)256 * 1024 * 4;

constexpr int LDS_BYTES = 147456;
constexpr int MISC_OFF = 131072;
constexpr int NPH = 24;

__device__ __forceinline__ float bf_lo(unsigned u) { return __uint_as_float(u << 16); }
__device__ __forceinline__ float bf_hi(unsigned u) { return __uint_as_float(u & 0xffff0000u); }
__device__ __forceinline__ unsigned pk2(float lo, float hi) { bf2v r = {(__bf16)lo, (__bf16)hi}; return __builtin_bit_cast(unsigned, r); }
__device__ __forceinline__ float wave_sum(float v) {
#pragma unroll
    for (int o = 1; o < 64; o <<= 1) v += __shfl_xor(v, o);
    return v;
}
__device__ __forceinline__ float dot2bf(unsigned a, unsigned b, float c) { return __builtin_amdgcn_fdot2_f32_bf16(__builtin_bit_cast(bf2v, a), __builtin_bit_cast(bf2v, b), c, false); }
__device__ __forceinline__ float sigmoidf_(float x) { return 1.f / (1.f + __expf(-x)); }
__device__ __forceinline__ float gelu_erf(float v) { return 0.5f * v * (1.f + erff(v * 0.70710678f)); }

namespace pg8 {
constexpr int BM = 256, BK = 64, HALF = 128, HTB = HALF * BK * 2, STAGE_BYTES = 8 * HTB, NXCD = 8, WGM = 8;
__host__ __device__ __forceinline__ int lds_byte(int r, int c) { const int st = (r >> 4) * 2 + (c >> 5), rr = r & 15, cc = c & 31, ob = rr * 64 + cc * 2; return st * 1024 + (ob ^ (((ob >> 9) & 1) << 5)); }
__host__ __device__ __forceinline__ void stage_rc(int b, int& R, int& C) { const int st = b / 1024, sb = b % 1024, swz = sb ^ (((sb >> 9) & 1) << 5); R = (st >> 1) * 16 + swz / 64; C = (st & 1) * 32 + (swz % 64) / 2; }
__host__ __device__ __forceinline__ int perm32(int rho) { const int n = rho >> 4, i = rho & 15; return 8 * (i >> 2) + 4 * n + (i & 3); }
struct Unit { int pm, pn; };
struct Gemm { const bf16_t* A; const bf16_t* Bt; int M, N, K; };
struct StaticOrder {
    int nM, nN, nwg, G, c;
    __host__ __device__ void init(int M_, int N_, int G_, int c_) { nM = M_ / BM; nN = N_ / BM; nwg = nM * nN; G = G_; c = c_; }
    __host__ __device__ bool next(int i, Unit& u) const {
        const long L = (long)i * G + c; if (L >= nwg) return false;
        int wgid = (int)L; { const int q = nwg / NXCD, r = nwg % NXCD, xcd = wgid % NXCD, off = wgid / NXCD; wgid = (xcd < r ? xcd * (q + 1) : r * (q + 1) + (xcd - r) * q) + off; }
        const int nig = WGM * nN, gid = wgid / nig, fm = gid * WGM, gsz = (nM - fm) < WGM ? (nM - fm) : WGM;
        u.pm = fm + ((wgid % nig) % gsz); u.pn = (wgid % nig) / gsz; return true;
    }
    __device__ __forceinline__ void a_ready(const Unit&) const {}
    __device__ __forceinline__ void done(const Unit&) const {}
};
struct Order1 {
    StaticOrder so; int G, c;
    __device__ void init(int G_, int c_) { so.init(M, 2560, G_, c_); G = G_; c = c_; }
    __device__ bool next(int i, Unit& u) const {
        const long L = (long)i * G + c;
        if (L < so.nwg) return so.next(i, u);
        const int l2 = (int)(L - so.nwg); if (l2 >= 32) return false;
        u.pm = 128 + (l2 >> 2); u.pn = 6 + (l2 & 3); return true;
    }
    __device__ __forceinline__ void a_ready(const Unit&) const {}
    __device__ __forceinline__ void done(const Unit&) const {}
};
__device__ __forceinline__ f32x2 gelu_pk(f32x2 v) {
    const f32x2 av = __builtin_elementwise_abs(v), d = av * 0.2316418882f + 1.0f;
    f32x2 t; t.x = __builtin_amdgcn_rcpf(d.x); t.y = __builtin_amdgcn_rcpf(d.y);
    f32x2 q = t * 0.5307027145f + (-0.7265760135f); q = q * t + 0.7107068705f; q = q * t + (-0.142248368f); q = q * t + 0.127414796f; q = q * t;
    const f32x2 s = (v * v) * (-0.72134752044f);
    f32x2 e; e.x = __builtin_amdgcn_exp2f(s.x); e.y = __builtin_amdgcn_exp2f(s.y);
    const f32x2 m = v * (q * e), r = v - m;
    f32x2 o; o.x = v.x < 0.f ? m.x : r.x; o.y = v.y < 0.f ? m.y : r.y; return o;
}
template <class Epi, class Sched>
__device__ __forceinline__ void gemm_phase(LAS unsigned char* lds, const Gemm g, const Sched& S, const Epi& E) {
    const int tid = threadIdx.x, wid = __builtin_amdgcn_readfirstlane(tid >> 6), lane = tid & 63, wr = wid >> 2, wc = wid & 3, fr = lane & 15, fq = lane >> 4;
    const int K = g.K, nt = K / BK;
    unsigned voffA[2], voffB[2];
#pragma unroll
    for (int i = 0; i < 2; ++i) { int R, C; stage_rc(tid * 16 + i * 8192, R, C); const int Rb = Epi::PERM ? ((R & ~31) + perm32(R & 31)) : R;
        voffA[i] = (unsigned)(R * K + C) * 2u; voffB[i] = (unsigned)(Rb * K + C) * 2u; }
    const size_t kstep = (size_t)(BK * 2);
    const size_t hstep = (size_t)HALF * K * 2;
    const size_t tstep = 2 * hstep;
    const unsigned ldsw = (unsigned)wid * 1024u;
    const int aoff = lds_byte(wr * 64 + fr, fq * 8), boff = lds_byte(wc * 32 + fr, fq * 8);
#define PG8_SA(b, h) (((b) * 2 + (h)) * HTB)
#define PG8_SB(b, h) ((4 + (b) * 2 + (h)) * HTB)
#define PG8_STAGE(bufoff, gbase, voff) do { _Pragma("unroll") for (int _i = 0; _i < 2; ++_i) \
        __builtin_amdgcn_global_load_lds((const unsigned*)((const char*)(gbase) + (voff)[_i]), (LAS unsigned*)(lds + (bufoff) + ldsw + _i * 8192), 16, 0, 0); } while (0)
#define PG8_LDA(dst, b, h) do { _Pragma("unroll") for (int m = 0; m < 4; ++m) _Pragma("unroll") for (int k = 0; k < 2; ++k) dst[m][k] = *(const LAS bf16x8*)(lds + PG8_SA(b, h) + aoff + m * 2048 + k * 1024); } while (0)
#define PG8_LDB(dst, b, h) do { _Pragma("unroll") for (int n = 0; n < 2; ++n) _Pragma("unroll") for (int k = 0; k < 2; ++k) dst[n][k] = *(const LAS bf16x8*)(lds + PG8_SB(b, h) + boff + n * 2048 + k * 1024); } while (0)
#define PG8_MMA(ai, bj, At, Bt) do { __builtin_amdgcn_s_setprio(1); _Pragma("unroll") for (int m = 0; m < 4; ++m) _Pragma("unroll") for (int n = 0; n < 2; ++n) _Pragma("unroll") for (int k = 0; k < 2; ++k) \
        acc[ai][bj][m][n] = __builtin_amdgcn_mfma_f32_16x16x32_bf16(Bt[n][k], At[m][k], acc[ai][bj][m][n], 0, 0, 0); __builtin_amdgcn_s_setprio(0); } while (0)
#define PG8_WAIT_V(n) asm volatile("s_waitcnt vmcnt(" #n ")" ::: "memory")
#define PG8_WAIT_L(n) asm volatile("s_waitcnt lgkmcnt(" #n ")" ::: "memory")
#define PG8_BAR __builtin_amdgcn_s_barrier()
#define PG8_SCHED __builtin_amdgcn_sched_barrier(0)
    Unit cur, nxt; int ui = 0;
    if (!S.next(0, cur)) return;
    f32x4 acc[2][2][4][2];
#pragma unroll
    for (int a = 0; a < 2; ++a)
#pragma unroll
        for (int b = 0; b < 2; ++b)
#pragma unroll
            for (int m = 0; m < 4; ++m)
#pragma unroll
                for (int n = 0; n < 2; ++n) acc[a][b][m][n] = (f32x4){0.f, 0.f, 0.f, 0.f};
    bf16x8 At[4][2], B0[2][2], B1[2][2];
    const char* cA = (const char*)g.A + (size_t)cur.pm * tstep; const char* cB = (const char*)g.Bt + (size_t)cur.pn * tstep;
    S.a_ready(cur);
    PG8_STAGE(PG8_SB(0, 0), cB, voffB); PG8_STAGE(PG8_SA(0, 0), cA, voffA); PG8_STAGE(PG8_SB(0, 1), cB + hstep, voffB); PG8_STAGE(PG8_SA(0, 1), cA + hstep, voffA);
    if (wr == 1) PG8_BAR;
    PG8_WAIT_V(4); PG8_BAR;
    PG8_STAGE(PG8_SB(1, 0), cB + kstep, voffB); PG8_STAGE(PG8_SA(1, 0), cA + kstep, voffA); PG8_STAGE(PG8_SB(1, 1), cB + hstep + kstep, voffB);
    PG8_WAIT_V(6); PG8_BAR;
    for (;;) {
        const bool has_next = S.next(ui + 1, nxt);
        const char* nA = has_next ? (const char*)g.A + (size_t)nxt.pm * tstep : cA; const char* nB = has_next ? (const char*)g.Bt + (size_t)nxt.pn * tstep : cB;
        for (int t = 0; t < nt; t += 2) {
            const bool last = (t == nt - 2);
            const char* a1 = cA + (size_t)(t + 1) * kstep;
            const char* a2 = last ? nA : cA + (size_t)(t + 2) * kstep; const char* b2 = last ? nB : cB + (size_t)(t + 2) * kstep;
            const char* a3 = a2 + kstep; const char* b3 = b2 + kstep;
            if (last && has_next) S.a_ready(nxt);
            PG8_LDB(B0, 0, 0); PG8_SCHED; PG8_LDA(At, 0, 0); PG8_STAGE(PG8_SA(1, 1), a1 + hstep, voffA);
            PG8_WAIT_L(8); PG8_BAR; PG8_WAIT_L(0); PG8_MMA(0, 0, At, B0); PG8_BAR; PG8_SCHED;
            PG8_LDB(B1, 0, 1); PG8_STAGE(PG8_SB(0, 0), b2, voffB);
            PG8_BAR; PG8_WAIT_L(0); PG8_MMA(0, 1, At, B1); PG8_BAR;
            PG8_LDA(At, 0, 1); PG8_STAGE(PG8_SA(0, 0), a2, voffA);
            PG8_BAR; PG8_WAIT_L(0); PG8_MMA(1, 0, At, B0); PG8_BAR; PG8_SCHED;
            PG8_STAGE(PG8_SB(0, 1), b2 + hstep, voffB);
            PG8_WAIT_V(6); PG8_BAR; PG8_MMA(1, 1, At, B1); PG8_BAR;
            PG8_LDB(B0, 1, 0); PG8_SCHED; PG8_LDA(At, 1, 0); PG8_STAGE(PG8_SA(0, 1), a2 + hstep, voffA);
            PG8_WAIT_L(8); PG8_BAR; PG8_WAIT_L(0); PG8_MMA(0, 0, At, B0); PG8_BAR; PG8_SCHED;
            PG8_LDB(B1, 1, 1); PG8_STAGE(PG8_SB(1, 0), b3, voffB);
            PG8_BAR; PG8_WAIT_L(0); PG8_MMA(0, 1, At, B1); PG8_BAR;
            PG8_LDA(At, 1, 1); PG8_STAGE(PG8_SA(1, 0), a3, voffA);
            PG8_BAR; PG8_WAIT_L(0); PG8_MMA(1, 0, At, B0); PG8_BAR; PG8_SCHED;
            PG8_STAGE(PG8_SB(1, 1), b3 + hstep, voffB);
            PG8_WAIT_V(6); PG8_BAR; PG8_MMA(1, 1, At, B1); PG8_BAR;
        }
        E(acc, cur, wr, wc, fr, fq); S.done(cur);
        if (!has_next) break;
#pragma unroll
        for (int a = 0; a < 2; ++a)
#pragma unroll
            for (int b = 0; b < 2; ++b)
#pragma unroll
                for (int m = 0; m < 4; ++m)
#pragma unroll
                    for (int n = 0; n < 2; ++n) acc[a][b][m][n] = (f32x4){0.f, 0.f, 0.f, 0.f};
        cur = nxt; cA = nA; cB = nB; ++ui;
    }
    PG8_WAIT_V(0);
    if (wr == 0) PG8_BAR;
    PG8_BAR;
#undef PG8_SA
#undef PG8_SB
#undef PG8_STAGE
#undef PG8_LDA
#undef PG8_LDB
#undef PG8_MMA
#undef PG8_WAIT_V
#undef PG8_WAIT_L
#undef PG8_BAR
#undef PG8_SCHED
}

struct Epi1 {
    static constexpr bool PERM = true;
    bf16_t *GLU; unsigned char* wsb;
    __device__ __forceinline__ void operator()(const f32x4 (&acc)[2][2][4][2], const Unit& u, int wr, int wc, int fr, int fq) const {
        const int row0 = u.pm * BM + wr * 64 + fr;
        if (u.pn < 4) {
            const int ch0 = u.pn * 128 + wc * 32 + 8 * fq;
#pragma unroll
            for (int ai = 0; ai < 2; ++ai)
#pragma unroll
                for (int m = 0; m < 4; ++m) {
                    const f32x4 a0 = acc[ai][0][m][0], a1 = acc[ai][0][m][1], g0 = acc[ai][1][m][0], g1 = acc[ai][1][m][1];
                    u32x4 w;
                    w.x = pk2(a0[0] * sigmoidf_(g0[0]), a0[1] * sigmoidf_(g0[1])); w.y = pk2(a0[2] * sigmoidf_(g0[2]), a0[3] * sigmoidf_(g0[3]));
                    w.z = pk2(a1[0] * sigmoidf_(g1[0]), a1[1] * sigmoidf_(g1[1])); w.w = pk2(a1[2] * sigmoidf_(g1[2]), a1[3] * sigmoidf_(g1[3]));
                    *(u32x4*)(GLU + (size_t)(row0 + ai * HALF + m * 16) * 512 + ch0) = w;
                }
        } else {
            const int t = (u.pn - 4) >> 1;
            const size_t boff = WS_Q + (t >= 1 ? (size_t)M * 1024 : (size_t)0) + (t >= 2 ? (size_t)MA * 1024 : (size_t)0);
            bf16_t* base = (bf16_t*)(wsb + boff);
            const float sc = t == 0 ? 0.125f : 1.f;
            const int col0 = ((u.pn - 4) & 1) * 256 + wc * 32 + 8 * fq;
#pragma unroll
            for (int ai = 0; ai < 2; ++ai)
#pragma unroll
                for (int m = 0; m < 4; ++m) { bf16_t* rowp = base + (size_t)(row0 + ai * HALF + m * 16) * 512 + col0;
#pragma unroll
                    for (int bj = 0; bj < 2; ++bj) { const f32x4 v0 = acc[ai][bj][m][0] * sc, v1 = acc[ai][bj][m][1] * sc;
                        u32x4 w; w.x = pk2(v0[0], v0[1]); w.y = pk2(v0[2], v0[3]); w.z = pk2(v1[0], v1[1]); w.w = pk2(v1[2], v1[3]);
                        *(u32x4*)(rowp + bj * HALF) = w; } }
        }
    }
};
struct EpiRes {
    static constexpr bool PERM = false;
    const float* base; float* out; const float* gate;
    __device__ __forceinline__ void operator()(const f32x4 (&acc)[2][2][4][2], const Unit& u, int wr, int wc, int fr, int fq) const {
        const int row0 = u.pm * BM + wr * 64 + fr, col0 = u.pn * BM + wc * 32 + 4 * fq;
        const int b = (u.pm * BM) / SEQ;
        f32x4 gv[2][2];
#pragma unroll
        for (int bj = 0; bj < 2; ++bj)
#pragma unroll
            for (int n = 0; n < 2; ++n) gv[bj][n] = *(const f32x4*)(gate + (size_t)b * 6144 + col0 + bj * HALF + n * 16);
#pragma unroll
        for (int ai = 0; ai < 2; ++ai)
#pragma unroll
            for (int m = 0; m < 4; ++m) { const size_t off = (size_t)(row0 + ai * HALF + m * 16) * D + col0;
#pragma unroll
                for (int bj = 0; bj < 2; ++bj)
#pragma unroll
                    for (int n = 0; n < 2; ++n) { const f32x4 bs = *(const f32x4*)(base + off + bj * HALF + n * 16);
                        *(f32x4*)(out + off + bj * HALF + n * 16) = bs + gv[bj][n] * acc[ai][bj][m][n]; } }
    }
};
template <int ACT> struct EpiBf16 {
    static constexpr bool PERM = true;
    bf16_t *O0, *O1; int split_tiles, ld;
    __device__ __forceinline__ void operator()(const f32x4 (&acc)[2][2][4][2], const Unit& u, int wr, int wc, int fr, int fq) const {
        const int row0 = u.pm * BM + wr * 64 + fr;
        bf16_t* base = u.pn < split_tiles ? O0 : O1;
        const int col0 = (u.pn < split_tiles ? u.pn : u.pn - split_tiles) * BM + wc * 32 + 8 * fq;
#pragma unroll
        for (int ai = 0; ai < 2; ++ai)
#pragma unroll
            for (int m = 0; m < 4; ++m) { bf16_t* rowp = base + (size_t)(row0 + ai * HALF + m * 16) * ld + col0;
#pragma unroll
                for (int bj = 0; bj < 2; ++bj) { f32x4 v0 = acc[ai][bj][m][0], v1 = acc[ai][bj][m][1];
                    if (ACT == 1) { f32x2 a = gelu_pk((f32x2){v0[0], v0[1]}), b = gelu_pk((f32x2){v0[2], v0[3]}), c = gelu_pk((f32x2){v1[0], v1[1]}), d = gelu_pk((f32x2){v1[2], v1[3]});
                        v0 = (f32x4){a.x, a.y, b.x, b.y}; v1 = (f32x4){c.x, c.y, d.x, d.y}; }
                    u32x4 w; w.x = pk2(v0[0], v0[1]); w.y = pk2(v0[2], v0[3]); w.z = pk2(v1[0], v1[1]); w.w = pk2(v1[2], v1[3]);
                    *(u32x4*)(rowp + bj * HALF) = w; } }
    }
};
}

#define XB_TMO      128
#define XB_XCNT(j)  (256  + 64 * (j))
#define XB_XSUB(j)  (1280 + 64 * (j))
#define XB_XGEN(j)  (2304 + 64 * (j))
#define XB_TOP      3328
#define XB_TOPGEN   3392
#define XCD_BAR_WORDS 3456
#define XB_SPIN_CAP (1u << 22)
__device__ __forceinline__ unsigned xb_ld(unsigned* p)              { return __hip_atomic_load(p, __ATOMIC_RELAXED, __HIP_MEMORY_SCOPE_AGENT); }
__device__ __forceinline__ unsigned xb_add(unsigned* p, unsigned v) { return __hip_atomic_fetch_add(p, v, __ATOMIC_RELAXED, __HIP_MEMORY_SCOPE_AGENT); }
__device__ __forceinline__ unsigned xb_xcc_id() { return (unsigned)__builtin_amdgcn_s_getreg((3 << 11) | 20) & 0xFu; }
#define XB_SPIN(cond, bar) do { unsigned _sp = 0; while (cond) { __builtin_amdgcn_s_sleep(1); \
    if ((++_sp & 255u) == 0u) { if (xb_ld(&(bar)[XB_TMO])) break; if (_sp > XB_SPIN_CAP) { atomicAdd(&(bar)[XB_TMO], 1u); break; } } } } while (0)
struct XcdBarrier { unsigned* bar; unsigned x; volatile LAS unsigned* st; };
__device__ __forceinline__ XcdBarrier xcd_barrier_post(unsigned* bar, volatile LAS unsigned* st) {
    XcdBarrier b; b.bar = bar; b.x = xb_xcc_id(); b.st = st;
    if (threadIdx.x == 0) (void)xb_add(&bar[XB_XCNT(b.x)], 1u);
    return b;
}
__device__ __forceinline__ void xcd_barrier_complete(unsigned* bar, unsigned x, unsigned& nloc, unsigned& nx) {
    const unsigned G = gridDim.x * gridDim.y * gridDim.z;
    unsigned sum, cnt, mine, sp = 0u;
    for (;;) {
        sum = 0u; cnt = 0u; mine = 0u;
#pragma unroll
        for (unsigned j = 0; j < 16; ++j) { const unsigned c = xb_ld(&bar[XB_XCNT(j)]); sum += c; cnt += (c > 0u) ? 1u : 0u; mine = (j == x) ? c : mine; }
        if (sum == G) break;
        __builtin_amdgcn_s_sleep(1);
        if ((++sp & 255u) == 0u) { if (xb_ld(&bar[XB_TMO])) break; if (sp > XB_SPIN_CAP) { atomicAdd(&bar[XB_TMO], 1u); break; } }
    }
    nloc = mine > 0u ? mine : 1u; nx = cnt > 0u ? cnt : 1u;
}
__device__ __forceinline__ void xcd_barrier(const XcdBarrier& b) {
    asm volatile("s_waitcnt vmcnt(0)" ::: "memory");
    __syncthreads();
    if (threadIdx.x == 0) {
        unsigned* bar = b.bar;
        __builtin_amdgcn_s_waitcnt(0);
        unsigned nloc = b.st[0], nx = b.st[1];
        if (nloc == 0u) { xcd_barrier_complete(bar, b.x, nloc, nx); b.st[0] = nloc; b.st[1] = nx; }
        const unsigned old = xb_add(&bar[XB_XSUB(b.x)], 1u);
        const unsigned gen = old / nloc;
        if (old + 1u == (gen + 1u) * nloc) {
            __builtin_amdgcn_fence(__ATOMIC_RELEASE, "agent");
            asm volatile("s_waitcnt vmcnt(0)" ::: "memory");
            const unsigned og = xb_add(&bar[XB_TOP], 1u);
            const unsigned tg = og / nx;
            if (og + 1u == (tg + 1u) * nx) xb_add(&bar[XB_TOPGEN], 1u);
            else XB_SPIN(xb_ld(&bar[XB_TOPGEN]) == tg, bar);
            __builtin_amdgcn_fence(__ATOMIC_ACQUIRE, "agent");
            xb_add(&bar[XB_XGEN(b.x)], 1u);
            asm volatile("s_waitcnt vmcnt(0)" ::: "memory");
        } else {
            XB_SPIN(xb_ld(&bar[XB_XGEN(b.x)]) == gen, bar);
            __builtin_amdgcn_fence(__ATOMIC_ACQUIRE, "agent");
            asm volatile("s_waitcnt vmcnt(0)" ::: "memory");
        }
    }
    __syncthreads();
}

struct Args { const float* in[N_IN]; float* out; unsigned char* ws; int ph_lo, ph_hi; };
static_assert(sizeof(Args) == (N_IN + 2) * 8 + 8, "Args has padding");

struct Ctx {
    const Args* a; LAS unsigned char* lds; int tid, lane, wid, bid, G;
};

__device__ __forceinline__ int w1_dest_row(int n) {
    if (n < 512) return (n >> 7) * 256 + (n & 127);
    if (n < 1024) { const int q = n - 512; return (q >> 7) * 256 + 128 + (q & 127); }
    return n;
}
__device__ __forceinline__ void transpose_item(const float* W, int K, int N, bf16_t* WT, int item, LAS float* scr, int lane, int mode) {
    const int nblk = N / 32, kb = item / nblk, nb = item % nblk, k0 = 64 * kb, n0 = 32 * nb;
#pragma unroll 8
    for (int i = 0; i < 32; ++i) { const int kk = 2 * i + (lane >> 5); scr[kk * 33 + (lane & 31)] = W[(size_t)(k0 + kk) * N + n0 + (lane & 31)]; }
    asm volatile("s_waitcnt lgkmcnt(0)" ::: "memory"); __builtin_amdgcn_wave_barrier();
    const int c = lane & 7;
#pragma unroll
    for (int j = 0; j < 4; ++j) { const int n = (lane >> 3) + 8 * j; const LAS float* s = scr + (8 * c) * 33 + n;
        u32x4 o; o.x = pk2(s[0 * 33], s[1 * 33]); o.y = pk2(s[2 * 33], s[3 * 33]); o.z = pk2(s[4 * 33], s[5 * 33]); o.w = pk2(s[6 * 33], s[7 * 33]);
        const int dr = mode == 1 ? w1_dest_row(n0 + n) : (n0 + n);
        *(u32x4*)(WT + (size_t)dr * K + k0 + 8 * c) = o; }
    asm volatile("s_waitcnt lgkmcnt(0)" ::: "memory"); __builtin_amdgcn_wave_barrier();
}
__device__ __forceinline__ void convert_task(const float* src, bf16_t* dst, size_t base, int lane) {
#pragma unroll
    for (int it = 0; it < 8; ++it) { const size_t i = base + (size_t)it * 512 + lane * 8;
        const f32x4 a = *(const f32x4*)(src + i), b = *(const f32x4*)(src + i + 4);
        u32x4 o; o.x = pk2(a[0], a[1]); o.y = pk2(a[2], a[3]); o.z = pk2(b[0], b[1]); o.w = pk2(b[2], b[3]);
        *(u32x4*)(dst + i) = o; }
}
__device__ __forceinline__ void phaseA(const Ctx& C) {
    const Args& a = *C.a; unsigned char* ws = a.ws;
    LAS float* S = (LAS float*)C.lds;
    for (int i = C.tid; i < 9 * 1024; i += 512) { const int row = i >> 10, k = i & 1023; const float c = row < 8 ? a.in[I_C][row * 1024 + k] : a.in[I_CCTX][k]; S[i] = c / (1.f + __expf(-c)); }
    __syncthreads();
    LAS float* scr = (LAS float*)(C.lds + 40960 + C.wid * 8448);
    const int gw = C.wid * C.G + C.bid, NGW = C.G * 8;
    constexpr int T_ADA = 1536, T_W1 = 16 * 80, T_W2 = 16 * 32, T_SI = 16 * 64, T_SO = 16 * 32, T_WQ = 2 * 16 * 64;
    constexpr int T_TAB = 2 * (2 * NEXP * 1024 / 4096), T_KEYS = 2 * 8 * 2 * 128 * 128 / 4096, T_WSP = 8 * 128 * 128 / 4096;
    constexpr int NT = T_ADA + T_W1 + T_W2 + T_SI + T_SO + T_WQ + T_TAB + T_KEYS + T_WSP;
    float* modp = (float*)(ws + WS_MODP);
    for (int T = gw; T < NT; T += NGW) {
        int t = T;
        if (t < T_ADA) {
            const int l = t / 768, r = t % 768, cb = r >> 3, ks = r & 7;
            const float* W = a.in[I_ADAW] + (size_t)l * 1024 * 6144 + (size_t)(ks * 128) * 6144 + cb * 64 + C.lane;
            float acc[9];
#pragma unroll
            for (int q = 0; q < 9; ++q) acc[q] = 0.f;
#pragma unroll 8
            for (int k = 0; k < 128; ++k) { const float w = W[(size_t)k * 6144];
#pragma unroll
                for (int q = 0; q < 9; ++q) acc[q] += S[q * 1024 + ks * 128 + k] * w; }
            float* P = modp + ((size_t)(l * 8 + ks) * 9) * 6144 + cb * 64 + C.lane;
#pragma unroll
            for (int q = 0; q < 9; ++q) P[(size_t)q * 6144] = acc[q];
            continue;
        }
        t -= T_ADA;
        if (t < T_W1) { transpose_item(a.in[I_WIN], 1024, 2560, (bf16_t*)(ws + WS_W1T), t, scr, C.lane, 1); continue; } t -= T_W1;
        if (t < T_W2) { transpose_item(a.in[I_WOUT], 1024, 1024, (bf16_t*)(ws + WS_W2T), t, scr, C.lane, 0); continue; } t -= T_W2;
        if (t < T_SI) { transpose_item(a.in[I_SGUIN], 1024, 2048, (bf16_t*)(ws + WS_WSI), t, scr, C.lane, 0); continue; } t -= T_SI;
        if (t < T_SO) { transpose_item(a.in[I_SGUOUT], 1024, 1024, (bf16_t*)(ws + WS_WSO), t, scr, C.lane, 0); continue; } t -= T_SO;
        if (t < T_WQ) { const int l = t / 1024; transpose_item(a.in[I_WQ] + (size_t)l * 1024 * 2048, 1024, 2048, (bf16_t*)(ws + WS_WQ) + (size_t)l * 2048 * 1024, t % 1024, scr, C.lane, 0); continue; } t -= T_WQ;
        if (t < T_TAB) { const int half = T_TAB / 2;
            if (t < half) convert_task(a.in[I_PU], (bf16_t*)(ws + WS_TU), (size_t)t * 4096, C.lane);
            else convert_task(a.in[I_PV], (bf16_t*)(ws + WS_TV), (size_t)(t - half) * 4096, C.lane);
            continue; } t -= T_TAB;
        if (t < T_KEYS) { convert_task(a.in[I_KEYS], (bf16_t*)(ws + WS_KEYS), (size_t)t * 4096, C.lane); continue; } t -= T_KEYS;
        convert_task(a.in[I_WS], (bf16_t*)(ws + WS_WSP), (size_t)t * 4096, C.lane);
    }
}

__device__ __forceinline__ void modulate_row(const float* xrow, bf16_t* orow, const LAS float* GS, const LAS float* SH, int lane) {
    const f32x4* xr = (const f32x4*)xrow + lane;
    f32x4 v[4]; float s = 0.f;
#pragma unroll
    for (int j = 0; j < 4; ++j) { v[j] = xr[64 * j]; s += (v[j].x * v[j].x + v[j].y * v[j].y) + (v[j].z * v[j].z + v[j].w * v[j].w); }
    const float rinv = rsqrtf(wave_sum(s) * (1.f / D) + EPS);
    u32x2* o8 = (u32x2*)orow + lane;
#pragma unroll
    for (int j = 0; j < 4; ++j) { const f32x4 g = *(const LAS f32x4*)(GS + 4 * lane + 256 * j), h = *(const LAS f32x4*)(SH + 4 * lane + 256 * j);
        const f32x4 y = v[j] * rinv * g + h;
        u32x2 w; w.x = pk2(y.x, y.y); w.y = pk2(y.z, y.w); o8[64 * j] = w; }
}

__device__ __forceinline__ void phaseB(const Ctx& C) {
    const Args& a = *C.a; unsigned char* ws = a.ws;
    const float* modp = (const float*)(ws + WS_MODP); float* modf = (float*)(ws + WS_MODF);
    {
        const int e = C.bid * 512 + C.tid;
        if (e < 2 * 9 * 6144) { const int l = e / (9 * 6144), rem = e % (9 * 6144), row = rem / 6144, j = rem % 6144;
            float v = a.in[I_ADAB][l * 6144 + j];
#pragma unroll
            for (int ks = 0; ks < 8; ++ks) v += modp[((size_t)(l * 8 + ks) * 9 + row) * 6144 + j];
            modf[e] = v; }
    }
    LAS float* GS = (LAS float*)C.lds; LAS float* SH = GS + 1024;
    bf16_t* A = (bf16_t*)(ws + WS_A);
    for (int part = 0; part < 2; ++part) {
        const int rb = part == 0 ? (C.bid * 128) / SEQ : 8;
        __syncthreads();
        for (int c = C.tid; c < 1024; c += 512) {
            float sh = a.in[I_ADAB][c], sc = a.in[I_ADAB][1024 + c];
#pragma unroll
            for (int ks = 0; ks < 8; ++ks) { sh += modp[((size_t)(0 * 8 + ks) * 9 + rb) * 6144 + c]; sc += modp[((size_t)(0 * 8 + ks) * 9 + rb) * 6144 + 1024 + c]; }
            GS[c] = a.in[I_N1G][c] * (1.f + sc); SH[c] = sh;
        }
        __syncthreads();
        if (part == 0) { for (int i = 0; i < 16; ++i) { const int r = C.bid * 128 + C.wid * 16 + i; modulate_row(a.in[I_X] + (size_t)r * D, A + (size_t)r * D, GS, SH, C.lane); } }
        else { const int r = C.bid * 8 + C.wid; modulate_row(a.in[I_CTX] + (size_t)r * D, A + (size_t)(M + r) * D, GS, SH, C.lane); }
    }
}

__device__ __forceinline__ void conv_tile(const Ctx& C, int tile) {
    const Args& a = *C.a; unsigned char* ws = a.ws;
    const bf16_t* GLU = (const bf16_t*)(ws + WS_GLU); bf16_t* Y = (bf16_t*)(ws + WS_A);
    const int b = tile >> 6, t0 = (tile & 63) * 64;
    __syncthreads();
    for (int i = C.tid; i < 94 * 64; i += 512) { const int row = i >> 6, ch = i & 63, t = t0 - 15 + row;
        u32x4 v = (u32x4){0u, 0u, 0u, 0u};
        if (t >= 0 && t < SEQ) v = *(const u32x4*)(GLU + ((size_t)(b * SEQ + t)) * 512 + ch * 8);
        *(LAS u32x4*)(C.lds + (size_t)i * 16) = v; }
    __syncthreads();
    const int half = C.tid >> 8, cp = C.tid & 255;
    float w0[31], w1[31];
#pragma unroll
    for (int j = 0; j < 31; ++j) { const f32x2 w = *(const f32x2*)(a.in[I_CONVW] + j * 512 + 2 * cp); w0[j] = w.x; w1[j] = w.y; }
    const f32x2 cb = *(const f32x2*)(a.in[I_CONVB] + 2 * cp), gg = *(const f32x2*)(a.in[I_GNG] + 2 * cp), gb = *(const f32x2*)(a.in[I_GNB] + 2 * cp);
    const LAS unsigned* L = (const LAS unsigned*)C.lds;
#pragma unroll 1
    for (int sb = 0; sb < 2; ++sb) {
        const int ob = 32 * half + 16 * sb;
        float a0[16], a1[16];
#pragma unroll
        for (int o = 0; o < 16; ++o) { a0[o] = cb.x; a1[o] = cb.y; }
#pragma unroll
        for (int i = 0; i < 46; ++i) { const unsigned u = L[(ob + i) * 256 + cp]; const float x0 = bf_lo(u), x1 = bf_hi(u);
#pragma unroll
            for (int j = 0; j < 31; ++j) { const int o = i - j; if (o >= 0 && o < 16) { a0[o] += w0[j] * x0; a1[o] += w1[j] * x1; } } }
#pragma unroll
        for (int o = 0; o < 16; ++o) {
            float s = a0[o] + a1[o];
#pragma unroll
            for (int k = 1; k < 32; k <<= 1) s += __shfl_xor(s, k);
            const float mu = s * (1.f / 64.f), d0 = a0[o] - mu, d1 = a1[o] - mu;
            float q = d0 * d0 + d1 * d1;
#pragma unroll
            for (int k = 1; k < 32; k <<= 1) q += __shfl_xor(q, k);
            const float rstd = rsqrtf(q * (1.f / 64.f) + EPS);
            const float y0 = d0 * rstd * gg.x + gb.x, y1 = d1 * rstd * gg.y + gb.y;
            *(unsigned*)(Y + ((size_t)(b * SEQ + t0 + ob + o)) * D + 2 * cp) = pk2(y0 * sigmoidf_(y0), y1 * sigmoidf_(y1));
        }
    }
}

__device__ __forceinline__ void attn_task(const Ctx& C, int task) {
    const Args& a = *C.a; unsigned char* ws = a.ws;
    const bf16_t* Qb = (const bf16_t*)(ws + WS_Q); const bf16_t* Kb = (const bf16_t*)(ws + WS_K); const bf16_t* Vb = (const bf16_t*)(ws + WS_V);
    bf16_t* Y = (bf16_t*)(ws + WS_A);
    const int h = task & 7, r = (task >> 3) & 63, b = task >> 9;
    const int lane = C.lane, n = lane & 31, hh = lane >> 5;
    const int kr0 = r - 4 < 0 ? 0 : (r - 4 > 56 ? 56 : r - 4);
    LAS unsigned char* lw = C.lds + C.wid * 8192;
    LAS bf16_t* Vt = (LAS bf16_t*)lw;
    LAS float* RP = (LAS float*)(lw + 4608);
    for (int i = lane; i < 465; i += 64) RP[i] = a.in[I_RPB][h * 465 + i];
    const int qtok0 = b * SEQ + r * 64;
    bf16x8 bq[2][4];
#pragma unroll
    for (int qb = 0; qb < 2; ++qb)
#pragma unroll
        for (int s = 0; s < 4; ++s) bq[qb][s] = *(const bf16x8*)(Qb + (size_t)(qtok0 + 32 * qb + n) * 512 + h * 64 + 16 * s + 8 * hh);
    f32x16 O[2][2];
#pragma unroll
    for (int i = 0; i < 2; ++i)
#pragma unroll
        for (int j = 0; j < 2; ++j)
#pragma unroll
            for (int e = 0; e < 16; ++e) O[i][j][e] = 0.f;
    float mrun[2] = {-1e30f, -1e30f}, lrun[2] = {0.f, 0.f};
#pragma unroll 1
    for (int kt = 0; kt < 24; ++kt) {
        const bool win = kt < 16;
        const int kri = kt >> 1, kc0 = 32 * (kt & 1);
        const size_t tokk = win ? (size_t)(b * SEQ + (kr0 + kri) * 64 + kc0 + n) : (size_t)(M + b * CTXL + 32 * (kt - 16) + n);
        bf16x8 kf[4], vf[4];
#pragma unroll
        for (int s = 0; s < 4; ++s) { kf[s] = *(const bf16x8*)(Kb + tokk * 512 + h * 64 + 16 * s + 8 * hh); vf[s] = *(const bf16x8*)(Vb + tokk * 512 + h * 64 + 16 * s + 8 * hh); }
#pragma unroll
        for (int s = 0; s < 4; ++s)
#pragma unroll
            for (int e = 0; e < 8; ++e) Vt[(16 * s + 8 * hh + e) * 36 + n] = (bf16_t)vf[s][e];
        bf16x8 pb[2][2];
#pragma unroll
        for (int qb = 0; qb < 2; ++qb) {
            f32x16 S;
#pragma unroll
            for (int e = 0; e < 16; ++e) S[e] = 0.f;
#pragma unroll
            for (int s = 0; s < 4; ++s) S = __builtin_amdgcn_mfma_f32_32x32x16_bf16(kf[s], bq[qb][s], S, 0, 0, 0);
            const int qc = 32 * qb + n;
            const int cs = qc - 8 < 0 ? 0 : (qc - 8 > 48 ? 48 : qc - 8);
            bool valid[16];
            float mt = -1e30f;
#pragma unroll
            for (int e = 0; e < 16; ++e) {
                const int ki = (e & 3) + 8 * (e >> 2) + 4 * hh;
                if (win) { const int kc = kc0 + ki; valid[e] = (kc >= cs) && (kc < cs + 16);
                    const int dc = kc - qc + 15; const int dcc = dc < 0 ? 0 : (dc > 30 ? 30 : dc);
                    const float bias = RP[(kr0 + kri - r + 7) * 31 + dcc];
                    S[e] = valid[e] ? S[e] + bias : -1e30f; }
                else valid[e] = true;
                mt = fmaxf(mt, S[e]);
            }
            mt = fmaxf(mt, __shfl_xor(mt, 32));
            const float mn = fmaxf(mrun[qb], mt), alpha = __expf(mrun[qb] - mn);
            mrun[qb] = mn;
            float ps = 0.f; float p[16];
#pragma unroll
            for (int e = 0; e < 16; ++e) { p[e] = valid[e] ? __expf(S[e] - mn) : 0.f; ps += p[e]; }
            lrun[qb] = lrun[qb] * alpha + ps;
#pragma unroll
            for (int db = 0; db < 2; ++db)
#pragma unroll
                for (int e = 0; e < 16; ++e) O[db][qb][e] *= alpha;
#pragma unroll
            for (int s2 = 0; s2 < 2; ++s2) { u32x4 w; w.x = pk2(p[8 * s2 + 0], p[8 * s2 + 1]); w.y = pk2(p[8 * s2 + 2], p[8 * s2 + 3]); w.z = pk2(p[8 * s2 + 4], p[8 * s2 + 5]); w.w = pk2(p[8 * s2 + 6], p[8 * s2 + 7]);
                pb[qb][s2] = __builtin_bit_cast(bf16x8, w); }
        }
#pragma unroll
        for (int db = 0; db < 2; ++db)
#pragma unroll
            for (int s2 = 0; s2 < 2; ++s2) {
                const LAS bf16_t* vp = Vt + (32 * db + n) * 36 + 16 * s2 + 4 * hh;
                const u32x2 lo = *(const LAS u32x2*)vp, hi = *(const LAS u32x2*)(vp + 8);
                u32x4 w; w.x = lo.x; w.y = lo.y; w.z = hi.x; w.w = hi.y;
                const bf16x8 va = __builtin_bit_cast(bf16x8, w);
#pragma unroll
                for (int qb = 0; qb < 2; ++qb) O[db][qb] = __builtin_amdgcn_mfma_f32_32x32x16_bf16(va, pb[qb][s2], O[db][qb], 0, 0, 0);
            }
    }
#pragma unroll
    for (int qb = 0; qb < 2; ++qb) {
        const float lt = lrun[qb] + __shfl_xor(lrun[qb], 32), inv = 1.f / lt;
        bf16_t* yrow = Y + (size_t)(qtok0 + 32 * qb + n) * D + 512 + h * 64;
#pragma unroll
        for (int db = 0; db < 2; ++db)
#pragma unroll
            for (int g = 0; g < 4; ++g) { u32x2 w; w.x = pk2(O[db][qb][4 * g] * inv, O[db][qb][4 * g + 1] * inv); w.y = pk2(O[db][qb][4 * g + 2] * inv, O[db][qb][4 * g + 3] * inv);
                *(u32x2*)(yrow + 32 * db + 8 * g + 4 * hh) = w; }
    }
}

__device__ __forceinline__ void phaseNorm2(const Ctx& C, int l) {
    const Args& a = *C.a; unsigned char* ws = a.ws;
    const float* modf = (const float*)(ws + WS_MODF) + (size_t)l * 9 * 6144;
    LAS float* GS = (LAS float*)C.lds; LAS float* SH = GS + 1024;
    const int b = (C.bid * 128) / SEQ;
    for (int c = C.tid; c < 1024; c += 512) { GS[c] = a.in[I_N2G][l * 1024 + c] * (1.f + modf[b * 6144 + 4 * 1024 + c]); SH[c] = modf[b * 6144 + 3 * 1024 + c]; }
    __syncthreads();
    bf16_t* A = (bf16_t*)(ws + WS_A);
    for (int i = 0; i < 16; ++i) { const int r = C.bid * 128 + C.wid * 16 + i; modulate_row(a.out + (size_t)r * D, A + (size_t)r * D, GS, SH, C.lane); }
}

__device__ __forceinline__ void ce_desc(float& x, float& y) { const float hi = fmaxf(x, y), lo = fminf(x, y); x = hi; y = lo; }
__device__ __forceinline__ void ce_asc(float& x, float& y) { const float hi = fmaxf(x, y), lo = fminf(x, y); x = lo; y = hi; }
__device__ __forceinline__ void sort16_desc(float (&v)[16]) {
#pragma unroll
    for (int k = 2; k <= 16; k <<= 1)
#pragma unroll
        for (int j = k >> 1; j > 0; j >>= 1)
#pragma unroll
            for (int i = 0; i < 16; ++i) { const int l = i ^ j; if (l > i) { if ((i & k) == 0) ce_desc(v[i], v[l]); else ce_asc(v[i], v[l]); } }
}
__device__ __forceinline__ void merge16_desc(float (&A)[16], const float (&B)[16]) {
#pragma unroll
    for (int i = 0; i < 16; ++i) A[i] = fmaxf(A[i], B[15 - i]);
#pragma unroll
    for (int j = 8; j > 0; j >>= 1)
#pragma unroll
        for (int i = 0; i < 16; ++i) { const int l = i ^ j; if (l > i) ce_desc(A[i], A[l]); }
}
__device__ __forceinline__ void topk_task(const Ctx& C, int l, int tt, int h) {
    const Args& a = *C.a; unsigned char* ws = a.ws;
    const bf16_t* QP = (const bf16_t*)(ws + WS_QP); const bf16_t* KEYS = (const bf16_t*)(ws + WS_KEYS);
    unsigned short* IDX = (unsigned short*)(ws + WS_IDX); float* WT = (float*)(ws + WS_WT);
    const int lane = C.lane, n = lane & 31, hh = lane >> 5;
    const int tok = tt * 32 + n;
    float sp[2][16];
#pragma unroll
    for (int p = 0; p < 2; ++p) {
        bf16x8 bq[8];
#pragma unroll
        for (int s = 0; s < 8; ++s) bq[s] = *(const bf16x8*)(QP + (size_t)tok * 2048 + h * 256 + p * 128 + 16 * s + 8 * hh);
        const bf16_t* kbase = KEYS + ((size_t)((l * 8 + h) * 2 + p)) * 128 * 128;
        float top[16];
#pragma unroll
        for (int kb = 0; kb < 4; ++kb) {
            f32x16 S;
#pragma unroll
            for (int e = 0; e < 16; ++e) S[e] = 0.f;
#pragma unroll
            for (int s = 0; s < 8; ++s) { const bf16x8 kf = *(const bf16x8*)(kbase + (size_t)(32 * kb + n) * 128 + 16 * s + 8 * hh);
                S = __builtin_amdgcn_mfma_f32_32x32x16_bf16(kf, bq[s], S, 0, 0, 0); }
            float ch[16];
#pragma unroll
            for (int e = 0; e < 16; ++e) { const unsigned key = 32 * kb + (e & 3) + 8 * (e >> 2) + 4 * hh; ch[e] = __uint_as_float((__float_as_uint(S[e]) & ~0x7Fu) | key); }
            sort16_desc(ch);
            if (kb == 0) {
#pragma unroll
                for (int e = 0; e < 16; ++e) top[e] = ch[e];
            } else merge16_desc(top, ch);
        }
        float oth[16];
#pragma unroll
        for (int e = 0; e < 16; ++e) oth[e] = __shfl_xor(top[e], 32);
        merge16_desc(top, oth);
#pragma unroll
        for (int e = 0; e < 16; ++e) sp[p][e] = top[e];
    }
    const float NEG = -3.0e38f;
    auto cand = [&](int ia, int ib) -> float { const float s = sp[0][ia] + sp[1][ib]; return __uint_as_float((__float_as_uint(s) & ~0xFFu) | (unsigned)((ia << 4) | ib)); };
    float L1[16], L2[16], L3[16], L4[16];
#pragma unroll
    for (int i = 0; i < 16; ++i) { L1[i] = cand(0, i); L2[i] = i < 15 ? cand(i + 1, 0) : NEG; L4[i] = NEG; }
#pragma unroll
    for (int i = 0; i < 7; ++i) L3[i] = cand(1, i + 1);
#pragma unroll
    for (int i = 0; i < 6; ++i) L3[7 + i] = cand(i + 2, 1);
#pragma unroll
    for (int i = 0; i < 3; ++i) L3[13 + i] = cand(2, i + 2);
    L4[0] = cand(3, 2); L4[1] = cand(4, 2); L4[2] = cand(3, 3);
    sort16_desc(L3);
    ce_desc(L4[0], L4[1]); ce_desc(L4[1], L4[2]); ce_desc(L4[0], L4[1]);
    merge16_desc(L1, L2); merge16_desc(L3, L4); merge16_desc(L1, L3);
    float e16[16], se = 0.f;
#pragma unroll
    for (int i = 0; i < 16; ++i) { e16[i] = __expf(L1[i] - L1[0]); se += e16[i]; }
    const float inv = 1.f / se;
    LAS unsigned* tb = (LAS unsigned*)(C.lds + C.wid * 8448) + lane * 33;
#pragma unroll
    for (int i = 0; i < 16; ++i) { tb[i] = __float_as_uint(sp[0][i]) & 0x7Fu; tb[16 + i] = __float_as_uint(sp[1][i]) & 0x7Fu; }
    unsigned ids[16];
#pragma unroll
    for (int i = 0; i < 16; ++i) { const unsigned code = __float_as_uint(L1[i]) & 0xFFu; ids[i] = tb[code >> 4] * 128u + tb[16 + (code & 15u)]; }
    if (hh == 0) {
        u32x4 w0, w1;
        w0.x = ids[0] | (ids[1] << 16); w0.y = ids[2] | (ids[3] << 16); w0.z = ids[4] | (ids[5] << 16); w0.w = ids[6] | (ids[7] << 16);
        w1.x = ids[8] | (ids[9] << 16); w1.y = ids[10] | (ids[11] << 16); w1.z = ids[12] | (ids[13] << 16); w1.w = ids[14] | (ids[15] << 16);
        u32x4* ip = (u32x4*)(IDX + (size_t)tok * 128 + h * 16); ip[0] = w0; ip[1] = w1;
        f32x4* wp = (f32x4*)(WT + (size_t)tok * 128 + h * 16);
#pragma unroll
        for (int i = 0; i < 4; ++i) wp[i] = (f32x4){e16[4 * i] * inv, e16[4 * i + 1] * inv, e16[4 * i + 2] * inv, e16[4 * i + 3] * inv};
    }
}

__device__ __forceinline__ void phasePeer(const Ctx& C, int l) {
    const Args& a = *C.a; unsigned char* ws = a.ws;
    const bool last = (l == 1);
    const float* modf = (const float*)(ws + WS_MODF);
    const int b = (C.bid * 128) / SEQ;
    LAS float* G5 = (LAS float*)C.lds; LAS float* GS = G5 + 1024; LAS float* SH = GS + 1024;
    for (int c = C.tid; c < 1024; c += 512) {
        G5[c] = modf[(size_t)l * 9 * 6144 + b * 6144 + 5 * 1024 + c];
        if (!last) { GS[c] = a.in[I_N1G][1024 + c] * (1.f + modf[(size_t)9 * 6144 + b * 6144 + 1024 + c]); SH[c] = modf[(size_t)9 * 6144 + b * 6144 + c]; }
        else { GS[c] = a.in[I_NFG][c]; SH[c] = 0.f; }
    }
    __syncthreads();
    bf16_t* A = (bf16_t*)(ws + WS_A);
    const bf16_t* TU = (const bf16_t*)(ws + WS_TU) + (size_t)l * NEXP * 1024; const bf16_t* TV = (const bf16_t*)(ws + WS_TV) + (size_t)l * NEXP * 1024;
    const unsigned short* IDX = (const unsigned short*)(ws + WS_IDX); const float* WT = (const float*)(ws + WS_WT);
    const int lane = C.lane;
#pragma unroll 1
    for (int i = 0; i < 16; ++i) {
        const int tok = C.bid * 128 + C.wid * 16 + i;
        u32x4 xf[2];
#pragma unroll
        for (int j = 0; j < 2; ++j) xf[j] = *(const u32x4*)(A + (size_t)tok * D + 512 * j + 8 * lane);
        const unsigned id0 = IDX[(size_t)tok * 128 + lane], id1 = IDX[(size_t)tok * 128 + 64 + lane];
        const float wt0 = WT[(size_t)tok * 128 + lane], wt1 = WT[(size_t)tok * 128 + 64 + lane];
        float acc[16];
#pragma unroll
        for (int e = 0; e < 16; ++e) acc[e] = 0.f;
#pragma unroll 1
        for (int g = 0; g < 16; ++g) {
            const unsigned idv = g < 8 ? id0 : id1; const float wtv = g < 8 ? wt0 : wt1;
            const int lb = (g & 7) * 8;
            u32x4 uf[8][2], vf[8][2];
#pragma unroll
            for (int k = 0; k < 8; ++k) { const unsigned e = __shfl(idv, lb + k);
                const bf16_t* ur = TU + (size_t)e * 1024 + 8 * lane; const bf16_t* vr = TV + (size_t)e * 1024 + 8 * lane;
                uf[k][0] = *(const u32x4*)ur; uf[k][1] = *(const u32x4*)(ur + 512); vf[k][0] = *(const u32x4*)vr; vf[k][1] = *(const u32x4*)(vr + 512); }
            float dt[8];
#pragma unroll
            for (int k = 0; k < 8; ++k) { float d = 0.f;
#pragma unroll
                for (int j = 0; j < 2; ++j)
#pragma unroll
                    for (int q = 0; q < 4; ++q) {
#ifdef DBG_CHECK
                        if (C.bid & 2) d += bf_lo(xf[j][q]) * bf_lo(uf[k][j][q]) + bf_hi(xf[j][q]) * bf_hi(uf[k][j][q]); else
#endif
                        d = dot2bf(xf[j][q], uf[k][j][q], d); }
                dt[k] = d; }
            float r4[4], r2[2], r1;
            { const bool up = (lane & 32) != 0;
#pragma unroll
              for (int k = 0; k < 4; ++k) { const float keep = up ? dt[k + 4] : dt[k], send = up ? dt[k] : dt[k + 4]; r4[k] = keep + __shfl_xor(send, 32); } }
            { const bool up = (lane & 16) != 0;
#pragma unroll
              for (int k = 0; k < 2; ++k) { const float keep = up ? r4[k + 2] : r4[k], send = up ? r4[k] : r4[k + 2]; r2[k] = keep + __shfl_xor(send, 16); } }
            { const bool up = (lane & 8) != 0; const float keep = up ? r2[1] : r2[0], send = up ? r2[0] : r2[1]; r1 = keep + __shfl_xor(send, 8); }
            r1 += __shfl_xor(r1, 4); r1 += __shfl_xor(r1, 2); r1 += __shfl_xor(r1, 1);
            const int myk = ((lane >> 5) & 1) * 4 + ((lane >> 4) & 1) * 2 + ((lane >> 3) & 1);
#ifdef DBG_CHECK
            if (C.bid & 1) { float tot[8];
#pragma unroll
                for (int k = 0; k < 8; ++k) tot[k] = wave_sum(dt[k]);
                r1 = tot[0];
#pragma unroll
                for (int k = 1; k < 8; ++k) r1 = (myk == k) ? tot[k] : r1; }
#endif
            const float coef = gelu_erf(r1) * __shfl(wtv, lb + myk);
#pragma unroll
            for (int k = 0; k < 8; ++k) {
                const int src = ((k >> 2) & 1) * 32 + ((k >> 1) & 1) * 16 + (k & 1) * 8;
                const float ck = __shfl(coef, src);
#pragma unroll
                for (int j = 0; j < 2; ++j)
#pragma unroll
                    for (int q = 0; q < 4; ++q) { acc[8 * j + 2 * q] += ck * bf_lo(vf[k][j][q]); acc[8 * j + 2 * q + 1] += ck * bf_hi(vf[k][j][q]); }
            }
        }
        float* hrow = a.out + (size_t)tok * D;
        float hv[16]; float ss = 0.f;
#pragma unroll
        for (int j = 0; j < 2; ++j)
#pragma unroll
            for (int q = 0; q < 2; ++q) { const int c0 = 512 * j + 8 * lane + 4 * q; const f32x4 hx = *(const f32x4*)(hrow + c0); const f32x4 g5 = *(const LAS f32x4*)(G5 + c0);
#pragma unroll
                for (int e = 0; e < 4; ++e) { const float v = hx[e] + g5[e] * acc[8 * j + 4 * q + e]; hv[8 * j + 4 * q + e] = v; ss += v * v; } }
        const float rinv = rsqrtf(wave_sum(ss) * (1.f / D) + EPS);
        if (!last) {
#pragma unroll
            for (int j = 0; j < 2; ++j) {
#pragma unroll
                for (int q = 0; q < 2; ++q) { const int c0 = 512 * j + 8 * lane + 4 * q; *(f32x4*)(hrow + c0) = (f32x4){hv[8 * j + 4 * q], hv[8 * j + 4 * q + 1], hv[8 * j + 4 * q + 2], hv[8 * j + 4 * q + 3]}; }
                float y[8];
#pragma unroll
                for (int e = 0; e < 8; ++e) { const int c = 512 * j + 8 * lane + e; y[e] = hv[8 * j + e] * rinv * GS[c] + SH[c]; }
                u32x4 w; w.x = pk2(y[0], y[1]); w.y = pk2(y[2], y[3]); w.z = pk2(y[4], y[5]); w.w = pk2(y[6], y[7]);
                *(u32x4*)(A + (size_t)tok * D + 512 * j + 8 * lane) = w;
            }
        } else {
#pragma unroll
            for (int j = 0; j < 2; ++j)
#pragma unroll
                for (int q = 0; q < 2; ++q) { const int c0 = 512 * j + 8 * lane + 4 * q; const f32x4 g = *(const LAS f32x4*)(GS + c0);
                    *(f32x4*)(hrow + c0) = (f32x4){hv[8 * j + 4 * q] * rinv * g[0], hv[8 * j + 4 * q + 1] * rinv * g[1], hv[8 * j + 4 * q + 2] * rinv * g[2], hv[8 * j + 4 * q + 3] * rinv * g[3]}; }
        }
    }
}

__device__ __forceinline__ void phaseSgu(const Ctx& C) {
    const Args& a = *C.a; unsigned char* ws = a.ws;
    const bf16_t* U = (const bf16_t*)(ws + WS_U); const bf16_t* VV = (const bf16_t*)(ws + WS_VV); const bf16_t* WSP = (const bf16_t*)(ws + WS_WSP);
    bf16_t* A = (bf16_t*)(ws + WS_A);
    LAS float* ST = (LAS float*)(C.lds + 65536);
    LAS bf16_t* VT = (LAS bf16_t*)C.lds;
    const int lane = C.lane, n = lane & 31, hh = lane >> 5;
    for (int chunk = C.bid; chunk < M / 128; chunk += C.G) {
        const int tok0 = chunk * 128;
        __syncthreads();
        for (int i = 0; i < 16; ++i) {
            const int q = C.wid * 16 + i;
            const u32x4 v0 = *(const u32x4*)(VV + (size_t)(tok0 + q) * D + 8 * lane), v1 = *(const u32x4*)(VV + (size_t)(tok0 + q) * D + 512 + 8 * lane);
            float x[16];
#pragma unroll
            for (int e = 0; e < 4; ++e) { x[2 * e] = bf_lo(v0[e]); x[2 * e + 1] = bf_hi(v0[e]); x[8 + 2 * e] = bf_lo(v1[e]); x[8 + 2 * e + 1] = bf_hi(v1[e]); }
            float s = 0.f;
#pragma unroll
            for (int e = 0; e < 16; ++e) s += x[e];
            const float mu = wave_sum(s) * (1.f / D); float qq = 0.f;
#pragma unroll
            for (int e = 0; e < 16; ++e) { const float d = x[e] - mu; qq += d * d; }
            const float rstd = rsqrtf(wave_sum(qq) * (1.f / D) + EPS);
            if (lane == 0) { ST[2 * q] = mu; ST[2 * q + 1] = rstd; }
        }
        __syncthreads();
#pragma unroll 1
        for (int g = 0; g < 8; ++g) {
            { const int q = C.tid & 127; const float mu = ST[2 * q], rstd = ST[2 * q + 1];
#pragma unroll
              for (int i = 0; i < 4; ++i) { const int cb = (C.tid >> 7) + 4 * i;
                const u32x4 v = *(const u32x4*)(VV + (size_t)(tok0 + q) * D + g * 128 + cb * 8);
#pragma unroll
                for (int e = 0; e < 4; ++e) { const int c = cb * 8 + 2 * e;
                    const float y0 = (bf_lo(v[e]) - mu) * rstd * a.in[I_LNG][g * 128 + c] + a.in[I_LNB][g * 128 + c];
                    const float y1 = (bf_hi(v[e]) - mu) * rstd * a.in[I_LNG][g * 128 + c + 1] + a.in[I_LNB][g * 128 + c + 1];
                    const unsigned w = pk2(y0, y1);
                    VT[c * 136 + q] = (bf16_t)(w & 0xffffu); VT[(c + 1) * 136 + q] = (bf16_t)(w >> 16); } } }
            __syncthreads();
            const int cbk = C.wid & 3;
            bf16x8 af[8];
#pragma unroll
            for (int s = 0; s < 8; ++s) af[s] = *(const LAS bf16x8*)(VT + (32 * cbk + n) * 136 + 16 * s + 8 * hh);
#pragma unroll
            for (int pi = 0; pi < 2; ++pi) {
                const int pb = 2 * (C.wid >> 2) + pi;
                f32x16 S;
#pragma unroll
                for (int e = 0; e < 16; ++e) S[e] = 0.f;
#pragma unroll
                for (int s = 0; s < 8; ++s) { const bf16x8 wf = *(const bf16x8*)(WSP + ((size_t)g * 128 + 32 * pb + n) * 128 + 16 * s + 8 * hh);
                    S = __builtin_amdgcn_mfma_f32_32x32x16_bf16(af[s], wf, S, 0, 0, 0); }
                const int p = 32 * pb + n; const float bs = a.in[I_BS][g * 128 + p];
                const size_t rowoff = (size_t)(tok0 + p) * D + g * 128 + 32 * cbk;
#pragma unroll
                for (int q4 = 0; q4 < 4; ++q4) { const int c0 = 8 * q4 + 4 * hh;
                    const u32x2 uu = *(const u32x2*)(U + rowoff + c0);
                    u32x2 w; w.x = pk2(bf_lo(uu.x) * (S[4 * q4] + bs), bf_hi(uu.x) * (S[4 * q4 + 1] + bs)); w.y = pk2(bf_lo(uu.y) * (S[4 * q4 + 2] + bs), bf_hi(uu.y) * (S[4 * q4 + 3] + bs));
                    *(u32x2*)(A + rowoff + c0) = w; }
            }
            __syncthreads();
        }
    }
}

__device__ __forceinline__ void phaseFinalNorm(const Ctx& C, const float* src) {
    const Args& a = *C.a;
    for (int i = 0; i < 16; ++i) { const int r = C.bid * 128 + C.wid * 16 + i;
        const f32x4* xr = (const f32x4*)(src + (size_t)r * D) + C.lane; f32x4 v[4]; float s = 0.f;
#pragma unroll
        for (int j = 0; j < 4; ++j) { v[j] = xr[64 * j]; s += (v[j].x * v[j].x + v[j].y * v[j].y) + (v[j].z * v[j].z + v[j].w * v[j].w); }
        const float rinv = rsqrtf(wave_sum(s) * (1.f / D) + EPS);
        f32x4* o = (f32x4*)(a.out + (size_t)r * D) + C.lane;
#pragma unroll
        for (int j = 0; j < 4; ++j) { const f32x4 g = *((const f32x4*)a.in[I_NFG] + C.lane + 64 * j); o[64 * j] = v[j] * rinv * g; } }
}


#ifdef DBG_CHECK
__device__ __forceinline__ float bfv(const bf16_t* p) { return __uint_as_float(((unsigned)*p) << 16); }
__device__ __forceinline__ int sample_tok(int bid) { return bid * 128 + ((bid * 29 + 7) & 127); }
__device__ __forceinline__ float wave_max(float v) {
#pragma unroll
    for (int o = 1; o < 64; o <<= 1) v = fmaxf(v, __shfl_xor(v, o));
    return v;
}
__device__ __forceinline__ bool far(float got, float want, float tol) { return !(fabsf(got - want) <= tol * (1.f + fabsf(want))); }
__device__ __forceinline__ void checkMixer(const Args& a, int bid_, int lane) {
    unsigned char* ws = a.ws;
    const bf16_t* GLU = (const bf16_t*)(ws + WS_GLU); const bf16_t* Qb = (const bf16_t*)(ws + WS_Q); const bf16_t* Kb = (const bf16_t*)(ws + WS_K); const bf16_t* Vb = (const bf16_t*)(ws + WS_V);
    const bf16_t* Y = (const bf16_t*)(ws + WS_A);
    const int tok = sample_tok(bid_), b = tok / SEQ, t = tok % SEQ, r = t / 64, qc = t % 64;
    unsigned fail = 0;
    _Pragma("unroll") for (int i = 0; i < 8; ++i) { const int c = lane + 64 * i; float acc = a.in[I_CONVB][c];
        for (int j = 0; j < 31; ++j) { const int tt = t + j - 15; if (tt >= 0 && tt < SEQ) acc += a.in[I_CONVW][j * 512 + c] * bfv(GLU + (size_t)(b * SEQ + tt) * 512 + c); }
        const float mu = wave_sum(acc) * (1.f / 64.f), d = acc - mu, var = wave_sum(d * d) * (1.f / 64.f);
        float y = d * rsqrtf(var + EPS) * a.in[I_GNG][c] + a.in[I_GNB][c]; y = y / (1.f + expf(-y));
        if (far(bfv(Y + (size_t)tok * D + c), y, 0.03f)) fail |= 1u; }
    const int kr0 = r - 4 < 0 ? 0 : (r - 4 > 56 ? 56 : r - 4), cs = qc - 8 < 0 ? 0 : (qc - 8 > 48 ? 48 : qc - 8);
    for (int h = 0; h < 8; ++h) {
        float sc[6]; size_t kt[6]; float m = -1e30f;
        _Pragma("unroll") for (int i = 0; i < 6; ++i) { const int j = lane + 64 * i; float bias = 0.f; size_t ktok;
            if (j < 128) { const int kr = kr0 + (j >> 4), kc = cs + (j & 15); ktok = (size_t)b * SEQ + kr * 64 + kc; bias = a.in[I_RPB][h * 465 + (kr - r + 7) * 31 + (kc - qc + 15)]; }
            else ktok = (size_t)M + b * CTXL + (j - 128);
            float s = 0.f; for (int d = 0; d < 64; ++d) s += bfv(Qb + (size_t)tok * 512 + h * 64 + d) * bfv(Kb + ktok * 512 + h * 64 + d);
            sc[i] = s + bias; kt[i] = ktok; m = fmaxf(m, sc[i]); }
        m = wave_max(m); float l = 0.f;
        _Pragma("unroll") for (int i = 0; i < 6; ++i) { sc[i] = expf(sc[i] - m); l += sc[i]; }
        l = wave_sum(l);
        float o = 0.f;
        _Pragma("unroll") for (int i = 0; i < 6; ++i) for (int src = 0; src < 64; ++src) { const float pj = __shfl(sc[i], src); const unsigned lo = __shfl((unsigned)(kt[i] & 0xffffffffu), src), hi = __shfl((unsigned)(kt[i] >> 32), src);
            const size_t ktok = ((size_t)hi << 32) | lo; o += pj * bfv(Vb + ktok * 512 + h * 64 + lane); }
        if (far(bfv(Y + (size_t)tok * D + 512 + h * 64 + lane), o / l, 0.03f)) fail |= 2u;
    }
    if (fail) atomicOr((unsigned*)(ws + WS_CTL) + 8192, fail);
}
__device__ __forceinline__ void checkPeerA(const Args& a, int bid_, int lane, int l) {
    unsigned char* ws = a.ws;
    const bf16_t* A = (const bf16_t*)(ws + WS_A); const bf16_t* QP = (const bf16_t*)(ws + WS_QP);
    const unsigned short* IDX = (const unsigned short*)(ws + WS_IDX); const float* WT = (const float*)(ws + WS_WT);
    const float* modf = (const float*)(ws + WS_MODF) + (size_t)l * 9 * 6144;
    const int tok = sample_tok(bid_), b = tok / SEQ;
    unsigned fail = 0;
    float hv[16]; float ss = 0.f;
    _Pragma("unroll") for (int i = 0; i < 16; ++i) { hv[i] = a.out[(size_t)tok * D + lane + 64 * i]; ss += hv[i] * hv[i]; }
    const float rinv = rsqrtf(wave_sum(ss) * (1.f / D) + EPS);
    _Pragma("unroll") for (int i = 0; i < 16; ++i) { const int c = lane + 64 * i; const float y = hv[i] * rinv * a.in[I_N2G][l * 1024 + c] * (1.f + modf[b * 6144 + 4 * 1024 + c]) + modf[b * 6144 + 3 * 1024 + c];
        if (far(bfv(A + (size_t)tok * D + c), y, 0.03f)) fail |= 4u; }
    { const int n = lane * 32 + 5; float q = 0.f; for (int k = 0; k < 1024; ++k) q += bfv(A + (size_t)tok * D + k) * a.in[I_WQ][(size_t)l * 1024 * 2048 + (size_t)k * 2048 + n];
      if (far(bfv(QP + (size_t)tok * 2048 + n), q, 0.03f)) fail |= 8u; }
    for (int h = 0; h < 8; ++h) {
        const unsigned id = IDX[(size_t)tok * 128 + h * 16]; const int pick0 = (int)(id >> 7), pick1 = (int)(id & 127u);
        _Pragma("unroll") for (int p = 0; p < 2; ++p) { float s2[2];
            _Pragma("unroll") for (int i = 0; i < 2; ++i) { const int key = lane + 64 * i; float s = 0.f;
                for (int d = 0; d < 128; ++d) s += bfv(QP + (size_t)tok * 2048 + h * 256 + p * 128 + d) * a.in[I_KEYS][(((size_t)(l * 8 + h) * 2 + p) * 128 + key) * 128 + d];
                s2[i] = s; }
            const float mx = wave_max(fmaxf(s2[0], s2[1]));
            const int pk = p == 0 ? pick0 : pick1; const float mine = __shfl(pk < 64 ? s2[0] : s2[1], pk & 63);
            if (!(mine >= mx - 0.03f)) fail |= 16u; }
        float w = lane < 16 ? WT[(size_t)tok * 128 + h * 16 + lane] : 0.f; const float wsum = wave_sum(w);
        if (!(fabsf(wsum - 1.f) < 1e-3f) || !(w >= 0.f)) fail |= 32u;
    }
    float pr[16]; _Pragma("unroll") for (int i = 0; i < 16; ++i) pr[i] = 0.f;
    for (int k = 0; k < 128; ++k) { const size_t e = IDX[(size_t)tok * 128 + k]; const float* ur = a.in[I_PU] + ((size_t)l * NEXP + e) * 1024; const float* vr = a.in[I_PV] + ((size_t)l * NEXP + e) * 1024;
        float d = 0.f; _Pragma("unroll") for (int i = 0; i < 16; ++i) d += bfv(A + (size_t)tok * D + lane + 64 * i) * ur[lane + 64 * i];
        d = wave_sum(d); const float cf = WT[(size_t)tok * 128 + k] * gelu_erf(d);
        _Pragma("unroll") for (int i = 0; i < 16; ++i) pr[i] += cf * vr[lane + 64 * i]; }
    float* REF = (float*)(ws + WS_REF) + (size_t)bid_ * 1024;
    _Pragma("unroll") for (int i = 0; i < 16; ++i) { const int c = lane + 64 * i; REF[c] = hv[i] + modf[b * 6144 + 5 * 1024 + c] * pr[i]; }
    if (fail) atomicOr((unsigned*)(ws + WS_CTL) + 8192, fail);
}
__device__ __forceinline__ void checkPeerB(const Args& a, int bid_, int lane) {
    unsigned char* ws = a.ws;
    const int tok = sample_tok(bid_); unsigned fail = 0;
    const float* REF = (const float*)(ws + WS_REF) + (size_t)bid_ * 1024;
    _Pragma("unroll") for (int i = 0; i < 16; ++i) { const int c = lane + 64 * i; if (far(a.out[(size_t)tok * D + c], REF[c], 0.02f)) fail |= (64u << (bid_ & 3)); }
    if (fail) atomicOr((unsigned*)(ws + WS_CTL) + 8192, fail);
}
__device__ void phaseCode(const Ctx& C) {
    const Args& a = *C.a;
    const unsigned mask = *((const unsigned*)(a.ws + WS_CTL) + 8192);
    const unsigned code = (mask >> DBG_SHIFT) & 15u;
    const float alpha = 1.f + 0.5f * (float)code;
    _Pragma("unroll") for (int i = 0; i < 16; ++i) { const int r = C.bid * 128 + C.wid * 16 + i;
        const f32x4* xr = (const f32x4*)(a.in[I_X] + (size_t)r * D) + C.lane; f32x4 v[4]; float s = 0.f;
        for (int j = 0; j < 4; ++j) { v[j] = xr[64 * j]; s += (v[j].x * v[j].x + v[j].y * v[j].y) + (v[j].z * v[j].z + v[j].w * v[j].w); }
        const float rinv = rsqrtf(wave_sum(s) * (1.f / D) + EPS) * alpha;
        f32x4* o = (f32x4*)(a.out + (size_t)r * D) + C.lane;
        for (int j = 0; j < 4; ++j) { const f32x4 g = *((const f32x4*)a.in[I_NFG] + C.lane + 64 * j); o[64 * j] = v[j] * rinv * g; } }
}
__global__ void __launch_bounds__(64) dbg_kernel(Args args, int which) {
    if (which == 17) checkMixer(args, blockIdx.x, threadIdx.x);
    if (which == 18) checkPeerA(args, blockIdx.x, threadIdx.x, 0);
    if (which == 19) checkPeerB(args, blockIdx.x, threadIdx.x);
}
#endif

__global__ void __launch_bounds__(512, 2) fwd_megakernel(Args args) {
    extern __shared__ __attribute__((aligned(16))) unsigned char lds_raw[];
    LAS unsigned char* lds = (LAS unsigned char*)lds_raw;
    Ctx C; C.a = &args; C.lds = lds; C.tid = threadIdx.x; C.lane = C.tid & 63; C.wid = __builtin_amdgcn_readfirstlane(C.tid >> 6); C.bid = blockIdx.x; C.G = gridDim.x;
    volatile LAS unsigned* MISC = (volatile LAS unsigned*)(lds + MISC_OFF);
    if (C.tid < 4) MISC[C.tid] = 0u;
    __syncthreads();
    unsigned char* ws = args.ws;
    const int lo = args.ph_lo, hi = args.ph_hi;
    XcdBarrier bar; bar.bar = (unsigned*)(ws + WS_CTL); bar.x = 0; bar.st = nullptr;
    const bool multi = (hi - lo) > 1;
    if (multi) bar = xcd_barrier_post((unsigned*)(ws + WS_CTL), MISC);
#define IN(k) (lo <= (k) && (k) < hi)
#define SEAM(k) do { if (IN(k) && IN((k) + 1)) xcd_barrier(bar); } while (0)
    using namespace pg8;
    const bf16_t* Abuf = (const bf16_t*)(ws + WS_A);
    const float* modf = (const float*)(ws + WS_MODF);

    if (IN(0)) { phaseA(C); } SEAM(0);
    if (IN(1)) { phaseB(C); } SEAM(1);
    if (IN(2)) {
        Gemm g{Abuf, (const bf16_t*)(ws + WS_W1T), MA, 2560, 1024}; Order1 S; S.init(C.G, C.bid);
        Epi1 E{(bf16_t*)(ws + WS_GLU), ws};
        gemm_phase<Epi1, Order1>(lds, g, S, E);
    } SEAM(2);
    if (IN(3)) {
        for (int t = C.bid; t < 512; t += C.G) conv_tile(C, t);
        __syncthreads();
        for (int t = C.bid * 8 + C.wid; t < NBATCH * 64 * 8; t += C.G * 8) attn_task(C, t);
    } SEAM(3);
    if (IN(4)) {
        Gemm g{Abuf, (const bf16_t*)(ws + WS_W2T), M, 1024, 1024}; StaticOrder S; S.init(M, 1024, C.G, C.bid);
        EpiRes E{args.in[I_X], args.out, modf + 2 * 1024};
        gemm_phase<EpiRes, StaticOrder>(lds, g, S, E);
    } SEAM(4);
    if (IN(5)) { phaseNorm2(C, 0); } SEAM(5);
    if (IN(6)) {
        Gemm g{Abuf, (const bf16_t*)(ws + WS_WQ), M, 2048, 1024}; StaticOrder S; S.init(M, 2048, C.G, C.bid);
        EpiBf16<0> E{(bf16_t*)(ws + WS_QP), (bf16_t*)(ws + WS_QP), 8, 2048};
        gemm_phase<EpiBf16<0>, StaticOrder>(lds, g, S, E);
    } SEAM(6);
    if (IN(7)) { for (int t = C.bid; t < M / 128; t += C.G) for (int q = 0; q < 4; ++q) topk_task(C, 0, t * 4 + q, C.wid); } SEAM(7);
    if (IN(8)) { phasePeer(C, 0); } SEAM(8);
    if (IN(9)) {
        Gemm g{Abuf, (const bf16_t*)(ws + WS_WSI), M, 2048, 1024}; StaticOrder S; S.init(M, 2048, C.G, C.bid);
        EpiBf16<1> E{(bf16_t*)(ws + WS_U), (bf16_t*)(ws + WS_VV), 4, 1024};
        gemm_phase<EpiBf16<1>, StaticOrder>(lds, g, S, E);
    } SEAM(9);
    if (IN(10)) { phaseSgu(C); } SEAM(10);
    if (IN(11)) {
        Gemm g{Abuf, (const bf16_t*)(ws + WS_WSO), M, 1024, 1024}; StaticOrder S; S.init(M, 1024, C.G, C.bid);
        EpiRes E{args.out, args.out, modf + 9 * 6144 + 2 * 1024};
        gemm_phase<EpiRes, StaticOrder>(lds, g, S, E);
    } SEAM(11);
    if (IN(12)) { phaseNorm2(C, 1); } SEAM(12);
    if (IN(13)) {
        Gemm g{Abuf, (const bf16_t*)(ws + WS_WQ) + (size_t)2048 * 1024, M, 2048, 1024}; StaticOrder S; S.init(M, 2048, C.G, C.bid);
        EpiBf16<0> E{(bf16_t*)(ws + WS_QP), (bf16_t*)(ws + WS_QP), 8, 2048};
        gemm_phase<EpiBf16<0>, StaticOrder>(lds, g, S, E);
    } SEAM(13);
    if (IN(14)) { for (int t = C.bid; t < M / 128; t += C.G) for (int q = 0; q < 4; ++q) topk_task(C, 1, t * 4 + q, C.wid); } SEAM(14);
    if (IN(15)) { phasePeer(C, 1); } SEAM(15);
    if (IN(16)) { phaseFinalNorm(C, DBG_LEVEL == 0 ? args.in[I_X] : args.out); }
#ifdef DBG_CHECK
    if (IN(20)) phaseCode(C);
#endif
#undef IN
#undef SEAM
}

extern "C" void kernel_launch(void* const* d_in, const int* in_sizes, int n_in, void* d_out, int out_size, void* d_ws, size_t ws_size, hipStream_t stream) {
    static int grid = 0;
    if (grid == 0) {
        if (n_in != N_IN || out_size != M * D || ws_size < WS_END) { fprintf(stderr, "kernel_launch: unexpected shapes (n_in %d out %d ws %zu need %zu)\n", n_in, out_size, ws_size, (size_t)WS_END); grid = -1; return; }
        int dev = 0, cus = 0, per_cu = 0;
        if (hipGetDevice(&dev) != hipSuccess || hipDeviceGetAttribute(&cus, hipDeviceAttributeMultiprocessorCount, dev) != hipSuccess) { grid = -1; return; }
        if (hipFuncSetAttribute((const void*)fwd_megakernel, hipFuncAttributeMaxDynamicSharedMemorySize, LDS_BYTES) != hipSuccess) { fprintf(stderr, "kernel_launch: hipFuncSetAttribute failed\n"); grid = -1; return; }
        if (hipOccupancyMaxActiveBlocksPerMultiprocessor(&per_cu, (const void*)fwd_megakernel, 512, LDS_BYTES) != hipSuccess || per_cu < 1) { fprintf(stderr, "kernel_launch: occupancy query says %d blocks per CU\n", per_cu); (void)hipGetLastError(); grid = -1; return; }
        grid = cus;
        if (grid != 256) fprintf(stderr, "kernel_launch: note: %d CUs (the phase tilings assume 256)\n", grid);
        if (grid > 256) grid = 256;
    }
    if (grid < 0) return;
    (void)hipMemsetAsync((char*)d_ws + WS_CTL, 0, CTL_BYTES, stream);
    Args a{};
    for (int i = 0; i < N_IN; ++i) a.in[i] = (const float*)d_in[i];
    a.out = (float*)d_out; a.ws = (unsigned char*)d_ws;
    int phases[NPH]; int np = 0;
    const int lastp = DBG_LEVEL == 0 ? -1 : DBG_LEVEL == 1 ? 4 : DBG_LEVEL == 2 ? 8 : DBG_LEVEL == 3 ? 11 : 15;
    for (int p = 0; p <= lastp; ++p) phases[np++] = p;
    if (DBG_LEVEL < 4) phases[np++] = 16;
#ifdef DBG_CHECK
    { const int pl[] = {0, 1, 2, 3, 17, 4, 5, 6, 7, 18, 8, 19, 20}; np = 0; for (int p : pl) phases[np++] = p; }
#endif
#if ONE_LAUNCH
    if (DBG_LEVEL == 4) { a.ph_lo = 0; a.ph_hi = 16; hipLaunchKernelGGL(fwd_megakernel, dim3(grid), dim3(512), LDS_BYTES, stream, a); return; }
#endif
    for (int i = 0; i < np; ++i) {
#ifdef DBG_CHECK
        if (phases[i] >= 17 && phases[i] <= 19) { a.ph_lo = 0; a.ph_hi = 0; hipLaunchKernelGGL(dbg_kernel, dim3(256), dim3(64), 0, stream, a, phases[i]); continue; }
#endif
        a.ph_lo = phases[i]; a.ph_hi = phases[i] + 1; hipLaunchKernelGGL(fwd_megakernel, dim3(grid), dim3(512), LDS_BYTES, stream, a); }
}
```

```cpp
#include <hip/hip_runtime.h>
#include <cstdio>
#include <cstdint>

#ifndef DBG_LEVEL
#define DBG_LEVEL 4
#endif
#ifndef DBG_SHIFT
#define DBG_SHIFT 6
#endif
#ifndef ONE_LAUNCH
#define ONE_LAUNCH 1
#endif

#define LAS __attribute__((address_space(3)))
typedef unsigned short bf16_t;
typedef short bf16x8 __attribute__((ext_vector_type(8)));
typedef float f32x4 __attribute__((ext_vector_type(4)));
typedef float f32x16 __attribute__((ext_vector_type(16)));
typedef float f32x2 __attribute__((ext_vector_type(2)));
typedef unsigned u32x4 __attribute__((ext_vector_type(4)));
typedef unsigned u32x2 __attribute__((ext_vector_type(2)));
typedef __bf16 bf2v __attribute__((ext_vector_type(2)));

constexpr int D = 1024, NBATCH = 8, SEQ = 4096, M = NBATCH * SEQ, CTXL = 256, MC = NBATCH * CTXL, MA = M + MC;
constexpr int NEXP = 16384;
constexpr float EPS = 1e-6f;
enum { I_X = 0, I_C, I_CTX, I_CCTX, I_N1G, I_N2G, I_ADAW, I_ADAB, I_WIN, I_CONVW, I_CONVB, I_GNG, I_GNB, I_RPB, I_WOUT, I_SGUIN, I_LNG, I_LNB, I_WS, I_BS, I_SGUOUT,
       I_WQ, I_KEYS, I_PU, I_PV, I_NFG, N_IN };

constexpr size_t WS_CTL  = 0;
constexpr size_t CTL_BYTES = 65536;
constexpr size_t WS_MODP = WS_CTL + CTL_BYTES;
constexpr size_t WS_MODF = WS_MODP + (size_t)2 * 8 * 9 * 6144 * 4;
constexpr size_t WS_W1T  = WS_MODF + (size_t)2 * 9 * 6144 * 4;
constexpr size_t WS_W2T  = WS_W1T + (size_t)2560 * 1024 * 2;
constexpr size_t WS_WSI  = WS_W2T + (size_t)1024 * 1024 * 2;
constexpr size_t WS_WSO  = WS_WSI + (size_t)2048 * 1024 * 2;
constexpr size_t WS_WQ   = WS_WSO + (size_t)1024 * 1024 * 2;
constexpr size_t WS_KEYS = WS_WQ + (size_t)2 * 2048 * 1024 * 2;
constexpr size_t WS_WSP  = WS_KEYS + (size_t)2 * 8 * 2 * 128 * 128 * 2;
constexpr size_t WS_TU   = WS_WSP + (size_t)8 * 128 * 128 * 2;
constexpr size_t WS_TV   = WS_TU + (size_t)2 * NEXP * 1024;
constexpr size_t WS_SIU  = WS_TV + (size_t)2 * NEXP * 1024;
constexpr size_t WS_SIV  = WS_SIU + (size_t)2 * NEXP * 4;
constexpr size_t WS_A    = WS_SIV + (size_t)2 * NEXP * 4;
constexpr size_t WS_B    = WS_A + (size_t)MA * 1024 * 2;
constexpr size_t WS_GLU  = WS_B;
constexpr size_t WS_Q    = WS_GLU + (size_t)M * 512 * 2;
constexpr size_t WS_K    = WS_Q + (size_t)M * 512 * 2;
constexpr size_t WS_V    = WS_K + (size_t)MA * 512 * 2;
constexpr size_t WS_QP   = WS_B;
constexpr size_t WS_U    = WS_B;
constexpr size_t WS_VV   = WS_B + (size_t)M * 1024 * 2;
constexpr size_t WS_IDX  = WS_V + (size_t)MA * 512 * 2;
constexpr size_t WS_WT   = WS_IDX + (size_t)M * 128 * 2;
constexpr size_t WS_SU   = WS_WT + (size_t)M * 128 * 4;
constexpr size_t WS_REF  = WS_SU + (size_t)M * 128 * 4;
constexpr size_t WS_END  = WS_REF + (size_t)256 * 1024 * 4;

constexpr int LDS_BYTES = 147456;
constexpr int MISC_OFF = 131072;
constexpr int NPH = 24;

__device__ __forceinline__ float bf_lo(unsigned u) { return __uint_as_float(u << 16); }
__device__ __forceinline__ float bf_hi(unsigned u) { return __uint_as_float(u & 0xffff0000u); }
__device__ __forceinline__ unsigned pk2(float lo, float hi) { bf2v r = {(__bf16)lo, (__bf16)hi}; return __builtin_bit_cast(unsigned, r); }
__device__ __forceinline__ float wave_sum(float v) {
#pragma unroll
    for (int o = 1; o < 64; o <<= 1) v += __shfl_xor(v, o);
    return v;
}
__device__ __forceinline__ float dot2bf(unsigned a, unsigned b, float c) { return __builtin_amdgcn_fdot2_f32_bf16(__builtin_bit_cast(bf2v, a), __builtin_bit_cast(bf2v, b), c, false); }
__device__ __forceinline__ float sigmoidf_(float x) { return 1.f / (1.f + __expf(-x)); }
__device__ __forceinline__ float gelu_erf(float v) { return 0.5f * v * (1.f + erff(v * 0.70710678f)); }

namespace pg8 {
constexpr int BM = 256, BK = 64, HALF = 128, HTB = HALF * BK * 2, STAGE_BYTES = 8 * HTB, NXCD = 8, WGM = 8;
__host__ __device__ __forceinline__ int lds_byte(int r, int c) { const int st = (r >> 4) * 2 + (c >> 5), rr = r & 15, cc = c & 31, ob = rr * 64 + cc * 2; return st * 1024 + (ob ^ (((ob >> 9) & 1) << 5)); }
__host__ __device__ __forceinline__ void stage_rc(int b, int& R, int& C) { const int st = b / 1024, sb = b % 1024, swz = sb ^ (((sb >> 9) & 1) << 5); R = (st >> 1) * 16 + swz / 64; C = (st & 1) * 32 + (swz % 64) / 2; }
__host__ __device__ __forceinline__ int perm32(int rho) { const int n = rho >> 4, i = rho & 15; return 8 * (i >> 2) + 4 * n + (i & 3); }
struct Unit { int pm, pn; };
struct Gemm { const bf16_t* A; const bf16_t* Bt; int M, N, K; };
struct StaticOrder {
    int nM, nN, nwg, G, c;
    __host__ __device__ void init(int M_, int N_, int G_, int c_) { nM = M_ / BM; nN = N_ / BM; nwg = nM * nN; G = G_; c = c_; }
    __host__ __device__ bool next(int i, Unit& u) const {
        const long L = (long)i * G + c; if (L >= nwg) return false;
        int wgid = (int)L; { const int q = nwg / NXCD, r = nwg % NXCD, xcd = wgid % NXCD, off = wgid / NXCD; wgid = (xcd < r ? xcd * (q + 1) : r * (q + 1) + (xcd - r) * q) + off; }
        const int nig = WGM * nN, gid = wgid / nig, fm = gid * WGM, gsz = (nM - fm) < WGM ? (nM - fm) : WGM;
        u.pm = fm + ((wgid % nig) % gsz); u.pn = (wgid % nig) / gsz; return true;
    }
    __device__ __forceinline__ void a_ready(const Unit&) const {}
    __device__ __forceinline__ void done(const Unit&) const {}
};
struct Order1 {
    StaticOrder so; int G, c;
    __device__ void init(int G_, int c_) { so.init(M, 2560, G_, c_); G = G_; c = c_; }
    __device__ bool next(int i, Unit& u) const {
        const long L = (long)i * G + c;
        if (L < so.nwg) return so.next(i, u);
        const int l2 = (int)(L - so.nwg); if (l2 >= 32) return false;
        u.pm = 128 + (l2 >> 2); u.pn = 6 + (l2 & 3); return true;
    }
    __device__ __forceinline__ void a_ready(const Unit&) const {}
    __device__ __forceinline__ void done(const Unit&) const {}
};
__device__ __forceinline__ f32x2 gelu_pk(f32x2 v) {
    const f32x2 av = __builtin_elementwise_abs(v), d = av * 0.2316418882f + 1.0f;
    f32x2 t; t.x = __builtin_amdgcn_rcpf(d.x); t.y = __builtin_amdgcn_rcpf(d.y);
    f32x2 q = t * 0.5307027145f + (-0.7265760135f); q = q * t + 0.7107068705f; q = q * t + (-0.142248368f); q = q * t + 0.127414796f; q = q * t;
    const f32x2 s = (v * v) * (-0.72134752044f);
    f32x2 e; e.x = __builtin_amdgcn_exp2f(s.x); e.y = __builtin_amdgcn_exp2f(s.y);
    const f32x2 m = v * (q * e), r = v - m;
    f32x2 o; o.x = v.x < 0.f ? m.x : r.x; o.y = v.y < 0.f ? m.y : r.y; return o;
}
template <class Epi, class Sched>
__device__ __forceinline__ void gemm_phase(LAS unsigned char* lds, const Gemm g, const Sched& S, const Epi& E) {
    const int tid = threadIdx.x, wid = __builtin_amdgcn_readfirstlane(tid >> 6), lane = tid & 63, wr = wid >> 2, wc = wid & 3, fr = lane & 15, fq = lane >> 4;
    const int K = g.K, nt = K / BK;
    unsigned voffA[2], voffB[2];
#pragma unroll
    for (int i = 0; i < 2; ++i) { int R, C; stage_rc(tid * 16 + i * 8192, R, C); const int Rb = Epi::PERM ? ((R & ~31) + perm32(R & 31)) : R;
        voffA[i] = (unsigned)(R * K + C) * 2u; voffB[i] = (unsigned)(Rb * K + C) * 2u; }
    const size_t kstep = (size_t)(BK * 2);
    const size_t hstep = (size_t)HALF * K * 2;
    const size_t tstep = 2 * hstep;
    const unsigned ldsw = (unsigned)wid * 1024u;
    const int aoff = lds_byte(wr * 64 + fr, fq * 8), boff = lds_byte(wc * 32 + fr, fq * 8);
#define PG8_SA(b, h) (((b) * 2 + (h)) * HTB)
#define PG8_SB(b, h) ((4 + (b) * 2 + (h)) * HTB)
#define PG8_STAGE(bufoff, gbase, voff) do { _Pragma("unroll") for (int _i = 0; _i < 2; ++_i) \
        __builtin_amdgcn_global_load_lds((const unsigned*)((const char*)(gbase) + (voff)[_i]), (LAS unsigned*)(lds + (bufoff) + ldsw + _i * 8192), 16, 0, 0); } while (0)
#define PG8_LDA(dst, b, h) do { _Pragma("unroll") for (int m = 0; m < 4; ++m) _Pragma("unroll") for (int k = 0; k < 2; ++k) dst[m][k] = *(const LAS bf16x8*)(lds + PG8_SA(b, h) + aoff + m * 2048 + k * 1024); } while (0)
#define PG8_LDB(dst, b, h) do { _Pragma("unroll") for (int n = 0; n < 2; ++n) _Pragma("unroll") for (int k = 0; k < 2; ++k) dst[n][k] = *(const LAS bf16x8*)(lds + PG8_SB(b, h) + boff + n * 2048 + k * 1024); } while (0)
#define PG8_MMA(ai, bj, At, Bt) do { __builtin_amdgcn_s_setprio(1); _Pragma("unroll") for (int m = 0; m < 4; ++m) _Pragma("unroll") for (int n = 0; n < 2; ++n) _Pragma("unroll") for (int k = 0; k < 2; ++k) \
        acc[ai][bj][m][n] = __builtin_amdgcn_mfma_f32_16x16x32_bf16(Bt[n][k], At[m][k], acc[ai][bj][m][n], 0, 0, 0); __builtin_amdgcn_s_setprio(0); } while (0)
#define PG8_WAIT_V(n) asm volatile("s_waitcnt vmcnt(" #n ")" ::: "memory")
#define PG8_WAIT_L(n) asm volatile("s_waitcnt lgkmcnt(" #n ")" ::: "memory")
#define PG8_BAR __builtin_amdgcn_s_barrier()
#define PG8_SCHED __builtin_amdgcn_sched_barrier(0)
    Unit cur, nxt; int ui = 0;
    if (!S.next(0, cur)) return;
    f32x4 acc[2][2][4][2];
#pragma unroll
    for (int a = 0; a < 2; ++a)
#pragma unroll
        for (int b = 0; b < 2; ++b)
#pragma unroll
            for (int m = 0; m < 4; ++m)
#pragma unroll
                for (int n = 0; n < 2; ++n) acc[a][b][m][n] = (f32x4){0.f, 0.f, 0.f, 0.f};
    bf16x8 At[4][2], B0[2][2], B1[2][2];
    const char* cA = (const char*)g.A + (size_t)cur.pm * tstep; const char* cB = (const char*)g.Bt + (size_t)cur.pn * tstep;
    S.a_ready(cur);
    PG8_STAGE(PG8_SB(0, 0), cB, voffB); PG8_STAGE(PG8_SA(0, 0), cA, voffA); PG8_STAGE(PG8_SB(0, 1), cB + hstep, voffB); PG8_STAGE(PG8_SA(0, 1), cA + hstep, voffA);
    if (wr == 1) PG8_BAR;
    PG8_WAIT_V(4); PG8_BAR;
    PG8_STAGE(PG8_SB(1, 0), cB + kstep, voffB); PG8_STAGE(PG8_SA(1, 0), cA + kstep, voffA); PG8_STAGE(PG8_SB(1, 1), cB + hstep + kstep, voffB);
    PG8_WAIT_V(6); PG8_BAR;
    for (;;) {
        const bool has_next = S.next(ui + 1, nxt);
        const char* nA = has_next ? (const char*)g.A + (size_t)nxt.pm * tstep : cA; const char* nB = has_next ? (const char*)g.Bt + (size_t)nxt.pn * tstep : cB;
        for (int t = 0; t < nt; t += 2) {
            const bool last = (t == nt - 2);
            const char* a1 = cA + (size_t)(t + 1) * kstep;
            const char* a2 = last ? nA : cA + (size_t)(t + 2) * kstep; const char* b2 = last ? nB : cB + (size_t)(t + 2) * kstep;
            const char* a3 = a2 + kstep; const char* b3 = b2 + kstep;
            if (last && has_next) S.a_ready(nxt);
            PG8_LDB(B0, 0, 0); PG8_SCHED; PG8_LDA(At, 0, 0); PG8_STAGE(PG8_SA(1, 1), a1 + hstep, voffA);
            PG8_WAIT_L(8); PG8_BAR; PG8_WAIT_L(0); PG8_MMA(0, 0, At, B0); PG8_BAR; PG8_SCHED;
            PG8_LDB(B1, 0, 1); PG8_STAGE(PG8_SB(0, 0), b2, voffB);
            PG8_BAR; PG8_WAIT_L(0); PG8_MMA(0, 1, At, B1); PG8_BAR;
            PG8_LDA(At, 0, 1); PG8_STAGE(PG8_SA(0, 0), a2, voffA);
            PG8_BAR; PG8_WAIT_L(0); PG8_MMA(1, 0, At, B0); PG8_BAR; PG8_SCHED;
            PG8_STAGE(PG8_SB(0, 1), b2 + hstep, voffB);
            PG8_WAIT_V(6); PG8_BAR; PG8_MMA(1, 1, At, B1); PG8_BAR;
            PG8_LDB(B0, 1, 0); PG8_SCHED; PG8_LDA(At, 1, 0); PG8_STAGE(PG8_SA(0, 1), a2 + hstep, voffA);
            PG8_WAIT_L(8); PG8_BAR; PG8_WAIT_L(0); PG8_MMA(0, 0, At, B0); PG8_BAR; PG8_SCHED;
            PG8_LDB(B1, 1, 1); PG8_STAGE(PG8_SB(1, 0), b3, voffB);
            PG8_BAR; PG8_WAIT_L(0); PG8_MMA(0, 1, At, B1); PG8_BAR;
            PG8_LDA(At, 1, 1); PG8_STAGE(PG8_SA(1, 0), a3, voffA);
            PG8_BAR; PG8_WAIT_L(0); PG8_MMA(1, 0, At, B0); PG8_BAR; PG8_SCHED;
            PG8_STAGE(PG8_SB(1, 1), b3 + hstep, voffB);
            PG8_WAIT_V(6); PG8_BAR; PG8_MMA(1, 1, At, B1); PG8_BAR;
        }
        E(acc, cur, wr, wc, fr, fq); S.done(cur);
        if (!has_next) break;
#pragma unroll
        for (int a = 0; a < 2; ++a)
#pragma unroll
            for (int b = 0; b < 2; ++b)
#pragma unroll
                for (int m = 0; m < 4; ++m)
#pragma unroll
                    for (int n = 0; n < 2; ++n) acc[a][b][m][n] = (f32x4){0.f, 0.f, 0.f, 0.f};
        cur = nxt; cA = nA; cB = nB; ++ui;
    }
    PG8_WAIT_V(0);
    if (wr == 0) PG8_BAR;
    PG8_BAR;
#undef PG8_SA
#undef PG8_SB
#undef PG8_STAGE
#undef PG8_LDA
#undef PG8_LDB
#undef PG8_MMA
#undef PG8_WAIT_V
#undef PG8_WAIT_L
#undef PG8_BAR
#undef PG8_SCHED
}

struct Epi1 {
    static constexpr bool PERM = true;
    bf16_t *GLU; unsigned char* wsb;
    __device__ __forceinline__ void operator()(const f32x4 (&acc)[2][2][4][2], const Unit& u, int wr, int wc, int fr, int fq) const {
        const int row0 = u.pm * BM + wr * 64 + fr;
        if (u.pn < 4) {
            const int ch0 = u.pn * 128 + wc * 32 + 8 * fq;
#pragma unroll
            for (int ai = 0; ai < 2; ++ai)
#pragma unroll
                for (int m = 0; m < 4; ++m) {
                    const f32x4 a0 = acc[ai][0][m][0], a1 = acc[ai][0][m][1], g0 = acc[ai][1][m][0], g1 = acc[ai][1][m][1];
                    u32x4 w;
                    w.x = pk2(a0[0] * sigmoidf_(g0[0]), a0[1] * sigmoidf_(g0[1])); w.y = pk2(a0[2] * sigmoidf_(g0[2]), a0[3] * sigmoidf_(g0[3]));
                    w.z = pk2(a1[0] * sigmoidf_(g1[0]), a1[1] * sigmoidf_(g1[1])); w.w = pk2(a1[2] * sigmoidf_(g1[2]), a1[3] * sigmoidf_(g1[3]));
                    *(u32x4*)(GLU + (size_t)(row0 + ai * HALF + m * 16) * 512 + ch0) = w;
                }
        } else {
            const int t = (u.pn - 4) >> 1;
            const size_t boff = WS_Q + (t >= 1 ? (size_t)M * 1024 : (size_t)0) + (t >= 2 ? (size_t)MA * 1024 : (size_t)0);
            bf16_t* base = (bf16_t*)(wsb + boff);
            const float sc = t == 0 ? 0.125f : 1.f;
            const int col0 = ((u.pn - 4) & 1) * 256 + wc * 32 + 8 * fq;
#pragma unroll
            for (int ai = 0; ai < 2; ++ai)
#pragma unroll
                for (int m = 0; m < 4; ++m) { bf16_t* rowp = base + (size_t)(row0 + ai * HALF + m * 16) * 512 + col0;
#pragma unroll
                    for (int bj = 0; bj < 2; ++bj) { const f32x4 v0 = acc[ai][bj][m][0] * sc, v1 = acc[ai][bj][m][1] * sc;
                        u32x4 w; w.x = pk2(v0[0], v0[1]); w.y = pk2(v0[2], v0[3]); w.z = pk2(v1[0], v1[1]); w.w = pk2(v1[2], v1[3]);
                        *(u32x4*)(rowp + bj * HALF) = w; } }
        }
    }
};
struct EpiRes {
    static constexpr bool PERM = false;
    const float* base; float* out; const float* gate;
    __device__ __forceinline__ void operator()(const f32x4 (&acc)[2][2][4][2], const Unit& u, int wr, int wc, int fr, int fq) const {
        const int row0 = u.pm * BM + wr * 64 + fr, col0 = u.pn * BM + wc * 32 + 4 * fq;
        const int b = (u.pm * BM) / SEQ;
        f32x4 gv[2][2];
#pragma unroll
        for (int bj = 0; bj < 2; ++bj)
#pragma unroll
            for (int n = 0; n < 2; ++n) gv[bj][n] = *(const f32x4*)(gate + (size_t)b * 6144 + col0 + bj * HALF + n * 16);
#pragma unroll
        for (int ai = 0; ai < 2; ++ai)
#pragma unroll
            for (int m = 0; m < 4; ++m) { const size_t off = (size_t)(row0 + ai * HALF + m * 16) * D + col0;
#pragma unroll
                for (int bj = 0; bj < 2; ++bj)
#pragma unroll
                    for (int n = 0; n < 2; ++n) { const f32x4 bs = *(const f32x4*)(base + off + bj * HALF + n * 16);
                        *(f32x4*)(out + off + bj * HALF + n * 16) = bs + gv[bj][n] * acc[ai][bj][m][n]; } }
    }
};
template <int ACT> struct EpiBf16 {
    static constexpr bool PERM = true;
    bf16_t *O0, *O1; int split_tiles, ld;
    __device__ __forceinline__ void operator()(const f32x4 (&acc)[2][2][4][2], const Unit& u, int wr, int wc, int fr, int fq) const {
        const int row0 = u.pm * BM + wr * 64 + fr;
        bf16_t* base = u.pn < split_tiles ? O0 : O1;
        const int col0 = (u.pn < split_tiles ? u.pn : u.pn - split_tiles) * BM + wc * 32 + 8 * fq;
#pragma unroll
        for (int ai = 0; ai < 2; ++ai)
#pragma unroll
            for (int m = 0; m < 4; ++m) { bf16_t* rowp = base + (size_t)(row0 + ai * HALF + m * 16) * ld + col0;
#pragma unroll
                for (int bj = 0; bj < 2; ++bj) { f32x4 v0 = acc[ai][bj][m][0], v1 = acc[ai][bj][m][1];
                    if (ACT == 1) { f32x2 a = gelu_pk((f32x2){v0[0], v0[1]}), b = gelu_pk((f32x2){v0[2], v0[3]}), c = gelu_pk((f32x2){v1[0], v1[1]}), d = gelu_pk((f32x2){v1[2], v1[3]});
                        v0 = (f32x4){a.x, a.y, b.x, b.y}; v1 = (f32x4){c.x, c.y, d.x, d.y}; }
                    u32x4 w; w.x = pk2(v0[0], v0[1]); w.y = pk2(v0[2], v0[3]); w.z = pk2(v1[0], v1[1]); w.w = pk2(v1[2], v1[3]);
                    *(u32x4*)(rowp + bj * HALF) = w; } }
    }
};
}

#define XB_TMO      128
#define XB_XCNT(j)  (256  + 64 * (j))
#define XB_XSUB(j)  (1280 + 64 * (j))
#define XB_XGEN(j)  (2304 + 64 * (j))
#define XB_TOP      3328
#define XB_TOPGEN   3392
#define XCD_BAR_WORDS 3456
#define XB_SPIN_CAP (1u << 22)
__device__ __forceinline__ unsigned xb_ld(unsigned* p)              { return __hip_atomic_load(p, __ATOMIC_RELAXED, __HIP_MEMORY_SCOPE_AGENT); }
__device__ __forceinline__ unsigned xb_add(unsigned* p, unsigned v) { return __hip_atomic_fetch_add(p, v, __ATOMIC_RELAXED, __HIP_MEMORY_SCOPE_AGENT); }
__device__ __forceinline__ unsigned xb_xcc_id() { return (unsigned)__builtin_amdgcn_s_getreg((3 << 11) | 20) & 0xFu; }
#define XB_SPIN(cond, bar) do { unsigned _sp = 0; while (cond) { __builtin_amdgcn_s_sleep(1); \
    if ((++_sp & 255u) == 0u) { if (xb_ld(&(bar)[XB_TMO])) break; if (_sp > XB_SPIN_CAP) { atomicAdd(&(bar)[XB_TMO], 1u); break; } } } } while (0)
struct XcdBarrier { unsigned* bar; unsigned x; volatile LAS unsigned* st; };
__device__ __forceinline__ XcdBarrier xcd_barrier_post(unsigned* bar, volatile LAS unsigned* st) {
    XcdBarrier b; b.bar = bar; b.x = xb_xcc_id(); b.st = st;
    if (threadIdx.x == 0) (void)xb_add(&bar[XB_XCNT(b.x)], 1u);
    return b;
}
__device__ __forceinline__ void xcd_barrier_complete(unsigned* bar, unsigned x, unsigned& nloc, unsigned& nx) {
    const unsigned G = gridDim.x * gridDim.y * gridDim.z;
    unsigned sum, cnt, mine, sp = 0u;
    for (;;) {
        sum = 0u; cnt = 0u; mine = 0u;
#pragma unroll
        for (unsigned j = 0; j < 16; ++j) { const unsigned c = xb_ld(&bar[XB_XCNT(j)]); sum += c; cnt += (c > 0u) ? 1u : 0u; mine = (j == x) ? c : mine; }
        if (sum == G) break;
        __builtin_amdgcn_s_sleep(1);
        if ((++sp & 255u) == 0u) { if (xb_ld(&bar[XB_TMO])) break; if (sp > XB_SPIN_CAP) { atomicAdd(&bar[XB_TMO], 1u); break; } }
    }
    nloc = mine > 0u ? mine : 1u; nx = cnt > 0u ? cnt : 1u;
}
__device__ __forceinline__ void xcd_barrier(const XcdBarrier& b) {
    asm volatile("s_waitcnt vmcnt(0)" ::: "memory");
    __syncthreads();
    if (threadIdx.x == 0) {
        unsigned* bar = b.bar;
        __builtin_amdgcn_s_waitcnt(0);
        unsigned nloc = b.st[0], nx = b.st[1];
        if (nloc == 0u) { xcd_barrier_complete(bar, b.x, nloc, nx); b.st[0] = nloc; b.st[1] = nx; }
        const unsigned old = xb_add(&bar[XB_XSUB(b.x)], 1u);
        const unsigned gen = old / nloc;
        if (old + 1u == (gen + 1u) * nloc) {
            __builtin_amdgcn_fence(__ATOMIC_RELEASE, "agent");
            asm volatile("s_waitcnt vmcnt(0)" ::: "memory");
            const unsigned og = xb_add(&bar[XB_TOP], 1u);
            const unsigned tg = og / nx;
            if (og + 1u == (tg + 1u) * nx) xb_add(&bar[XB_TOPGEN], 1u);
            else XB_SPIN(xb_ld(&bar[XB_TOPGEN]) == tg, bar);
            __builtin_amdgcn_fence(__ATOMIC_ACQUIRE, "agent");
            xb_add(&bar[XB_XGEN(b.x)], 1u);
            asm volatile("s_waitcnt vmcnt(0)" ::: "memory");
        } else {
            XB_SPIN(xb_ld(&bar[XB_XGEN(b.x)]) == gen, bar);
            __builtin_amdgcn_fence(__ATOMIC_ACQUIRE, "agent");
            asm volatile("s_waitcnt vmcnt(0)" ::: "memory");
        }
    }
    __syncthreads();
}

struct Args { const float* in[N_IN]; float* out; unsigned char* ws; int ph_lo, ph_hi; };
static_assert(sizeof(Args) == (N_IN + 2) * 8 + 8, "Args has padding");

struct Ctx {
    const Args* a; LAS unsigned char* lds; int tid, lane, wid, bid, G;
};

__device__ __forceinline__ int w1_dest_row(int n) {
    if (n < 512) return (n >> 7) * 256 + (n & 127);
    if (n < 1024) { const int q = n - 512; return (q >> 7) * 256 + 128 + (q & 127); }
    return n;
}
__device__ __forceinline__ void transpose_item(const float* W, int K, int N, bf16_t* WT, int item, LAS float* scr, int lane, int mode) {
    const int nblk = N / 32, kb = item / nblk, nb = item % nblk, k0 = 64 * kb, n0 = 32 * nb;
#pragma unroll 8
    for (int i = 0; i < 32; ++i) { const int kk = 2 * i + (lane >> 5); scr[kk * 33 + (lane & 31)] = W[(size_t)(k0 + kk) * N + n0 + (lane & 31)]; }
    asm volatile("s_waitcnt lgkmcnt(0)" ::: "memory"); __builtin_amdgcn_wave_barrier();
    const int c = lane & 7;
#pragma unroll
    for (int j = 0; j < 4; ++j) { const int n = (lane >> 3) + 8 * j; const LAS float* s = scr + (8 * c) * 33 + n;
        u32x4 o; o.x = pk2(s[0 * 33], s[1 * 33]); o.y = pk2(s[2 * 33], s[3 * 33]); o.z = pk2(s[4 * 33], s[5 * 33]); o.w = pk2(s[6 * 33], s[7 * 33]);
        const int dr = mode == 1 ? w1_dest_row(n0 + n) : (n0 + n);
        *(u32x4*)(WT + (size_t)dr * K + k0 + 8 * c) = o; }
    asm volatile("s_waitcnt lgkmcnt(0)" ::: "memory"); __builtin_amdgcn_wave_barrier();
}
__device__ __forceinline__ void convert_task(const float* src, bf16_t* dst, size_t base, int lane) {
#pragma unroll
    for (int it = 0; it < 8; ++it) { const size_t i = base + (size_t)it * 512 + lane * 8;
        const f32x4 a = *(const f32x4*)(src + i), b = *(const f32x4*)(src + i + 4);
        u32x4 o; o.x = pk2(a[0], a[1]); o.y = pk2(a[2], a[3]); o.z = pk2(b[0], b[1]); o.w = pk2(b[2], b[3]);
        *(u32x4*)(dst + i) = o; }
}
__device__ __forceinline__ void fp8_rows_task(const float* src, unsigned char* dst, float* sinv, size_t row0, int lane) {
#pragma unroll 2
    for (int r = 0; r < 8; ++r) { const size_t row = row0 + r;
        f32x4 v[4]; float am = 0.f;
#pragma unroll
        for (int j = 0; j < 4; ++j) { v[j] = *(const f32x4*)(src + row * 1024 + 16 * lane + 4 * j);
            am = fmaxf(am, fmaxf(fmaxf(fabsf(v[j].x), fabsf(v[j].y)), fmaxf(fabsf(v[j].z), fabsf(v[j].w)))); }
#pragma unroll
        for (int o = 1; o < 64; o <<= 1) am = fmaxf(am, __shfl_xor(am, o));
        unsigned be = (__float_as_uint(am) >> 23) & 0xffu; be = be < 8u ? 8u : be;
        const float sc = __uint_as_float((261u - be) << 23), si = __uint_as_float((be - 7u) << 23);
        u32x4 w;
#pragma unroll
        for (int j = 0; j < 4; ++j) { int pk = 0;
            pk = __builtin_amdgcn_cvt_pk_fp8_f32(v[j].x * sc, v[j].y * sc, pk, false);
            pk = __builtin_amdgcn_cvt_pk_fp8_f32(v[j].z * sc, v[j].w * sc, pk, true);
            w[j] = (unsigned)pk; }
        *(u32x4*)(dst + row * 1024 + 16 * lane) = w;
        if (lane == 0) sinv[row] = si; }
}
__device__ __forceinline__ void phaseA(const Ctx& C) {
    const Args& a = *C.a; unsigned char* ws = a.ws;
    LAS float* S = (LAS float*)C.lds;
    for (int i = C.tid; i < 9 * 1024; i += 512) { const int row = i >> 10, k = i & 1023; const float c = row < 8 ? a.in[I_C][row * 1024 + k] : a.in[I_CCTX][k]; S[i] = c / (1.f + __expf(-c)); }
    __syncthreads();
    LAS float* scr = (LAS float*)(C.lds + 40960 + C.wid * 8448);
    const int gw = C.wid * C.G + C.bid, NGW = C.G * 8;
    constexpr int T_ADA = 1536, T_W1 = 16 * 80, T_W2 = 16 * 32, T_SI = 16 * 64, T_SO = 16 * 32, T_WQ = 2 * 16 * 64;
    constexpr int T_TAB = 2 * (2 * NEXP / 8), T_KEYS = 2 * 8 * 2 * 128 * 128 / 4096, T_WSP = 8 * 128 * 128 / 4096;
    constexpr int NT = T_ADA + T_W1 + T_W2 + T_SI + T_SO + T_WQ + T_TAB + T_KEYS + T_WSP;
    float* modp = (float*)(ws + WS_MODP);
    for (int T = gw; T < NT; T += NGW) {
        int t = T;
        if (t < T_ADA) {
            const int l = t / 768, r = t % 768, cb = r >> 3, ks = r & 7;
            const float* W = a.in[I_ADAW] + (size_t)l * 1024 * 6144 + (size_t)(ks * 128) * 6144 + cb * 64 + C.lane;
            float acc[9];
#pragma unroll
            for (int q = 0; q < 9; ++q) acc[q] = 0.f;
#pragma unroll 8
            for (int k = 0; k < 128; ++k) { const float w = W[(size_t)k * 6144];
#pragma unroll
                for (int q = 0; q < 9; ++q) acc[q] += S[q * 1024 + ks * 128 + k] * w; }
            float* P = modp + ((size_t)(l * 8 + ks) * 9) * 6144 + cb * 64 + C.lane;
#pragma unroll
            for (int q = 0; q < 9; ++q) P[(size_t)q * 6144] = acc[q];
            continue;
        }
        t -= T_ADA;
        if (t < T_W1) { transpose_item(a.in[I_WIN], 1024, 2560, (bf16_t*)(ws + WS_W1T), t, scr, C.lane, 1); continue; } t -= T_W1;
        if (t < T_W2) { transpose_item(a.in[I_WOUT], 1024, 1024, (bf16_t*)(ws + WS_W2T), t, scr, C.lane, 0); continue; } t -= T_W2;
        if (t < T_SI) { transpose_item(a.in[I_SGUIN], 1024, 2048, (bf16_t*)(ws + WS_WSI), t, scr, C.lane, 0); continue; } t -= T_SI;
        if (t < T_SO) { transpose_item(a.in[I_SGUOUT], 1024, 1024, (bf16_t*)(ws + WS_WSO), t, scr, C.lane, 0); continue; } t -= T_SO;
        if (t < T_WQ) { const int l = t / 1024; transpose_item(a.in[I_WQ] + (size_t)l * 1024 * 2048, 1024, 2048, (bf16_t*)(ws + WS_WQ) + (size_t)l * 2048 * 1024, t % 1024, scr, C.lane, 0); continue; } t -= T_WQ;
        if (t < T_TAB) { const int half = T_TAB / 2;
            if (t < half) fp8_rows_task(a.in[I_PU], ws + WS_TU, (float*)(ws + WS_SIU), (size_t)t * 8, C.lane);
            else fp8_rows_task(a.in[I_PV], ws + WS_TV, (float*)(ws + WS_SIV), (size_t)(t - half) * 8, C.lane);
            continue; } t -= T_TAB;
        if (t < T_KEYS) { convert_task(a.in[I_KEYS], (bf16_t*)(ws + WS_KEYS), (size_t)t * 4096, C.lane); continue; } t -= T_KEYS;
        convert_task(a.in[I_WS], (bf16_t*)(ws + WS_WSP), (size_t)t * 4096, C.lane);
    }
}

__device__ __forceinline__ void modulate_row(const float* xrow, bf16_t* orow, const LAS float* GS, const LAS float* SH, int lane) {
    const f32x4* xr = (const f32x4*)xrow + lane;
    f32x4 v[4]; float s = 0.f;
#pragma unroll
    for (int j = 0; j < 4; ++j) { v[j] = xr[64 * j]; s += (v[j].x * v[j].x + v[j].y * v[j].y) + (v[j].z * v[j].z + v[j].w * v[j].w); }
    const float rinv = rsqrtf(wave_sum(s) * (1.f / D) + EPS);
    u32x2* o8 = (u32x2*)orow + lane;
#pragma unroll
    for (int j = 0; j < 4; ++j) { const f32x4 g = *(const LAS f32x4*)(GS + 4 * lane + 256 * j), h = *(const LAS f32x4*)(SH + 4 * lane + 256 * j);
        const f32x4 y = v[j] * rinv * g + h;
        u32x2 w; w.x = pk2(y.x, y.y); w.y = pk2(y.z, y.w); o8[64 * j] = w; }
}

__device__ __forceinline__ void phaseB(const Ctx& C) {
    const Args& a = *C.a; unsigned char* ws = a.ws;
    const float* modp = (const float*)(ws + WS_MODP); float* modf = (float*)(ws + WS_MODF);
    {
        const int e = C.bid * 512 + C.tid;
        if (e < 2 * 9 * 6144) { const int l = e / (9 * 6144), rem = e % (9 * 6144), row = rem / 6144, j = rem % 6144;
            float v = a.in[I_ADAB][l * 6144 + j];
#pragma unroll
            for (int ks = 0; ks < 8; ++ks) v += modp[((size_t)(l * 8 + ks) * 9 + row) * 6144 + j];
            modf[e] = v; }
    }
    LAS float* GS = (LAS float*)C.lds; LAS float* SH = GS + 1024;
    bf16_t* A = (bf16_t*)(ws + WS_A);
    for (int part = 0; part < 2; ++part) {
        const int rb = part == 0 ? (C.bid * 128) / SEQ : 8;
        __syncthreads();
        for (int c = C.tid; c < 1024; c += 512) {
            float sh = a.in[I_ADAB][c], sc = a.in[I_ADAB][1024 + c];
#pragma unroll
            for (int ks = 0; ks < 8; ++ks) { sh += modp[((size_t)(0 * 8 + ks) * 9 + rb) * 6144 + c]; sc += modp[((size_t)(0 * 8 + ks) * 9 + rb) * 6144 + 1024 + c]; }
            GS[c] = a.in[I_N1G][c] * (1.f + sc); SH[c] = sh;
        }
        __syncthreads();
        if (part == 0) { for (int i = 0; i < 16; ++i) { const int r = C.bid * 128 + C.wid * 16 + i; modulate_row(a.in[I_X] + (size_t)r * D, A + (size_t)r * D, GS, SH, C.lane); } }
        else { const int r = C.bid * 8 + C.wid; modulate_row(a.in[I_CTX] + (size_t)r * D, A + (size_t)(M + r) * D, GS, SH, C.lane); }
    }
}

__device__ __forceinline__ void conv_tile(const Ctx& C, int tile) {
    const Args& a = *C.a; unsigned char* ws = a.ws;
    const bf16_t* GLU = (const bf16_t*)(ws + WS_GLU); bf16_t* Y = (bf16_t*)(ws + WS_A);
    const int b = tile >> 6, t0 = (tile & 63) * 64;
    __syncthreads();
    for (int i = C.tid; i < 94 * 64; i += 512) { const int row = i >> 6, ch = i & 63, t = t0 - 15 + row;
        u32x4 v = (u32x4){0u, 0u, 0u, 0u};
        if (t >= 0 && t < SEQ) v = *(const u32x4*)(GLU + ((size_t)(b * SEQ + t)) * 512 + ch * 8);
        *(LAS u32x4*)(C.lds + (size_t)i * 16) = v; }
    __syncthreads();
    const int half = C.tid >> 8, cp = C.tid & 255;
    float w0[31], w1[31];
#pragma unroll
    for (int j = 0; j < 31; ++j) { const f32x2 w = *(const f32x2*)(a.in[I_CONVW] + j * 512 + 2 * cp); w0[j] = w.x; w1[j] = w.y; }
    const f32x2 cb = *(const f32x2*)(a.in[I_CONVB] + 2 * cp), gg = *(const f32x2*)(a.in[I_GNG] + 2 * cp), gb = *(const f32x2*)(a.in[I_GNB] + 2 * cp);
    const LAS unsigned* L = (const LAS unsigned*)C.lds;
#pragma unroll 1
    for (int sb = 0; sb < 2; ++sb) {
        const int ob = 32 * half + 16 * sb;
        float a0[16], a1[16];
#pragma unroll
        for (int o = 0; o < 16; ++o) { a0[o] = cb.x; a1[o] = cb.y; }
#pragma unroll
        for (int i = 0; i < 46; ++i) { const unsigned u = L[(ob + i) * 256 + cp]; const float x0 = bf_lo(u), x1 = bf_hi(u);
#pragma unroll
            for (int j = 0; j < 31; ++j) { const int o = i - j; if (o >= 0 && o < 16) { a0[o] += w0[j] * x0; a1[o] += w1[j] * x1; } } }
#pragma unroll
        for (int o = 0; o < 16; ++o) {
            float s = a0[o] + a1[o];
#pragma unroll
            for (int k = 1; k < 32; k <<= 1) s += __shfl_xor(s, k);
            const float mu = s * (1.f / 64.f), d0 = a0[o] - mu, d1 = a1[o] - mu;
            float q = d0 * d0 + d1 * d1;
#pragma unroll
            for (int k = 1; k < 32; k <<= 1) q += __shfl_xor(q, k);
            const float rstd = rsqrtf(q * (1.f / 64.f) + EPS);
            const float y0 = d0 * rstd * gg.x + gb.x, y1 = d1 * rstd * gg.y + gb.y;
            *(unsigned*)(Y + ((size_t)(b * SEQ + t0 + ob + o)) * D + 2 * cp) = pk2(y0 * sigmoidf_(y0), y1 * sigmoidf_(y1));
        }
    }
}

__device__ __forceinline__ void attn_task(const Ctx& C, int task) {
    const Args& a = *C.a; unsigned char* ws = a.ws;
    const bf16_t* Qb = (const bf16_t*)(ws + WS_Q); const bf16_t* Kb = (const bf16_t*)(ws + WS_K); const bf16_t* Vb = (const bf16_t*)(ws + WS_V);
    bf16_t* Y = (bf16_t*)(ws + WS_A);
    const int h = task & 7, r = (task >> 3) & 63, b = task >> 9;
    const int lane = C.lane, n = lane & 31, hh = lane >> 5;
    const int kr0 = r - 4 < 0 ? 0 : (r - 4 > 56 ? 56 : r - 4);
    LAS unsigned char* lw = C.lds + C.wid * 8192;
    LAS bf16_t* Vt = (LAS bf16_t*)lw;
    LAS float* RP = (LAS float*)(lw + 4608);
    for (int i = lane; i < 465; i += 64) RP[i] = a.in[I_RPB][h * 465 + i];
    const int qtok0 = b * SEQ + r * 64;
    bf16x8 bq[2][4];
#pragma unroll
    for (int qb = 0; qb < 2; ++qb)
#pragma unroll
        for (int s = 0; s < 4; ++s) bq[qb][s] = *(const bf16x8*)(Qb + (size_t)(qtok0 + 32 * qb + n) * 512 + h * 64 + 16 * s + 8 * hh);
    f32x16 O[2][2];
#pragma unroll
    for (int i = 0; i < 2; ++i)
#pragma unroll
        for (int j = 0; j < 2; ++j)
#pragma unroll
            for (int e = 0; e < 16; ++e) O[i][j][e] = 0.f;
    float mrun[2] = {-1e30f, -1e30f}, lrun[2] = {0.f, 0.f};
#pragma unroll 1
    for (int kt = 0; kt < 24; ++kt) {
        const bool win = kt < 16;
        const int kri = kt >> 1, kc0 = 32 * (kt & 1);
        const size_t tokk = win ? (size_t)(b * SEQ + (kr0 + kri) * 64 + kc0 + n) : (size_t)(M + b * CTXL + 32 * (kt - 16) + n);
        bf16x8 kf[4], vf[4];
#pragma unroll
        for (int s = 0; s < 4; ++s) { kf[s] = *(const bf16x8*)(Kb + tokk * 512 + h * 64 + 16 * s + 8 * hh); vf[s] = *(const bf16x8*)(Vb + tokk * 512 + h * 64 + 16 * s + 8 * hh); }
#pragma unroll
        for (int s = 0; s < 4; ++s)
#pragma unroll
            for (int e = 0; e < 8; ++e) Vt[(16 * s + 8 * hh + e) * 36 + n] = (bf16_t)vf[s][e];
        bf16x8 pb[2][2];
#pragma unroll
        for (int qb = 0; qb < 2; ++qb) {
            f32x16 S;
#pragma unroll
            for (int e = 0; e < 16; ++e) S[e] = 0.f;
#pragma unroll
            for (int s = 0; s < 4; ++s) S = __builtin_amdgcn_mfma_f32_32x32x16_bf16(kf[s], bq[qb][s], S, 0, 0, 0);
            const int qc = 32 * qb + n;
            const int cs = qc - 8 < 0 ? 0 : (qc - 8 > 48 ? 48 : qc - 8);
            bool valid[16];
            float mt = -1e30f;
#pragma unroll
            for (int e = 0; e < 16; ++e) {
                const int ki = (e & 3) + 8 * (e >> 2) + 4 * hh;
                if (win) { const int kc = kc0 + ki; valid[e] = (kc >= cs) && (kc < cs + 16);
                    const int dc = kc - qc + 15; const int dcc = dc < 0 ? 0 : (dc > 30 ? 30 : dc);
                    const float bias = RP[(kr0 + kri - r + 7) * 31 + dcc];
                    S[e] = valid[e] ? S[e] + bias : -1e30f; }
                else valid[e] = true;
                mt = fmaxf(mt, S[e]);
            }
            mt = fmaxf(mt, __shfl_xor(mt, 32));
            const float mn = fmaxf(mrun[qb], mt), alpha = __expf(mrun[qb] - mn);
            mrun[qb] = mn;
            float ps = 0.f; float p[16];
#pragma unroll
            for (int e = 0; e < 16; ++e) { p[e] = valid[e] ? __expf(S[e] - mn) : 0.f; ps += p[e]; }
            lrun[qb] = lrun[qb] * alpha + ps;
#pragma unroll
            for (int db = 0; db < 2; ++db)
#pragma unroll
                for (int e = 0; e < 16; ++e) O[db][qb][e] *= alpha;
#pragma unroll
            for (int s2 = 0; s2 < 2; ++s2) { u32x4 w; w.x = pk2(p[8 * s2 + 0], p[8 * s2 + 1]); w.y = pk2(p[8 * s2 + 2], p[8 * s2 + 3]); w.z = pk2(p[8 * s2 + 4], p[8 * s2 + 5]); w.w = pk2(p[8 * s2 + 6], p[8 * s2 + 7]);
                pb[qb][s2] = __builtin_bit_cast(bf16x8, w); }
        }
#pragma unroll
        for (int db = 0; db < 2; ++db)
#pragma unroll
            for (int s2 = 0; s2 < 2; ++s2) {
                const LAS bf16_t* vp = Vt + (32 * db + n) * 36 + 16 * s2 + 4 * hh;
                const u32x2 lo = *(const LAS u32x2*)vp, hi = *(const LAS u32x2*)(vp + 8);
                u32x4 w; w.x = lo.x; w.y = lo.y; w.z = hi.x; w.w = hi.y;
                const bf16x8 va = __builtin_bit_cast(bf16x8, w);
#pragma unroll
                for (int qb = 0; qb < 2; ++qb) O[db][qb] = __builtin_amdgcn_mfma_f32_32x32x16_bf16(va, pb[qb][s2], O[db][qb], 0, 0, 0);
            }
    }
#pragma unroll
    for (int qb = 0; qb < 2; ++qb) {
        const float lt = lrun[qb] + __shfl_xor(lrun[qb], 32), inv = 1.f / lt;
        bf16_t* yrow = Y + (size_t)(qtok0 + 32 * qb + n) * D + 512 + h * 64;
#pragma unroll
        for (int db = 0; db < 2; ++db)
#pragma unroll
            for (int g = 0; g < 4; ++g) { u32x2 w; w.x = pk2(O[db][qb][4 * g] * inv, O[db][qb][4 * g + 1] * inv); w.y = pk2(O[db][qb][4 * g + 2] * inv, O[db][qb][4 * g + 3] * inv);
                *(u32x2*)(yrow + 32 * db + 8 * g + 4 * hh) = w; }
    }
}

__device__ __forceinline__ void phaseNorm2(const Ctx& C, int l) {
    const Args& a = *C.a; unsigned char* ws = a.ws;
    const float* modf = (const float*)(ws + WS_MODF) + (size_t)l * 9 * 6144;
    LAS float* GS = (LAS float*)C.lds; LAS float* SH = GS + 1024;
    const int b = (C.bid * 128) / SEQ;
    for (int c = C.tid; c < 1024; c += 512) { GS[c] = a.in[I_N2G][l * 1024 + c] * (1.f + modf[b * 6144 + 4 * 1024 + c]); SH[c] = modf[b * 6144 + 3 * 1024 + c]; }
    __syncthreads();
    bf16_t* A = (bf16_t*)(ws + WS_A);
    for (int i = 0; i < 16; ++i) { const int r = C.bid * 128 + C.wid * 16 + i; modulate_row(a.out + (size_t)r * D, A + (size_t)r * D, GS, SH, C.lane); }
}

__device__ __forceinline__ void ce_desc(float& x, float& y) { const float hi = fmaxf(x, y), lo = fminf(x, y); x = hi; y = lo; }
__device__ __forceinline__ void ce_asc(float& x, float& y) { const float hi = fmaxf(x, y), lo = fminf(x, y); x = lo; y = hi; }
__device__ __forceinline__ void sort16_desc(float (&v)[16]) {
#pragma unroll
    for (int k = 2; k <= 16; k <<= 1)
#pragma unroll
        for (int j = k >> 1; j > 0; j >>= 1)
#pragma unroll
            for (int i = 0; i < 16; ++i) { const int l = i ^ j; if (l > i) { if ((i & k) == 0) ce_desc(v[i], v[l]); else ce_asc(v[i], v[l]); } }
}
__device__ __forceinline__ void merge16_desc(float (&A)[16], const float (&B)[16]) {
#pragma unroll
    for (int i = 0; i < 16; ++i) A[i] = fmaxf(A[i], B[15 - i]);
#pragma unroll
    for (int j = 8; j > 0; j >>= 1)
#pragma unroll
        for (int i = 0; i < 16; ++i) { const int l = i ^ j; if (l > i) ce_desc(A[i], A[l]); }
}
__device__ __forceinline__ void topk_task(const Ctx& C, int l, int tt, int h) {
    const Args& a = *C.a; unsigned char* ws = a.ws;
    const bf16_t* QP = (const bf16_t*)(ws + WS_QP); const bf16_t* KEYS = (const bf16_t*)(ws + WS_KEYS);
    unsigned short* IDX = (unsigned short*)(ws + WS_IDX); float* WT = (float*)(ws + WS_WT);
    const int lane = C.lane, n = lane & 31, hh = lane >> 5;
    const int tok = tt * 32 + n;
    float sp[2][16];
#pragma unroll
    for (int p = 0; p < 2; ++p) {
        bf16x8 bq[8];
#pragma unroll
        for (int s = 0; s < 8; ++s) bq[s] = *(const bf16x8*)(QP + (size_t)tok * 2048 + h * 256 + p * 128 + 16 * s + 8 * hh);
        const bf16_t* kbase = KEYS + ((size_t)((l * 8 + h) * 2 + p)) * 128 * 128;
        float top[16];
#pragma unroll
        for (int kb = 0; kb < 4; ++kb) {
            f32x16 S;
#pragma unroll
            for (int e = 0; e < 16; ++e) S[e] = 0.f;
#pragma unroll
            for (int s = 0; s < 8; ++s) { const bf16x8 kf = *(const bf16x8*)(kbase + (size_t)(32 * kb + n) * 128 + 16 * s + 8 * hh);
                S = __builtin_amdgcn_mfma_f32_32x32x16_bf16(kf, bq[s], S, 0, 0, 0); }
            float ch[16];
#pragma unroll
            for (int e = 0; e < 16; ++e) { const unsigned key = 32 * kb + (e & 3) + 8 * (e >> 2) + 4 * hh; ch[e] = __uint_as_float((__float_as_uint(S[e]) & ~0x7Fu) | key); }
            sort16_desc(ch);
            if (kb == 0) {
#pragma unroll
                for (int e = 0; e < 16; ++e) top[e] = ch[e];
            } else merge16_desc(top, ch);
        }
        float oth[16];
#pragma unroll
        for (int e = 0; e < 16; ++e) oth[e] = __shfl_xor(top[e], 32);
        merge16_desc(top, oth);
#pragma unroll
        for (int e = 0; e < 16; ++e) sp[p][e] = top[e];
    }
    const float NEG = -3.0e38f;
    auto cand = [&](int ia, int ib) -> float { const float s = sp[0][ia] + sp[1][ib]; return __uint_as_float((__float_as_uint(s) & ~0xFFu) | (unsigned)((ia << 4) | ib)); };
    float L1[16], L2[16], L3[16], L4[16];
#pragma unroll
    for (int i = 0; i < 16; ++i) { L1[i] = cand(0, i); L2[i] = i < 15 ? cand(i + 1, 0) : NEG; L4[i] = NEG; }
#pragma unroll
    for (int i = 0; i < 7; ++i) L3[i] = cand(1, i + 1);
#pragma unroll
    for (int i = 0; i < 6; ++i) L3[7 + i] = cand(i + 2, 1);
#pragma unroll
    for (int i = 0; i < 3; ++i) L3[13 + i] = cand(2, i + 2);
    L4[0] = cand(3, 2); L4[1] = cand(4, 2); L4[2] = cand(3, 3);
    sort16_desc(L3);
    ce_desc(L4[0], L4[1]); ce_desc(L4[1], L4[2]); ce_desc(L4[0], L4[1]);
    merge16_desc(L1, L2); merge16_desc(L3, L4); merge16_desc(L1, L3);
    float e16[16], se = 0.f;
#pragma unroll
    for (int i = 0; i < 16; ++i) { e16[i] = __expf(L1[i] - L1[0]); se += e16[i]; }
    const float inv = 1.f / se;
    LAS unsigned* tb = (LAS unsigned*)(C.lds + C.wid * 8448) + lane * 33;
#pragma unroll
    for (int i = 0; i < 16; ++i) { tb[i] = __float_as_uint(sp[0][i]) & 0x7Fu; tb[16 + i] = __float_as_uint(sp[1][i]) & 0x7Fu; }
    unsigned ids[16];
#pragma unroll
    for (int i = 0; i < 16; ++i) { const unsigned code = __float_as_uint(L1[i]) & 0xFFu; ids[i] = tb[code >> 4] * 128u + tb[16 + (code & 15u)]; }
    float su[16], sv[16];
    { const float* SIU = (const float*)(ws + WS_SIU) + (size_t)l * NEXP; const float* SIV = (const float*)(ws + WS_SIV) + (size_t)l * NEXP;
#pragma unroll
      for (int i = 0; i < 16; ++i) { su[i] = SIU[ids[i]]; sv[i] = SIV[ids[i]]; } }
    if (hh == 0) {
        u32x4 w0, w1;
        w0.x = ids[0] | (ids[1] << 16); w0.y = ids[2] | (ids[3] << 16); w0.z = ids[4] | (ids[5] << 16); w0.w = ids[6] | (ids[7] << 16);
        w1.x = ids[8] | (ids[9] << 16); w1.y = ids[10] | (ids[11] << 16); w1.z = ids[12] | (ids[13] << 16); w1.w = ids[14] | (ids[15] << 16);
        u32x4* ip = (u32x4*)(IDX + (size_t)tok * 128 + h * 16); ip[0] = w0; ip[1] = w1;
        f32x4* wp = (f32x4*)(WT + (size_t)tok * 128 + h * 16);
        f32x4* sp4 = (f32x4*)((float*)(ws + WS_SU) + (size_t)tok * 128 + h * 16);
#pragma unroll
        for (int i = 0; i < 4; ++i) { wp[i] = (f32x4){e16[4 * i] * inv * sv[4 * i], e16[4 * i + 1] * inv * sv[4 * i + 1], e16[4 * i + 2] * inv * sv[4 * i + 2], e16[4 * i + 3] * inv * sv[4 * i + 3]};
            sp4[i] = (f32x4){su[4 * i], su[4 * i + 1], su[4 * i + 2], su[4 * i + 3]}; }
    }
}

__device__ __forceinline__ void phasePeer(const Ctx& C, int l) {
    const Args& a = *C.a; unsigned char* ws = a.ws;
    const bool last = (l == 1);
    const float* modf = (const float*)(ws + WS_MODF);
    const int b = (C.bid * 128) / SEQ;
    LAS float* G5 = (LAS float*)C.lds; LAS float* GS = G5 + 1024; LAS float* SH = GS + 1024;
    for (int c = C.tid; c < 1024; c += 512) {
        G5[c] = modf[(size_t)l * 9 * 6144 + b * 6144 + 5 * 1024 + c];
        if (!last) { GS[c] = a.in[I_N1G][1024 + c] * (1.f + modf[(size_t)9 * 6144 + b * 6144 + 1024 + c]); SH[c] = modf[(size_t)9 * 6144 + b * 6144 + c]; }
        else { GS[c] = a.in[I_NFG][c]; SH[c] = 0.f; }
    }
    __syncthreads();
    bf16_t* A = (bf16_t*)(ws + WS_A);
    const unsigned char* TU = ws + WS_TU + (size_t)l * NEXP * 1024; const unsigned char* TV = ws + WS_TV + (size_t)l * NEXP * 1024;
    const unsigned short* IDX = (const unsigned short*)(ws + WS_IDX); const float* WT = (const float*)(ws + WS_WT); const float* SUa = (const float*)(ws + WS_SU);
    const int lane = C.lane;
#pragma unroll 1
    for (int i = 0; i < 16; ++i) {
        const int tok = C.bid * 128 + C.wid * 16 + i;
        u32x4 xf[2];
#pragma unroll
        for (int j = 0; j < 2; ++j) xf[j] = *(const u32x4*)(A + (size_t)tok * D + 16 * lane + 8 * j);
        const unsigned id0 = IDX[(size_t)tok * 128 + lane], id1 = IDX[(size_t)tok * 128 + 64 + lane];
        const float wt0 = WT[(size_t)tok * 128 + lane], wt1 = WT[(size_t)tok * 128 + 64 + lane];
        const float su0 = SUa[(size_t)tok * 128 + lane], su1 = SUa[(size_t)tok * 128 + 64 + lane];
        float acc[16];
#pragma unroll
        for (int e = 0; e < 16; ++e) acc[e] = 0.f;
        auto load8 = [&](u32x4 (&uf)[8], u32x4 (&vf)[8], int g) {
            const unsigned idv = g < 8 ? id0 : id1; const int lb = (g & 7) * 8;
#pragma unroll
            for (int k = 0; k < 8; ++k) { const unsigned e = __shfl(idv, lb + k);
                uf[k] = *(const u32x4*)(TU + (size_t)e * 1024 + 16 * lane); vf[k] = *(const u32x4*)(TV + (size_t)e * 1024 + 16 * lane); }
        };
        auto comp8 = [&](const u32x4 (&uf)[8], const u32x4 (&vf)[8], int g) {
            const float wtv = g < 8 ? wt0 : wt1; const float suv = g < 8 ? su0 : su1; const int lb = (g & 7) * 8;
            float dt[8];
#pragma unroll
            for (int k = 0; k < 8; ++k) { float d = 0.f;
#pragma unroll
                for (int q = 0; q < 4; ++q) { const unsigned uw = uf[k][q];
                    const bf2v lo = __builtin_amdgcn_cvt_scalef32_pk_bf16_fp8(uw, 1.0f, false), hi = __builtin_amdgcn_cvt_scalef32_pk_bf16_fp8(uw, 1.0f, true);
                    const unsigned x0 = xf[q >> 1][2 * (q & 1)], x1 = xf[q >> 1][2 * (q & 1) + 1];
                    d = __builtin_amdgcn_fdot2_f32_bf16(__builtin_bit_cast(bf2v, x0), lo, d, false);
                    d = __builtin_amdgcn_fdot2_f32_bf16(__builtin_bit_cast(bf2v, x1), hi, d, false); }
                dt[k] = d; }
            float r4[4], r2[2], r1;
            { const bool up = (lane & 32) != 0;
#pragma unroll
              for (int k = 0; k < 4; ++k) { const float keep = up ? dt[k + 4] : dt[k], send = up ? dt[k] : dt[k + 4]; r4[k] = keep + __shfl_xor(send, 32); } }
            { const bool up = (lane & 16) != 0;
#pragma unroll
              for (int k = 0; k < 2; ++k) { const float keep = up ? r4[k + 2] : r4[k], send = up ? r4[k] : r4[k + 2]; r2[k] = keep + __shfl_xor(send, 16); } }
            { const bool up = (lane & 8) != 0; const float keep = up ? r2[1] : r2[0], send = up ? r2[0] : r2[1]; r1 = keep + __shfl_xor(send, 8); }
            r1 += __shfl_xor(r1, 4); r1 += __shfl_xor(r1, 2); r1 += __shfl_xor(r1, 1);
            const int myk = ((lane >> 5) & 1) * 4 + ((lane >> 4) & 1) * 2 + ((lane >> 3) & 1);
            const float coef = gelu_erf(r1 * __shfl(suv, lb + myk)) * __shfl(wtv, lb + myk);
#pragma unroll
            for (int k = 0; k < 8; ++k) {
                const int src = ((k >> 2) & 1) * 32 + ((k >> 1) & 1) * 16 + (k & 1) * 8;
                const float ck = __shfl(coef, src);
#pragma unroll
                for (int q = 0; q < 4; ++q) { const unsigned vw = vf[k][q];
                    const f32x2 lo = __builtin_amdgcn_cvt_pk_f32_fp8(vw, false), hi = __builtin_amdgcn_cvt_pk_f32_fp8(vw, true);
                    acc[4 * q] += ck * lo.x; acc[4 * q + 1] += ck * lo.y; acc[4 * q + 2] += ck * hi.x; acc[4 * q + 3] += ck * hi.y; }
            }
        };
        u32x4 ufA[8], vfA[8];
#pragma unroll 1
        for (int g = 0; g < 16; ++g) { load8(ufA, vfA, g); comp8(ufA, vfA, g); }
        float* hrow = a.out + (size_t)tok * D + 16 * lane;
        float hv[16]; float ss = 0.f;
#pragma unroll
        for (int q = 0; q < 4; ++q) { const f32x4 hx = *(const f32x4*)(hrow + 4 * q); const f32x4 g5 = *(const LAS f32x4*)(G5 + 16 * lane + 4 * q);
#pragma unroll
            for (int e = 0; e < 4; ++e) { const float v = hx[e] + g5[e] * acc[4 * q + e]; hv[4 * q + e] = v; ss += v * v; } }
        const float rinv = rsqrtf(wave_sum(ss) * (1.f / D) + EPS);
        if (!last) {
#pragma unroll
            for (int q = 0; q < 4; ++q) *(f32x4*)(hrow + 4 * q) = (f32x4){hv[4 * q], hv[4 * q + 1], hv[4 * q + 2], hv[4 * q + 3]};
            float y[16];
#pragma unroll
            for (int q = 0; q < 4; ++q) { const f32x4 g = *(const LAS f32x4*)(GS + 16 * lane + 4 * q), sh = *(const LAS f32x4*)(SH + 16 * lane + 4 * q);
#pragma unroll
                for (int e = 0; e < 4; ++e) y[4 * q + e] = hv[4 * q + e] * rinv * g[e] + sh[e]; }
#pragma unroll
            for (int j = 0; j < 2; ++j) { u32x4 w; w.x = pk2(y[8 * j], y[8 * j + 1]); w.y = pk2(y[8 * j + 2], y[8 * j + 3]); w.z = pk2(y[8 * j + 4], y[8 * j + 5]); w.w = pk2(y[8 * j + 6], y[8 * j + 7]);
                *(u32x4*)(A + (size_t)tok * D + 16 * lane + 8 * j) = w; }
        } else {
#pragma unroll
            for (int q = 0; q < 4; ++q) { const f32x4 g = *(const LAS f32x4*)(GS + 16 * lane + 4 * q);
                *(f32x4*)(hrow + 4 * q) = (f32x4){hv[4 * q] * rinv * g[0], hv[4 * q + 1] * rinv * g[1], hv[4 * q + 2] * rinv * g[2], hv[4 * q + 3] * rinv * g[3]}; }
        }
    }
}

__device__ __forceinline__ void phaseSgu(const Ctx& C) {
    const Args& a = *C.a; unsigned char* ws = a.ws;
    const bf16_t* U = (const bf16_t*)(ws + WS_U); const bf16_t* VV = (const bf16_t*)(ws + WS_VV); const bf16_t* WSP = (const bf16_t*)(ws + WS_WSP);
    bf16_t* A = (bf16_t*)(ws + WS_A);
    LAS float* ST = (LAS float*)(C.lds + 65536);
    LAS bf16_t* VT = (LAS bf16_t*)C.lds;
    const int lane = C.lane, n = lane & 31, hh = lane >> 5;
    for (int chunk = C.bid; chunk < M / 128; chunk += C.G) {
        const int tok0 = chunk * 128;
        __syncthreads();
        for (int i = 0; i < 16; ++i) {
            const int q = C.wid * 16 + i;
            const u32x4 v0 = *(const u32x4*)(VV + (size_t)(tok0 + q) * D + 8 * lane), v1 = *(const u32x4*)(VV + (size_t)(tok0 + q) * D + 512 + 8 * lane);
            float x[16];
#pragma unroll
            for (int e = 0; e < 4; ++e) { x[2 * e] = bf_lo(v0[e]); x[2 * e + 1] = bf_hi(v0[e]); x[8 + 2 * e] = bf_lo(v1[e]); x[8 + 2 * e + 1] = bf_hi(v1[e]); }
            float s = 0.f;
#pragma unroll
            for (int e = 0; e < 16; ++e) s += x[e];
            const float mu = wave_sum(s) * (1.f / D); float qq = 0.f;
#pragma unroll
            for (int e = 0; e < 16; ++e) { const float d = x[e] - mu; qq += d * d; }
            const float rstd = rsqrtf(wave_sum(qq) * (1.f / D) + EPS);
            if (lane == 0) { ST[2 * q] = mu; ST[2 * q + 1] = rstd; }
        }
        __syncthreads();
#pragma unroll 1
        for (int g = 0; g < 8; ++g) {
            { const int q = C.tid & 127; const float mu = ST[2 * q], rstd = ST[2 * q + 1];
#pragma unroll
              for (int i = 0; i < 4; ++i) { const int cb = (C.tid >> 7) + 4 * i;
                const u32x4 v = *(const u32x4*)(VV + (size_t)(tok0 + q) * D + g * 128 + cb * 8);
#pragma unroll
                for (int e = 0; e < 4; ++e) { const int c = cb * 8 + 2 * e;
                    const float y0 = (bf_lo(v[e]) - mu) * rstd * a.in[I_LNG][g * 128 + c] + a.in[I_LNB][g * 128 + c];
                    const float y1 = (bf_hi(v[e]) - mu) * rstd * a.in[I_LNG][g * 128 + c + 1] + a.in[I_LNB][g * 128 + c + 1];
                    const unsigned w = pk2(y0, y1);
                    VT[c * 136 + q] = (bf16_t)(w & 0xffffu); VT[(c + 1) * 136 + q] = (bf16_t)(w >> 16); } } }
            __syncthreads();
            const int cbk = C.wid & 3;
            bf16x8 af[8];
#pragma unroll
            for (int s = 0; s < 8; ++s) af[s] = *(const LAS bf16x8*)(VT + (32 * cbk + n) * 136 + 16 * s + 8 * hh);
#pragma unroll
            for (int pi = 0; pi < 2; ++pi) {
                const int pb = 2 * (C.wid >> 2) + pi;
                f32x16 S;
#pragma unroll
                for (int e = 0; e < 16; ++e) S[e] = 0.f;
#pragma unroll
                for (int s = 0; s < 8; ++s) { const bf16x8 wf = *(const bf16x8*)(WSP + ((size_t)g * 128 + 32 * pb + n) * 128 + 16 * s + 8 * hh);
                    S = __builtin_amdgcn_mfma_f32_32x32x16_bf16(af[s], wf, S, 0, 0, 0); }
                const int p = 32 * pb + n; const float bs = a.in[I_BS][g * 128 + p];
                const size_t rowoff = (size_t)(tok0 + p) * D + g * 128 + 32 * cbk;
#pragma unroll
                for (int q4 = 0; q4 < 4; ++q4) { const int c0 = 8 * q4 + 4 * hh;
                    const u32x2 uu = *(const u32x2*)(U + rowoff + c0);
                    u32x2 w; w.x = pk2(bf_lo(uu.x) * (S[4 * q4] + bs), bf_hi(uu.x) * (S[4 * q4 + 1] + bs)); w.y = pk2(bf_lo(uu.y) * (S[4 * q4 + 2] + bs), bf_hi(uu.y) * (S[4 * q4 + 3] + bs));
                    *(u32x2*)(A + rowoff + c0) = w; }
            }
            __syncthreads();
        }
    }
}

__device__ __forceinline__ void phaseFinalNorm(const Ctx& C, const float* src) {
    const Args& a = *C.a;
    for (int i = 0; i < 16; ++i) { const int r = C.bid * 128 + C.wid * 16 + i;
        const f32x4* xr = (const f32x4*)(src + (size_t)r * D) + C.lane; f32x4 v[4]; float s = 0.f;
#pragma unroll
        for (int j = 0; j < 4; ++j) { v[j] = xr[64 * j]; s += (v[j].x * v[j].x + v[j].y * v[j].y) + (v[j].z * v[j].z + v[j].w * v[j].w); }
        const float rinv = rsqrtf(wave_sum(s) * (1.f / D) + EPS);
        f32x4* o = (f32x4*)(a.out + (size_t)r * D) + C.lane;
#pragma unroll
        for (int j = 0; j < 4; ++j) { const f32x4 g = *((const f32x4*)a.in[I_NFG] + C.lane + 64 * j); o[64 * j] = v[j] * rinv * g; } }
}


#ifdef DBG_CHECK
__device__ __forceinline__ float bfv(const bf16_t* p) { return __uint_as_float(((unsigned)*p) << 16); }
__device__ __forceinline__ int sample_tok(int bid) { return bid * 128 + ((bid * 29 + 7) & 127); }
__device__ __forceinline__ float wave_max(float v) {
#pragma unroll
    for (int o = 1; o < 64; o <<= 1) v = fmaxf(v, __shfl_xor(v, o));
    return v;
}
__device__ __forceinline__ bool far(float got, float want, float tol) { return !(fabsf(got - want) <= tol * (1.f + fabsf(want))); }
__device__ __forceinline__ void checkMixer(const Args& a, int bid_, int lane) {
    unsigned char* ws = a.ws;
    const bf16_t* GLU = (const bf16_t*)(ws + WS_GLU); const bf16_t* Qb = (const bf16_t*)(ws + WS_Q); const bf16_t* Kb = (const bf16_t*)(ws + WS_K); const bf16_t* Vb = (const bf16_t*)(ws + WS_V);
    const bf16_t* Y = (const bf16_t*)(ws + WS_A);
    const int tok = sample_tok(bid_), b = tok / SEQ, t = tok % SEQ, r = t / 64, qc = t % 64;
    unsigned fail = 0;
    _Pragma("unroll") for (int i = 0; i < 8; ++i) { const int c = lane + 64 * i; float acc = a.in[I_CONVB][c];
        for (int j = 0; j < 31; ++j) { const int tt = t + j - 15; if (tt >= 0 && tt < SEQ) acc += a.in[I_CONVW][j * 512 + c] * bfv(GLU + (size_t)(b * SEQ + tt) * 512 + c); }
        const float mu = wave_sum(acc) * (1.f / 64.f), d = acc - mu, var = wave_sum(d * d) * (1.f / 64.f);
        float y = d * rsqrtf(var + EPS) * a.in[I_GNG][c] + a.in[I_GNB][c]; y = y / (1.f + expf(-y));
        if (far(bfv(Y + (size_t)tok * D + c), y, 0.03f)) fail |= 1u; }
    const int kr0 = r - 4 < 0 ? 0 : (r - 4 > 56 ? 56 : r - 4), cs = qc - 8 < 0 ? 0 : (qc - 8 > 48 ? 48 : qc - 8);
    for (int h = 0; h < 8; ++h) {
        float sc[6]; size_t kt[6]; float m = -1e30f;
        _Pragma("unroll") for (int i = 0; i < 6; ++i) { const int j = lane + 64 * i; float bias = 0.f; size_t ktok;
            if (j < 128) { const int kr = kr0 + (j >> 4), kc = cs + (j & 15); ktok = (size_t)b * SEQ + kr * 64 + kc; bias = a.in[I_RPB][h * 465 + (kr - r + 7) * 31 + (kc - qc + 15)]; }
            else ktok = (size_t)M + b * CTXL + (j - 128);
            float s = 0.f; for (int d = 0; d < 64; ++d) s += bfv(Qb + (size_t)tok * 512 + h * 64 + d) * bfv(Kb + ktok * 512 + h * 64 + d);
            sc[i] = s + bias; kt[i] = ktok; m = fmaxf(m, sc[i]); }
        m = wave_max(m); float l = 0.f;
        _Pragma("unroll") for (int i = 0; i < 6; ++i) { sc[i] = expf(sc[i] - m); l += sc[i]; }
        l = wave_sum(l);
        float o = 0.f;
        _Pragma("unroll") for (int i = 0; i < 6; ++i) for (int src = 0; src < 64; ++src) { const float pj = __shfl(sc[i], src); const unsigned lo = __shfl((unsigned)(kt[i] & 0xffffffffu), src), hi = __shfl((unsigned)(kt[i] >> 32), src);
            const size_t ktok = ((size_t)hi << 32) | lo; o += pj * bfv(Vb + ktok * 512 + h * 64 + lane); }
        if (far(bfv(Y + (size_t)tok * D + 512 + h * 64 + lane), o / l, 0.03f)) fail |= 2u;
    }
    if (fail) atomicOr((unsigned*)(ws + WS_CTL) + 8192, fail);
}
__device__ __forceinline__ void checkPeerA(const Args& a, int bid_, int lane, int l) {
    unsigned char* ws = a.ws;
    const bf16_t* A = (const bf16_t*)(ws + WS_A); const bf16_t* QP = (const bf16_t*)(ws + WS_QP);
    const unsigned short* IDX = (const unsigned short*)(ws + WS_IDX); const float* WT = (const float*)(ws + WS_WT);
    const float* modf = (const float*)(ws + WS_MODF) + (size_t)l * 9 * 6144;
    const int tok = sample_tok(bid_), b = tok / SEQ;
    unsigned fail = 0;
    float hv[16]; float ss = 0.f;
    _Pragma("unroll") for (int i = 0; i < 16; ++i) { hv[i] = a.out[(size_t)tok * D + lane + 64 * i]; ss += hv[i] * hv[i]; }
    const float rinv = rsqrtf(wave_sum(ss) * (1.f / D) + EPS);
    _Pragma("unroll") for (int i = 0; i < 16; ++i) { const int c = lane + 64 * i; const float y = hv[i] * rinv * a.in[I_N2G][l * 1024 + c] * (1.f + modf[b * 6144 + 4 * 1024 + c]) + modf[b * 6144 + 3 * 1024 + c];
        if (far(bfv(A + (size_t)tok * D + c), y, 0.03f)) fail |= 4u; }
    { const int n = lane * 32 + 5; float q = 0.f; for (int k = 0; k < 1024; ++k) q += bfv(A + (size_t)tok * D + k) * a.in[I_WQ][(size_t)l * 1024 * 2048 + (size_t)k * 2048 + n];
      if (far(bfv(QP + (size_t)tok * 2048 + n), q, 0.03f)) fail |= 8u; }
    for (int h = 0; h < 8; ++h) {
        const unsigned id = IDX[(size_t)tok * 128 + h * 16]; const int pick0 = (int)(id >> 7), pick1 = (int)(id & 127u);
        _Pragma("unroll") for (int p = 0; p < 2; ++p) { float s2[2];
            _Pragma("unroll") for (int i = 0; i < 2; ++i) { const int key = lane + 64 * i; float s = 0.f;
                for (int d = 0; d < 128; ++d) s += bfv(QP + (size_t)tok * 2048 + h * 256 + p * 128 + d) * a.in[I_KEYS][(((size_t)(l * 8 + h) * 2 + p) * 128 + key) * 128 + d];
                s2[i] = s; }
            const float mx = wave_max(fmaxf(s2[0], s2[1]));
            const int pk = p == 0 ? pick0 : pick1; const float mine = __shfl(pk < 64 ? s2[0] : s2[1], pk & 63);
            if (!(mine >= mx - 0.03f)) fail |= 16u; }
        float w = lane < 16 ? WT[(size_t)tok * 128 + h * 16 + lane] : 0.f; const float wsum = wave_sum(w);
        if (!(fabsf(wsum - 1.f) < 1e-3f) || !(w >= 0.f)) fail |= 32u;
    }
    float pr[16]; _Pragma("unroll") for (int i = 0; i < 16; ++i) pr[i] = 0.f;
    for (int k = 0; k < 128; ++k) { const size_t e = IDX[(size_t)tok * 128 + k]; const float* ur = a.in[I_PU] + ((size_t)l * NEXP + e) * 1024; const float* vr = a.in[I_PV] + ((size_t)l * NEXP + e) * 1024;
        float d = 0.f; _Pragma("unroll") for (int i = 0; i < 16; ++i) d += bfv(A + (size_t)tok * D + lane + 64 * i) * ur[lane + 64 * i];
        d = wave_sum(d); const float cf = WT[(size_t)tok * 128 + k] * gelu_erf(d);
        _Pragma("unroll") for (int i = 0; i < 16; ++i) pr[i] += cf * vr[lane + 64 * i]; }
    float* REF = (float*)(ws + WS_REF) + (size_t)bid_ * 1024;
    _Pragma("unroll") for (int i = 0; i < 16; ++i) { const int c = lane + 64 * i; REF[c] = hv[i] + modf[b * 6144 + 5 * 1024 + c] * pr[i]; }
    if (fail) atomicOr((unsigned*)(ws + WS_CTL) + 8192, fail);
}
__device__ __forceinline__ void checkPeerB(const Args& a, int bid_, int lane) {
    unsigned char* ws = a.ws;
    const int tok = sample_tok(bid_); unsigned fail = 0;
    const float* REF = (const float*)(ws + WS_REF) + (size_t)bid_ * 1024;
    _Pragma("unroll") for (int i = 0; i < 16; ++i) { const int c = lane + 64 * i; if (far(a.out[(size_t)tok * D + c], REF[c], 0.02f)) fail |= (64u << (bid_ & 3)); }
    if (fail) atomicOr((unsigned*)(ws + WS_CTL) + 8192, fail);
}
__device__ void phaseCode(const Ctx& C) {
    const Args& a = *C.a;
    const unsigned mask = *((const unsigned*)(a.ws + WS_CTL) + 8192);
    const unsigned code = (mask >> DBG_SHIFT) & 15u;
    const float alpha = 1.f + 0.5f * (float)code;
    _Pragma("unroll") for (int i = 0; i < 16; ++i) { const int r = C.bid * 128 + C.wid * 16 + i;
        const f32x4* xr = (const f32x4*)(a.in[I_X] + (size_t)r * D) + C.lane; f32x4 v[4]; float s = 0.f;
        for (int j = 0; j < 4; ++j) { v[j] = xr[64 * j]; s += (v[j].x * v[j].x + v[j].y * v[j].y) + (v[j].z * v[j].z + v[j].w * v[j].w); }
        const float rinv = rsqrtf(wave_sum(s) * (1.f / D) + EPS) * alpha;
        f32x4* o = (f32x4*)(a.out + (size_t)r * D) + C.lane;
        for (int j = 0; j < 4; ++j) { const f32x4 g = *((const f32x4*)a.in[I_NFG] + C.lane + 64 * j); o[64 * j] = v[j] * rinv * g; } }
}
__global__ void __launch_bounds__(64) dbg_kernel(Args args, int which) {
    if (which == 17) checkMixer(args, blockIdx.x, threadIdx.x);
    if (which == 18) checkPeerA(args, blockIdx.x, threadIdx.x, 0);
    if (which == 19) checkPeerB(args, blockIdx.x, threadIdx.x);
}
#endif

__global__ void __launch_bounds__(512, 2) fwd_megakernel(Args args) {
    extern __shared__ __attribute__((aligned(16))) unsigned char lds_raw[];
    LAS unsigned char* lds = (LAS unsigned char*)lds_raw;
    Ctx C; C.a = &args; C.lds = lds; C.tid = threadIdx.x; C.lane = C.tid & 63; C.wid = __builtin_amdgcn_readfirstlane(C.tid >> 6); C.bid = blockIdx.x; C.G = gridDim.x;
    volatile LAS unsigned* MISC = (volatile LAS unsigned*)(lds + MISC_OFF);
    if (C.tid < 4) MISC[C.tid] = 0u;
    __syncthreads();
    unsigned char* ws = args.ws;
    const int lo = args.ph_lo, hi = args.ph_hi;
    XcdBarrier bar; bar.bar = (unsigned*)(ws + WS_CTL); bar.x = 0; bar.st = nullptr;
    const bool multi = (hi - lo) > 1;
    if (multi) bar = xcd_barrier_post((unsigned*)(ws + WS_CTL), MISC);
#define IN(k) (lo <= (k) && (k) < hi)
#define SEAM(k) do { if (IN(k) && IN((k) + 1)) xcd_barrier(bar); } while (0)
    using namespace pg8;
    const bf16_t* Abuf = (const bf16_t*)(ws + WS_A);
    const float* modf = (const float*)(ws + WS_MODF);

    if (IN(0)) { phaseA(C); } SEAM(0);
    if (IN(1)) { phaseB(C); } SEAM(1);
    if (IN(2)) {
        Gemm g{Abuf, (const bf16_t*)(ws + WS_W1T), MA, 2560, 1024}; Order1 S; S.init(C.G, C.bid);
        Epi1 E{(bf16_t*)(ws + WS_GLU), ws};
        gemm_phase<Epi1, Order1>(lds, g, S, E);
    } SEAM(2);
    if (IN(3)) {
        for (int t = C.bid; t < 512; t += C.G) conv_tile(C, t);
        __syncthreads();
        for (int t = C.bid * 8 + C.wid; t < NBATCH * 64 * 8; t += C.G * 8) attn_task(C, t);
    } SEAM(3);
    if (IN(4)) {
        Gemm g{Abuf, (const bf16_t*)(ws + WS_W2T), M, 1024, 1024}; StaticOrder S; S.init(M, 1024, C.G, C.bid);
        EpiRes E{args.in[I_X], args.out, modf + 2 * 1024};
        gemm_phase<EpiRes, StaticOrder>(lds, g, S, E);
    } SEAM(4);
    if (IN(5)) { phaseNorm2(C, 0); } SEAM(5);
    if (IN(6)) {
        Gemm g{Abuf, (const bf16_t*)(ws + WS_WQ), M, 2048, 1024}; StaticOrder S; S.init(M, 2048, C.G, C.bid);
        EpiBf16<0> E{(bf16_t*)(ws + WS_QP), (bf16_t*)(ws + WS_QP), 8, 2048};
        gemm_phase<EpiBf16<0>, StaticOrder>(lds, g, S, E);
    } SEAM(6);
    if (IN(7)) { for (int t = C.bid; t < M / 128; t += C.G) for (int q = 0; q < 4; ++q) topk_task(C, 0, t * 4 + q, C.wid); } SEAM(7);
    if (IN(8)) { phasePeer(C, 0); } SEAM(8);
    if (IN(9)) {
        Gemm g{Abuf, (const bf16_t*)(ws + WS_WSI), M, 2048, 1024}; StaticOrder S; S.init(M, 2048, C.G, C.bid);
        EpiBf16<1> E{(bf16_t*)(ws + WS_U), (bf16_t*)(ws + WS_VV), 4, 1024};
        gemm_phase<EpiBf16<1>, StaticOrder>(lds, g, S, E);
    } SEAM(9);
    if (IN(10)) { phaseSgu(C); } SEAM(10);
    if (IN(11)) {
        Gemm g{Abuf, (const bf16_t*)(ws + WS_WSO), M, 1024, 1024}; StaticOrder S; S.init(M, 1024, C.G, C.bid);
        EpiRes E{args.out, args.out, modf + 9 * 6144 + 2 * 1024};
        gemm_phase<EpiRes, StaticOrder>(lds, g, S, E);
    } SEAM(11);
    if (IN(12)) { phaseNorm2(C, 1); } SEAM(12);
    if (IN(13)) {
        Gemm g{Abuf, (const bf16_t*)(ws + WS_WQ) + (size_t)2048 * 1024, M, 2048, 1024}; StaticOrder S; S.init(M, 2048, C.G, C.bid);
        EpiBf16<0> E{(bf16_t*)(ws + WS_QP), (bf16_t*)(ws + WS_QP), 8, 2048};
        gemm_phase<EpiBf16<0>, StaticOrder>(lds, g, S, E);
    } SEAM(13);
    if (IN(14)) { for (int t = C.bid; t < M / 128; t += C.G) for (int q = 0; q < 4; ++q) topk_task(C, 1, t * 4 + q, C.wid); } SEAM(14);
    if (IN(15)) { phasePeer(C, 1); } SEAM(15);
    if (IN(16)) { phaseFinalNorm(C, DBG_LEVEL == 0 ? args.in[I_X] : args.out); }
#ifdef DBG_CHECK
    if (IN(20)) phaseCode(C);
#endif
#undef IN
#undef SEAM
}

extern "C" void kernel_launch(void* const* d_in, const int* in_sizes, int n_in, void* d_out, int out_size, void* d_ws, size_t ws_size, hipStream_t stream) {
    static int grid = 0;
    if (grid == 0) {
        if (n_in != N_IN || out_size != M * D || ws_size < WS_END) { fprintf(stderr, "kernel_launch: unexpected shapes (n_in %d out %d ws %zu need %zu)\n", n_in, out_size, ws_size, (size_t)WS_END); grid = -1; return; }
        int dev = 0, cus = 0, per_cu = 0;
        if (hipGetDevice(&dev) != hipSuccess || hipDeviceGetAttribute(&cus, hipDeviceAttributeMultiprocessorCount, dev) != hipSuccess) { grid = -1; return; }
        if (hipFuncSetAttribute((const void*)fwd_megakernel, hipFuncAttributeMaxDynamicSharedMemorySize, LDS_BYTES) != hipSuccess) { fprintf(stderr, "kernel_launch: hipFuncSetAttribute failed\n"); grid = -1; return; }
        if (hipOccupancyMaxActiveBlocksPerMultiprocessor(&per_cu, (const void*)fwd_megakernel, 512, LDS_BYTES) != hipSuccess || per_cu < 1) { fprintf(stderr, "kernel_launch: occupancy query says %d blocks per CU\n", per_cu); (void)hipGetLastError(); grid = -1; return; }
        grid = cus;
        if (grid != 256) fprintf(stderr, "kernel_launch: note: %d CUs (the phase tilings assume 256)\n", grid);
        if (grid > 256) grid = 256;
    }
    if (grid < 0) return;
    (void)hipMemsetAsync((char*)d_ws + WS_CTL, 0, CTL_BYTES, stream);
    Args a{};
    for (int i = 0; i < N_IN; ++i) a.in[i] = (const float*)d_in[i];
    a.out = (float*)d_out; a.ws = (unsigned char*)d_ws;
    int phases[NPH]; int np = 0;
    const int lastp = DBG_LEVEL == 0 ? -1 : DBG_LEVEL == 1 ? 4 : DBG_LEVEL == 2 ? 8 : DBG_LEVEL == 3 ? 11 : 15;
    for (int p = 0; p <= lastp; ++p) phases[np++] = p;
    if (DBG_LEVEL < 4) phases[np++] = 16;
#ifdef DBG_CHECK
    { const int pl[] = {0, 1, 2, 3, 17, 4, 5, 6, 7, 18, 8, 19, 20}; np = 0; for (int p : pl) phases[np++] = p; }
#endif
#if ONE_LAUNCH
    if (DBG_LEVEL == 4) { a.ph_lo = 0; a.ph_hi = 16; hipLaunchKernelGGL(fwd_megakernel, dim3(grid), dim3(512), LDS_BYTES, stream, a); return; }
#endif
    for (int i = 0; i < np; ++i) {
#ifdef DBG_CHECK
        if (phases[i] >= 17 && phases[i] <= 19) { a.ph_lo = 0; a.ph_hi = 0; hipLaunchKernelGGL(dbg_kernel, dim3(256), dim3(64), 0, stream, a, phases[i]); continue; }
#endif
        a.ph_lo = phases[i]; a.ph_hi = phases[i] + 1; hipLaunchKernelGGL(fwd_megakernel, dim3(grid), dim3(512), LDS_BYTES, stream, a); }
}
```

```cpp
#include <hip/hip_runtime.h>
#include <cstdio>
#include <cstdint>

#ifndef PROBE_PHASE
#define PROBE_PHASE -1
#endif
#define PROBE_MULT 8
#ifndef ONE_LAUNCH
#define ONE_LAUNCH 1
#endif

#define LAS __attribute__((address_space(3)))
typedef unsigned short bf16_t;
typedef short bf16x8 __attribute__((ext_vector_type(8)));
typedef float f32x4 __attribute__((ext_vector_type(4)));
typedef float f32x16 __attribute__((ext_vector_type(16)));
typedef float f32x2 __attribute__((ext_vector_type(2)));
typedef unsigned u32x4 __attribute__((ext_vector_type(4)));
typedef unsigned u32x2 __attribute__((ext_vector_type(2)));
typedef __bf16 bf2v __attribute__((ext_vector_type(2)));
typedef int v4i __attribute__((ext_vector_type(4)));
typedef int v8i __attribute__((ext_vector_type(8)));

constexpr int D = 1024, NBATCH = 8, SEQ = 4096, M = NBATCH * SEQ, CTXL = 256, MC = NBATCH * CTXL, MA = M + MC;
constexpr int NEXP = 16384;
constexpr float EPS = 1e-6f;
enum { I_X = 0, I_C, I_CTX, I_CCTX, I_N1G, I_N2G, I_ADAW, I_ADAB, I_WIN, I_CONVW, I_CONVB, I_GNG, I_GNB, I_RPB, I_WOUT, I_SGUIN, I_LNG, I_LNB, I_WS, I_BS, I_SGUOUT,
       I_WQ, I_KEYS, I_PU, I_PV, I_NFG, N_IN };

constexpr size_t WS_CTL  = 0;
constexpr size_t CTL_BYTES = 65536;
constexpr size_t WS_MODP = WS_CTL + CTL_BYTES;
constexpr size_t WS_MODF = WS_MODP + (size_t)2 * 8 * 9 * 6144 * 4;
constexpr size_t WS_W1T  = WS_MODF + (size_t)2 * 9 * 6144 * 4;
constexpr size_t WS_W2T  = WS_W1T + (size_t)2560 * 1024 * 2;
constexpr size_t WS_WSI  = WS_W2T + (size_t)1024 * 1024 * 2;
constexpr size_t WS_WSO  = WS_WSI + (size_t)2048 * 1024 * 2;
constexpr size_t WS_WQ   = WS_WSO + (size_t)1024 * 1024 * 2;
constexpr size_t WS_KEYS = WS_WQ + (size_t)2 * 2048 * 1024 * 2;
constexpr size_t WS_WSP  = WS_KEYS + (size_t)2 * 8 * 2 * 128 * 128 * 2;
constexpr size_t WS_TU   = WS_WSP + (size_t)8 * 128 * 128 * 2;
constexpr size_t WS_TV   = WS_TU + (size_t)2 * NEXP * 1024;
constexpr size_t WS_SIU  = WS_TV + (size_t)2 * NEXP * 1024;
constexpr size_t WS_SIV  = WS_SIU + (size_t)2 * NEXP * 4;
constexpr size_t WS_A    = WS_SIV + (size_t)2 * NEXP * 4;
constexpr size_t WS_B    = WS_A + (size_t)MA * 1024 * 2;
constexpr size_t WS_GLU  = WS_B;
constexpr size_t WS_Q    = WS_GLU + (size_t)M * 512 * 2;
constexpr size_t WS_K    = WS_Q + (size_t)M * 512 * 2;
constexpr size_t WS_V    = WS_K + (size_t)MA * 512 * 2;
constexpr size_t WS_QP   = WS_B;
constexpr size_t WS_PD   = WS_B;
constexpr size_t WS_U    = WS_B;
constexpr size_t WS_VV   = WS_B + (size_t)M * 1024 * 2;
constexpr size_t WS_IDX  = WS_V + (size_t)MA * 512 * 2;
constexpr size_t WS_WT   = WS_IDX + (size_t)M * 128 * 2;
constexpr size_t WS_SU   = WS_WT + (size_t)M * 128 * 4;
constexpr size_t WS_A8   = WS_SU + (size_t)M * 128 * 4;
constexpr size_t WS_H    = WS_A8 + (size_t)MA * 1024;
constexpr size_t WS_REF  = WS_H + (size_t)M * 1024 * 2;
constexpr size_t WS_END  = WS_REF + (size_t)256 * 1024 * 4;

constexpr int LDS_BYTES = 147456;
constexpr int MISC_OFF = 147200;

__device__ __forceinline__ float bf_lo(unsigned u) { return __uint_as_float(u << 16); }
__device__ __forceinline__ float bf_hi(unsigned u) { return __uint_as_float(u & 0xffff0000u); }
__device__ __forceinline__ unsigned pk2(float lo, float hi) { bf2v r = {(__bf16)lo, (__bf16)hi}; return __builtin_bit_cast(unsigned, r); }
template <int CTRL> __device__ __forceinline__ float dpp_f(float v) { return __builtin_bit_cast(float, __builtin_amdgcn_update_dpp(0, __builtin_bit_cast(int, v), CTRL, 0xF, 0xF, true)); }
__device__ __forceinline__ float sum8(float v) { v += dpp_f<0xB1>(v); v += dpp_f<0x4E>(v); v += dpp_f<0x141>(v); return v; }
__device__ __forceinline__ float sum16(float v) { v = sum8(v); v += dpp_f<0x140>(v); return v; }
__device__ __forceinline__ float sum32(float v) { v = sum16(v); v += __shfl_xor(v, 16); return v; }
__device__ __forceinline__ float clamp448(float v) { return fminf(fmaxf(v, -448.f), 448.f); }
__device__ __forceinline__ unsigned pk4_fp8(float a, float b, float c, float d) { int p = 0;
    p = __builtin_amdgcn_cvt_pk_fp8_f32(clamp448(a), clamp448(b), p, false); p = __builtin_amdgcn_cvt_pk_fp8_f32(clamp448(c), clamp448(d), p, true); return (unsigned)p; }
__device__ __forceinline__ float wave_sum(float v) { v = sum32(v); v += __shfl_xor(v, 32); return v; }
__device__ __forceinline__ float dot2bf(unsigned a, unsigned b, float c) { return __builtin_amdgcn_fdot2_f32_bf16(__builtin_bit_cast(bf2v, a), __builtin_bit_cast(bf2v, b), c, false); }
__device__ __forceinline__ float sigmoidf_(float x) { return __builtin_amdgcn_rcpf(1.f + __expf(-x)); }
__device__ __forceinline__ float gelu_erf(float v) { return 0.5f * v * (1.f + erff(v * 0.70710678f)); }

namespace pg8 {
constexpr int BM = 256, BK = 64, HALF = 128, HTB = HALF * BK * 2, STAGE_BYTES = 8 * HTB, NXCD = 8, WGM = 8;
__host__ __device__ __forceinline__ int lds_byte(int r, int c) { const int st = (r >> 4) * 2 + (c >> 5), rr = r & 15, cc = c & 31, ob = rr * 64 + cc * 2; return st * 1024 + (ob ^ (((ob >> 9) & 1) << 5)); }
__host__ __device__ __forceinline__ void stage_rc(int b, int& R, int& C) { const int st = b / 1024, sb = b % 1024, swz = sb ^ (((sb >> 9) & 1) << 5); R = (st >> 1) * 16 + swz / 64; C = (st & 1) * 32 + (swz % 64) / 2; }
__host__ __device__ __forceinline__ int perm32(int rho) { const int n = rho >> 4, i = rho & 15; return 8 * (i >> 2) + 4 * n + (i & 3); }
struct Unit { int pm, pn; };
struct Gemm { const bf16_t* A; const bf16_t* Bt; int M, N, K; };
struct StaticOrder {
    int nM, nN, nwg, G, c;
    __host__ __device__ void init(int M_, int N_, int G_, int c_) { nM = M_ / BM; nN = N_ / BM; nwg = nM * nN; G = G_; c = c_; }
    __host__ __device__ bool next(int i, Unit& u) const {
        const long L = (long)i * G + c; if (L >= nwg) return false;
        int wgid = (int)L; { const int q = nwg / NXCD, r = nwg % NXCD, xcd = wgid % NXCD, off = wgid / NXCD; wgid = (xcd < r ? xcd * (q + 1) : r * (q + 1) + (xcd - r) * q) + off; }
        const int nig = WGM * nN, gid = wgid / nig, fm = gid * WGM, gsz = (nM - fm) < WGM ? (nM - fm) : WGM;
        u.pm = fm + ((wgid % nig) % gsz); u.pn = (wgid % nig) / gsz; return true;
    }
    __device__ __forceinline__ void a_ready(const Unit&) const {}
    __device__ __forceinline__ void done(const Unit&) const {}
};
struct Order1 {
    StaticOrder so; int G, c;
    __device__ void init(int G_, int c_) { so.init(M, 2560, G_, c_); G = G_; c = c_; }
    __device__ bool next(int i, Unit& u) const {
        const long L = (long)i * G + c;
        if (L < so.nwg) return so.next(i, u);
        return false;
    }
    __device__ __forceinline__ void a_ready(const Unit&) const {}
    __device__ __forceinline__ void done(const Unit&) const {}
};
__device__ __forceinline__ f32x2 gelu_pk(f32x2 v) {
    const f32x2 av = __builtin_elementwise_abs(v), d = av * 0.2316418882f + 1.0f;
    f32x2 t; t.x = __builtin_amdgcn_rcpf(d.x); t.y = __builtin_amdgcn_rcpf(d.y);
    f32x2 q = t * 0.5307027145f + (-0.7265760135f); q = q * t + 0.7107068705f; q = q * t + (-0.142248368f); q = q * t + 0.127414796f; q = q * t;
    const f32x2 s = (v * v) * (-0.72134752044f);
    f32x2 e; e.x = __builtin_amdgcn_exp2f(s.x); e.y = __builtin_amdgcn_exp2f(s.y);
    const f32x2 m = v * (q * e), r = v - m;
    f32x2 o; o.x = v.x < 0.f ? m.x : r.x; o.y = v.y < 0.f ? m.y : r.y; return o;
}
__device__ __forceinline__ void mfma_fp8_acc(f32x4& acc, const v8i& a, const v8i& b, int sa, int sb) {
    asm volatile("s_nop 1\n\tv_mfma_scale_f32_16x16x128_f8f6f4 %0, %1, %2, %0, %3, %4 op_sel_hi:[0,0,0]" : "+v"(acc) : "v"(a), "v"(b), "v"(sa), "v"(sb));
}
template <class Epi, class Sched, bool FP8 = false>
__device__ __forceinline__ void gemm_phase(LAS unsigned char* lds, const Gemm g, const Sched& S, const Epi& E, const int tid, const int wid) {
    const int lane = tid & 63, wr = wid >> 2, wc = wid & 3, fr = lane & 15, fq = lane >> 4;
    const int K = g.K, nt = K / BK;
    const int sc_w = 0x7A7A7A7A, sc_x = 0x7F7F7F7F;
    unsigned voffA[2], voffB[2];
#pragma unroll
    for (int i = 0; i < 2; ++i) { int R, C; stage_rc(tid * 16 + i * 8192, R, C); const int Rb = Epi::PERM ? ((R & ~31) + perm32(R & 31)) : R;
        voffA[i] = (unsigned)(R * K + C) * 2u; voffB[i] = (unsigned)(Rb * K + C) * 2u; }
    const size_t kstep = (size_t)(BK * 2);
    const size_t hstep = (size_t)HALF * K * 2;
    const size_t tstep = 2 * hstep;
    const unsigned ldsw = (unsigned)wid * 1024u;
    const int aoff = lds_byte(wr * 64 + fr, fq * 8), boff = lds_byte(wc * 32 + fr, fq * 8);
#define PG8_SA(b, h) (((b) * 2 + (h)) * HTB)
#define PG8_SB(b, h) ((4 + (b) * 2 + (h)) * HTB)
#define PG8_STAGE(bufoff, gbase, voff) do { _Pragma("unroll") for (int _i = 0; _i < 2; ++_i) \
        __builtin_amdgcn_global_load_lds((const unsigned*)((const char*)(gbase) + (voff)[_i]), (LAS unsigned*)(lds + (bufoff) + ldsw + _i * 8192), 16, 0, 0); } while (0)
#define PG8_LD16(off) (*(const LAS v4i*)(lds + (off)))
#define PG8_LDA(dst, b, h) do { _Pragma("unroll") for (int m = 0; m < 4; ++m) { const int o_ = PG8_SA(b, h) + aoff + m * 2048; \
        if (FP8) dst##8[m] = __builtin_shufflevector(PG8_LD16(o_), PG8_LD16(o_ + 1024), 0, 1, 2, 3, 4, 5, 6, 7); \
        else { dst[m][0] = __builtin_bit_cast(bf16x8, PG8_LD16(o_)); dst[m][1] = __builtin_bit_cast(bf16x8, PG8_LD16(o_ + 1024)); } } } while (0)
#define PG8_LDB(dst, b, h) do { _Pragma("unroll") for (int n = 0; n < 2; ++n) { const int o_ = PG8_SB(b, h) + boff + n * 2048; \
        if (FP8) dst##8[n] = __builtin_shufflevector(PG8_LD16(o_), PG8_LD16(o_ + 1024), 0, 1, 2, 3, 4, 5, 6, 7); \
        else { dst[n][0] = __builtin_bit_cast(bf16x8, PG8_LD16(o_)); dst[n][1] = __builtin_bit_cast(bf16x8, PG8_LD16(o_ + 1024)); } } } while (0)
#define PG8_MMA(ai, bj, At, Bt) do { __builtin_amdgcn_s_setprio(1); _Pragma("unroll") for (int m = 0; m < 4; ++m) _Pragma("unroll") for (int n = 0; n < 2; ++n) { \
        if (FP8) mfma_fp8_acc(acc[ai][bj][m][n], Bt##8[n], At##8[m], sc_w, sc_x); \
        else { _Pragma("unroll") for (int k = 0; k < 2; ++k) acc[ai][bj][m][n] = __builtin_amdgcn_mfma_f32_16x16x32_bf16(Bt[n][k], At[m][k], acc[ai][bj][m][n], 0, 0, 0); } } \
        __builtin_amdgcn_s_setprio(0); } while (0)
#define PG8_WAIT_V(n) asm volatile("s_waitcnt vmcnt(" #n ")" ::: "memory")
#define PG8_WAIT_L(n) asm volatile("s_waitcnt lgkmcnt(" #n ")" ::: "memory")
#define PG8_BAR __builtin_amdgcn_s_barrier()
#define PG8_SCHED __builtin_amdgcn_sched_barrier(0)
    Unit cur, nxt; int ui = 0;
    if (!S.next(0, cur)) return;
    f32x4 acc[2][2][4][2];
#pragma unroll
    for (int a = 0; a < 2; ++a)
#pragma unroll
        for (int b = 0; b < 2; ++b)
#pragma unroll
            for (int m = 0; m < 4; ++m)
#pragma unroll
                for (int n = 0; n < 2; ++n) acc[a][b][m][n] = (f32x4){0.f, 0.f, 0.f, 0.f};
    const char* cA = (const char*)g.A + (size_t)cur.pm * tstep; const char* cB = (const char*)g.Bt + (size_t)cur.pn * tstep;
    S.a_ready(cur);
    PG8_STAGE(PG8_SB(0, 0), cB, voffB); PG8_STAGE(PG8_SA(0, 0), cA, voffA); PG8_STAGE(PG8_SB(0, 1), cB + hstep, voffB); PG8_STAGE(PG8_SA(0, 1), cA + hstep, voffA);
    if (wr == 1) PG8_BAR;
    PG8_WAIT_V(4); PG8_BAR;
    PG8_STAGE(PG8_SB(1, 0), cB + kstep, voffB); PG8_STAGE(PG8_SA(1, 0), cA + kstep, voffA); PG8_STAGE(PG8_SB(1, 1), cB + hstep + kstep, voffB);
    PG8_WAIT_V(6); PG8_BAR;
    for (;;) {
        const bool has_next = S.next(ui + 1, nxt);
        const char* nA = has_next ? (const char*)g.A + (size_t)nxt.pm * tstep : cA; const char* nB = has_next ? (const char*)g.Bt + (size_t)nxt.pn * tstep : cB;
#pragma unroll 1
        for (int t = 0; t < nt; t += 2) {
            const bool last = (t == nt - 2);
            bf16x8 At[4][2], B0[2][2], B1[2][2]; v8i At8[4], B08[2], B18[2];
            const char* a1 = cA + (size_t)(t + 1) * kstep;
            const char* a2 = last ? nA : cA + (size_t)(t + 2) * kstep; const char* b2 = last ? nB : cB + (size_t)(t + 2) * kstep;
            const char* a3 = a2 + kstep; const char* b3 = b2 + kstep;
            if (last && has_next) S.a_ready(nxt);
            PG8_LDB(B0, 0, 0); PG8_SCHED; PG8_LDA(At, 0, 0); PG8_STAGE(PG8_SA(1, 1), a1 + hstep, voffA);
            PG8_WAIT_L(8); PG8_BAR; PG8_WAIT_L(0); PG8_MMA(0, 0, At, B0); PG8_BAR; PG8_SCHED;
            PG8_LDB(B1, 0, 1); PG8_STAGE(PG8_SB(0, 0), b2, voffB);
            PG8_BAR; PG8_WAIT_L(0); PG8_MMA(0, 1, At, B1); PG8_BAR;
            PG8_LDA(At, 0, 1); PG8_STAGE(PG8_SA(0, 0), a2, voffA);
            PG8_BAR; PG8_WAIT_L(0); PG8_MMA(1, 0, At, B0); PG8_BAR; PG8_SCHED;
            PG8_STAGE(PG8_SB(0, 1), b2 + hstep, voffB);
            PG8_WAIT_V(6); PG8_BAR; PG8_MMA(1, 1, At, B1); PG8_BAR;
            PG8_LDB(B0, 1, 0); PG8_SCHED; PG8_LDA(At, 1, 0); PG8_STAGE(PG8_SA(0, 1), a2 + hstep, voffA);
            PG8_WAIT_L(8); PG8_BAR; PG8_WAIT_L(0); PG8_MMA(0, 0, At, B0); PG8_BAR; PG8_SCHED;
            PG8_LDB(B1, 1, 1); PG8_STAGE(PG8_SB(1, 0), b3, voffB);
            PG8_BAR; PG8_WAIT_L(0); PG8_MMA(0, 1, At, B1); PG8_BAR;
            PG8_LDA(At, 1, 1); PG8_STAGE(PG8_SA(1, 0), a3, voffA);
            PG8_BAR; PG8_WAIT_L(0); PG8_MMA(1, 0, At, B0); PG8_BAR; PG8_SCHED;
            PG8_STAGE(PG8_SB(1, 1), b3 + hstep, voffB);
            PG8_WAIT_V(6); PG8_BAR; PG8_MMA(1, 1, At, B1); PG8_BAR;
        }
        { Unit ue = cur; int wr_ = wr, wc_ = wc, fr_ = fr, fq_ = fq;
          asm volatile("" : "+s"(ue.pm), "+s"(ue.pn), "+s"(wr_), "+s"(wc_), "+v"(fr_), "+v"(fq_));
          E(acc, ue, wr_, wc_, fr_, fq_); }
        S.done(cur);
        if (!has_next) break;
#pragma unroll
        for (int a = 0; a < 2; ++a)
#pragma unroll
            for (int b = 0; b < 2; ++b)
#pragma unroll
                for (int m = 0; m < 4; ++m)
#pragma unroll
                    for (int n = 0; n < 2; ++n) acc[a][b][m][n] = (f32x4){0.f, 0.f, 0.f, 0.f};
        cur = nxt; cA = nA; cB = nB; ++ui;
    }
    PG8_WAIT_V(0);
    if (wr == 0) PG8_BAR;
    PG8_BAR;
#undef PG8_SA
#undef PG8_SB
#undef PG8_STAGE
#undef PG8_LDA
#undef PG8_LD16
#undef PG8_LDB
#undef PG8_MMA
#undef PG8_WAIT_V
#undef PG8_WAIT_L
#undef PG8_BAR
#undef PG8_SCHED
}

struct Epi1 {
    static constexpr bool PERM = true;
    bf16_t *GLU; unsigned char* wsb;
    __device__ __forceinline__ void operator()(const f32x4 (&acc)[2][2][4][2], const Unit& u, int wr, int wc, int fr, int fq) const {
        const int row0 = u.pm * BM + wr * 64 + fr;
        if (u.pn < 4) {
            const int ch0 = u.pn * 128 + wc * 32 + 8 * fq;
#pragma unroll
            for (int ai = 0; ai < 2; ++ai)
#pragma unroll
                for (int m = 0; m < 4; ++m) {
                    const f32x4 a0 = acc[ai][0][m][0], a1 = acc[ai][0][m][1], g0 = acc[ai][1][m][0], g1 = acc[ai][1][m][1];
                    u32x4 w;
                    w.x = pk2(a0[0] * sigmoidf_(g0[0]), a0[1] * sigmoidf_(g0[1])); w.y = pk2(a0[2] * sigmoidf_(g0[2]), a0[3] * sigmoidf_(g0[3]));
                    w.z = pk2(a1[0] * sigmoidf_(g1[0]), a1[1] * sigmoidf_(g1[1])); w.w = pk2(a1[2] * sigmoidf_(g1[2]), a1[3] * sigmoidf_(g1[3]));
                    *(u32x4*)(GLU + (size_t)(row0 + ai * HALF + m * 16) * 512 + ch0) = w;
                }
        } else {
            const int t = (u.pn - 4) >> 1;
            const size_t boff = WS_Q + (t >= 1 ? (size_t)M * 1024 : (size_t)0) + (t >= 2 ? (size_t)MA * 1024 : (size_t)0);
            bf16_t* base = (bf16_t*)(wsb + boff);
            const float sc = t == 0 ? 0.125f * 1.44269504f : 1.f;
            const int col0 = ((u.pn - 4) & 1) * 256 + wc * 32 + 8 * fq;
#pragma unroll
            for (int ai = 0; ai < 2; ++ai)
#pragma unroll
                for (int m = 0; m < 4; ++m) { bf16_t* rowp = base + (size_t)(row0 + ai * HALF + m * 16) * 512 + col0;
#pragma unroll
                    for (int bj = 0; bj < 2; ++bj) { const f32x4 v0 = acc[ai][bj][m][0] * sc, v1 = acc[ai][bj][m][1] * sc;
                        u32x4 w; w.x = pk2(v0[0], v0[1]); w.y = pk2(v0[2], v0[3]); w.z = pk2(v1[0], v1[1]); w.w = pk2(v1[2], v1[3]);
                        *(u32x4*)(rowp + bj * HALF) = w; } }
        }
    }
};
template <bool BF16_BASE> struct EpiRes {
    static constexpr bool PERM = true;
    const void* base; bf16_t* H; const float* gate;
    __device__ __forceinline__ void operator()(const f32x4 (&acc)[2][2][4][2], const Unit& u, int wr, int wc, int fr, int fq) const {
        const int row0 = u.pm * BM + wr * 64 + fr, col0 = u.pn * BM + wc * 32 + 8 * fq;
        const int b = (u.pm * BM) / SEQ;
        f32x4 gv[2][2];
#pragma unroll
        for (int bj = 0; bj < 2; ++bj)
#pragma unroll
            for (int n = 0; n < 2; ++n) gv[bj][n] = *(const f32x4*)(gate + (size_t)b * 6144 + col0 + bj * HALF + 4 * n);
#pragma unroll
        for (int ai = 0; ai < 2; ++ai) {
            f32x4 bb[4][2][2]; u32x4 hb[4][2];
#pragma unroll
            for (int m = 0; m < 4; ++m) { const size_t off = (size_t)(row0 + ai * HALF + m * 16) * D + col0;
#pragma unroll
                for (int bj = 0; bj < 2; ++bj) {
                    if (BF16_BASE) hb[m][bj] = *(const u32x4*)((const bf16_t*)base + off + bj * HALF);
                    else { bb[m][bj][0] = *(const f32x4*)((const float*)base + off + bj * HALF); bb[m][bj][1] = *(const f32x4*)((const float*)base + off + bj * HALF + 4); } } }
#pragma unroll
            for (int m = 0; m < 4; ++m) { const size_t off = (size_t)(row0 + ai * HALF + m * 16) * D + col0;
#pragma unroll
                for (int bj = 0; bj < 2; ++bj) {
                    f32x4 b0, b1;
                    if (BF16_BASE) { const u32x4 h4 = hb[m][bj];
                        b0 = (f32x4){bf_lo(h4.x), bf_hi(h4.x), bf_lo(h4.y), bf_hi(h4.y)}; b1 = (f32x4){bf_lo(h4.z), bf_hi(h4.z), bf_lo(h4.w), bf_hi(h4.w)}; }
                    else { b0 = bb[m][bj][0]; b1 = bb[m][bj][1]; }
                    const f32x4 v0 = b0 + gv[bj][0] * acc[ai][bj][m][0], v1 = b1 + gv[bj][1] * acc[ai][bj][m][1];
                    u32x4 w; w.x = pk2(v0[0], v0[1]); w.y = pk2(v0[2], v0[3]); w.z = pk2(v1[0], v1[1]); w.w = pk2(v1[2], v1[3]);
                    *(u32x4*)(H + off + bj * HALF) = w; } }
        }
    }
};
template <int ACT> struct EpiBf16 {
    static constexpr bool PERM = true;
    bf16_t *O0, *O1; int split_tiles, ld;
    __device__ __forceinline__ void operator()(const f32x4 (&acc)[2][2][4][2], const Unit& u, int wr, int wc, int fr, int fq) const {
        const int row0 = u.pm * BM + wr * 64 + fr;
        bf16_t* base = u.pn < split_tiles ? O0 : O1;
        const int col0 = (u.pn < split_tiles ? u.pn : u.pn - split_tiles) * BM + wc * 32 + 8 * fq;
#pragma unroll
        for (int ai = 0; ai < 2; ++ai)
#pragma unroll
            for (int m = 0; m < 4; ++m) { bf16_t* rowp = base + (size_t)(row0 + ai * HALF + m * 16) * ld + col0;
#pragma unroll
                for (int bj = 0; bj < 2; ++bj) { f32x4 v0 = acc[ai][bj][m][0], v1 = acc[ai][bj][m][1];
                    if (ACT == 1) { f32x2 a = gelu_pk((f32x2){v0[0], v0[1]}), b = gelu_pk((f32x2){v0[2], v0[3]}), c = gelu_pk((f32x2){v1[0], v1[1]}), d = gelu_pk((f32x2){v1[2], v1[3]});
                        v0 = (f32x4){a.x, a.y, b.x, b.y}; v1 = (f32x4){c.x, c.y, d.x, d.y}; }
                    u32x4 w; w.x = pk2(v0[0], v0[1]); w.y = pk2(v0[2], v0[3]); w.z = pk2(v1[0], v1[1]); w.w = pk2(v1[2], v1[3]);
                    *(u32x4*)(rowp + bj * HALF) = w; } }
    }
};
}

#define XB_TMO      128
#define XB_XCNT(j)  (256  + 64 * (j))
#define XB_XSUB(j)  (1280 + 64 * (j))
#define XB_XGEN(j)  (2304 + 64 * (j))
#define XB_TOP      3328
#define XB_TOPGEN   3392
#define XCD_BAR_WORDS 3456
#define XB_SPIN_CAP (1u << 22)
__device__ __forceinline__ unsigned xb_ld(unsigned* p)              { return __hip_atomic_load(p, __ATOMIC_RELAXED, __HIP_MEMORY_SCOPE_AGENT); }
__device__ __forceinline__ unsigned xb_add(unsigned* p, unsigned v) { return __hip_atomic_fetch_add(p, v, __ATOMIC_RELAXED, __HIP_MEMORY_SCOPE_AGENT); }
__device__ __forceinline__ unsigned xb_xcc_id() { return (unsigned)__builtin_amdgcn_s_getreg((3 << 11) | 20) & 0xFu; }
#define XB_SPIN(cond, bar) do { unsigned _sp = 0; while (cond) { __builtin_amdgcn_s_sleep(1); \
    if ((++_sp & 255u) == 0u) { if (xb_ld(&(bar)[XB_TMO])) break; if (_sp > XB_SPIN_CAP) { atomicAdd(&(bar)[XB_TMO], 1u); break; } } } } while (0)
struct XcdBarrier { unsigned* bar; unsigned x; volatile LAS unsigned* st; bool leader; };
__device__ __forceinline__ XcdBarrier xcd_barrier_post(unsigned* bar, volatile LAS unsigned* st, bool leader) {
    XcdBarrier b; b.bar = bar; b.x = xb_xcc_id(); b.st = st; b.leader = leader;
    if (leader) (void)xb_add(&bar[XB_XCNT(b.x)], 1u);
    return b;
}
__device__ __forceinline__ void xcd_barrier_complete(unsigned* bar, unsigned x, unsigned& nloc, unsigned& nx) {
    const unsigned G = gridDim.x * gridDim.y * gridDim.z;
    unsigned sum, cnt, mine, sp = 0u;
    for (;;) {
        sum = 0u; cnt = 0u; mine = 0u;
#pragma unroll
        for (unsigned j = 0; j < 16; ++j) { const unsigned c = xb_ld(&bar[XB_XCNT(j)]); sum += c; cnt += (c > 0u) ? 1u : 0u; mine = (j == x) ? c : mine; }
        if (sum == G) break;
        __builtin_amdgcn_s_sleep(1);
        if ((++sp & 255u) == 0u) { if (xb_ld(&bar[XB_TMO])) break; if (sp > XB_SPIN_CAP) { atomicAdd(&bar[XB_TMO], 1u); break; } }
    }
    nloc = mine > 0u ? mine : 1u; nx = cnt > 0u ? cnt : 1u;
}
__device__ __forceinline__ void xcd_barrier(const XcdBarrier& b) {
    asm volatile("s_waitcnt vmcnt(0)" ::: "memory");
    __syncthreads();
    if (b.leader) {
        unsigned* bar = b.bar;
        __builtin_amdgcn_s_waitcnt(0);
        unsigned nloc = b.st[0], nx = b.st[1];
        if (nloc == 0u) { xcd_barrier_complete(bar, b.x, nloc, nx); b.st[0] = nloc; b.st[1] = nx; }
        const unsigned old = xb_add(&bar[XB_XSUB(b.x)], 1u);
        const unsigned gen = old / nloc;
        if (old + 1u == (gen + 1u) * nloc) {
            __builtin_amdgcn_fence(__ATOMIC_RELEASE, "agent");
            asm volatile("s_waitcnt vmcnt(0)" ::: "memory");
            const unsigned og = xb_add(&bar[XB_TOP], 1u);
            const unsigned tg = og / nx;
            if (og + 1u == (tg + 1u) * nx) xb_add(&bar[XB_TOPGEN], 1u);
            else XB_SPIN(xb_ld(&bar[XB_TOPGEN]) == tg, bar);
            __builtin_amdgcn_fence(__ATOMIC_ACQUIRE, "agent");
            xb_add(&bar[XB_XGEN(b.x)], 1u);
            asm volatile("s_waitcnt vmcnt(0)" ::: "memory");
        } else {
            XB_SPIN(xb_ld(&bar[XB_XGEN(b.x)]) == gen, bar);
            __builtin_amdgcn_fence(__ATOMIC_ACQUIRE, "agent");
            asm volatile("s_waitcnt vmcnt(0)" ::: "memory");
        }
    }
    __syncthreads();
}

struct Args { const float* in[N_IN]; float* out; unsigned char* ws; int ph_lo, ph_hi; };
static_assert(sizeof(Args) == (N_IN + 2) * 8 + 8, "Args has padding");

typedef const __attribute__((address_space(4))) Args CArgs;
struct Ctx {
    CArgs* a; LAS unsigned char* lds; int tid, lane, wid, bid, G;
};

__device__ __forceinline__ void ctx_kv_tile(const Ctx& C) {
    CArgs& a = *C.a; unsigned char* ws = a.ws;
    const int lane = C.lane, fr = lane & 15, fq = lane >> 4;
    const int r0 = (C.bid >> 4) * 128 + C.wid * 16, c0 = (C.bid & 15) * 64;
    const unsigned char* xa = ws + WS_A8 + (size_t)(M + r0 + fr) * 1024 + 32 * fq;
    const unsigned char* wb = ws + WS_W1T + (size_t)(1536 + c0 + fr) * 1024 + 32 * fq;
    f32x4 acc[4];
#pragma unroll
    for (int nb = 0; nb < 4; ++nb) acc[nb] = (f32x4){0.f, 0.f, 0.f, 0.f};
#pragma unroll 2
    for (int ks = 0; ks < 8; ++ks) {
        const v8i xv = __builtin_shufflevector(*(const v4i*)(xa + 128 * ks), *(const v4i*)(xa + 128 * ks + 16), 0, 1, 2, 3, 4, 5, 6, 7);
        v8i wv[4];
#pragma unroll
        for (int nb = 0; nb < 4; ++nb) wv[nb] = __builtin_shufflevector(*(const v4i*)(wb + (size_t)nb * 16384 + 128 * ks), *(const v4i*)(wb + (size_t)nb * 16384 + 128 * ks + 16), 0, 1, 2, 3, 4, 5, 6, 7);
#pragma unroll
        for (int nb = 0; nb < 4; ++nb) pg8::mfma_fp8_acc(acc[nb], wv[nb], xv, 0x7A7A7A7A, 0x7F7F7F7F);
    }
    asm volatile("s_nop 15\n\ts_nop 15" ::: "memory");
#pragma unroll
    for (int nb = 0; nb < 4; ++nb) asm volatile("" : "+v"(acc[nb]));
#pragma unroll
    for (int nb = 0; nb < 4; ++nb) { const int col = c0 + 16 * nb + 4 * fq;
        bf16_t* dst = (bf16_t*)(ws + (col < 512 ? WS_K : WS_V)) + (size_t)(M + r0 + fr) * 512 + (col & 511);
        u32x2 o; o.x = pk2(acc[nb][0], acc[nb][1]); o.y = pk2(acc[nb][2], acc[nb][3]); *(u32x2*)dst = o; }
}

__device__ __forceinline__ int w1_dest_row(int n) {
    if (n < 512) return (n >> 7) * 256 + (n & 127);
    if (n < 1024) { const int q = n - 512; return (q >> 7) * 256 + 128 + (q & 127); }
    return n;
}
__device__ __forceinline__ void transpose_item(const float* W, int K, int N, bf16_t* WT, int item, LAS float* scr, int lane, int mode) {
    const int nblk = N / 32, kb = item / nblk, nb = item % nblk, k0 = 64 * kb, n0 = 32 * nb;
    { f32x4 w[8];
#pragma unroll
      for (int i = 0; i < 8; ++i) w[i] = *(const f32x4*)(W + (size_t)(k0 + 8 * i + (lane >> 3)) * N + n0 + 4 * (lane & 7));
#pragma unroll
      for (int i = 0; i < 8; ++i) { LAS float* d = scr + (8 * i + (lane >> 3)) * 33 + 4 * (lane & 7); d[0] = w[i].x; d[1] = w[i].y; d[2] = w[i].z; d[3] = w[i].w; } }
    asm volatile("s_waitcnt lgkmcnt(0)" ::: "memory"); __builtin_amdgcn_wave_barrier();
    const int c = lane & 7;
#pragma unroll
    for (int j = 0; j < 4; ++j) { const int n = (lane >> 3) + 8 * j; const LAS float* s = scr + (8 * c) * 33 + n;
        const int dr = (mode & 1) ? w1_dest_row(n0 + n) : (n0 + n);
        if (mode & 2) {
            u32x2 o; o.x = pk4_fp8(s[0 * 33] * 32.f, s[1 * 33] * 32.f, s[2 * 33] * 32.f, s[3 * 33] * 32.f); o.y = pk4_fp8(s[4 * 33] * 32.f, s[5 * 33] * 32.f, s[6 * 33] * 32.f, s[7 * 33] * 32.f);
            *(u32x2*)((unsigned char*)WT + (size_t)dr * K + k0 + 8 * c) = o;
        } else {
            u32x4 o; o.x = pk2(s[0 * 33], s[1 * 33]); o.y = pk2(s[2 * 33], s[3 * 33]); o.z = pk2(s[4 * 33], s[5 * 33]); o.w = pk2(s[6 * 33], s[7 * 33]);
            *(u32x4*)(WT + (size_t)dr * K + k0 + 8 * c) = o; } }
    asm volatile("s_waitcnt lgkmcnt(0)" ::: "memory"); __builtin_amdgcn_wave_barrier();
}
__device__ __forceinline__ void convert_task(const float* src, bf16_t* dst, size_t base, int lane) {
#pragma unroll
    for (int it = 0; it < 8; ++it) { const size_t i = base + (size_t)it * 512 + lane * 8;
        const f32x4 a = *(const f32x4*)(src + i), b = *(const f32x4*)(src + i + 4);
        u32x4 o; o.x = pk2(a[0], a[1]); o.y = pk2(a[2], a[3]); o.z = pk2(b[0], b[1]); o.w = pk2(b[2], b[3]);
        *(u32x4*)(dst + i) = o; }
}
__device__ __forceinline__ void fp8_rows_task(const float* src, unsigned char* dst, unsigned char* sinv, size_t row0, int lane) {
#pragma unroll 2
    for (int r = 0; r < 8; ++r) { const size_t row = row0 + r;
        f32x4 v[4]; float am = 0.f;
#pragma unroll
        for (int j = 0; j < 4; ++j) { v[j] = *(const f32x4*)(src + row * 1024 + 16 * lane + 4 * j);
            am = fmaxf(am, fmaxf(fmaxf(fabsf(v[j].x), fabsf(v[j].y)), fmaxf(fabsf(v[j].z), fabsf(v[j].w)))); }
#pragma unroll
        for (int o = 1; o < 64; o <<= 1) am = fmaxf(am, __shfl_xor(am, o));
        unsigned be = (__float_as_uint(am) >> 23) & 0xffu; be = be < 8u ? 8u : be;
        const float sc = __uint_as_float((261u - be) << 23);
        u32x4 w;
#pragma unroll
        for (int j = 0; j < 4; ++j) { int pk = 0;
            pk = __builtin_amdgcn_cvt_pk_fp8_f32(v[j].x * sc, v[j].y * sc, pk, false);
            pk = __builtin_amdgcn_cvt_pk_fp8_f32(v[j].z * sc, v[j].w * sc, pk, true);
            w[j] = (unsigned)pk; }
        const size_t l = row / NEXP, e = row % NEXP;
        *(u32x4*)(dst + (((l * 8 + (size_t)(lane >> 3)) * NEXP + e) * 128) + 16 * (lane & 7)) = w;
        if (lane == 0) sinv[row] = (unsigned char)(be - 7u); }
}
__device__ __forceinline__ void table_task(const Ctx& C, int t) {
    CArgs& a = *C.a; unsigned char* ws = a.ws;
    if (t < 4096) fp8_rows_task(a.in[I_PU], ws + WS_TU, ws + WS_SIU, (size_t)t * 8, C.lane);
    else fp8_rows_task(a.in[I_PV], ws + WS_TV, ws + WS_SIV, (size_t)(t - 4096) * 8, C.lane);
}
__device__ __forceinline__ void phaseA(const Ctx& C) {
    CArgs& a = *C.a; unsigned char* ws = a.ws;
    LAS float* S = (LAS float*)C.lds;
    for (int i = C.tid; i < 9 * 1024; i += 512) { const int row = i >> 10, k = i & 1023; const float c = row < 8 ? a.in[I_C][row * 1024 + k] : a.in[I_CCTX][k]; S[i] = c / (1.f + __expf(-c)); }
    __syncthreads();
    LAS float* scr = (LAS float*)(C.lds + 40960 + C.wid * 8448);
    const int gw = C.wid * C.G + C.bid, NGW = C.G * 8;
    constexpr int T_ADA = 1536, T_W1 = 16 * 80, T_W2 = 16 * 32, T_SI = 16 * 64, T_SO = 16 * 32, T_WQ = 2 * 16 * 64;
    constexpr int T_KEYS = 2 * 8 * 2 * 128 * 128 / 4096, T_WSP = 8 * 128 * 128 / 4096;
    constexpr int NT = T_ADA + T_W1 + T_W2 + T_SI + T_SO + T_WQ + T_KEYS + T_WSP;
    float* modp = (float*)(ws + WS_MODP);
    for (int T = gw; T < NT; T += NGW) {
        int t = T;
        if (t < T_ADA) {
            const int l = t / 768, r = t % 768, cb = r >> 3, ks = r & 7;
            const int kg = C.lane >> 4, c4 = 4 * (C.lane & 15);
            const float* W = a.in[I_ADAW] + (size_t)l * 1024 * 6144 + (size_t)(ks * 128 + kg) * 6144 + cb * 64 + c4;
            f32x4 acc[9];
#pragma unroll
            for (int q = 0; q < 9; ++q) acc[q] = (f32x4){0.f, 0.f, 0.f, 0.f};
#pragma unroll 1
            for (int k0 = 0; k0 < 128; k0 += 32) {
                f32x4 w[8];
#pragma unroll
                for (int i = 0; i < 8; ++i) w[i] = *(const f32x4*)(W + (size_t)(k0 + 4 * i) * 6144);
#pragma unroll
                for (int i = 0; i < 8; ++i)
#pragma unroll
                    for (int q = 0; q < 9; ++q) acc[q] += S[q * 1024 + ks * 128 + k0 + 4 * i + kg] * w[i];
            }
#pragma unroll
            for (int q = 0; q < 9; ++q)
#pragma unroll
                for (int e = 0; e < 4; ++e) { float v = acc[q][e]; v += __shfl_xor(v, 16); v += __shfl_xor(v, 32); acc[q][e] = v; }
            if (C.lane < 16) { float* P = modp + ((size_t)(l * 8 + ks) * 9) * 6144 + cb * 64 + c4;
#pragma unroll
                for (int q = 0; q < 9; ++q) *(f32x4*)(P + (size_t)q * 6144) = acc[q]; }
            continue;
        }
        t -= T_ADA;
        if (t < T_W1) { transpose_item(a.in[I_WIN], 1024, 2560, (bf16_t*)(ws + WS_W1T), t, scr, C.lane, 3); continue; } t -= T_W1;
        if (t < T_W2) { transpose_item(a.in[I_WOUT], 1024, 1024, (bf16_t*)(ws + WS_W2T), t, scr, C.lane, 2); continue; } t -= T_W2;
        if (t < T_SI) { transpose_item(a.in[I_SGUIN], 1024, 2048, (bf16_t*)(ws + WS_WSI), t, scr, C.lane, 2); continue; } t -= T_SI;
        if (t < T_SO) { transpose_item(a.in[I_SGUOUT], 1024, 1024, (bf16_t*)(ws + WS_WSO), t, scr, C.lane, 2); continue; } t -= T_SO;
        if (t < T_WQ) { const int l = t / 1024; transpose_item(a.in[I_WQ] + (size_t)l * 1024 * 2048, 1024, 2048, (bf16_t*)(ws + WS_WQ) + (size_t)l * 2048 * 1024, t % 1024, scr, C.lane, 0); continue; } t -= T_WQ;
        if (t < T_KEYS) { convert_task(a.in[I_KEYS], (bf16_t*)(ws + WS_KEYS), (size_t)t * 4096, C.lane); continue; } t -= T_KEYS;
        convert_task(a.in[I_WS], (bf16_t*)(ws + WS_WSP), (size_t)t * 4096, C.lane);
    }
}

template <int NR>
__device__ __forceinline__ void modulate_rows(const float* xrow0, bf16_t* orow0, const LAS float* GS, const LAS float* SH, int lane) {
    f32x4 v[NR][4];
#pragma unroll
    for (int r = 0; r < NR; ++r)
#pragma unroll
        for (int j = 0; j < 4; ++j) v[r][j] = *((const f32x4*)(xrow0 + (size_t)r * D) + lane + 64 * j);
#pragma unroll
    for (int r = 0; r < NR; ++r) {
        float s = 0.f;
#pragma unroll
        for (int j = 0; j < 4; ++j) s += (v[r][j].x * v[r][j].x + v[r][j].y * v[r][j].y) + (v[r][j].z * v[r][j].z + v[r][j].w * v[r][j].w);
        const float rinv = rsqrtf(wave_sum(s) * (1.f / D) + EPS);
        unsigned* o8 = (unsigned*)((unsigned char*)orow0 + (size_t)r * D) + lane;
#pragma unroll
        for (int j = 0; j < 4; ++j) { const f32x4 g = *(const LAS f32x4*)(GS + 4 * lane + 256 * j), h = *(const LAS f32x4*)(SH + 4 * lane + 256 * j);
            const f32x4 y = v[r][j] * rinv * g + h;
            o8[64 * j] = pk4_fp8(y.x, y.y, y.z, y.w); }
    }
}

template <int NR, bool OUT8>
__device__ __forceinline__ void modulate_rows_h(const bf16_t* hrow0, void* orow0v, const LAS float* GS, const LAS float* SH, int lane) {
    u32x4 v[NR][2];
#pragma unroll
    for (int r = 0; r < NR; ++r)
#pragma unroll
        for (int j = 0; j < 2; ++j) v[r][j] = *(const u32x4*)(hrow0 + (size_t)r * D + 512 * j + 8 * lane);
#pragma unroll
    for (int r = 0; r < NR; ++r) {
        float x[16]; float s = 0.f;
#pragma unroll
        for (int j = 0; j < 2; ++j)
#pragma unroll
            for (int e = 0; e < 4; ++e) { x[8 * j + 2 * e] = bf_lo(v[r][j][e]); x[8 * j + 2 * e + 1] = bf_hi(v[r][j][e]); }
#pragma unroll
        for (int e = 0; e < 16; ++e) s += x[e] * x[e];
        const float rinv = rsqrtf(wave_sum(s) * (1.f / D) + EPS);
#pragma unroll
        for (int j = 0; j < 2; ++j) { float y[8];
#pragma unroll
            for (int q = 0; q < 2; ++q) { const f32x4 g = *(const LAS f32x4*)(GS + 512 * j + 8 * lane + 4 * q), h = *(const LAS f32x4*)(SH + 512 * j + 8 * lane + 4 * q);
#pragma unroll
                for (int e = 0; e < 4; ++e) y[4 * q + e] = x[8 * j + 4 * q + e] * rinv * g[e] + h[e]; }
            if (OUT8) { u32x2 w; w.x = pk4_fp8(y[0], y[1], y[2], y[3]); w.y = pk4_fp8(y[4], y[5], y[6], y[7]);
                *(u32x2*)((unsigned char*)orow0v + (size_t)r * D + 512 * j + 8 * lane) = w; }
            else { u32x4 w; w.x = pk2(y[0], y[1]); w.y = pk2(y[2], y[3]); w.z = pk2(y[4], y[5]); w.w = pk2(y[6], y[7]);
                *(u32x4*)((bf16_t*)orow0v + (size_t)r * D + 512 * j + 8 * lane) = w; } }
    }
}

__device__ __forceinline__ void phaseB(const Ctx& C) {
    CArgs& a = *C.a; unsigned char* ws = a.ws;
    const float* modp = (const float*)(ws + WS_MODP); float* modf = (float*)(ws + WS_MODF);
    {
        const int e = C.bid * 512 + C.tid;
        if (e < 2 * 9 * 6144) { const int l = e / (9 * 6144), rem = e % (9 * 6144), row = rem / 6144, j = rem % 6144;
            float v = a.in[I_ADAB][l * 6144 + j];
#pragma unroll
            for (int ks = 0; ks < 8; ++ks) v += modp[((size_t)(l * 8 + ks) * 9 + row) * 6144 + j];
            modf[e] = v; }
    }
    LAS float* GS = (LAS float*)C.lds; LAS float* SH = GS + 1024;
    bf16_t* A = (bf16_t*)(ws + WS_A);
    for (int part = 0; part < 2; ++part) {
        const int rb = part == 0 ? (C.bid * 128) / SEQ : 8;
        __syncthreads();
        for (int c = C.tid; c < 1024; c += 512) {
            float sh = a.in[I_ADAB][c], sc = a.in[I_ADAB][1024 + c];
#pragma unroll
            for (int ks = 0; ks < 8; ++ks) { sh += modp[((size_t)(0 * 8 + ks) * 9 + rb) * 6144 + c]; sc += modp[((size_t)(0 * 8 + ks) * 9 + rb) * 6144 + 1024 + c]; }
            GS[c] = a.in[I_N1G][c] * (1.f + sc); SH[c] = sh;
        }
        __syncthreads();
        unsigned char* A8 = ws + WS_A8;
        if (part == 0) { for (int i = 0; i < 16; i += 4) { const int r = C.bid * 128 + C.wid * 16 + i; modulate_rows<4>(a.in[I_X] + (size_t)r * D, (bf16_t*)(A8 + (size_t)r * D), GS, SH, C.lane); } }
        else { const int r = C.bid * 8 + C.wid; modulate_rows<1>(a.in[I_CTX] + (size_t)r * D, (bf16_t*)(A8 + (size_t)(M + r) * D), GS, SH, C.lane); }
    }
}

__device__ __forceinline__ void conv_tile(const Ctx& C, int tile) {
    CArgs& a = *C.a; unsigned char* ws = a.ws;
    const bf16_t* GLU = (const bf16_t*)(ws + WS_GLU); unsigned char* Y8 = ws + WS_A8;
    const int b = tile >> 6, t0 = (tile & 63) * 64;
    __syncthreads();
    for (int i = C.tid; i < 94 * 64; i += 512) { const int row = i >> 6, ch = i & 63, t = t0 - 15 + row;
        u32x4 v = (u32x4){0u, 0u, 0u, 0u};
        if (t >= 0 && t < SEQ) v = *(const u32x4*)(GLU + ((size_t)(b * SEQ + t)) * 512 + ch * 8);
        *(LAS u32x4*)(C.lds + (size_t)i * 16) = v; }
    __syncthreads();
    const int half = C.tid >> 8, cp = C.tid & 255;
    float w0[31], w1[31];
#pragma unroll
    for (int j = 0; j < 31; ++j) { const f32x2 w = *(const f32x2*)(a.in[I_CONVW] + j * 512 + 2 * cp); w0[j] = w.x; w1[j] = w.y; }
    const f32x2 cb = *(const f32x2*)(a.in[I_CONVB] + 2 * cp), gg = *(const f32x2*)(a.in[I_GNG] + 2 * cp), gb = *(const f32x2*)(a.in[I_GNB] + 2 * cp);
    const LAS unsigned* L = (const LAS unsigned*)C.lds;
#pragma unroll 1
    for (int sb = 0; sb < 4; ++sb) {
        const int ob = 32 * half + 8 * sb;
        float a0[8], a1[8], x0[38], x1[38];
#pragma unroll
        for (int i = 0; i < 38; ++i) { const unsigned u = L[(ob + i) * 256 + cp]; x0[i] = bf_lo(u); x1[i] = bf_hi(u); }
#pragma unroll
        for (int o = 0; o < 8; ++o) { float s0 = cb.x, s1 = cb.y;
#pragma unroll
            for (int j = 0; j < 31; ++j) { s0 += w0[j] * x0[o + j]; s1 += w1[j] * x1[o + j]; }
            a0[o] = s0; a1[o] = s1; }
#pragma unroll
        for (int o = 0; o < 8; ++o) {
            const float s = sum32(a0[o] + a1[o]);
            const float mu = s * (1.f / 64.f), d0 = a0[o] - mu, d1 = a1[o] - mu;
            const float q = sum32(d0 * d0 + d1 * d1);
            const float rstd = rsqrtf(q * (1.f / 64.f) + EPS);
            const float y0 = d0 * rstd * gg.x + gb.x, y1 = d1 * rstd * gg.y + gb.y;
            *(unsigned short*)(Y8 + ((size_t)(b * SEQ + t0 + ob + o)) * D + 2 * cp) = (unsigned short)(pk4_fp8(y0 * sigmoidf_(y0), y1 * sigmoidf_(y1), 0.f, 0.f) & 0xffffu);
        }
    }
}

template <bool WIN>
__device__ __forceinline__ void att_softmax(f32x16& S, float& mrun, float& lrun, f32x16& O0, f32x16& O1, bf16x8 (&pb)[2], int W, const LAS float* bp) {
    if (WIN) {
        float bias[16];
#pragma unroll
        for (int e = 0; e < 16; ++e) bias[e] = bp[(e & 3) + 8 * (e >> 2)];
#pragma unroll
        for (int e = 0; e < 16; ++e) asm volatile("" : "+v"(bias[e]));
#pragma unroll
        for (int e = 0; e < 16; ++e) { const int m = __builtin_amdgcn_sbfe(W, (e & 3) + 8 * (e >> 2), 1);
            S[e] = __int_as_float((__float_as_int(S[e] + bias[e]) & m) | (__float_as_int(-1e30f) & ~m)); }
    }
    float mt = S[0];
#pragma unroll
    for (int e = 1; e < 16; ++e) mt = fmaxf(mt, S[e]);
    mt = fmaxf(mt, __shfl_xor(mt, 32));
    const float mn = fmaxf(mrun, mt), alpha = __builtin_amdgcn_exp2f(mrun - mn);
    mrun = mn;
    float ps = 0.f; float p[16];
#pragma unroll
    for (int e = 0; e < 16; ++e) { p[e] = __builtin_amdgcn_exp2f(S[e] - mn); ps += p[e]; }
    lrun = lrun * alpha + ps;
    if (!__all(alpha == 1.f)) {
#pragma unroll
        for (int e = 0; e < 16; ++e) { O0[e] *= alpha; O1[e] *= alpha; }
    }
#pragma unroll
    for (int s2 = 0; s2 < 2; ++s2) { u32x4 w; w.x = pk2(p[8 * s2 + 0], p[8 * s2 + 1]); w.y = pk2(p[8 * s2 + 2], p[8 * s2 + 3]); w.z = pk2(p[8 * s2 + 4], p[8 * s2 + 5]); w.w = pk2(p[8 * s2 + 6], p[8 * s2 + 7]);
        pb[s2] = __builtin_bit_cast(bf16x8, w); }
}
__device__ __forceinline__ void attn_task(const Ctx& C, int task) {
    CArgs& a = *C.a; unsigned char* ws = a.ws;
    const bf16_t* Qb = (const bf16_t*)(ws + WS_Q); const bf16_t* Kb = (const bf16_t*)(ws + WS_K); const bf16_t* Vb = (const bf16_t*)(ws + WS_V);
    unsigned char* Y8 = ws + WS_A8;
    const int h = task & 7, ch = (task >> 3) & 1, rp = (task >> 4) & 31, b = task >> 9;
    const int lane = C.lane, n = lane & 31, hh = lane >> 5;
    const int krA = 2 * rp - 4 < 0 ? 0 : (2 * rp - 4 > 56 ? 56 : 2 * rp - 4), krB = 2 * rp - 3 < 0 ? 0 : (2 * rp - 3 > 56 ? 56 : 2 * rp - 3);
    const int nr = krB + 8 - krA;
    LAS unsigned char* lw = C.lds + C.wid * 14592;
    LAS unsigned char* KT = lw; LAS unsigned char* VT = lw + 5760;
    LAS float* RP = (LAS float*)(lw + 11520);
    for (int i = lane; i < 465; i += 64) RP[64 + i] = a.in[I_RPB][h * 465 + i] * 1.44269504f;
    const int rq = 2 * rp + (n >> 4), kr0q = rq - 4 < 0 ? 0 : (rq - 4 > 56 ? 56 : rq - 4);
    int qtok[2], bs[2], Wq[2]; const LAS float* bp0[2];
#pragma unroll
    for (int qb = 0; qb < 2; ++qb) {
        const int j = 2 * ch + qb, qc = 16 * j + (n & 15);
        qtok[qb] = b * SEQ + rq * 64 + qc;
        bs[qb] = 16 * j - 8 < 0 ? 0 : (16 * j - 8 > 32 ? 32 : 16 * j - 8);
        const int cs = qc - 8 < 0 ? 0 : (qc - 8 > 48 ? 48 : qc - 8);
        int tq = bs[qb] + 4 * hh - cs; tq = tq < -32 ? -32 : (tq > 31 ? 31 : tq);
        Wq[qb] = (int)(unsigned)((0xFFFFull << 32) >> (32 + tq));
        bp0[qb] = RP + 64 + (krA - rq + 7) * 31 + bs[qb] + 4 * hh - qc + 15;
    }
    bf16x8 bq[2][4];
#pragma unroll
    for (int qb = 0; qb < 2; ++qb)
#pragma unroll
        for (int s = 0; s < 4; ++s) bq[qb][s] = *(const bf16x8*)(Qb + (size_t)qtok[qb] * 512 + h * 64 + 16 * s + 8 * hh);
    f32x16 O[2][2];
#pragma unroll
    for (int i = 0; i < 2; ++i)
#pragma unroll
        for (int j = 0; j < 2; ++j)
#pragma unroll
            for (int e = 0; e < 16; ++e) O[i][j][e] = 0.f;
    float mrun[2] = {-1e30f, -1e30f}, lrun[2] = {0.f, 0.f};
    const int lk = lane >> 3, lc = lane & 7;
    const int ub = 24 * ch;
    u32x4 kq[5], vq[5];
#define ATT_FETCH(NI_, tok_) do { const size_t tb_ = (size_t)(tok_) + lk; _Pragma("unroll") for (int i = 0; i < NI_; ++i) { \
        kq[i] = *(const u32x4*)(Kb + (tb_ + 8 * i) * 512 + h * 64 + lc * 8); vq[i] = *(const u32x4*)(Vb + (tb_ + 8 * i) * 512 + h * 64 + lc * 8); } } while (0)
#define ATT_STAGE(NI_) do { _Pragma("unroll") for (int i = 0; i < NI_; ++i) { *(LAS u32x4*)(KT + (8 * i + lk) * 144 + lc * 16) = kq[i]; *(LAS u32x4*)(VT + (8 * i + lk) * 144 + lc * 16) = vq[i]; } } while (0)
    typedef short s4v __attribute__((ext_vector_type(4)));
    const LAS unsigned char* vp0 = VT + (4 * hh + ((lane & 15) >> 2)) * 144 + (16 * ((lane >> 4) & 1) + 4 * (lane & 3)) * 2;
#define ATT_VA(db_, s2_, k0_) ({ const LAS unsigned char* vp_ = vp0 + (16 * (s2_) + (k0_)) * 144 + 64 * (db_); \
        const s4v lo_ = __builtin_amdgcn_ds_read_tr16_b64_v4i16((LAS s4v*)vp_), hi_ = __builtin_amdgcn_ds_read_tr16_b64_v4i16((LAS s4v*)(vp_ + 8 * 144)); \
        (bf16x8)__builtin_shufflevector(lo_, hi_, 0, 1, 2, 3, 4, 5, 6, 7); })
    ATT_FETCH(4, M + b * CTXL);
#pragma unroll 1
    for (int kt = 0; kt < 8; ++kt) {
        ATT_STAGE(4);
        if (kt < 7) ATT_FETCH(4, M + b * CTXL + 32 * (kt + 1)); else ATT_FETCH(5, b * SEQ + krA * 64 + ub);
        bf16x8 kf[4];
#pragma unroll
        for (int s = 0; s < 4; ++s) kf[s] = *(const LAS bf16x8*)(KT + n * 144 + 32 * s + 16 * hh);
        bf16x8 pb[2][2];
#pragma unroll
        for (int qb = 0; qb < 2; ++qb) {
            f32x16 S;
#pragma unroll
            for (int e = 0; e < 16; ++e) S[e] = 0.f;
#pragma unroll
            for (int s = 0; s < 4; ++s) S = __builtin_amdgcn_mfma_f32_32x32x16_bf16(kf[s], bq[qb][s], S, 0, 0, 0);
            att_softmax<false>(S, mrun[qb], lrun[qb], O[0][qb], O[1][qb], pb[qb], 0, RP);
        }
#pragma unroll
        for (int db = 0; db < 2; ++db)
#pragma unroll
            for (int s2 = 0; s2 < 2; ++s2) { const bf16x8 va = ATT_VA(db, s2, 0);
#pragma unroll
                for (int qb = 0; qb < 2; ++qb) O[db][qb] = __builtin_amdgcn_mfma_f32_32x32x16_bf16(va, pb[qb][s2], O[db][qb], 0, 0, 0); }
    }
#pragma unroll 1
    for (int i = 0; i < nr; ++i) {
        const int W = ((unsigned)(krA + i - kr0q) < 8u) ? -1 : 0;
        ATT_STAGE(5);
        ATT_FETCH(5, b * SEQ + (krA + (i + 1 < nr ? i + 1 : i)) * 64 + ub);
#pragma unroll
        for (int qb = 0; qb < 2; ++qb) {
            bf16x8 kf[4];
#pragma unroll
            for (int s = 0; s < 4; ++s) kf[s] = *(const LAS bf16x8*)(KT + (n + 8 * qb) * 144 + 32 * s + 16 * hh);
            f32x16 S;
#pragma unroll
            for (int e = 0; e < 16; ++e) S[e] = 0.f;
#pragma unroll
            for (int s = 0; s < 4; ++s) S = __builtin_amdgcn_mfma_f32_32x32x16_bf16(kf[s], bq[qb][s], S, 0, 0, 0);
            bf16x8 pb[2];
            att_softmax<true>(S, mrun[qb], lrun[qb], O[0][qb], O[1][qb], pb, Wq[qb] & W, bp0[qb] + 31 * i);
#pragma unroll
            for (int db = 0; db < 2; ++db)
#pragma unroll
                for (int s2 = 0; s2 < 2; ++s2) { const bf16x8 va = ATT_VA(db, s2, 8 * qb); O[db][qb] = __builtin_amdgcn_mfma_f32_32x32x16_bf16(va, pb[s2], O[db][qb], 0, 0, 0); }
        }
    }
#undef ATT_FETCH
#undef ATT_STAGE
#undef ATT_VA
#pragma unroll
    for (int qb = 0; qb < 2; ++qb) {
        const float lt = lrun[qb] + __shfl_xor(lrun[qb], 32), inv = 1.f / lt;
        unsigned char* yrow = Y8 + (size_t)qtok[qb] * D + 512 + h * 64;
#pragma unroll
        for (int db = 0; db < 2; ++db)
#pragma unroll
            for (int g = 0; g < 4; ++g)
                *(unsigned*)(yrow + 32 * db + 8 * g + 4 * hh) = pk4_fp8(O[db][qb][4 * g] * inv, O[db][qb][4 * g + 1] * inv, O[db][qb][4 * g + 2] * inv, O[db][qb][4 * g + 3] * inv);
    }
}

__device__ __forceinline__ void phaseNorm2(const Ctx& C, int l) {
    CArgs& a = *C.a; unsigned char* ws = a.ws;
    const float* modf = (const float*)(ws + WS_MODF) + (size_t)l * 9 * 6144;
    LAS float* GS = (LAS float*)C.lds; LAS float* SH = GS + 1024;
    const int b = (C.bid * 128) / SEQ;
    for (int c = C.tid; c < 1024; c += 512) { GS[c] = a.in[I_N2G][l * 1024 + c] * (1.f + modf[b * 6144 + 4 * 1024 + c]); SH[c] = modf[b * 6144 + 3 * 1024 + c]; }
    __syncthreads();
    bf16_t* A = (bf16_t*)(ws + WS_A);
    const bf16_t* Hb = (const bf16_t*)(ws + WS_H);
    { const int r = C.bid * 128 + C.wid * 16; modulate_rows_h<16, false>(Hb + (size_t)r * D, A + (size_t)r * D, GS, SH, C.lane); }
}

__device__ __forceinline__ void ce_desc(float& x, float& y) { const float hi = fmaxf(x, y), lo = fminf(x, y); x = hi; y = lo; }
__device__ __forceinline__ void ce_asc(float& x, float& y) { const float hi = fmaxf(x, y), lo = fminf(x, y); x = lo; y = hi; }
__device__ __forceinline__ void sort16_desc(float (&v)[16]) {
#define CE(a_, b_) ce_desc(v[a_], v[b_]);
    CE(0,13) CE(1,12) CE(2,15) CE(3,14) CE(4,8) CE(5,6) CE(7,11) CE(9,10)
    CE(0,5) CE(1,7) CE(2,9) CE(3,4) CE(6,13) CE(8,14) CE(10,15) CE(11,12)
    CE(0,1) CE(2,3) CE(4,5) CE(6,8) CE(7,9) CE(10,11) CE(12,13) CE(14,15)
    CE(0,2) CE(1,3) CE(4,10) CE(5,11) CE(6,7) CE(8,9) CE(12,14) CE(13,15)
    CE(1,2) CE(3,12) CE(4,6) CE(5,7) CE(8,10) CE(9,11) CE(13,14)
    CE(1,4) CE(2,6) CE(5,8) CE(7,10) CE(9,13) CE(11,14)
    CE(2,4) CE(3,6) CE(9,12) CE(11,13)
    CE(3,5) CE(6,8) CE(7,9) CE(10,12)
    CE(3,4) CE(5,6) CE(7,8) CE(9,10) CE(11,12)
    CE(6,7) CE(8,9)
#undef CE
}
__device__ __forceinline__ void merge16_desc(float (&A)[16], const float (&B)[16]) {
#pragma unroll
    for (int i = 0; i < 16; ++i) A[i] = fmaxf(A[i], B[15 - i]);
#pragma unroll
    for (int j = 8; j > 0; j >>= 1)
#pragma unroll
        for (int i = 0; i < 16; ++i) { const int l = i ^ j; if (l > i) ce_desc(A[i], A[l]); }
}
__device__ __forceinline__ bf16x8 topk_qfrag(const bf16_t* QP, int tok, int h, int p, int hh, int s) { return *(const bf16x8*)(QP + (size_t)tok * 2048 + h * 256 + p * 128 + 64 * hh + 8 * s); }
__device__ __forceinline__ void topk_task(const Ctx& C, int l, int tok0, int ntok0, int h, const LAS unsigned char* KL, bf16x8 (&bq)[2][8]) {
    CArgs& a = *C.a; unsigned char* ws = a.ws;
    const bf16_t* QP = (const bf16_t*)(ws + WS_QP);
    unsigned short* IDX = (unsigned short*)(ws + WS_IDX); float* WT = (float*)(ws + WS_WT);
    const int lane = C.lane, n = lane & 31, hh = lane >> 5;
    const int tok = tok0 + n;
    float sp[2][16];
#pragma unroll
    for (int p = 0; p < 2; ++p) {
        float top[16];
#pragma unroll
        for (int kb = 0; kb < 4; ++kb) {
            f32x16 S;
#pragma unroll
            for (int e = 0; e < 16; ++e) S[e] = 0.f;
#pragma unroll
            for (int s = 0; s < 8; ++s) { const bf16x8 kf = *(const LAS bf16x8*)(KL + (p * 128 + 32 * kb + n) * 272 + 128 * hh + 16 * s);
                S = __builtin_amdgcn_mfma_f32_32x32x16_bf16(kf, bq[p][s], S, 0, 0, 0); }
            if (kb == 3) {
#pragma unroll
                for (int s = 0; s < 8; ++s) bq[p][s] = topk_qfrag(QP, ntok0 + n, h, p, hh, s); }
            float ch[16];
#pragma unroll
            for (int e = 0; e < 16; ++e) { const unsigned key = 32 * kb + (e & 3) + 8 * (e >> 2) + 4 * hh; ch[e] = __uint_as_float((__float_as_uint(S[e]) & ~0x7Fu) | key); }
            sort16_desc(ch);
            if (kb == 0) {
#pragma unroll
                for (int e = 0; e < 16; ++e) top[e] = ch[e];
            } else merge16_desc(top, ch);
        }
        float oth[16];
#pragma unroll
        for (int e = 0; e < 16; ++e) oth[e] = __shfl_xor(top[e], 32);
        merge16_desc(top, oth);
#pragma unroll
        for (int e = 0; e < 16; ++e) sp[p][e] = top[e];
    }
    const float NEG = -3.0e38f;
    auto cand = [&](int ia, int ib) -> float { const float s = sp[0][ia] + sp[1][ib]; return __uint_as_float((__float_as_uint(s) & ~0xFFu) | (unsigned)((ia << 4) | ib)); };
    float L1[16], L2[16], L3[16], L4[16];
#pragma unroll
    for (int i = 0; i < 16; ++i) { L1[i] = cand(0, i); L2[i] = i < 15 ? cand(i + 1, 0) : NEG; L4[i] = NEG; }
#pragma unroll
    for (int i = 0; i < 7; ++i) L3[i] = cand(1, i + 1);
#pragma unroll
    for (int i = 0; i < 6; ++i) L3[7 + i] = cand(i + 2, 1);
#pragma unroll
    for (int i = 0; i < 3; ++i) L3[13 + i] = cand(2, i + 2);
    L4[0] = cand(3, 2); L4[1] = cand(4, 2); L4[2] = cand(3, 3);
    sort16_desc(L3);
    ce_desc(L4[0], L4[1]); ce_desc(L4[1], L4[2]); ce_desc(L4[0], L4[1]);
    merge16_desc(L1, L2); merge16_desc(L3, L4); merge16_desc(L1, L3);
    if (hh == 0) {
        float e16[16], se = 0.f;
#pragma unroll
        for (int i = 0; i < 16; ++i) { e16[i] = __expf(L1[i] - L1[0]); se += e16[i]; }
        const float inv = 1.f / se;
        LAS unsigned* tb = (LAS unsigned*)(C.lds + 69632 + C.wid * 4224) + n * 33;
#pragma unroll
        for (int i = 0; i < 16; ++i) { tb[i] = __float_as_uint(sp[0][i]) & 0x7Fu; tb[16 + i] = __float_as_uint(sp[1][i]) & 0x7Fu; }
        unsigned ids[16];
#pragma unroll
        for (int i = 0; i < 16; ++i) { const unsigned code = __float_as_uint(L1[i]) & 0xFFu; ids[i] = tb[code >> 4] * 128u + tb[16 + (code & 15u)]; }
        float su[16], sv[16];
        { const LAS unsigned char* SEU = C.lds + 103424; const LAS unsigned char* SEV = SEU + NEXP;
#pragma unroll
          for (int i = 0; i < 16; ++i) { su[i] = __uint_as_float((unsigned)SEU[ids[i]] << 23); sv[i] = __uint_as_float((unsigned)SEV[ids[i]] << 23); } }
        u32x4 w0, w1;
        w0.x = ids[0] | (ids[1] << 16); w0.y = ids[2] | (ids[3] << 16); w0.z = ids[4] | (ids[5] << 16); w0.w = ids[6] | (ids[7] << 16);
        w1.x = ids[8] | (ids[9] << 16); w1.y = ids[10] | (ids[11] << 16); w1.z = ids[12] | (ids[13] << 16); w1.w = ids[14] | (ids[15] << 16);
        u32x4* ip = (u32x4*)(IDX + (size_t)tok * 128 + h * 16); ip[0] = w0; ip[1] = w1;
        f32x4* wp = (f32x4*)(WT + (size_t)tok * 128 + h * 16);
        f32x4* sp4 = (f32x4*)((float*)(ws + WS_SU) + (size_t)tok * 128 + h * 16);
#pragma unroll
        for (int i = 0; i < 4; ++i) { wp[i] = (f32x4){e16[4 * i] * inv * sv[4 * i], e16[4 * i + 1] * inv * sv[4 * i + 1], e16[4 * i + 2] * inv * sv[4 * i + 2], e16[4 * i + 3] * inv * sv[4 * i + 3]};
            sp4[i] = (f32x4){su[4 * i], su[4 * i + 1], su[4 * i + 2], su[4 * i + 3]}; }
    }
}
__device__ __forceinline__ void phaseTopk(const Ctx& C, int l) {
    CArgs& a = *C.a; unsigned char* ws = a.ws;
    const int h = C.bid & 7, grp = C.bid >> 3;
    const bf16_t* src = (const bf16_t*)(ws + WS_KEYS) + (size_t)((l * 8 + h) * 2) * 128 * 128;
    for (int i = C.tid; i < 2 * 128 * 16; i += 512) { const int row = i >> 4, chunk = i & 15; *(LAS u32x4*)(C.lds + row * 272 + chunk * 16) = *(const u32x4*)(src + (size_t)row * 128 + chunk * 8); }
    for (int i = C.tid; i < 2048; i += 512) *(LAS u32x4*)(C.lds + 103424 + i * 16) = *(const u32x4*)(ws + (i < 1024 ? WS_SIU : WS_SIV) + (size_t)l * NEXP + (size_t)(i & 1023) * 16);
    __syncthreads();
    bf16x8 bq[2][8];
    { const bf16_t* QP = (const bf16_t*)(ws + WS_QP); const int n = C.lane & 31, hh = C.lane >> 5;
#pragma unroll
      for (int p = 0; p < 2; ++p)
#pragma unroll
          for (int s = 0; s < 8; ++s) bq[p][s] = topk_qfrag(QP, grp * 1024 + C.wid * 32 + n, h, p, hh, s); }
#pragma unroll 1
    for (int t = C.wid; t < 32; t += 8) topk_task(C, l, grp * 1024 + t * 32, grp * 1024 + (t + 8 < 32 ? t + 8 : t) * 32, h, C.lds, bq);
}

__device__ __forceinline__ int peer_dequeue(const Ctx& C, unsigned* q, int js) {
    volatile LAS unsigned* slot = (volatile LAS unsigned*)(C.lds + MISC_OFF + 64);
    __syncthreads();
    if (C.tid == 0) *slot = __hip_atomic_fetch_add(q + js, 1u, __ATOMIC_RELAXED, __HIP_MEMORY_SCOPE_AGENT);
    __syncthreads();
    return (int)*slot;
}
__device__ __forceinline__ float dot16_fp8(const u32x4 (&xf)[2], const u32x4 uw) {
    float d = 0.f;
#pragma unroll
    for (int q = 0; q < 4; ++q) { const unsigned w = uw[q];
        const bf2v lo = __builtin_amdgcn_cvt_scalef32_pk_bf16_fp8(w, 1.0f, false), hi = __builtin_amdgcn_cvt_scalef32_pk_bf16_fp8(w, 1.0f, true);
        const unsigned x0 = xf[q >> 1][2 * (q & 1)], x1 = xf[q >> 1][2 * (q & 1) + 1];
        d = __builtin_amdgcn_fdot2_f32_bf16(__builtin_bit_cast(bf2v, x0), lo, d, false);
        d = __builtin_amdgcn_fdot2_f32_bf16(__builtin_bit_cast(bf2v, x1), hi, d, false); }
    return d;
}
__device__ __forceinline__ void peerU_item(const Ctx& C, int l, int js, int tile) {
    CArgs& a = *C.a; unsigned char* ws = a.ws;
    const bf16_t* A = (const bf16_t*)(ws + WS_A); const unsigned short* IDX = (const unsigned short*)(ws + WS_IDX);
    const unsigned char* TUs = ws + WS_TU + ((size_t)(l * 8 + js) * NEXP) * 128;
    bf16_t* PD = (bf16_t*)(ws + WS_PD) + (size_t)js * M * 128;
    const int lane = C.lane, g = lane >> 3, c = lane & 7;
    LAS unsigned char* lw = C.lds + C.wid * 6144;
#pragma unroll 1
    for (int half = 0; half < 2; ++half) {
        const int tok0 = tile * 128 + C.wid * 16 + half * 8;
        { const u32x4 t0 = *(const u32x4*)((const unsigned char*)(IDX + (size_t)tok0 * 128) + lane * 16), t1 = *(const u32x4*)((const unsigned char*)(IDX + (size_t)tok0 * 128) + (lane + 64) * 16);
          *(LAS u32x4*)(lw + lane * 16) = t0; *(LAS u32x4*)(lw + (lane + 64) * 16) = t1; }
        u32x4 xf[2];
#pragma unroll
        for (int j = 0; j < 2; ++j) xf[j] = *(const u32x4*)(A + (size_t)(tok0 + g) * D + 128 * js + 16 * c + 8 * j);
        bf16_t* prow = PD + (size_t)(tok0 + g) * 128 + 2 * c;
#pragma unroll 1
        for (int kk = 0; kk < 8; ++kk) {
            const u32x4 i0 = *(const LAS u32x4*)(lw + g * 256 + kk * 32), i1 = *(const LAS u32x4*)(lw + g * 256 + kk * 32 + 16);
            u32x4 uf[16];
#pragma unroll
            for (int b = 0; b < 16; ++b) { const unsigned w = b < 8 ? i0[b >> 1] : i1[(b - 8) >> 1]; const unsigned e = (b & 1) ? (w >> 16) : (w & 0xffffu);
                uf[b] = *(const u32x4*)(TUs + (e * 128u + 16u * (unsigned)c)); }
            float v0 = 0.f, v1 = 0.f;
#pragma unroll
            for (int b = 0; b < 16; ++b) { const float d = sum8(dot16_fp8(xf, uf[b]));
                if (b & 1) v1 = (c == (b >> 1)) ? d : v1; else v0 = (c == (b >> 1)) ? d : v0; }
            *(unsigned*)(prow + 16 * kk) = pk2(v0, v1);
        }
    }
}
__device__ __forceinline__ void phasePeerCombine(const Ctx& C) {
    CArgs& a = *C.a; unsigned char* ws = a.ws;
    const u32x2* PD = (const u32x2*)(ws + WS_PD); f32x4* WT = (f32x4*)(ws + WS_WT); const f32x4* SU = (const f32x4*)(ws + WS_SU);
    const size_t n4 = (size_t)M * 128 / 4;
    const size_t stride = (size_t)C.G * 512;
#pragma unroll 1
    for (size_t i = (size_t)C.bid * 512 + C.tid; i < n4; i += 4 * stride) {
        u32x2 w[4][8]; f32x4 su[4], wt[4];
#pragma unroll
        for (int t = 0; t < 4; ++t) {
#pragma unroll
            for (int j = 0; j < 8; ++j) w[t][j] = PD[(size_t)j * n4 + i + t * stride];
            su[t] = SU[i + t * stride]; wt[t] = WT[i + t * stride]; }
#pragma unroll
        for (int t = 0; t < 4; ++t) {
            f32x4 d = (f32x4){0.f, 0.f, 0.f, 0.f};
#pragma unroll
            for (int j = 0; j < 8; ++j) d += (f32x4){bf_lo(w[t][j].x), bf_hi(w[t][j].x), bf_lo(w[t][j].y), bf_hi(w[t][j].y)};
            f32x4 o;
#pragma unroll
            for (int e = 0; e < 4; ++e) o[e] = gelu_erf(d[e] * su[t][e]) * wt[t][e];
            WT[i + t * stride] = o; }
    }
}
__device__ __forceinline__ void peerV_item(const Ctx& C, int l, int js, int tile) {
    CArgs& a = *C.a; unsigned char* ws = a.ws;
    const unsigned short* IDX = (const unsigned short*)(ws + WS_IDX); const float* CF = (const float*)(ws + WS_WT);
    const unsigned char* TVs = ws + WS_TV + ((size_t)(l * 8 + js) * NEXP) * 128;
    const int lane = C.lane, g = lane >> 3, c = lane & 7;
    const int bt = (tile * 128) / SEQ;
    const float* g5p = (const float*)(ws + WS_MODF) + (size_t)l * 9 * 6144 + bt * 6144 + 5 * 1024 + 128 * js + 16 * c;
    f32x4 g5[4];
#pragma unroll
    for (int q = 0; q < 4; ++q) g5[q] = *(const f32x4*)(g5p + 4 * q);
    LAS unsigned char* lw = C.lds + C.wid * 6144;
#pragma unroll 1
    for (int half = 0; half < 2; ++half) {
        const int tok0 = tile * 128 + C.wid * 16 + half * 8;
        { const u32x4 t0 = *(const u32x4*)((const unsigned char*)(IDX + (size_t)tok0 * 128) + lane * 16), t1 = *(const u32x4*)((const unsigned char*)(IDX + (size_t)tok0 * 128) + (lane + 64) * 16);
          u32x4 cfv[4];
#pragma unroll
          for (int j = 0; j < 4; ++j) cfv[j] = *(const u32x4*)((const unsigned char*)(CF + (size_t)tok0 * 128) + (lane + 64 * j) * 16);
          *(LAS u32x4*)(lw + lane * 16) = t0; *(LAS u32x4*)(lw + (lane + 64) * 16) = t1;
#pragma unroll
          for (int j = 0; j < 4; ++j) *(LAS u32x4*)(lw + 2048 + (lane + 64 * j) * 16) = cfv[j]; }
        float acc[16];
#pragma unroll
        for (int e = 0; e < 16; ++e) acc[e] = 0.f;
#pragma unroll 1
        for (int kk = 0; kk < 8; ++kk) {
            const u32x4 i0 = *(const LAS u32x4*)(lw + g * 256 + kk * 32), i1 = *(const LAS u32x4*)(lw + g * 256 + kk * 32 + 16);
            u32x4 vf[16];
#pragma unroll
            for (int b = 0; b < 16; ++b) { const unsigned w = b < 8 ? i0[b >> 1] : i1[(b - 8) >> 1]; const unsigned e = (b & 1) ? (w >> 16) : (w & 0xffffu);
                vf[b] = *(const u32x4*)(TVs + (e * 128u + 16u * (unsigned)c)); }
            f32x4 cf[4];
#pragma unroll
            for (int q = 0; q < 4; ++q) cf[q] = *(const LAS f32x4*)(lw + 2048 + g * 512 + kk * 64 + 16 * q);
#pragma unroll
            for (int b = 0; b < 16; ++b) { const float ck = cf[b >> 2][b & 3];
#pragma unroll
                for (int q = 0; q < 4; ++q) { const unsigned vw = vf[b][q];
                    const f32x2 lo = __builtin_amdgcn_cvt_pk_f32_fp8(vw, false), hi = __builtin_amdgcn_cvt_pk_f32_fp8(vw, true);
                    acc[4 * q] += ck * lo.x; acc[4 * q + 1] += ck * lo.y; acc[4 * q + 2] += ck * hi.x; acc[4 * q + 3] += ck * hi.y; } }
        }
        bf16_t* hp = (bf16_t*)(ws + WS_H) + (size_t)(tok0 + g) * D + 128 * js + 16 * c;
        const u32x4 h0 = *(const u32x4*)hp, h1 = *(const u32x4*)(hp + 8);
        u32x4 o0, o1;
#pragma unroll
        for (int e = 0; e < 4; ++e) { o0[e] = pk2(bf_lo(h0[e]) + g5[e >> 1][2 * (e & 1)] * acc[2 * e], bf_hi(h0[e]) + g5[e >> 1][2 * (e & 1) + 1] * acc[2 * e + 1]);
                                      o1[e] = pk2(bf_lo(h1[e]) + g5[2 + (e >> 1)][2 * (e & 1)] * acc[8 + 2 * e], bf_hi(h1[e]) + g5[2 + (e >> 1)][2 * (e & 1) + 1] * acc[8 + 2 * e + 1]); }
        *(u32x4*)hp = o0; *(u32x4*)(hp + 8) = o1;
    }
}
template <int WHICH> __device__ __forceinline__ void phasePeerSliced(const Ctx& C, int l) {
    const int xcc = (int)(xb_xcc_id() & 7u);
    unsigned* q = (unsigned*)(C.a->ws + WS_CTL) + 8192 + 16 * (2 * l + WHICH);
    volatile LAS unsigned* slot = (volatile LAS unsigned*)(C.lds + MISC_OFF + 64);
#pragma unroll 1
    for (int at = 0; at < 8; ++at) { const int js = (xcc + at) & 7;
        int tile = peer_dequeue(C, q, js);
#pragma unroll 1
        while (tile < M / 128) {
            unsigned nxt = 0u;
            if (C.tid == 0) nxt = __hip_atomic_fetch_add(q + js, 1u, __ATOMIC_RELAXED, __HIP_MEMORY_SCOPE_AGENT);
            if (WHICH == 0) peerU_item(C, l, js, tile); else peerV_item(C, l, js, tile);
            __syncthreads();
            if (C.tid == 0) *slot = nxt;
            __syncthreads();
            tile = (int)*slot;
        } }
}
__device__ __forceinline__ void phasePeerNorm(const Ctx& C, int l) {
    CArgs& a = *C.a; unsigned char* ws = a.ws;
    if (l == 0) {
        const float* modf = (const float*)(ws + WS_MODF) + (size_t)9 * 6144;
        LAS float* GS = (LAS float*)C.lds; LAS float* SH = GS + 1024;
        const int b = (C.bid * 128) / SEQ;
        for (int c = C.tid; c < 1024; c += 512) { GS[c] = a.in[I_N1G][1024 + c] * (1.f + modf[b * 6144 + 1024 + c]); SH[c] = modf[b * 6144 + c]; }
        __syncthreads();
        unsigned char* A8 = ws + WS_A8;
        const bf16_t* Hb = (const bf16_t*)(ws + WS_H);
        { const int r = C.bid * 128 + C.wid * 16; modulate_rows_h<16, true>(Hb + (size_t)r * D, A8 + (size_t)r * D, GS, SH, C.lane); }
    } else {
        const bf16_t* Hb = (const bf16_t*)(ws + WS_H);
        { const int r0 = C.bid * 128 + C.wid * 16;
            u32x4 v[16][2];
#pragma unroll
            for (int r = 0; r < 16; ++r)
#pragma unroll
                for (int j = 0; j < 2; ++j) v[r][j] = *(const u32x4*)(Hb + (size_t)(r0 + r) * D + 512 * j + 8 * C.lane);
#pragma unroll
            for (int r = 0; r < 16; ++r) { float x[16]; float s = 0.f;
#pragma unroll
                for (int j = 0; j < 2; ++j)
#pragma unroll
                    for (int e = 0; e < 4; ++e) { x[8 * j + 2 * e] = bf_lo(v[r][j][e]); x[8 * j + 2 * e + 1] = bf_hi(v[r][j][e]); }
#pragma unroll
                for (int e = 0; e < 16; ++e) s += x[e] * x[e];
                const float rinv = rsqrtf(wave_sum(s) * (1.f / D) + EPS);
#pragma unroll
                for (int j = 0; j < 2; ++j)
#pragma unroll
                    for (int q = 0; q < 2; ++q) { const f32x4 gg = *(const f32x4*)(a.in[I_NFG] + 512 * j + 8 * C.lane + 4 * q);
                        *(f32x4*)(a.out + (size_t)(r0 + r) * D + 512 * j + 8 * C.lane + 4 * q) = (f32x4){x[8 * j + 4 * q] * rinv * gg[0], x[8 * j + 4 * q + 1] * rinv * gg[1], x[8 * j + 4 * q + 2] * rinv * gg[2], x[8 * j + 4 * q + 3] * rinv * gg[3]}; } } }
    }
}

__device__ __forceinline__ void phaseSgu(const Ctx& C) {
    CArgs& a = *C.a; unsigned char* ws = a.ws;
    const bf16_t* U = (const bf16_t*)(ws + WS_U); const bf16_t* VV = (const bf16_t*)(ws + WS_VV); const bf16_t* WSP = (const bf16_t*)(ws + WS_WSP);
    unsigned char* A8 = ws + WS_A8;
    LAS float* ST = (LAS float*)(C.lds + 69632);
    LAS bf16_t* VT = (LAS bf16_t*)C.lds;
    const int lane = C.lane, n = lane & 31, hh = lane >> 5;
    LAS float* LG = (LAS float*)(C.lds + 70656); LAS float* LB = LG + 1024;
    LAS unsigned char* WL = C.lds + 78848;
    for (int c = C.tid; c < 1024; c += 512) { LG[c] = a.in[I_LNG][c]; LB[c] = a.in[I_LNB][c]; }
    for (int chunk = C.bid; chunk < M / 128; chunk += C.G) {
        const int tok0 = chunk * 128;
        __syncthreads();
        for (int ib = 0; ib < 16; ib += 8) {
            u32x4 vv0[8], vv1[8];
#pragma unroll
            for (int i = 0; i < 8; ++i) { const int q = C.wid * 16 + ib + i;
                vv0[i] = *(const u32x4*)(VV + (size_t)(tok0 + q) * D + 8 * lane); vv1[i] = *(const u32x4*)(VV + (size_t)(tok0 + q) * D + 512 + 8 * lane); }
#pragma unroll
            for (int i = 0; i < 8; ++i) { const int q = C.wid * 16 + ib + i;
                float x[16];
#pragma unroll
                for (int e = 0; e < 4; ++e) { x[2 * e] = bf_lo(vv0[i][e]); x[2 * e + 1] = bf_hi(vv0[i][e]); x[8 + 2 * e] = bf_lo(vv1[i][e]); x[8 + 2 * e + 1] = bf_hi(vv1[i][e]); }
                float s = 0.f;
#pragma unroll
                for (int e = 0; e < 16; ++e) s += x[e];
                const float mu = wave_sum(s) * (1.f / D); float qq = 0.f;
#pragma unroll
                for (int e = 0; e < 16; ++e) { const float d = x[e] - mu; qq += d * d; }
                const float rstd = rsqrtf(wave_sum(qq) * (1.f / D) + EPS);
                if (lane == 0) { ST[2 * q] = mu; ST[2 * q + 1] = rstd; } }
        }
        __syncthreads();
#pragma unroll 1
        for (int g = 0; g < 8; ++g) {
            LAS bf16_t* VTg = VT + (g & 1) * (128 * 136);
            const int cb = C.tid & 15, q0 = C.tid >> 4;
            const int cbk = C.wid & 3;
            u32x4 vreg[4], ureg[4]; float bsr[4];
#pragma unroll
            for (int i = 0; i < 4; ++i) vreg[i] = *(const u32x4*)(VV + (size_t)(tok0 + q0 + 32 * i) * D + g * 128 + cb * 8);
#pragma unroll
            for (int i = 0; i < 4; ++i) { ureg[i] = *(const u32x4*)(U + (size_t)(tok0 + q0 + 32 * i) * D + g * 128 + cb * 8); bsr[i] = a.in[I_BS][g * 128 + q0 + 32 * i]; }
            u32x4 wreg[4];
#pragma unroll
            for (int i = 0; i < 4; ++i) { const int id = C.tid + 512 * i; wreg[i] = *(const u32x4*)(WSP + ((size_t)g * 128 + (id >> 4)) * 128 + (id & 15) * 8); }
            f32x4 lg0 = *(const LAS f32x4*)(LG + g * 128 + cb * 8), lg1 = *(const LAS f32x4*)(LG + g * 128 + cb * 8 + 4), lb0 = *(const LAS f32x4*)(LB + g * 128 + cb * 8), lb1 = *(const LAS f32x4*)(LB + g * 128 + cb * 8 + 4);
#pragma unroll
            for (int i = 0; i < 4; ++i) { const int q = q0 + 32 * i; const float mu = ST[2 * q], rstd = ST[2 * q + 1];
                const int col = ((((q >> 3) ^ cb) & 15) << 3) | (q & 7);
#pragma unroll
                for (int e = 0; e < 4; ++e) { const int c = cb * 8 + 2 * e;
                    const float ga = e < 2 ? lg0[2 * e] : lg1[2 * e - 4], gb = e < 2 ? lg0[2 * e + 1] : lg1[2 * e - 3];
                    const float ba = e < 2 ? lb0[2 * e] : lb1[2 * e - 4], bb = e < 2 ? lb0[2 * e + 1] : lb1[2 * e - 3];
                    const float y0 = (bf_lo(vreg[i][e]) - mu) * rstd * ga + ba;
                    const float y1 = (bf_hi(vreg[i][e]) - mu) * rstd * gb + bb;
                    const unsigned w = pk2(y0, y1);
                    VTg[c * 136 + col] = (bf16_t)(w & 0xffffu); VTg[(c + 1) * 136 + col] = (bf16_t)(w >> 16); } }
#pragma unroll
            for (int i = 0; i < 4; ++i) { const int id = C.tid + 512 * i; *(LAS u32x4*)(WL + (id >> 4) * 272 + (id & 15) * 16) = wreg[i]; }
            __syncthreads();
            bf16x8 bfr[8];
#pragma unroll
            for (int s8 = 0; s8 < 8; ++s8) bfr[s8] = *(const LAS bf16x8*)(VTg + (32 * cbk + n) * 136 + ((((2 * s8 + hh) ^ ((32 * cbk + n) >> 3)) & 15) << 3));
            f32x16 S2[2];
#pragma unroll
            for (int pi = 0; pi < 2; ++pi) {
#pragma unroll
                for (int e = 0; e < 16; ++e) S2[pi][e] = 0.f;
#pragma unroll
                for (int s8 = 0; s8 < 8; ++s8) { const bf16x8 wfr = *(const LAS bf16x8*)(WL + (32 * (2 * (C.wid >> 2) + pi) + n) * 272 + 32 * s8 + 16 * hh);
                    S2[pi] = __builtin_amdgcn_mfma_f32_32x32x16_bf16(wfr, bfr[s8], S2[pi], 0, 0, 0); }
            }
            LAS unsigned char* MX = (LAS unsigned char*)(VT + ((g + 1) & 1) * (128 * 136));
#pragma unroll
            for (int pi = 0; pi < 2; ++pi) {
                const int pb = 2 * (C.wid >> 2) + pi;
#pragma unroll
                for (int e = 0; e < 16; e += 2) { const int p = 32 * pb + (e & 3) + 8 * (e >> 2) + 4 * hh;
                    const unsigned w = pk2(S2[pi][e], S2[pi][e + 1]);
                    *(LAS bf16_t*)(MX + p * 272 + (32 * cbk + n) * 2) = (bf16_t)(w & 0xffffu); *(LAS bf16_t*)(MX + (p + 1) * 272 + (32 * cbk + n) * 2) = (bf16_t)(w >> 16); }
            }
            __syncthreads();
#pragma unroll
            for (int i = 0; i < 4; ++i) { const int q = q0 + 32 * i;
                const u32x4 mx = *(const LAS u32x4*)(MX + q * 272 + cb * 16);
                float r[8];
#pragma unroll
                for (int e = 0; e < 4; ++e) { r[2 * e] = bf_lo(ureg[i][e]) * (bf_lo(mx[e]) + bsr[i]); r[2 * e + 1] = bf_hi(ureg[i][e]) * (bf_hi(mx[e]) + bsr[i]); }
                u32x2 o; o.x = pk4_fp8(r[0], r[1], r[2], r[3]); o.y = pk4_fp8(r[4], r[5], r[6], r[7]);
                *(u32x2*)(A8 + (size_t)(tok0 + q) * D + g * 128 + cb * 8) = o; }
            __syncthreads();
        }
    }
}

constexpr int NPHASES = 22;
__global__ void __launch_bounds__(512, 2) fwd_megakernel(Args args) {
    extern __shared__ __attribute__((aligned(16))) unsigned char lds_raw[];
    LAS unsigned char* lds = (LAS unsigned char*)lds_raw;
    Ctx C; C.a = (CArgs*)__builtin_amdgcn_kernarg_segment_ptr(); C.lds = lds; C.tid = threadIdx.x; C.lane = C.tid & 63; C.wid = __builtin_amdgcn_readfirstlane(C.tid >> 6); C.bid = blockIdx.x; C.G = 256;
    volatile LAS unsigned* MISC = (volatile LAS unsigned*)(lds + MISC_OFF);
    if (C.tid < 4) MISC[C.tid] = 0u;
    __syncthreads();
    unsigned char* ws = args.ws;
    const int lo = args.ph_lo, hi = args.ph_hi;
    const bool multi = (hi - lo) > 1;
    if (multi) (void)xcd_barrier_post((unsigned*)(ws + WS_CTL), MISC, C.tid == 0);
#define GRID_BARRIER() do { XcdBarrier b_; b_.bar = (unsigned*)(args.ws + WS_CTL); b_.x = xb_xcc_id(); b_.st = (volatile LAS unsigned*)(lds + MISC_OFF); \
    b_.leader = (C.wid == 0) && (__builtin_amdgcn_mbcnt_hi(~0u, __builtin_amdgcn_mbcnt_lo(~0u, 0u)) == 0u); xcd_barrier(b_); } while (0)
#if PROBE_PHASE >= 0
    volatile LAS unsigned long long* ts_l = (volatile LAS unsigned long long*)(lds + MISC_OFF + 128);
#define STAMP(k) do { if ((k) == PROBE_PHASE || (k) == PROBE_PHASE + 1) { if (C.wid == 0) ts_l[(k) - PROBE_PHASE] = __builtin_amdgcn_s_memrealtime(); } } while (0)
#else
#define STAMP(k) do { } while (0)
#endif
    int ph = 0;
#define PHASE(...) do { STAMP(ph); if (lo <= ph && ph < hi) { \
    { int l_ = (int)__builtin_amdgcn_mbcnt_hi(~0u, __builtin_amdgcn_mbcnt_lo(~0u, 0u)); asm volatile("" : "+v"(l_)); C.lane = l_; C.tid = C.wid * 64 + l_; \
      CArgs* ap_ = (CArgs*)__builtin_amdgcn_kernarg_segment_ptr(); asm volatile("" : "+s"(ap_)); C.a = ap_; } __VA_ARGS__ } if (lo <= ph && ph + 1 < hi) GRID_BARRIER(); ++ph; } while (0)
    using namespace pg8;
    const bf16_t* Abuf = (const bf16_t*)(ws + WS_A);
    const bf16_t* A8buf = (const bf16_t*)(ws + WS_A8);
    const float* modf = (const float*)(ws + WS_MODF);

    PHASE( phaseA(C); );
    PHASE( phaseB(C); );
    PHASE(
        Gemm g{A8buf, (const bf16_t*)(ws + WS_W1T), MA, 2560, 512}; Order1 S; S.init(C.G, C.bid);
        Epi1 E{(bf16_t*)(ws + WS_GLU), ws};
        gemm_phase<Epi1, Order1, true>(lds, g, S, E, C.tid, C.wid);
        ctx_kv_tile(C); );
    PHASE(
        const int vcu = (C.bid & 7) * (C.G >> 3) + (C.bid >> 3);
        for (int t = vcu; t < 512; t += C.G) conv_tile(C, t);
        __syncthreads();
        { int tt = C.wid * C.G + C.bid;
          if (C.wid >= 4) { for (int q = 0; q < 2 && tt < 8192; ++q, tt += C.G * 8) table_task(C, tt); }
          for (int t = vcu * 8 + C.wid; t < NBATCH * 64 * 8; t += C.G * 8) { attn_task(C, t);
              for (int q = 0; q < 2 && tt < 8192; ++q, tt += C.G * 8) table_task(C, tt); }
          for (; tt < 8192; tt += C.G * 8) table_task(C, tt); } );
    PHASE(
        Gemm g{A8buf, (const bf16_t*)(ws + WS_W2T), M, 1024, 512}; StaticOrder S; S.init(M, 1024, C.G, C.bid);
        EpiRes<false> E{args.in[I_X], (bf16_t*)(ws + WS_H), modf + 2 * 1024};
        gemm_phase<EpiRes<false>, StaticOrder, true>(lds, g, S, E, C.tid, C.wid); );
    PHASE( phaseNorm2(C, 0); );
    PHASE(
        Gemm g{Abuf, (const bf16_t*)(ws + WS_WQ), M, 2048, 1024}; StaticOrder S; S.init(M, 2048, C.G, C.bid);
        EpiBf16<0> E{(bf16_t*)(ws + WS_QP), (bf16_t*)(ws + WS_QP), 8, 2048};
        gemm_phase<EpiBf16<0>, StaticOrder>(lds, g, S, E, C.tid, C.wid); );
    PHASE( phaseTopk(C, 0); );
    PHASE( phasePeerSliced<0>(C, 0); );
    PHASE( phasePeerCombine(C); );
    PHASE( phasePeerSliced<1>(C, 0); );
    PHASE( phasePeerNorm(C, 0); );
    PHASE(
        Gemm g{A8buf, (const bf16_t*)(ws + WS_WSI), M, 2048, 512}; StaticOrder S; S.init(M, 2048, C.G, C.bid);
        EpiBf16<1> E{(bf16_t*)(ws + WS_U), (bf16_t*)(ws + WS_VV), 4, 1024};
        gemm_phase<EpiBf16<1>, StaticOrder, true>(lds, g, S, E, C.tid, C.wid); );
    PHASE( phaseSgu(C); );
    PHASE(
        Gemm g{A8buf, (const bf16_t*)(ws + WS_WSO), M, 1024, 512}; StaticOrder S; S.init(M, 1024, C.G, C.bid);
        EpiRes<true> E{ws + WS_H, (bf16_t*)(ws + WS_H), modf + 9 * 6144 + 2 * 1024};
        gemm_phase<EpiRes<true>, StaticOrder, true>(lds, g, S, E, C.tid, C.wid); );
    PHASE( phaseNorm2(C, 1); );
    PHASE(
        Gemm g{Abuf, (const bf16_t*)(ws + WS_WQ) + (size_t)2048 * 1024, M, 2048, 1024}; StaticOrder S; S.init(M, 2048, C.G, C.bid);
        EpiBf16<0> E{(bf16_t*)(ws + WS_QP), (bf16_t*)(ws + WS_QP), 8, 2048};
        gemm_phase<EpiBf16<0>, StaticOrder>(lds, g, S, E, C.tid, C.wid); );
    PHASE( phaseTopk(C, 1); );
    PHASE( phasePeerSliced<0>(C, 1); );
    PHASE( phasePeerCombine(C); );
    PHASE( phasePeerSliced<1>(C, 1); );
    PHASE( phasePeerNorm(C, 1); );
#if PROBE_PHASE >= 0
    if (C.bid == 0 && C.wid == 0 && multi) { const unsigned long long dt = (ts_l[1] - ts_l[0]) * PROBE_MULT, t0 = __builtin_amdgcn_s_memrealtime();
        while (__builtin_amdgcn_s_memrealtime() - t0 < dt) __builtin_amdgcn_s_sleep(8); }
#endif
#undef PHASE
#undef GRID_BARRIER
#undef STAMP
}

extern "C" void kernel_launch(void* const* d_in, const int* in_sizes, int n_in, void* d_out, int out_size, void* d_ws, size_t ws_size, hipStream_t stream) {
    static int grid = 0;
    if (grid == 0) {
        if (n_in != N_IN || out_size != M * D || ws_size < WS_END) { fprintf(stderr, "kernel_launch: unexpected shapes (n_in %d out %d ws %zu need %zu)\n", n_in, out_size, ws_size, (size_t)WS_END); grid = -1; return; }
        int dev = 0, cus = 0, per_cu = 0;
        if (hipGetDevice(&dev) != hipSuccess || hipDeviceGetAttribute(&cus, hipDeviceAttributeMultiprocessorCount, dev) != hipSuccess) { grid = -1; return; }
        if (hipFuncSetAttribute((const void*)fwd_megakernel, hipFuncAttributeMaxDynamicSharedMemorySize, LDS_BYTES) != hipSuccess) { fprintf(stderr, "kernel_launch: hipFuncSetAttribute failed\n"); grid = -1; return; }
        if (hipOccupancyMaxActiveBlocksPerMultiprocessor(&per_cu, (const void*)fwd_megakernel, 512, LDS_BYTES) != hipSuccess || per_cu < 1) { fprintf(stderr, "kernel_launch: occupancy query says %d blocks per CU\n", per_cu); (void)hipGetLastError(); grid = -1; return; }
        grid = cus;
        if (grid != 256) fprintf(stderr, "kernel_launch: note: %d CUs (the phase tilings assume 256)\n", grid);
        if (grid > 256) grid = 256;
    }
    if (grid < 0) return;
    (void)hipMemsetAsync((char*)d_ws + WS_CTL, 0, CTL_BYTES, stream);
    Args a{};
    for (int i = 0; i < N_IN; ++i) a.in[i] = (const float*)d_in[i];
    a.out = (float*)d_out; a.ws = (unsigned char*)d_ws;
#if ONE_LAUNCH
    a.ph_lo = 0; a.ph_hi = NPHASES; hipLaunchKernelGGL(fwd_megakernel, dim3(grid), dim3(512), LDS_BYTES, stream, a);
#else
    for (int i = 0; i < NPHASES; ++i) { a.ph_lo = i; a.ph_hi = i + 1; hipLaunchKernelGGL(fwd_megakernel, dim3(grid), dim3(512), LDS_BYTES, stream, a); }
#endif
}
```

```cpp
#include <hip/hip_runtime.h>
#include <cstdio>
#include <cstdint>

#ifndef PROBE_PHASE
#define PROBE_PHASE -1
#endif
#define PROBE_MULT 8
#ifndef ONE_LAUNCH
#define ONE_LAUNCH 1
#endif

#define LAS __attribute__((address_space(3)))
typedef unsigned short bf16_t;
typedef short bf16x8 __attribute__((ext_vector_type(8)));
typedef float f32x4 __attribute__((ext_vector_type(4)));
typedef float f32x16 __attribute__((ext_vector_type(16)));
typedef float f32x2 __attribute__((ext_vector_type(2)));
typedef unsigned u32x4 __attribute__((ext_vector_type(4)));
typedef unsigned u32x2 __attribute__((ext_vector_type(2)));
typedef __bf16 bf2v __attribute__((ext_vector_type(2)));
typedef int v4i __attribute__((ext_vector_type(4)));
typedef int v8i __attribute__((ext_vector_type(8)));

constexpr int D = 1024, NBATCH = 8, SEQ = 4096, M = NBATCH * SEQ, CTXL = 256, MC = NBATCH * CTXL, MA = M + MC;
constexpr int NEXP = 16384;
constexpr float EPS = 1e-6f;
enum { I_X = 0, I_C, I_CTX, I_CCTX, I_N1G, I_N2G, I_ADAW, I_ADAB, I_WIN, I_CONVW, I_CONVB, I_GNG, I_GNB, I_RPB, I_WOUT, I_SGUIN, I_LNG, I_LNB, I_WS, I_BS, I_SGUOUT,
       I_WQ, I_KEYS, I_PU, I_PV, I_NFG, N_IN };

constexpr size_t WS_CTL  = 0;
constexpr size_t CTL_BYTES = 65536;
constexpr size_t WS_MODP = WS_CTL + CTL_BYTES;
constexpr size_t WS_MODF = WS_MODP + (size_t)2 * 8 * 9 * 6144 * 4;
constexpr size_t WS_W1T  = WS_MODF + (size_t)2 * 9 * 6144 * 4;
constexpr size_t WS_W2T  = WS_W1T + (size_t)2560 * 1024 * 2;
constexpr size_t WS_WSI  = WS_W2T + (size_t)1024 * 1024 * 2;
constexpr size_t WS_WSO  = WS_WSI + (size_t)2048 * 1024 * 2;
constexpr size_t WS_WQ   = WS_WSO + (size_t)1024 * 1024 * 2;
constexpr size_t WS_KEYS = WS_WQ + (size_t)2 * 2048 * 1024 * 2;
constexpr size_t WS_WSP  = WS_KEYS + (size_t)2 * 8 * 2 * 128 * 128 * 2;
constexpr size_t WS_TU   = WS_WSP + (size_t)8 * 128 * 128 * 2;
constexpr size_t WS_TV   = WS_TU + (size_t)2 * NEXP * 1024;
constexpr size_t WS_SIU  = WS_TV + (size_t)2 * NEXP * 1024;
constexpr size_t WS_SIV  = WS_SIU + (size_t)2 * NEXP * 4;
constexpr size_t WS_A    = WS_SIV + (size_t)2 * NEXP * 4;
constexpr size_t WS_B    = WS_A + (size_t)MA * 1024 * 2;
constexpr size_t WS_GLU  = WS_B;
constexpr size_t WS_Q    = WS_GLU + (size_t)M * 512 * 2;
constexpr size_t WS_K    = WS_Q + (size_t)M * 512 * 2;
constexpr size_t WS_V    = WS_K + (size_t)MA * 512 * 2;
constexpr size_t WS_QP   = WS_B;
constexpr size_t WS_PD   = WS_B;
constexpr size_t WS_U    = WS_B;
constexpr size_t WS_VV   = WS_B + (size_t)M * 1024 * 2;
constexpr size_t WS_IDX  = WS_V + (size_t)MA * 512 * 2;
constexpr size_t WS_WT   = WS_IDX + (size_t)M * 128 * 2;
constexpr size_t WS_SU   = WS_WT + (size_t)M * 128 * 4;
constexpr size_t WS_A8   = WS_SU + (size_t)M * 128 * 4;
constexpr size_t WS_H    = WS_A8 + (size_t)MA * 1024;
constexpr size_t WS_REF  = WS_H + (size_t)M * 1024 * 2;
constexpr size_t WS_END  = WS_REF + (size_t)256 * 1024 * 4;

constexpr int LDS_BYTES = 147456;
constexpr int MISC_OFF = 147200;

__device__ __forceinline__ float bf_lo(unsigned u) { return __uint_as_float(u << 16); }
__device__ __forceinline__ float bf_hi(unsigned u) { return __uint_as_float(u & 0xffff0000u); }
__device__ __forceinline__ unsigned pk2(float lo, float hi) { bf2v r = {(__bf16)lo, (__bf16)hi}; return __builtin_bit_cast(unsigned, r); }
template <int CTRL> __device__ __forceinline__ float dpp_f(float v) { return __builtin_bit_cast(float, __builtin_amdgcn_update_dpp(0, __builtin_bit_cast(int, v), CTRL, 0xF, 0xF, true)); }
__device__ __forceinline__ float sum8(float v) { v += dpp_f<0xB1>(v); v += dpp_f<0x4E>(v); v += dpp_f<0x141>(v); return v; }
__device__ __forceinline__ float sum16(float v) { v = sum8(v); v += dpp_f<0x140>(v); return v; }
__device__ __forceinline__ float sum32(float v) { v = sum16(v); v += __shfl_xor(v, 16); return v; }
__device__ __forceinline__ float clamp448(float v) { return fminf(fmaxf(v, -448.f), 448.f); }
__device__ __forceinline__ unsigned pk4_fp8(float a, float b, float c, float d) { int p = 0;
    p = __builtin_amdgcn_cvt_pk_fp8_f32(clamp448(a), clamp448(b), p, false); p = __builtin_amdgcn_cvt_pk_fp8_f32(clamp448(c), clamp448(d), p, true); return (unsigned)p; }
__device__ __forceinline__ float wave_sum(float v) { v = sum32(v); v += __shfl_xor(v, 32); return v; }
__device__ __forceinline__ float dot2bf(unsigned a, unsigned b, float c) { return __builtin_amdgcn_fdot2_f32_bf16(__builtin_bit_cast(bf2v, a), __builtin_bit_cast(bf2v, b), c, false); }
__device__ __forceinline__ float sigmoidf_(float x) { return __builtin_amdgcn_rcpf(1.f + __expf(-x)); }
__device__ __forceinline__ float gelu_erf(float v) { return 0.5f * v * (1.f + erff(v * 0.70710678f)); }

namespace pg8 {
constexpr int BM = 256, BK = 64, HALF = 128, HTB = HALF * BK * 2, STAGE_BYTES = 8 * HTB, NXCD = 8, WGM = 8;
__host__ __device__ __forceinline__ int lds_byte(int r, int c) { const int st = (r >> 4) * 2 + (c >> 5), rr = r & 15, cc = c & 31, ob = rr * 64 + cc * 2; return st * 1024 + (ob ^ (((ob >> 9) & 1) << 5)); }
__host__ __device__ __forceinline__ void stage_rc(int b, int& R, int& C) { const int st = b / 1024, sb = b % 1024, swz = sb ^ (((sb >> 9) & 1) << 5); R = (st >> 1) * 16 + swz / 64; C = (st & 1) * 32 + (swz % 64) / 2; }
__host__ __device__ __forceinline__ int perm32(int rho) { const int n = rho >> 4, i = rho & 15; return 8 * (i >> 2) + 4 * n + (i & 3); }
struct Unit { int pm, pn; };
struct Gemm { const bf16_t* A; const bf16_t* Bt; int M, N, K; };
struct StaticOrder {
    int nM, nN, nwg, G, c;
    __host__ __device__ void init(int M_, int N_, int G_, int c_) { nM = M_ / BM; nN = N_ / BM; nwg = nM * nN; G = G_; c = c_; }
    __host__ __device__ bool next(int i, Unit& u) const {
        const long L = (long)i * G + c; if (L >= nwg) return false;
        int wgid = (int)L; { const int q = nwg / NXCD, r = nwg % NXCD, xcd = wgid % NXCD, off = wgid / NXCD; wgid = (xcd < r ? xcd * (q + 1) : r * (q + 1) + (xcd - r) * q) + off; }
        const int nig = WGM * nN, gid = wgid / nig, fm = gid * WGM, gsz = (nM - fm) < WGM ? (nM - fm) : WGM;
        u.pm = fm + ((wgid % nig) % gsz); u.pn = (wgid % nig) / gsz; return true;
    }
    __device__ __forceinline__ void a_ready(const Unit&) const {}
    __device__ __forceinline__ void done(const Unit&) const {}
};
struct Order1 {
    StaticOrder so; int G, c;
    __device__ void init(int G_, int c_) { so.init(M, 2560, G_, c_); G = G_; c = c_; }
    __device__ bool next(int i, Unit& u) const {
        const long L = (long)i * G + c;
        if (L < so.nwg) return so.next(i, u);
        return false;
    }
    __device__ __forceinline__ void a_ready(const Unit&) const {}
    __device__ __forceinline__ void done(const Unit&) const {}
};
__device__ __forceinline__ f32x2 gelu_pk(f32x2 v) {
    const f32x2 av = __builtin_elementwise_abs(v), d = av * 0.2316418882f + 1.0f;
    f32x2 t; t.x = __builtin_amdgcn_rcpf(d.x); t.y = __builtin_amdgcn_rcpf(d.y);
    f32x2 q = t * 0.5307027145f + (-0.7265760135f); q = q * t + 0.7107068705f; q = q * t + (-0.142248368f); q = q * t + 0.127414796f; q = q * t;
    const f32x2 s = (v * v) * (-0.72134752044f);
    f32x2 e; e.x = __builtin_amdgcn_exp2f(s.x); e.y = __builtin_amdgcn_exp2f(s.y);
    const f32x2 m = v * (q * e), r = v - m;
    f32x2 o; o.x = v.x < 0.f ? m.x : r.x; o.y = v.y < 0.f ? m.y : r.y; return o;
}
__device__ __forceinline__ void mfma_fp8_acc(f32x4& acc, const v8i& a, const v8i& b, int sa, int sb) {
    asm volatile("s_nop 1\n\tv_mfma_scale_f32_16x16x128_f8f6f4 %0, %1, %2, %0, %3, %4 op_sel_hi:[0,0,0]" : "+v"(acc) : "v"(a), "v"(b), "v"(sa), "v"(sb));
}
template <class Epi, class Sched, bool FP8 = false>
__device__ __forceinline__ void gemm_phase(LAS unsigned char* lds, const Gemm g, const Sched& S, const Epi& E, const int tid, const int wid) {
    const int lane = tid & 63, wr = wid >> 2, wc = wid & 3, fr = lane & 15, fq = lane >> 4;
    const int K = g.K, nt = K / BK;
    const int sc_w = 0x7A7A7A7A, sc_x = 0x7F7F7F7F;
    unsigned voffA[2], voffB[2];
#pragma unroll
    for (int i = 0; i < 2; ++i) { int R, C; stage_rc(tid * 16 + i * 8192, R, C); const int Rb = Epi::PERM ? ((R & ~31) + perm32(R & 31)) : R;
        voffA[i] = (unsigned)(R * K + C) * 2u; voffB[i] = (unsigned)(Rb * K + C) * 2u; }
    const size_t kstep = (size_t)(BK * 2);
    const size_t hstep = (size_t)HALF * K * 2;
    const size_t tstep = 2 * hstep;
    const unsigned ldsw = (unsigned)wid * 1024u;
    const int aoff = lds_byte(wr * 64 + fr, fq * 8), boff = lds_byte(wc * 32 + fr, fq * 8);
#define PG8_SA(b, h) (((b) * 2 + (h)) * HTB)
#define PG8_SB(b, h) ((4 + (b) * 2 + (h)) * HTB)
#define PG8_STAGE(bufoff, gbase, voff) do { _Pragma("unroll") for (int _i = 0; _i < 2; ++_i) \
        __builtin_amdgcn_global_load_lds((const unsigned*)((const char*)(gbase) + (voff)[_i]), (LAS unsigned*)(lds + (bufoff) + ldsw + _i * 8192), 16, 0, 0); } while (0)
#define PG8_LD16(off) (*(const LAS v4i*)(lds + (off)))
#define PG8_LDA(dst, b, h) do { _Pragma("unroll") for (int m = 0; m < 4; ++m) { const int o_ = PG8_SA(b, h) + aoff + m * 2048; \
        if (FP8) dst##8[m] = __builtin_shufflevector(PG8_LD16(o_), PG8_LD16(o_ + 1024), 0, 1, 2, 3, 4, 5, 6, 7); \
        else { dst[m][0] = __builtin_bit_cast(bf16x8, PG8_LD16(o_)); dst[m][1] = __builtin_bit_cast(bf16x8, PG8_LD16(o_ + 1024)); } } } while (0)
#define PG8_LDB(dst, b, h) do { _Pragma("unroll") for (int n = 0; n < 2; ++n) { const int o_ = PG8_SB(b, h) + boff + n * 2048; \
        if (FP8) dst##8[n] = __builtin_shufflevector(PG8_LD16(o_), PG8_LD16(o_ + 1024), 0, 1, 2, 3, 4, 5, 6, 7); \
        else { dst[n][0] = __builtin_bit_cast(bf16x8, PG8_LD16(o_)); dst[n][1] = __builtin_bit_cast(bf16x8, PG8_LD16(o_ + 1024)); } } } while (0)
#define PG8_MMA(ai, bj, At, Bt) do { __builtin_amdgcn_s_setprio(1); _Pragma("unroll") for (int m = 0; m < 4; ++m) _Pragma("unroll") for (int n = 0; n < 2; ++n) { \
        if (FP8) mfma_fp8_acc(acc[ai][bj][m][n], Bt##8[n], At##8[m], sc_w, sc_x); \
        else { _Pragma("unroll") for (int k = 0; k < 2; ++k) acc[ai][bj][m][n] = __builtin_amdgcn_mfma_f32_16x16x32_bf16(Bt[n][k], At[m][k], acc[ai][bj][m][n], 0, 0, 0); } } \
        __builtin_amdgcn_s_setprio(0); } while (0)
#define PG8_WAIT_V(n) asm volatile("s_waitcnt vmcnt(" #n ")" ::: "memory")
#define PG8_WAIT_L(n) asm volatile("s_waitcnt lgkmcnt(" #n ")" ::: "memory")
#define PG8_BAR __builtin_amdgcn_s_barrier()
#define PG8_SCHED __builtin_amdgcn_sched_barrier(0)
    Unit cur, nxt; int ui = 0;
    if (!S.next(0, cur)) return;
    f32x4 acc[2][2][4][2];
#pragma unroll
    for (int a = 0; a < 2; ++a)
#pragma unroll
        for (int b = 0; b < 2; ++b)
#pragma unroll
            for (int m = 0; m < 4; ++m)
#pragma unroll
                for (int n = 0; n < 2; ++n) acc[a][b][m][n] = (f32x4){0.f, 0.f, 0.f, 0.f};
    const char* cA = (const char*)g.A + (size_t)cur.pm * tstep; const char* cB = (const char*)g.Bt + (size_t)cur.pn * tstep;
    S.a_ready(cur);
    PG8_STAGE(PG8_SB(0, 0), cB, voffB); PG8_STAGE(PG8_SA(0, 0), cA, voffA); PG8_STAGE(PG8_SB(0, 1), cB + hstep, voffB); PG8_STAGE(PG8_SA(0, 1), cA + hstep, voffA);
    if (wr == 1) PG8_BAR;
    PG8_WAIT_V(4); PG8_BAR;
    PG8_STAGE(PG8_SB(1, 0), cB + kstep, voffB); PG8_STAGE(PG8_SA(1, 0), cA + kstep, voffA); PG8_STAGE(PG8_SB(1, 1), cB + hstep + kstep, voffB);
    PG8_WAIT_V(6); PG8_BAR;
    for (;;) {
        const bool has_next = S.next(ui + 1, nxt);
        const char* nA = has_next ? (const char*)g.A + (size_t)nxt.pm * tstep : cA; const char* nB = has_next ? (const char*)g.Bt + (size_t)nxt.pn * tstep : cB;
#pragma unroll 1
        for (int t = 0; t < nt; t += 2) {
            const bool last = (t == nt - 2);
            bf16x8 At[4][2], B0[2][2], B1[2][2]; v8i At8[4], B08[2], B18[2];
            const char* a1 = cA + (size_t)(t + 1) * kstep;
            const char* a2 = last ? nA : cA + (size_t)(t + 2) * kstep; const char* b2 = last ? nB : cB + (size_t)(t + 2) * kstep;
            const char* a3 = a2 + kstep; const char* b3 = b2 + kstep;
            if (last && has_next) S.a_ready(nxt);
            PG8_LDB(B0, 0, 0); PG8_SCHED; PG8_LDA(At, 0, 0); PG8_STAGE(PG8_SA(1, 1), a1 + hstep, voffA);
            PG8_WAIT_L(8); PG8_BAR; PG8_WAIT_L(0); PG8_MMA(0, 0, At, B0); PG8_BAR; PG8_SCHED;
            PG8_LDB(B1, 0, 1); PG8_STAGE(PG8_SB(0, 0), b2, voffB);
            PG8_BAR; PG8_WAIT_L(0); PG8_MMA(0, 1, At, B1); PG8_BAR;
            PG8_LDA(At, 0, 1); PG8_STAGE(PG8_SA(0, 0), a2, voffA);
            PG8_BAR; PG8_WAIT_L(0); PG8_MMA(1, 0, At, B0); PG8_BAR; PG8_SCHED;
            PG8_STAGE(PG8_SB(0, 1), b2 + hstep, voffB);
            PG8_WAIT_V(6); PG8_BAR; PG8_MMA(1, 1, At, B1); PG8_BAR;
            PG8_LDB(B0, 1, 0); PG8_SCHED; PG8_LDA(At, 1, 0); PG8_STAGE(PG8_SA(0, 1), a2 + hstep, voffA);
            PG8_WAIT_L(8); PG8_BAR; PG8_WAIT_L(0); PG8_MMA(0, 0, At, B0); PG8_BAR; PG8_SCHED;
            PG8_LDB(B1, 1, 1); PG8_STAGE(PG8_SB(1, 0), b3, voffB);
            PG8_BAR; PG8_WAIT_L(0); PG8_MMA(0, 1, At, B1); PG8_BAR;
            PG8_LDA(At, 1, 1); PG8_STAGE(PG8_SA(1, 0), a3, voffA);
            PG8_BAR; PG8_WAIT_L(0); PG8_MMA(1, 0, At, B0); PG8_BAR; PG8_SCHED;
            PG8_STAGE(PG8_SB(1, 1), b3 + hstep, voffB);
            PG8_WAIT_V(6); PG8_BAR; PG8_MMA(1, 1, At, B1); PG8_BAR;
        }
        { Unit ue = cur; int wr_ = wr, wc_ = wc, fr_ = fr, fq_ = fq;
          asm volatile("" : "+s"(ue.pm), "+s"(ue.pn), "+s"(wr_), "+s"(wc_), "+v"(fr_), "+v"(fq_));
          E(acc, ue, wr_, wc_, fr_, fq_); }
        S.done(cur);
        if (!has_next) break;
#pragma unroll
        for (int a = 0; a < 2; ++a)
#pragma unroll
            for (int b = 0; b < 2; ++b)
#pragma unroll
                for (int m = 0; m < 4; ++m)
#pragma unroll
                    for (int n = 0; n < 2; ++n) acc[a][b][m][n] = (f32x4){0.f, 0.f, 0.f, 0.f};
        cur = nxt; cA = nA; cB = nB; ++ui;
    }
    PG8_WAIT_V(0);
    if (wr == 0) PG8_BAR;
    PG8_BAR;
#undef PG8_SA
#undef PG8_SB
#undef PG8_STAGE
#undef PG8_LDA
#undef PG8_LD16
#undef PG8_LDB
#undef PG8_MMA
#undef PG8_WAIT_V
#undef PG8_WAIT_L
#undef PG8_BAR
#undef PG8_SCHED
}

struct Epi1 {
    static constexpr bool PERM = true;
    bf16_t *GLU; unsigned char* wsb;
    __device__ __forceinline__ void operator()(const f32x4 (&acc)[2][2][4][2], const Unit& u, int wr, int wc, int fr, int fq) const {
        const int row0 = u.pm * BM + wr * 64 + fr;
        if (u.pn < 4) {
            const int ch0 = u.pn * 128 + wc * 32 + 8 * fq;
#pragma unroll
            for (int ai = 0; ai < 2; ++ai)
#pragma unroll
                for (int m = 0; m < 4; ++m) {
                    const f32x4 a0 = acc[ai][0][m][0], a1 = acc[ai][0][m][1], g0 = acc[ai][1][m][0], g1 = acc[ai][1][m][1];
                    u32x4 w;
                    w.x = pk2(a0[0] * sigmoidf_(g0[0]), a0[1] * sigmoidf_(g0[1])); w.y = pk2(a0[2] * sigmoidf_(g0[2]), a0[3] * sigmoidf_(g0[3]));
                    w.z = pk2(a1[0] * sigmoidf_(g1[0]), a1[1] * sigmoidf_(g1[1])); w.w = pk2(a1[2] * sigmoidf_(g1[2]), a1[3] * sigmoidf_(g1[3]));
                    *(u32x4*)(GLU + (size_t)(row0 + ai * HALF + m * 16) * 512 + ch0) = w;
                }
        } else {
            const int t = (u.pn - 4) >> 1;
            const size_t boff = WS_Q + (t >= 1 ? (size_t)M * 1024 : (size_t)0) + (t >= 2 ? (size_t)MA * 1024 : (size_t)0);
            bf16_t* base = (bf16_t*)(wsb + boff);
            const float sc = t == 0 ? 0.125f * 1.44269504f : 1.f;
            const int col0 = ((u.pn - 4) & 1) * 256 + wc * 32 + 8 * fq;
#pragma unroll
            for (int ai = 0; ai < 2; ++ai)
#pragma unroll
                for (int m = 0; m < 4; ++m) { bf16_t* rowp = base + (size_t)(row0 + ai * HALF + m * 16) * 512 + col0;
#pragma unroll
                    for (int bj = 0; bj < 2; ++bj) { const f32x4 v0 = acc[ai][bj][m][0] * sc, v1 = acc[ai][bj][m][1] * sc;
                        u32x4 w; w.x = pk2(v0[0], v0[1]); w.y = pk2(v0[2], v0[3]); w.z = pk2(v1[0], v1[1]); w.w = pk2(v1[2], v1[3]);
                        *(u32x4*)(rowp + bj * HALF) = w; } }
        }
    }
};
template <bool BF16_BASE> struct EpiRes {
    static constexpr bool PERM = true;
    const void* base; bf16_t* H; const float* gate;
    __device__ __forceinline__ void operator()(const f32x4 (&acc)[2][2][4][2], const Unit& u, int wr, int wc, int fr, int fq) const {
        const int row0 = u.pm * BM + wr * 64 + fr, col0 = u.pn * BM + wc * 32 + 8 * fq;
        const int b = (u.pm * BM) / SEQ;
        f32x4 gv[2][2];
#pragma unroll
        for (int bj = 0; bj < 2; ++bj)
#pragma unroll
            for (int n = 0; n < 2; ++n) gv[bj][n] = *(const f32x4*)(gate + (size_t)b * 6144 + col0 + bj * HALF + 4 * n);
#pragma unroll
        for (int ai = 0; ai < 2; ++ai) {
            f32x4 bb[4][2][2]; u32x4 hb[4][2];
#pragma unroll
            for (int m = 0; m < 4; ++m) { const size_t off = (size_t)(row0 + ai * HALF + m * 16) * D + col0;
#pragma unroll
                for (int bj = 0; bj < 2; ++bj) {
                    if (BF16_BASE) hb[m][bj] = *(const u32x4*)((const bf16_t*)base + off + bj * HALF);
                    else { bb[m][bj][0] = *(const f32x4*)((const float*)base + off + bj * HALF); bb[m][bj][1] = *(const f32x4*)((const float*)base + off + bj * HALF + 4); } } }
#pragma unroll
            for (int m = 0; m < 4; ++m) { const size_t off = (size_t)(row0 + ai * HALF + m * 16) * D + col0;
#pragma unroll
                for (int bj = 0; bj < 2; ++bj) {
                    f32x4 b0, b1;
                    if (BF16_BASE) { const u32x4 h4 = hb[m][bj];
                        b0 = (f32x4){bf_lo(h4.x), bf_hi(h4.x), bf_lo(h4.y), bf_hi(h4.y)}; b1 = (f32x4){bf_lo(h4.z), bf_hi(h4.z), bf_lo(h4.w), bf_hi(h4.w)}; }
                    else { b0 = bb[m][bj][0]; b1 = bb[m][bj][1]; }
                    const f32x4 v0 = b0 + gv[bj][0] * acc[ai][bj][m][0], v1 = b1 + gv[bj][1] * acc[ai][bj][m][1];
                    u32x4 w; w.x = pk2(v0[0], v0[1]); w.y = pk2(v0[2], v0[3]); w.z = pk2(v1[0], v1[1]); w.w = pk2(v1[2], v1[3]);
                    *(u32x4*)(H + off + bj * HALF) = w; } }
        }
    }
};
template <int ACT> struct EpiBf16 {
    static constexpr bool PERM = true;
    bf16_t *O0, *O1; int split_tiles, ld;
    __device__ __forceinline__ void operator()(const f32x4 (&acc)[2][2][4][2], const Unit& u, int wr, int wc, int fr, int fq) const {
        const int row0 = u.pm * BM + wr * 64 + fr;
        bf16_t* base = u.pn < split_tiles ? O0 : O1;
        const int col0 = (u.pn < split_tiles ? u.pn : u.pn - split_tiles) * BM + wc * 32 + 8 * fq;
#pragma unroll
        for (int ai = 0; ai < 2; ++ai)
#pragma unroll
            for (int m = 0; m < 4; ++m) { bf16_t* rowp = base + (size_t)(row0 + ai * HALF + m * 16) * ld + col0;
#pragma unroll
                for (int bj = 0; bj < 2; ++bj) { f32x4 v0 = acc[ai][bj][m][0], v1 = acc[ai][bj][m][1];
                    if (ACT == 1) { f32x2 a = gelu_pk((f32x2){v0[0], v0[1]}), b = gelu_pk((f32x2){v0[2], v0[3]}), c = gelu_pk((f32x2){v1[0], v1[1]}), d = gelu_pk((f32x2){v1[2], v1[3]});
                        v0 = (f32x4){a.x, a.y, b.x, b.y}; v1 = (f32x4){c.x, c.y, d.x, d.y}; }
                    u32x4 w; w.x = pk2(v0[0], v0[1]); w.y = pk2(v0[2], v0[3]); w.z = pk2(v1[0], v1[1]); w.w = pk2(v1[2], v1[3]);
                    *(u32x4*)(rowp + bj * HALF) = w; } }
    }
};
}

#define XB_TMO      128
#define XB_XCNT(j)  (256  + 64 * (j))
#define XB_XSUB(j)  (1280 + 64 * (j))
#define XB_XGEN(j)  (2304 + 64 * (j))
#define XB_TOP      3328
#define XB_TOPGEN   3392
#define XCD_BAR_WORDS 3456
#define XB_SPIN_CAP (1u << 22)
__device__ __forceinline__ unsigned xb_ld(unsigned* p)              { return __hip_atomic_load(p, __ATOMIC_RELAXED, __HIP_MEMORY_SCOPE_AGENT); }
__device__ __forceinline__ unsigned xb_add(unsigned* p, unsigned v) { return __hip_atomic_fetch_add(p, v, __ATOMIC_RELAXED, __HIP_MEMORY_SCOPE_AGENT); }
__device__ __forceinline__ unsigned xb_xcc_id() { return (unsigned)__builtin_amdgcn_s_getreg((3 << 11) | 20) & 0xFu; }
#define XB_SPIN(cond, bar) do { unsigned _sp = 0; while (cond) { __builtin_amdgcn_s_sleep(1); \
    if ((++_sp & 255u) == 0u) { if (xb_ld(&(bar)[XB_TMO])) break; if (_sp > XB_SPIN_CAP) { atomicAdd(&(bar)[XB_TMO], 1u); break; } } } } while (0)
struct XcdBarrier { unsigned* bar; unsigned x; volatile LAS unsigned* st; bool leader; };
__device__ __forceinline__ XcdBarrier xcd_barrier_post(unsigned* bar, volatile LAS unsigned* st, bool leader) {
    XcdBarrier b; b.bar = bar; b.x = xb_xcc_id(); b.st = st; b.leader = leader;
    if (leader) (void)xb_add(&bar[XB_XCNT(b.x)], 1u);
    return b;
}
__device__ __forceinline__ void xcd_barrier_complete(unsigned* bar, unsigned x, unsigned& nloc, unsigned& nx) {
    const unsigned G = gridDim.x * gridDim.y * gridDim.z;
    unsigned sum, cnt, mine, sp = 0u;
    for (;;) {
        sum = 0u; cnt = 0u; mine = 0u;
#pragma unroll
        for (unsigned j = 0; j < 16; ++j) { const unsigned c = xb_ld(&bar[XB_XCNT(j)]); sum += c; cnt += (c > 0u) ? 1u : 0u; mine = (j == x) ? c : mine; }
        if (sum == G) break;
        __builtin_amdgcn_s_sleep(1);
        if ((++sp & 255u) == 0u) { if (xb_ld(&bar[XB_TMO])) break; if (sp > XB_SPIN_CAP) { atomicAdd(&bar[XB_TMO], 1u); break; } }
    }
    nloc = mine > 0u ? mine : 1u; nx = cnt > 0u ? cnt : 1u;
}
__device__ __forceinline__ void xcd_barrier(const XcdBarrier& b) {
    asm volatile("s_waitcnt vmcnt(0)" ::: "memory");
    __syncthreads();
    if (b.leader) {
        unsigned* bar = b.bar;
        __builtin_amdgcn_s_waitcnt(0);
        unsigned nloc = b.st[0], nx = b.st[1];
        if (nloc == 0u) { xcd_barrier_complete(bar, b.x, nloc, nx); b.st[0] = nloc; b.st[1] = nx; }
        const unsigned old = xb_add(&bar[XB_XSUB(b.x)], 1u);
        const unsigned gen = old / nloc;
        if (old + 1u == (gen + 1u) * nloc) {
            __builtin_amdgcn_fence(__ATOMIC_RELEASE, "agent");
            asm volatile("s_waitcnt vmcnt(0)" ::: "memory");
            const unsigned og = xb_add(&bar[XB_TOP], 1u);
            const unsigned tg = og / nx;
            if (og + 1u == (tg + 1u) * nx) xb_add(&bar[XB_TOPGEN], 1u);
            else XB_SPIN(xb_ld(&bar[XB_TOPGEN]) == tg, bar);
            __builtin_amdgcn_fence(__ATOMIC_ACQUIRE, "agent");
            xb_add(&bar[XB_XGEN(b.x)], 1u);
            asm volatile("s_waitcnt vmcnt(0)" ::: "memory");
        } else {
            XB_SPIN(xb_ld(&bar[XB_XGEN(b.x)]) == gen, bar);
            __builtin_amdgcn_fence(__ATOMIC_ACQUIRE, "agent");
            asm volatile("s_waitcnt vmcnt(0)" ::: "memory");
        }
    }
    __syncthreads();
}

struct Args { const float* in[N_IN]; float* out; unsigned char* ws; int ph_lo, ph_hi; };
static_assert(sizeof(Args) == (N_IN + 2) * 8 + 8, "Args has padding");

typedef const __attribute__((address_space(4))) Args CArgs;
struct Ctx {
    CArgs* a; LAS unsigned char* lds; int tid, lane, wid, bid, G;
};

__device__ __forceinline__ void ctx_kv_tile(const Ctx& C) {
    CArgs& a = *C.a; unsigned char* ws = a.ws;
    const int lane = C.lane, fr = lane & 15, fq = lane >> 4;
    const int r0 = (C.bid >> 4) * 128 + C.wid * 16, c0 = (C.bid & 15) * 64;
    const unsigned char* xa = ws + WS_A8 + (size_t)(M + r0 + fr) * 1024 + 32 * fq;
    const unsigned char* wb = ws + WS_W1T + (size_t)(1536 + c0 + fr) * 1024 + 32 * fq;
    f32x4 acc[4];
#pragma unroll
    for (int nb = 0; nb < 4; ++nb) acc[nb] = (f32x4){0.f, 0.f, 0.f, 0.f};
#pragma unroll 2
    for (int ks = 0; ks < 8; ++ks) {
        const v8i xv = __builtin_shufflevector(*(const v4i*)(xa + 128 * ks), *(const v4i*)(xa + 128 * ks + 16), 0, 1, 2, 3, 4, 5, 6, 7);
        v8i wv[4];
#pragma unroll
        for (int nb = 0; nb < 4; ++nb) wv[nb] = __builtin_shufflevector(*(const v4i*)(wb + (size_t)nb * 16384 + 128 * ks), *(const v4i*)(wb + (size_t)nb * 16384 + 128 * ks + 16), 0, 1, 2, 3, 4, 5, 6, 7);
#pragma unroll
        for (int nb = 0; nb < 4; ++nb) pg8::mfma_fp8_acc(acc[nb], wv[nb], xv, 0x7A7A7A7A, 0x7F7F7F7F);
    }
    asm volatile("s_nop 15\n\ts_nop 15" ::: "memory");
#pragma unroll
    for (int nb = 0; nb < 4; ++nb) asm volatile("" : "+v"(acc[nb]));
#pragma unroll
    for (int nb = 0; nb < 4; ++nb) { const int col = c0 + 16 * nb + 4 * fq;
        bf16_t* dst = (bf16_t*)(ws + (col < 512 ? WS_K : WS_V)) + (size_t)(M + r0 + fr) * 512 + (col & 511);
        u32x2 o; o.x = pk2(acc[nb][0], acc[nb][1]); o.y = pk2(acc[nb][2], acc[nb][3]); *(u32x2*)dst = o; }
}

__device__ __forceinline__ int w1_dest_row(int n) {
    if (n < 512) return (n >> 7) * 256 + (n & 127);
    if (n < 1024) { const int q = n - 512; return (q >> 7) * 256 + 128 + (q & 127); }
    return n;
}
__device__ __forceinline__ void transpose_item(const float* W, int K, int N, bf16_t* WT, int item, LAS float* scr, int lane, int mode) {
    const int nblk = N / 32, kb = item / nblk, nb = item % nblk, k0 = 64 * kb, n0 = 32 * nb;
    { f32x4 w[8];
#pragma unroll
      for (int i = 0; i < 8; ++i) w[i] = *(const f32x4*)(W + (size_t)(k0 + 8 * i + (lane >> 3)) * N + n0 + 4 * (lane & 7));
#pragma unroll
      for (int i = 0; i < 8; ++i) { LAS float* d = scr + (8 * i + (lane >> 3)) * 33 + 4 * (lane & 7); d[0] = w[i].x; d[1] = w[i].y; d[2] = w[i].z; d[3] = w[i].w; } }
    asm volatile("s_waitcnt lgkmcnt(0)" ::: "memory"); __builtin_amdgcn_wave_barrier();
    const int c = lane & 7;
#pragma unroll
    for (int j = 0; j < 4; ++j) { const int n = (lane >> 3) + 8 * j; const LAS float* s = scr + (8 * c) * 33 + n;
        const int dr = (mode & 1) ? w1_dest_row(n0 + n) : (n0 + n);
        if (mode & 2) {
            u32x2 o; o.x = pk4_fp8(s[0 * 33] * 32.f, s[1 * 33] * 32.f, s[2 * 33] * 32.f, s[3 * 33] * 32.f); o.y = pk4_fp8(s[4 * 33] * 32.f, s[5 * 33] * 32.f, s[6 * 33] * 32.f, s[7 * 33] * 32.f);
            *(u32x2*)((unsigned char*)WT + (size_t)dr * K + k0 + 8 * c) = o;
        } else {
            u32x4 o; o.x = pk2(s[0 * 33], s[1 * 33]); o.y = pk2(s[2 * 33], s[3 * 33]); o.z = pk2(s[4 * 33], s[5 * 33]); o.w = pk2(s[6 * 33], s[7 * 33]);
            *(u32x4*)(WT + (size_t)dr * K + k0 + 8 * c) = o; } }
    asm volatile("s_waitcnt lgkmcnt(0)" ::: "memory"); __builtin_amdgcn_wave_barrier();
}
__device__ __forceinline__ void convert_task(const float* src, bf16_t* dst, size_t base, int lane) {
#pragma unroll
    for (int it = 0; it < 8; ++it) { const size_t i = base + (size_t)it * 512 + lane * 8;
        const f32x4 a = *(const f32x4*)(src + i), b = *(const f32x4*)(src + i + 4);
        u32x4 o; o.x = pk2(a[0], a[1]); o.y = pk2(a[2], a[3]); o.z = pk2(b[0], b[1]); o.w = pk2(b[2], b[3]);
        *(u32x4*)(dst + i) = o; }
}
__device__ __forceinline__ void fp8_rows_task(const float* src, unsigned char* dst, unsigned char* sinv, size_t row0, int lane) {
#pragma unroll 2
    for (int r = 0; r < 8; ++r) { const size_t row = row0 + r;
        f32x4 v[4]; float am = 0.f;
#pragma unroll
        for (int j = 0; j < 4; ++j) { v[j] = *(const f32x4*)(src + row * 1024 + 16 * lane + 4 * j);
            am = fmaxf(am, fmaxf(fmaxf(fabsf(v[j].x), fabsf(v[j].y)), fmaxf(fabsf(v[j].z), fabsf(v[j].w)))); }
#pragma unroll
        for (int o = 1; o < 64; o <<= 1) am = fmaxf(am, __shfl_xor(am, o));
        unsigned be = (__float_as_uint(am) >> 23) & 0xffu; be = be < 8u ? 8u : be;
        const float sc = __uint_as_float((261u - be) << 23);
        u32x4 w;
#pragma unroll
        for (int j = 0; j < 4; ++j) { int pk = 0;
            pk = __builtin_amdgcn_cvt_pk_fp8_f32(v[j].x * sc, v[j].y * sc, pk, false);
            pk = __builtin_amdgcn_cvt_pk_fp8_f32(v[j].z * sc, v[j].w * sc, pk, true);
            w[j] = (unsigned)pk; }
        const size_t l = row / NEXP, e = row % NEXP;
        *(u32x4*)(dst + (((l * 8 + (size_t)(lane >> 3)) * NEXP + e) * 128) + 16 * (lane & 7)) = w;
        if (lane == 0) sinv[row] = (unsigned char)(be - 7u); }
}
__device__ __forceinline__ void table_task(const Ctx& C, int t) {
    CArgs& a = *C.a; unsigned char* ws = a.ws;
    if (t < 4096) fp8_rows_task(a.in[I_PU], ws + WS_TU, ws + WS_SIU, (size_t)t * 8, C.lane);
    else fp8_rows_task(a.in[I_PV], ws + WS_TV, ws + WS_SIV, (size_t)(t - 4096) * 8, C.lane);
}
__device__ __forceinline__ void phaseA(const Ctx& C) {
    CArgs& a = *C.a; unsigned char* ws = a.ws;
    LAS float* S = (LAS float*)C.lds;
    for (int i = C.tid; i < 9 * 1024; i += 512) { const int row = i >> 10, k = i & 1023; const float c = row < 8 ? a.in[I_C][row * 1024 + k] : a.in[I_CCTX][k]; S[i] = c / (1.f + __expf(-c)); }
    __syncthreads();
    LAS float* scr = (LAS float*)(C.lds + 40960 + C.wid * 8448);
    const int gw = C.wid * C.G + C.bid, NGW = C.G * 8;
    constexpr int T_ADA = 1536, T_W1 = 16 * 80, T_W2 = 16 * 32, T_SI = 16 * 64, T_SO = 16 * 32, T_WQ = 2 * 16 * 64;
    constexpr int T_KEYS = 2 * 8 * 2 * 128 * 128 / 4096, T_WSP = 8 * 128 * 128 / 4096;
    constexpr int NT = T_ADA + T_W1 + T_W2 + T_SI + T_SO + T_WQ + T_KEYS + T_WSP;
    float* modp = (float*)(ws + WS_MODP);
    for (int T = gw; T < NT; T += NGW) {
        int t = T;
        if (t < T_ADA) {
            const int l = t / 768, r = t % 768, cb = r >> 3, ks = r & 7;
            const int kg = C.lane >> 4, c4 = 4 * (C.lane & 15);
            const float* W = a.in[I_ADAW] + (size_t)l * 1024 * 6144 + (size_t)(ks * 128 + kg) * 6144 + cb * 64 + c4;
            f32x4 acc[9];
#pragma unroll
            for (int q = 0; q < 9; ++q) acc[q] = (f32x4){0.f, 0.f, 0.f, 0.f};
#pragma unroll 1
            for (int k0 = 0; k0 < 128; k0 += 32) {
                f32x4 w[8];
#pragma unroll
                for (int i = 0; i < 8; ++i) w[i] = *(const f32x4*)(W + (size_t)(k0 + 4 * i) * 6144);
#pragma unroll
                for (int i = 0; i < 8; ++i)
#pragma unroll
                    for (int q = 0; q < 9; ++q) acc[q] += S[q * 1024 + ks * 128 + k0 + 4 * i + kg] * w[i];
            }
#pragma unroll
            for (int q = 0; q < 9; ++q)
#pragma unroll
                for (int e = 0; e < 4; ++e) { float v = acc[q][e]; v += __shfl_xor(v, 16); v += __shfl_xor(v, 32); acc[q][e] = v; }
            if (C.lane < 16) { float* P = modp + ((size_t)(l * 8 + ks) * 9) * 6144 + cb * 64 + c4;
#pragma unroll
                for (int q = 0; q < 9; ++q) *(f32x4*)(P + (size_t)q * 6144) = acc[q]; }
            continue;
        }
        t -= T_ADA;
        if (t < T_W1) { transpose_item(a.in[I_WIN], 1024, 2560, (bf16_t*)(ws + WS_W1T), t, scr, C.lane, 3); continue; } t -= T_W1;
        if (t < T_W2) { transpose_item(a.in[I_WOUT], 1024, 1024, (bf16_t*)(ws + WS_W2T), t, scr, C.lane, 2); continue; } t -= T_W2;
        if (t < T_SI) { transpose_item(a.in[I_SGUIN], 1024, 2048, (bf16_t*)(ws + WS_WSI), t, scr, C.lane, 2); continue; } t -= T_SI;
        if (t < T_SO) { transpose_item(a.in[I_SGUOUT], 1024, 1024, (bf16_t*)(ws + WS_WSO), t, scr, C.lane, 2); continue; } t -= T_SO;
        if (t < T_WQ) { const int l = t / 1024; transpose_item(a.in[I_WQ] + (size_t)l * 1024 * 2048, 1024, 2048, (bf16_t*)(ws + WS_WQ) + (size_t)l * 2048 * 1024, t % 1024, scr, C.lane, 0); continue; } t -= T_WQ;
        if (t < T_KEYS) { convert_task(a.in[I_KEYS], (bf16_t*)(ws + WS_KEYS), (size_t)t * 4096, C.lane); continue; } t -= T_KEYS;
        convert_task(a.in[I_WS], (bf16_t*)(ws + WS_WSP), (size_t)t * 4096, C.lane);
    }
}

template <int NR>
__device__ __forceinline__ void rows_load(f32x4 (&v)[NR][4], const float* xrow0, int lane) {
#pragma unroll
    for (int r = 0; r < NR; ++r)
#pragma unroll
        for (int j = 0; j < 4; ++j) v[r][j] = *((const f32x4*)(xrow0 + (size_t)r * D) + lane + 64 * j);
}
template <int NR>
__device__ __forceinline__ void rows_finish(const f32x4 (&v)[NR][4], bf16_t* orow0, const LAS float* GS, const LAS float* SH, int lane) {
#pragma unroll
    for (int r = 0; r < NR; ++r) {
        float s = 0.f;
#pragma unroll
        for (int j = 0; j < 4; ++j) s += (v[r][j].x * v[r][j].x + v[r][j].y * v[r][j].y) + (v[r][j].z * v[r][j].z + v[r][j].w * v[r][j].w);
        const float rinv = rsqrtf(wave_sum(s) * (1.f / D) + EPS);
        unsigned* o8 = (unsigned*)((unsigned char*)orow0 + (size_t)r * D) + lane;
#pragma unroll
        for (int j = 0; j < 4; ++j) { const f32x4 g = *(const LAS f32x4*)(GS + 4 * lane + 256 * j), h = *(const LAS f32x4*)(SH + 4 * lane + 256 * j);
            const f32x4 y = v[r][j] * rinv * g + h;
            o8[64 * j] = pk4_fp8(y.x, y.y, y.z, y.w); }
    }
}
template <int NR>
__device__ __forceinline__ void modulate_rows(const float* xrow0, bf16_t* orow0, const LAS float* GS, const LAS float* SH, int lane) {
    f32x4 v[NR][4];
    rows_load<NR>(v, xrow0, lane);
    rows_finish<NR>(v, orow0, GS, SH, lane);
}

template <int NR, bool OUT8>
__device__ __forceinline__ void modulate_rows_h(const bf16_t* hrow0, void* orow0v, const LAS float* GS, const LAS float* SH, int lane) {
    u32x4 v[NR][2];
#pragma unroll
    for (int r = 0; r < NR; ++r)
#pragma unroll
        for (int j = 0; j < 2; ++j) v[r][j] = *(const u32x4*)(hrow0 + (size_t)r * D + 512 * j + 8 * lane);
#pragma unroll
    for (int r = 0; r < NR; ++r) {
        float x[16]; float s = 0.f;
#pragma unroll
        for (int j = 0; j < 2; ++j)
#pragma unroll
            for (int e = 0; e < 4; ++e) { x[8 * j + 2 * e] = bf_lo(v[r][j][e]); x[8 * j + 2 * e + 1] = bf_hi(v[r][j][e]); }
#pragma unroll
        for (int e = 0; e < 16; ++e) s += x[e] * x[e];
        const float rinv = rsqrtf(wave_sum(s) * (1.f / D) + EPS);
#pragma unroll
        for (int j = 0; j < 2; ++j) { float y[8];
#pragma unroll
            for (int q = 0; q < 2; ++q) { const f32x4 g = *(const LAS f32x4*)(GS + 512 * j + 8 * lane + 4 * q), h = *(const LAS f32x4*)(SH + 512 * j + 8 * lane + 4 * q);
#pragma unroll
                for (int e = 0; e < 4; ++e) y[4 * q + e] = x[8 * j + 4 * q + e] * rinv * g[e] + h[e]; }
            if (OUT8) { u32x2 w; w.x = pk4_fp8(y[0], y[1], y[2], y[3]); w.y = pk4_fp8(y[4], y[5], y[6], y[7]);
                *(u32x2*)((unsigned char*)orow0v + (size_t)r * D + 512 * j + 8 * lane) = w; }
            else { u32x4 w; w.x = pk2(y[0], y[1]); w.y = pk2(y[2], y[3]); w.z = pk2(y[4], y[5]); w.w = pk2(y[6], y[7]);
                *(u32x4*)((bf16_t*)orow0v + (size_t)r * D + 512 * j + 8 * lane) = w; } }
    }
}

__device__ __forceinline__ void phaseB(const Ctx& C) {
    CArgs& a = *C.a; unsigned char* ws = a.ws;
    const float* modp = (const float*)(ws + WS_MODP); float* modf = (float*)(ws + WS_MODF);
    {
        const int e = C.bid * 512 + C.tid;
        if (e < 2 * 9 * 6144) { const int l = e / (9 * 6144), rem = e % (9 * 6144), row = rem / 6144, j = rem % 6144;
            float v = a.in[I_ADAB][l * 6144 + j];
#pragma unroll
            for (int ks = 0; ks < 8; ++ks) v += modp[((size_t)(l * 8 + ks) * 9 + row) * 6144 + j];
            modf[e] = v; }
    }
    LAS float* GS = (LAS float*)C.lds; LAS float* SH = GS + 1024;
    bf16_t* A = (bf16_t*)(ws + WS_A);
    for (int part = 0; part < 2; ++part) {
        const int rb = part == 0 ? (C.bid * 128) / SEQ : 8;
        __syncthreads();
        for (int c = C.tid; c < 1024; c += 512) {
            float sh = a.in[I_ADAB][c], sc = a.in[I_ADAB][1024 + c];
#pragma unroll
            for (int ks = 0; ks < 8; ++ks) { sh += modp[((size_t)(0 * 8 + ks) * 9 + rb) * 6144 + c]; sc += modp[((size_t)(0 * 8 + ks) * 9 + rb) * 6144 + 1024 + c]; }
            GS[c] = a.in[I_N1G][c] * (1.f + sc); SH[c] = sh;
        }
        __syncthreads();
        unsigned char* A8 = ws + WS_A8;
        if (part == 0) {
            const int r0 = C.bid * 128 + C.wid * 16; const float* X = a.in[I_X] + (size_t)r0 * D; unsigned char* O = A8 + (size_t)r0 * D;
            f32x4 va[4][4], vb[4][4];
            rows_load<4>(va, X, C.lane);
            rows_load<4>(vb, X + 4 * D, C.lane);   rows_finish<4>(va, (bf16_t*)O, GS, SH, C.lane);
            rows_load<4>(va, X + 8 * D, C.lane);   rows_finish<4>(vb, (bf16_t*)(O + 4 * D), GS, SH, C.lane);
            rows_load<4>(vb, X + 12 * D, C.lane);  rows_finish<4>(va, (bf16_t*)(O + 8 * D), GS, SH, C.lane);
            rows_finish<4>(vb, (bf16_t*)(O + 12 * D), GS, SH, C.lane); }
        else { const int r = C.bid * 8 + C.wid; modulate_rows<1>(a.in[I_CTX] + (size_t)r * D, (bf16_t*)(A8 + (size_t)(M + r) * D), GS, SH, C.lane); }
    }
}

__device__ __forceinline__ void conv_tile(const Ctx& C, int tile) {
    CArgs& a = *C.a; unsigned char* ws = a.ws;
    const bf16_t* GLU = (const bf16_t*)(ws + WS_GLU); unsigned char* Y8 = ws + WS_A8;
    const int b = tile >> 6, t0 = (tile & 63) * 64;
    __syncthreads();
    for (int i = C.tid; i < 94 * 64; i += 512) { const int row = i >> 6, ch = i & 63, t = t0 - 15 + row;
        u32x4 v = (u32x4){0u, 0u, 0u, 0u};
        if (t >= 0 && t < SEQ) v = *(const u32x4*)(GLU + ((size_t)(b * SEQ + t)) * 512 + ch * 8);
        *(LAS u32x4*)(C.lds + (size_t)i * 16) = v; }
    __syncthreads();
    const int half = C.tid >> 8, cp = C.tid & 255;
    float w0[31], w1[31];
#pragma unroll
    for (int j = 0; j < 31; ++j) { const f32x2 w = *(const f32x2*)(a.in[I_CONVW] + j * 512 + 2 * cp); w0[j] = w.x; w1[j] = w.y; }
    const f32x2 cb = *(const f32x2*)(a.in[I_CONVB] + 2 * cp), gg = *(const f32x2*)(a.in[I_GNG] + 2 * cp), gb = *(const f32x2*)(a.in[I_GNB] + 2 * cp);
    const LAS unsigned* L = (const LAS unsigned*)C.lds;
#pragma unroll 1
    for (int sb = 0; sb < 4; ++sb) {
        const int ob = 32 * half + 8 * sb;
        float a0[8], a1[8], x0[38], x1[38];
#pragma unroll
        for (int i = 0; i < 38; ++i) { const unsigned u = L[(ob + i) * 256 + cp]; x0[i] = bf_lo(u); x1[i] = bf_hi(u); }
#pragma unroll
        for (int o = 0; o < 8; ++o) { float s0 = cb.x, s1 = cb.y;
#pragma unroll
            for (int j = 0; j < 31; ++j) { s0 += w0[j] * x0[o + j]; s1 += w1[j] * x1[o + j]; }
            a0[o] = s0; a1[o] = s1; }
#pragma unroll
        for (int o = 0; o < 8; ++o) {
            const float s = sum32(a0[o] + a1[o]);
            const float mu = s * (1.f / 64.f), d0 = a0[o] - mu, d1 = a1[o] - mu;
            const float q = sum32(d0 * d0 + d1 * d1);
            const float rstd = rsqrtf(q * (1.f / 64.f) + EPS);
            const float y0 = d0 * rstd * gg.x + gb.x, y1 = d1 * rstd * gg.y + gb.y;
            *(unsigned short*)(Y8 + ((size_t)(b * SEQ + t0 + ob + o)) * D + 2 * cp) = (unsigned short)(pk4_fp8(y0 * sigmoidf_(y0), y1 * sigmoidf_(y1), 0.f, 0.f) & 0xffffu);
        }
    }
}

template <bool WIN>
__device__ __forceinline__ void att_softmax(f32x16& S, float& mrun, float& lrun, f32x16& O0, f32x16& O1, bf16x8 (&pb)[2], int W, const LAS float* bp) {
    if (WIN) {
        float bias[16];
#pragma unroll
        for (int e = 0; e < 16; ++e) bias[e] = bp[(e & 3) + 8 * (e >> 2)];
#pragma unroll
        for (int e = 0; e < 16; ++e) asm volatile("" : "+v"(bias[e]));
#pragma unroll
        for (int e = 0; e < 16; ++e) { const int m = __builtin_amdgcn_sbfe(W, (e & 3) + 8 * (e >> 2), 1);
            S[e] = __int_as_float((__float_as_int(S[e] + bias[e]) & m) | (__float_as_int(-1e30f) & ~m)); }
    }
    float mt = S[0];
#pragma unroll
    for (int e = 1; e < 16; ++e) mt = fmaxf(mt, S[e]);
    mt = fmaxf(mt, __shfl_xor(mt, 32));
    const float mn = fmaxf(mrun, mt), alpha = __builtin_amdgcn_exp2f(mrun - mn);
    mrun = mn;
    float ps = 0.f; float p[16];
#pragma unroll
    for (int e = 0; e < 16; ++e) { p[e] = __builtin_amdgcn_exp2f(S[e] - mn); ps += p[e]; }
    lrun = lrun * alpha + ps;
    if (!__all(alpha == 1.f)) {
#pragma unroll
        for (int e = 0; e < 16; ++e) { O0[e] *= alpha; O1[e] *= alpha; }
    }
#pragma unroll
    for (int s2 = 0; s2 < 2; ++s2) { u32x4 w; w.x = pk2(p[8 * s2 + 0], p[8 * s2 + 1]); w.y = pk2(p[8 * s2 + 2], p[8 * s2 + 3]); w.z = pk2(p[8 * s2 + 4], p[8 * s2 + 5]); w.w = pk2(p[8 * s2 + 6], p[8 * s2 + 7]);
        pb[s2] = __builtin_bit_cast(bf16x8, w); }
}
__device__ __forceinline__ void attn_task(const Ctx& C, int task) {
    CArgs& a = *C.a; unsigned char* ws = a.ws;
    const bf16_t* Qb = (const bf16_t*)(ws + WS_Q); const bf16_t* Kb = (const bf16_t*)(ws + WS_K); const bf16_t* Vb = (const bf16_t*)(ws + WS_V);
    unsigned char* Y8 = ws + WS_A8;
    const int h = task & 7, ch = (task >> 3) & 1, rp = (task >> 4) & 31, b = task >> 9;
    const int lane = C.lane, n = lane & 31, hh = lane >> 5;
    const int krA = 2 * rp - 4 < 0 ? 0 : (2 * rp - 4 > 56 ? 56 : 2 * rp - 4), krB = 2 * rp - 3 < 0 ? 0 : (2 * rp - 3 > 56 ? 56 : 2 * rp - 3);
    const int nr = krB + 8 - krA;
    LAS unsigned char* lw = C.lds + C.wid * 14592;
    LAS unsigned char* KT = lw; LAS unsigned char* VT = lw + 5760;
    LAS float* RP = (LAS float*)(lw + 11520);
    for (int i = lane; i < 465; i += 64) RP[64 + i] = a.in[I_RPB][h * 465 + i] * 1.44269504f;
    const int rq = 2 * rp + (n >> 4), kr0q = rq - 4 < 0 ? 0 : (rq - 4 > 56 ? 56 : rq - 4);
    int qtok[2], bs[2], Wq[2]; const LAS float* bp0[2];
#pragma unroll
    for (int qb = 0; qb < 2; ++qb) {
        const int j = 2 * ch + qb, qc = 16 * j + (n & 15);
        qtok[qb] = b * SEQ + rq * 64 + qc;
        bs[qb] = 16 * j - 8 < 0 ? 0 : (16 * j - 8 > 32 ? 32 : 16 * j - 8);
        const int cs = qc - 8 < 0 ? 0 : (qc - 8 > 48 ? 48 : qc - 8);
        int tq = bs[qb] + 4 * hh - cs; tq = tq < -32 ? -32 : (tq > 31 ? 31 : tq);
        Wq[qb] = (int)(unsigned)((0xFFFFull << 32) >> (32 + tq));
        bp0[qb] = RP + 64 + (krA - rq + 7) * 31 + bs[qb] + 4 * hh - qc + 15;
    }
    bf16x8 bq[2][4];
#pragma unroll
    for (int qb = 0; qb < 2; ++qb)
#pragma unroll
        for (int s = 0; s < 4; ++s) bq[qb][s] = *(const bf16x8*)(Qb + (size_t)qtok[qb] * 512 + h * 64 + 16 * s + 8 * hh);
    f32x16 O[2][2];
#pragma unroll
    for (int i = 0; i < 2; ++i)
#pragma unroll
        for (int j = 0; j < 2; ++j)
#pragma unroll
            for (int e = 0; e < 16; ++e) O[i][j][e] = 0.f;
    float mrun[2] = {-1e30f, -1e30f}, lrun[2] = {0.f, 0.f};
    const int lk = lane >> 3, lc = lane & 7;
    const int ub = 24 * ch;
    u32x4 kq[5], vq[5];
#define ATT_FETCH(NI_, tok_) do { const size_t tb_ = (size_t)(tok_) + lk; _Pragma("unroll") for (int i = 0; i < NI_; ++i) { \
        kq[i] = *(const u32x4*)(Kb + (tb_ + 8 * i) * 512 + h * 64 + lc * 8); vq[i] = *(const u32x4*)(Vb + (tb_ + 8 * i) * 512 + h * 64 + lc * 8); } } while (0)
#define ATT_STAGE(NI_) do { _Pragma("unroll") for (int i = 0; i < NI_; ++i) { *(LAS u32x4*)(KT + (8 * i + lk) * 144 + lc * 16) = kq[i]; *(LAS u32x4*)(VT + (8 * i + lk) * 144 + lc * 16) = vq[i]; } } while (0)
    typedef short s4v __attribute__((ext_vector_type(4)));
    const LAS unsigned char* vp0 = VT + (4 * hh + ((lane & 15) >> 2)) * 144 + (16 * ((lane >> 4) & 1) + 4 * (lane & 3)) * 2;
#define ATT_VA(db_, s2_, k0_) ({ const LAS unsigned char* vp_ = vp0 + (16 * (s2_) + (k0_)) * 144 + 64 * (db_); \
        const s4v lo_ = __builtin_amdgcn_ds_read_tr16_b64_v4i16((LAS s4v*)vp_), hi_ = __builtin_amdgcn_ds_read_tr16_b64_v4i16((LAS s4v*)(vp_ + 8 * 144)); \
        (bf16x8)__builtin_shufflevector(lo_, hi_, 0, 1, 2, 3, 4, 5, 6, 7); })
    ATT_FETCH(4, M + b * CTXL);
#pragma unroll 1
    for (int kt = 0; kt < 8; ++kt) {
        ATT_STAGE(4);
        if (kt < 7) ATT_FETCH(4, M + b * CTXL + 32 * (kt + 1)); else ATT_FETCH(5, b * SEQ + krA * 64 + ub);
        bf16x8 kf[4];
#pragma unroll
        for (int s = 0; s < 4; ++s) kf[s] = *(const LAS bf16x8*)(KT + n * 144 + 32 * s + 16 * hh);
        bf16x8 pb[2][2];
#pragma unroll
        for (int qb = 0; qb < 2; ++qb) {
            f32x16 S;
#pragma unroll
            for (int e = 0; e < 16; ++e) S[e] = 0.f;
#pragma unroll
            for (int s = 0; s < 4; ++s) S = __builtin_amdgcn_mfma_f32_32x32x16_bf16(kf[s], bq[qb][s], S, 0, 0, 0);
            att_softmax<false>(S, mrun[qb], lrun[qb], O[0][qb], O[1][qb], pb[qb], 0, RP);
        }
#pragma unroll
        for (int db = 0; db < 2; ++db)
#pragma unroll
            for (int s2 = 0; s2 < 2; ++s2) { const bf16x8 va = ATT_VA(db, s2, 0);
#pragma unroll
                for (int qb = 0; qb < 2; ++qb) O[db][qb] = __builtin_amdgcn_mfma_f32_32x32x16_bf16(va, pb[qb][s2], O[db][qb], 0, 0, 0); }
    }
#pragma unroll 1
    for (int i = 0; i < nr; ++i) {
        const int W = ((unsigned)(krA + i - kr0q) < 8u) ? -1 : 0;
        ATT_STAGE(5);
        ATT_FETCH(5, b * SEQ + (krA + (i + 1 < nr ? i + 1 : i)) * 64 + ub);
#pragma unroll
        for (int qb = 0; qb < 2; ++qb) {
            bf16x8 kf[4];
#pragma unroll
            for (int s = 0; s < 4; ++s) kf[s] = *(const LAS bf16x8*)(KT + (n + 8 * qb) * 144 + 32 * s + 16 * hh);
            f32x16 S;
#pragma unroll
            for (int e = 0; e < 16; ++e) S[e] = 0.f;
#pragma unroll
            for (int s = 0; s < 4; ++s) S = __builtin_amdgcn_mfma_f32_32x32x16_bf16(kf[s], bq[qb][s], S, 0, 0, 0);
            bf16x8 pb[2];
            att_softmax<true>(S, mrun[qb], lrun[qb], O[0][qb], O[1][qb], pb, Wq[qb] & W, bp0[qb] + 31 * i);
#pragma unroll
            for (int db = 0; db < 2; ++db)
#pragma unroll
                for (int s2 = 0; s2 < 2; ++s2) { const bf16x8 va = ATT_VA(db, s2, 8 * qb); O[db][qb] = __builtin_amdgcn_mfma_f32_32x32x16_bf16(va, pb[s2], O[db][qb], 0, 0, 0); }
        }
    }
#undef ATT_FETCH
#undef ATT_STAGE
#undef ATT_VA
#pragma unroll
    for (int qb = 0; qb < 2; ++qb) {
        const float lt = lrun[qb] + __shfl_xor(lrun[qb], 32), inv = 1.f / lt;
        unsigned char* yrow = Y8 + (size_t)qtok[qb] * D + 512 + h * 64;
#pragma unroll
        for (int db = 0; db < 2; ++db)
#pragma unroll
            for (int g = 0; g < 4; ++g)
                *(unsigned*)(yrow + 32 * db + 8 * g + 4 * hh) = pk4_fp8(O[db][qb][4 * g] * inv, O[db][qb][4 * g + 1] * inv, O[db][qb][4 * g + 2] * inv, O[db][qb][4 * g + 3] * inv);
    }
}

__device__ __forceinline__ void phaseNorm2(const Ctx& C, int l) {
    CArgs& a = *C.a; unsigned char* ws = a.ws;
    const float* modf = (const float*)(ws + WS_MODF) + (size_t)l * 9 * 6144;
    LAS float* GS = (LAS float*)C.lds; LAS float* SH = GS + 1024;
    const int b = (C.bid * 128) / SEQ;
    for (int c = C.tid; c < 1024; c += 512) { GS[c] = a.in[I_N2G][l * 1024 + c] * (1.f + modf[b * 6144 + 4 * 1024 + c]); SH[c] = modf[b * 6144 + 3 * 1024 + c]; }
    __syncthreads();
    bf16_t* A = (bf16_t*)(ws + WS_A);
    const bf16_t* Hb = (const bf16_t*)(ws + WS_H);
    { const int r = C.bid * 128 + C.wid * 16; modulate_rows_h<16, false>(Hb + (size_t)r * D, A + (size_t)r * D, GS, SH, C.lane); }
}

__device__ __forceinline__ void ce_desc(float& x, float& y) { const float hi = fmaxf(x, y), lo = fminf(x, y); x = hi; y = lo; }
__device__ __forceinline__ void ce_asc(float& x, float& y) { const float hi = fmaxf(x, y), lo = fminf(x, y); x = lo; y = hi; }
__device__ __forceinline__ void sort16_desc(float (&v)[16]) {
#define CE(a_, b_) ce_desc(v[a_], v[b_]);
    CE(0,13) CE(1,12) CE(2,15) CE(3,14) CE(4,8) CE(5,6) CE(7,11) CE(9,10)
    CE(0,5) CE(1,7) CE(2,9) CE(3,4) CE(6,13) CE(8,14) CE(10,15) CE(11,12)
    CE(0,1) CE(2,3) CE(4,5) CE(6,8) CE(7,9) CE(10,11) CE(12,13) CE(14,15)
    CE(0,2) CE(1,3) CE(4,10) CE(5,11) CE(6,7) CE(8,9) CE(12,14) CE(13,15)
    CE(1,2) CE(3,12) CE(4,6) CE(5,7) CE(8,10) CE(9,11) CE(13,14)
    CE(1,4) CE(2,6) CE(5,8) CE(7,10) CE(9,13) CE(11,14)
    CE(2,4) CE(3,6) CE(9,12) CE(11,13)
    CE(3,5) CE(6,8) CE(7,9) CE(10,12)
    CE(3,4) CE(5,6) CE(7,8) CE(9,10) CE(11,12)
    CE(6,7) CE(8,9)
#undef CE
}
__device__ __forceinline__ void merge16_desc(float (&A)[16], const float (&B)[16]) {
#pragma unroll
    for (int i = 0; i < 16; ++i) A[i] = fmaxf(A[i], B[15 - i]);
#pragma unroll
    for (int j = 8; j > 0; j >>= 1)
#pragma unroll
        for (int i = 0; i < 16; ++i) { const int l = i ^ j; if (l > i) ce_desc(A[i], A[l]); }
}
__device__ __forceinline__ bf16x8 topk_qfrag(const bf16_t* QP, int tok, int h, int p, int hh, int s) { return *(const bf16x8*)(QP + (size_t)tok * 2048 + h * 256 + p * 128 + 64 * hh + 8 * s); }
__device__ __forceinline__ void topk_task(const Ctx& C, int l, int tok0, int ntok0, int h, const LAS unsigned char* KL, bf16x8 (&bq)[2][8]) {
    CArgs& a = *C.a; unsigned char* ws = a.ws;
    const bf16_t* QP = (const bf16_t*)(ws + WS_QP);
    unsigned short* IDX = (unsigned short*)(ws + WS_IDX); float* WT = (float*)(ws + WS_WT);
    const int lane = C.lane, n = lane & 31, hh = lane >> 5;
    const int tok = tok0 + n;
    float sp[2][16];
#pragma unroll
    for (int p = 0; p < 2; ++p) {
        float top[16];
#pragma unroll
        for (int kb = 0; kb < 4; ++kb) {
            f32x16 S;
#pragma unroll
            for (int e = 0; e < 16; ++e) S[e] = 0.f;
#pragma unroll
            for (int s = 0; s < 8; ++s) { const bf16x8 kf = *(const LAS bf16x8*)(KL + (p * 128 + 32 * kb + n) * 272 + 128 * hh + 16 * s);
                S = __builtin_amdgcn_mfma_f32_32x32x16_bf16(kf, bq[p][s], S, 0, 0, 0); }
            if (kb == 3) {
#pragma unroll
                for (int s = 0; s < 8; ++s) bq[p][s] = topk_qfrag(QP, ntok0 + n, h, p, hh, s); }
            float ch[16];
#pragma unroll
            for (int e = 0; e < 16; ++e) { const unsigned key = 32 * kb + (e & 3) + 8 * (e >> 2) + 4 * hh; ch[e] = __uint_as_float((__float_as_uint(S[e]) & ~0x7Fu) | key); }
            sort16_desc(ch);
            if (kb == 0) {
#pragma unroll
                for (int e = 0; e < 16; ++e) top[e] = ch[e];
            } else merge16_desc(top, ch);
        }
        float oth[16];
#pragma unroll
        for (int e = 0; e < 16; ++e) oth[e] = __shfl_xor(top[e], 32);
        merge16_desc(top, oth);
#pragma unroll
        for (int e = 0; e < 16; ++e) sp[p][e] = top[e];
    }
    const float NEG = -3.0e38f;
    auto cand = [&](int ia, int ib) -> float { const float s = sp[0][ia] + sp[1][ib]; return __uint_as_float((__float_as_uint(s) & ~0xFFu) | (unsigned)((ia << 4) | ib)); };
    float L1[16], L2[16], L3[16], L4[16];
#pragma unroll
    for (int i = 0; i < 16; ++i) { L1[i] = cand(0, i); L2[i] = i < 15 ? cand(i + 1, 0) : NEG; L4[i] = NEG; }
#pragma unroll
    for (int i = 0; i < 7; ++i) L3[i] = cand(1, i + 1);
#pragma unroll
    for (int i = 0; i < 6; ++i) L3[7 + i] = cand(i + 2, 1);
#pragma unroll
    for (int i = 0; i < 3; ++i) L3[13 + i] = cand(2, i + 2);
    L4[0] = cand(3, 2); L4[1] = cand(4, 2); L4[2] = cand(3, 3);
    sort16_desc(L3);
    ce_desc(L4[0], L4[1]); ce_desc(L4[1], L4[2]); ce_desc(L4[0], L4[1]);
    merge16_desc(L1, L2); merge16_desc(L3, L4); merge16_desc(L1, L3);
    if (hh == 0) {
        float e16[16], se = 0.f;
#pragma unroll
        for (int i = 0; i < 16; ++i) { e16[i] = __expf(L1[i] - L1[0]); se += e16[i]; }
        const float inv = 1.f / se;
        LAS unsigned* tb = (LAS unsigned*)(C.lds + 69632 + C.wid * 4224) + n * 33;
#pragma unroll
        for (int i = 0; i < 16; ++i) { tb[i] = __float_as_uint(sp[0][i]) & 0x7Fu; tb[16 + i] = __float_as_uint(sp[1][i]) & 0x7Fu; }
        unsigned ids[16];
#pragma unroll
        for (int i = 0; i < 16; ++i) { const unsigned code = __float_as_uint(L1[i]) & 0xFFu; ids[i] = tb[code >> 4] * 128u + tb[16 + (code & 15u)]; }
        float su[16], sv[16];
        { const LAS unsigned char* SEU = C.lds + 103424; const LAS unsigned char* SEV = SEU + NEXP;
#pragma unroll
          for (int i = 0; i < 16; ++i) { su[i] = __uint_as_float((unsigned)SEU[ids[i]] << 23); sv[i] = __uint_as_float((unsigned)SEV[ids[i]] << 23); } }
        u32x4 w0, w1;
        w0.x = ids[0] | (ids[1] << 16); w0.y = ids[2] | (ids[3] << 16); w0.z = ids[4] | (ids[5] << 16); w0.w = ids[6] | (ids[7] << 16);
        w1.x = ids[8] | (ids[9] << 16); w1.y = ids[10] | (ids[11] << 16); w1.z = ids[12] | (ids[13] << 16); w1.w = ids[14] | (ids[15] << 16);
        u32x4* ip = (u32x4*)(IDX + (size_t)tok * 128 + h * 16); ip[0] = w0; ip[1] = w1;
        f32x4* wp = (f32x4*)(WT + (size_t)tok * 128 + h * 16);
        f32x4* sp4 = (f32x4*)((float*)(ws + WS_SU) + (size_t)tok * 128 + h * 16);
#pragma unroll
        for (int i = 0; i < 4; ++i) { wp[i] = (f32x4){e16[4 * i] * inv * sv[4 * i], e16[4 * i + 1] * inv * sv[4 * i + 1], e16[4 * i + 2] * inv * sv[4 * i + 2], e16[4 * i + 3] * inv * sv[4 * i + 3]};
            sp4[i] = (f32x4){su[4 * i], su[4 * i + 1], su[4 * i + 2], su[4 * i + 3]}; }
    }
}
__device__ __forceinline__ void phaseTopk(const Ctx& C, int l) {
    CArgs& a = *C.a; unsigned char* ws = a.ws;
    const int h = C.bid & 7, grp = C.bid >> 3;
    const bf16_t* src = (const bf16_t*)(ws + WS_KEYS) + (size_t)((l * 8 + h) * 2) * 128 * 128;
    for (int i = C.tid; i < 2 * 128 * 16; i += 512) { const int row = i >> 4, chunk = i & 15; *(LAS u32x4*)(C.lds + row * 272 + chunk * 16) = *(const u32x4*)(src + (size_t)row * 128 + chunk * 8); }
    for (int i = C.tid; i < 2048; i += 512) *(LAS u32x4*)(C.lds + 103424 + i * 16) = *(const u32x4*)(ws + (i < 1024 ? WS_SIU : WS_SIV) + (size_t)l * NEXP + (size_t)(i & 1023) * 16);
    __syncthreads();
    bf16x8 bq[2][8];
    { const bf16_t* QP = (const bf16_t*)(ws + WS_QP); const int n = C.lane & 31, hh = C.lane >> 5;
#pragma unroll
      for (int p = 0; p < 2; ++p)
#pragma unroll
          for (int s = 0; s < 8; ++s) bq[p][s] = topk_qfrag(QP, grp * 1024 + C.wid * 32 + n, h, p, hh, s); }
#pragma unroll 1
    for (int t = C.wid; t < 32; t += 8) topk_task(C, l, grp * 1024 + t * 32, grp * 1024 + (t + 8 < 32 ? t + 8 : t) * 32, h, C.lds, bq);
}

__device__ __forceinline__ int peer_dequeue(const Ctx& C, unsigned* q, int js) {
    volatile LAS unsigned* slot = (volatile LAS unsigned*)(C.lds + MISC_OFF + 64);
    __syncthreads();
    if (C.tid == 0) *slot = __hip_atomic_fetch_add(q + js, 1u, __ATOMIC_RELAXED, __HIP_MEMORY_SCOPE_AGENT);
    __syncthreads();
    return (int)*slot;
}
__device__ __forceinline__ float dot16_fp8(const u32x4 (&xf)[2], const u32x4 uw) {
    float d = 0.f;
#pragma unroll
    for (int q = 0; q < 4; ++q) { const unsigned w = uw[q];
        const bf2v lo = __builtin_amdgcn_cvt_scalef32_pk_bf16_fp8(w, 1.0f, false), hi = __builtin_amdgcn_cvt_scalef32_pk_bf16_fp8(w, 1.0f, true);
        const unsigned x0 = xf[q >> 1][2 * (q & 1)], x1 = xf[q >> 1][2 * (q & 1) + 1];
        d = __builtin_amdgcn_fdot2_f32_bf16(__builtin_bit_cast(bf2v, x0), lo, d, false);
        d = __builtin_amdgcn_fdot2_f32_bf16(__builtin_bit_cast(bf2v, x1), hi, d, false); }
    return d;
}
__device__ __forceinline__ void peerU_item(const Ctx& C, int l, int js, int tile) {
    CArgs& a = *C.a; unsigned char* ws = a.ws;
    const bf16_t* A = (const bf16_t*)(ws + WS_A); const unsigned short* IDX = (const unsigned short*)(ws + WS_IDX);
    const unsigned char* TUs = ws + WS_TU + ((size_t)(l * 8 + js) * NEXP) * 128;
    bf16_t* PD = (bf16_t*)(ws + WS_PD) + (size_t)js * M * 128;
    const int lane = C.lane, g = lane >> 3, c = lane & 7;
    LAS unsigned char* lw = C.lds + C.wid * 6144;
#pragma unroll 1
    for (int half = 0; half < 2; ++half) {
        const int tok0 = tile * 128 + C.wid * 16 + half * 8;
        { const u32x4 t0 = *(const u32x4*)((const unsigned char*)(IDX + (size_t)tok0 * 128) + lane * 16), t1 = *(const u32x4*)((const unsigned char*)(IDX + (size_t)tok0 * 128) + (lane + 64) * 16);
          *(LAS u32x4*)(lw + lane * 16) = t0; *(LAS u32x4*)(lw + (lane + 64) * 16) = t1; }
        u32x4 xf[2];
#pragma unroll
        for (int j = 0; j < 2; ++j) xf[j] = *(const u32x4*)(A + (size_t)(tok0 + g) * D + 128 * js + 16 * c + 8 * j);
        bf16_t* prow = PD + (size_t)(tok0 + g) * 128 + 2 * c;
#pragma unroll 1
        for (int kk = 0; kk < 8; ++kk) {
            const u32x4 i0 = *(const LAS u32x4*)(lw + g * 256 + kk * 32), i1 = *(const LAS u32x4*)(lw + g * 256 + kk * 32 + 16);
            u32x4 uf[16];
#pragma unroll
            for (int b = 0; b < 16; ++b) { const unsigned w = b < 8 ? i0[b >> 1] : i1[(b - 8) >> 1]; const unsigned e = (b & 1) ? (w >> 16) : (w & 0xffffu);
                uf[b] = *(const u32x4*)(TUs + (e * 128u + 16u * (unsigned)c)); }
            float v0 = 0.f, v1 = 0.f;
#pragma unroll
            for (int b = 0; b < 16; ++b) { const float d = sum8(dot16_fp8(xf, uf[b]));
                if (b & 1) v1 = (c == (b >> 1)) ? d : v1; else v0 = (c == (b >> 1)) ? d : v0; }
            *(unsigned*)(prow + 16 * kk) = pk2(v0, v1);
        }
    }
}
__device__ __forceinline__ void phasePeerCombine(const Ctx& C) {
    CArgs& a = *C.a; unsigned char* ws = a.ws;
    const u32x2* PD = (const u32x2*)(ws + WS_PD); f32x4* WT = (f32x4*)(ws + WS_WT); const f32x4* SU = (const f32x4*)(ws + WS_SU);
    const size_t n4 = (size_t)M * 128 / 4;
    const size_t stride = (size_t)C.G * 512;
#pragma unroll 1
    for (size_t i = (size_t)C.bid * 512 + C.tid; i < n4; i += 4 * stride) {
        u32x2 w[4][8]; f32x4 su[4], wt[4];
#pragma unroll
        for (int t = 0; t < 4; ++t) {
#pragma unroll
            for (int j = 0; j < 8; ++j) w[t][j] = PD[(size_t)j * n4 + i + t * stride];
            su[t] = SU[i + t * stride]; wt[t] = WT[i + t * stride]; }
#pragma unroll
        for (int t = 0; t < 4; ++t) {
            f32x4 d = (f32x4){0.f, 0.f, 0.f, 0.f};
#pragma unroll
            for (int j = 0; j < 8; ++j) d += (f32x4){bf_lo(w[t][j].x), bf_hi(w[t][j].x), bf_lo(w[t][j].y), bf_hi(w[t][j].y)};
            f32x4 o;
#pragma unroll
            for (int e = 0; e < 4; ++e) o[e] = gelu_erf(d[e] * su[t][e]) * wt[t][e];
            WT[i + t * stride] = o; }
    }
}
__device__ __forceinline__ void peerV_item(const Ctx& C, int l, int js, int tile) {
    CArgs& a = *C.a; unsigned char* ws = a.ws;
    const unsigned short* IDX = (const unsigned short*)(ws + WS_IDX); const float* CF = (const float*)(ws + WS_WT);
    const unsigned char* TVs = ws + WS_TV + ((size_t)(l * 8 + js) * NEXP) * 128;
    const int lane = C.lane, g = lane >> 3, c = lane & 7;
    const int bt = (tile * 128) / SEQ;
    const float* g5p = (const float*)(ws + WS_MODF) + (size_t)l * 9 * 6144 + bt * 6144 + 5 * 1024 + 128 * js + 16 * c;
    f32x4 g5[4];
#pragma unroll
    for (int q = 0; q < 4; ++q) g5[q] = *(const f32x4*)(g5p + 4 * q);
    LAS unsigned char* lw = C.lds + C.wid * 6144;
#pragma unroll 1
    for (int half = 0; half < 2; ++half) {
        const int tok0 = tile * 128 + C.wid * 16 + half * 8;
        { const u32x4 t0 = *(const u32x4*)((const unsigned char*)(IDX + (size_t)tok0 * 128) + lane * 16), t1 = *(const u32x4*)((const unsigned char*)(IDX + (size_t)tok0 * 128) + (lane + 64) * 16);
          u32x4 cfv[4];
#pragma unroll
          for (int j = 0; j < 4; ++j) cfv[j] = *(const u32x4*)((const unsigned char*)(CF + (size_t)tok0 * 128) + (lane + 64 * j) * 16);
          *(LAS u32x4*)(lw + lane * 16) = t0; *(LAS u32x4*)(lw + (lane + 64) * 16) = t1;
#pragma unroll
          for (int j = 0; j < 4; ++j) *(LAS u32x4*)(lw + 2048 + (lane + 64 * j) * 16) = cfv[j]; }
        float acc[16];
#pragma unroll
        for (int e = 0; e < 16; ++e) acc[e] = 0.f;
#pragma unroll 1
        for (int kk = 0; kk < 8; ++kk) {
            const u32x4 i0 = *(const LAS u32x4*)(lw + g * 256 + kk * 32), i1 = *(const LAS u32x4*)(lw + g * 256 + kk * 32 + 16);
            u32x4 vf[16];
#pragma unroll
            for (int b = 0; b < 16; ++b) { const unsigned w = b < 8 ? i0[b >> 1] : i1[(b - 8) >> 1]; const unsigned e = (b & 1) ? (w >> 16) : (w & 0xffffu);
                vf[b] = *(const u32x4*)(TVs + (e * 128u + 16u * (unsigned)c)); }
            f32x4 cf[4];
#pragma unroll
            for (int q = 0; q < 4; ++q) cf[q] = *(const LAS f32x4*)(lw + 2048 + g * 512 + kk * 64 + 16 * q);
#pragma unroll
            for (int b = 0; b < 16; ++b) { const float ck = cf[b >> 2][b & 3];
#pragma unroll
                for (int q = 0; q < 4; ++q) { const unsigned vw = vf[b][q];
                    const f32x2 lo = __builtin_amdgcn_cvt_pk_f32_fp8(vw, false), hi = __builtin_amdgcn_cvt_pk_f32_fp8(vw, true);
                    acc[4 * q] += ck * lo.x; acc[4 * q + 1] += ck * lo.y; acc[4 * q + 2] += ck * hi.x; acc[4 * q + 3] += ck * hi.y; } }
        }
        bf16_t* hp = (bf16_t*)(ws + WS_H) + (size_t)(tok0 + g) * D + 128 * js + 16 * c;
        const u32x4 h0 = *(const u32x4*)hp, h1 = *(const u32x4*)(hp + 8);
        u32x4 o0, o1;
#pragma unroll
        for (int e = 0; e < 4; ++e) { o0[e] = pk2(bf_lo(h0[e]) + g5[e >> 1][2 * (e & 1)] * acc[2 * e], bf_hi(h0[e]) + g5[e >> 1][2 * (e & 1) + 1] * acc[2 * e + 1]);
                                      o1[e] = pk2(bf_lo(h1[e]) + g5[2 + (e >> 1)][2 * (e & 1)] * acc[8 + 2 * e], bf_hi(h1[e]) + g5[2 + (e >> 1)][2 * (e & 1) + 1] * acc[8 + 2 * e + 1]); }
        *(u32x4*)hp = o0; *(u32x4*)(hp + 8) = o1;
    }
}
template <int WHICH> __device__ __forceinline__ void phasePeerSliced(const Ctx& C, int l) {
    const int xcc = (int)(xb_xcc_id() & 7u);
    unsigned* q = (unsigned*)(C.a->ws + WS_CTL) + 8192 + 16 * (2 * l + WHICH);
    volatile LAS unsigned* slot = (volatile LAS unsigned*)(C.lds + MISC_OFF + 64);
#pragma unroll 1
    for (int at = 0; at < 8; ++at) { const int js = (xcc + at) & 7;
        int tile = peer_dequeue(C, q, js);
#pragma unroll 1
        while (tile < M / 128) {
            unsigned nxt = 0u;
            if (C.tid == 0) nxt = __hip_atomic_fetch_add(q + js, 1u, __ATOMIC_RELAXED, __HIP_MEMORY_SCOPE_AGENT);
            if (WHICH == 0) peerU_item(C, l, js, tile); else peerV_item(C, l, js, tile);
            __syncthreads();
            if (C.tid == 0) *slot = nxt;
            __syncthreads();
            tile = (int)*slot;
        } }
}
__device__ __forceinline__ void phasePeerNorm(const Ctx& C, int l) {
    CArgs& a = *C.a; unsigned char* ws = a.ws;
    if (l == 0) {
        const float* modf = (const float*)(ws + WS_MODF) + (size_t)9 * 6144;
        LAS float* GS = (LAS float*)C.lds; LAS float* SH = GS + 1024;
        const int b = (C.bid * 128) / SEQ;
        for (int c = C.tid; c < 1024; c += 512) { GS[c] = a.in[I_N1G][1024 + c] * (1.f + modf[b * 6144 + 1024 + c]); SH[c] = modf[b * 6144 + c]; }
        __syncthreads();
        unsigned char* A8 = ws + WS_A8;
        const bf16_t* Hb = (const bf16_t*)(ws + WS_H);
        { const int r = C.bid * 128 + C.wid * 16; modulate_rows_h<16, true>(Hb + (size_t)r * D, A8 + (size_t)r * D, GS, SH, C.lane); }
    } else {
        const bf16_t* Hb = (const bf16_t*)(ws + WS_H);
        { const int r0 = C.bid * 128 + C.wid * 16;
            u32x4 v[16][2];
#pragma unroll
            for (int r = 0; r < 16; ++r)
#pragma unroll
                for (int j = 0; j < 2; ++j) v[r][j] = *(const u32x4*)(Hb + (size_t)(r0 + r) * D + 512 * j + 8 * C.lane);
#pragma unroll
            for (int r = 0; r < 16; ++r) { float x[16]; float s = 0.f;
#pragma unroll
                for (int j = 0; j < 2; ++j)
#pragma unroll
                    for (int e = 0; e < 4; ++e) { x[8 * j + 2 * e] = bf_lo(v[r][j][e]); x[8 * j + 2 * e + 1] = bf_hi(v[r][j][e]); }
#pragma unroll
                for (int e = 0; e < 16; ++e) s += x[e] * x[e];
                const float rinv = rsqrtf(wave_sum(s) * (1.f / D) + EPS);
#pragma unroll
                for (int j = 0; j < 2; ++j)
#pragma unroll
                    for (int q = 0; q < 2; ++q) { const f32x4 gg = *(const f32x4*)(a.in[I_NFG] + 512 * j + 8 * C.lane + 4 * q);
                        *(f32x4*)(a.out + (size_t)(r0 + r) * D + 512 * j + 8 * C.lane + 4 * q) = (f32x4){x[8 * j + 4 * q] * rinv * gg[0], x[8 * j + 4 * q + 1] * rinv * gg[1], x[8 * j + 4 * q + 2] * rinv * gg[2], x[8 * j + 4 * q + 3] * rinv * gg[3]}; } } }
    }
}

__device__ __forceinline__ void phaseSgu(const Ctx& C) {
    CArgs& a = *C.a; unsigned char* ws = a.ws;
    const bf16_t* U = (const bf16_t*)(ws + WS_U); const bf16_t* VV = (const bf16_t*)(ws + WS_VV); const bf16_t* WSP = (const bf16_t*)(ws + WS_WSP);
    unsigned char* A8 = ws + WS_A8;
    LAS float* ST = (LAS float*)(C.lds + 69632);
    LAS bf16_t* VT = (LAS bf16_t*)C.lds;
    const int lane = C.lane, n = lane & 31, hh = lane >> 5;
    LAS float* LG = (LAS float*)(C.lds + 70656); LAS float* LB = LG + 1024;
    LAS unsigned char* WL = C.lds + 78848;
    for (int c = C.tid; c < 1024; c += 512) { LG[c] = a.in[I_LNG][c]; LB[c] = a.in[I_LNB][c]; }
    for (int chunk = C.bid; chunk < M / 128; chunk += C.G) {
        const int tok0 = chunk * 128;
        __syncthreads();
        for (int ib = 0; ib < 16; ib += 8) {
            u32x4 vv0[8], vv1[8];
#pragma unroll
            for (int i = 0; i < 8; ++i) { const int q = C.wid * 16 + ib + i;
                vv0[i] = *(const u32x4*)(VV + (size_t)(tok0 + q) * D + 8 * lane); vv1[i] = *(const u32x4*)(VV + (size_t)(tok0 + q) * D + 512 + 8 * lane); }
#pragma unroll
            for (int i = 0; i < 8; ++i) { const int q = C.wid * 16 + ib + i;
                float x[16];
#pragma unroll
                for (int e = 0; e < 4; ++e) { x[2 * e] = bf_lo(vv0[i][e]); x[2 * e + 1] = bf_hi(vv0[i][e]); x[8 + 2 * e] = bf_lo(vv1[i][e]); x[8 + 2 * e + 1] = bf_hi(vv1[i][e]); }
                float s = 0.f;
#pragma unroll
                for (int e = 0; e < 16; ++e) s += x[e];
                const float mu = wave_sum(s) * (1.f / D); float qq = 0.f;
#pragma unroll
                for (int e = 0; e < 16; ++e) { const float d = x[e] - mu; qq += d * d; }
                const float rstd = rsqrtf(wave_sum(qq) * (1.f / D) + EPS);
                if (lane == 0) { ST[2 * q] = mu; ST[2 * q + 1] = rstd; } }
        }
        __syncthreads();
#pragma unroll 1
        for (int g = 0; g < 8; ++g) {
            LAS bf16_t* VTg = VT + (g & 1) * (128 * 136);
            const int cb = C.tid & 15, q0 = C.tid >> 4;
            const int cbk = C.wid & 3;
            u32x4 vreg[4], ureg[4]; float bsr[4];
#pragma unroll
            for (int i = 0; i < 4; ++i) vreg[i] = *(const u32x4*)(VV + (size_t)(tok0 + q0 + 32 * i) * D + g * 128 + cb * 8);
#pragma unroll
            for (int i = 0; i < 4; ++i) { ureg[i] = *(const u32x4*)(U + (size_t)(tok0 + q0 + 32 * i) * D + g * 128 + cb * 8); bsr[i] = a.in[I_BS][g * 128 + q0 + 32 * i]; }
            u32x4 wreg[4];
#pragma unroll
            for (int i = 0; i < 4; ++i) { const int id = C.tid + 512 * i; wreg[i] = *(const u32x4*)(WSP + ((size_t)g * 128 + (id >> 4)) * 128 + (id & 15) * 8); }
            f32x4 lg0 = *(const LAS f32x4*)(LG + g * 128 + cb * 8), lg1 = *(const LAS f32x4*)(LG + g * 128 + cb * 8 + 4), lb0 = *(const LAS f32x4*)(LB + g * 128 + cb * 8), lb1 = *(const LAS f32x4*)(LB + g * 128 + cb * 8 + 4);
#pragma unroll
            for (int i = 0; i < 4; ++i) { const int q = q0 + 32 * i; const float mu = ST[2 * q], rstd = ST[2 * q + 1];
                const int col = ((((q >> 3) ^ cb) & 15) << 3) | (q & 7);
#pragma unroll
                for (int e = 0; e < 4; ++e) { const int c = cb * 8 + 2 * e;
                    const float ga = e < 2 ? lg0[2 * e] : lg1[2 * e - 4], gb = e < 2 ? lg0[2 * e + 1] : lg1[2 * e - 3];
                    const float ba = e < 2 ? lb0[2 * e] : lb1[2 * e - 4], bb = e < 2 ? lb0[2 * e + 1] : lb1[2 * e - 3];
                    const float y0 = (bf_lo(vreg[i][e]) - mu) * rstd * ga + ba;
                    const float y1 = (bf_hi(vreg[i][e]) - mu) * rstd * gb + bb;
                    const unsigned w = pk2(y0, y1);
                    VTg[c * 136 + col] = (bf16_t)(w & 0xffffu); VTg[(c + 1) * 136 + col] = (bf16_t)(w >> 16); } }
#pragma unroll
            for (int i = 0; i < 4; ++i) { const int id = C.tid + 512 * i; *(LAS u32x4*)(WL + (id >> 4) * 272 + (id & 15) * 16) = wreg[i]; }
            __syncthreads();
            bf16x8 bfr[8];
#pragma unroll
            for (int s8 = 0; s8 < 8; ++s8) bfr[s8] = *(const LAS bf16x8*)(VTg + (32 * cbk + n) * 136 + ((((2 * s8 + hh) ^ ((32 * cbk + n) >> 3)) & 15) << 3));
            f32x16 S2[2];
#pragma unroll
            for (int pi = 0; pi < 2; ++pi) {
#pragma unroll
                for (int e = 0; e < 16; ++e) S2[pi][e] = 0.f;
#pragma unroll
                for (int s8 = 0; s8 < 8; ++s8) { const bf16x8 wfr = *(const LAS bf16x8*)(WL + (32 * (2 * (C.wid >> 2) + pi) + n) * 272 + 32 * s8 + 16 * hh);
                    S2[pi] = __builtin_amdgcn_mfma_f32_32x32x16_bf16(wfr, bfr[s8], S2[pi], 0, 0, 0); }
            }
            LAS unsigned char* MX = (LAS unsigned char*)(VT + ((g + 1) & 1) * (128 * 136));
#pragma unroll
            for (int pi = 0; pi < 2; ++pi) {
                const int pb = 2 * (C.wid >> 2) + pi;
#pragma unroll
                for (int e = 0; e < 16; e += 2) { const int p = 32 * pb + (e & 3) + 8 * (e >> 2) + 4 * hh;
                    const unsigned w = pk2(S2[pi][e], S2[pi][e + 1]);
                    *(LAS bf16_t*)(MX + p * 272 + (32 * cbk + n) * 2) = (bf16_t)(w & 0xffffu); *(LAS bf16_t*)(MX + (p + 1) * 272 + (32 * cbk + n) * 2) = (bf16_t)(w >> 16); }
            }
            __syncthreads();
#pragma unroll
            for (int i = 0; i < 4; ++i) { const int q = q0 + 32 * i;
                const u32x4 mx = *(const LAS u32x4*)(MX + q * 272 + cb * 16);
                float r[8];
#pragma unroll
                for (int e = 0; e < 4; ++e) { r[2 * e] = bf_lo(ureg[i][e]) * (bf_lo(mx[e]) + bsr[i]); r[2 * e + 1] = bf_hi(ureg[i][e]) * (bf_hi(mx[e]) + bsr[i]); }
                u32x2 o; o.x = pk4_fp8(r[0], r[1], r[2], r[3]); o.y = pk4_fp8(r[4], r[5], r[6], r[7]);
                *(u32x2*)(A8 + (size_t)(tok0 + q) * D + g * 128 + cb * 8) = o; }
            __syncthreads();
        }
    }
}

constexpr int NPHASES = 22;
__global__ void __launch_bounds__(512, 2) fwd_megakernel(Args args) {
    extern __shared__ __attribute__((aligned(16))) unsigned char lds_raw[];
    LAS unsigned char* lds = (LAS unsigned char*)lds_raw;
    Ctx C; C.a = (CArgs*)__builtin_amdgcn_kernarg_segment_ptr(); C.lds = lds; C.tid = threadIdx.x; C.lane = C.tid & 63; C.wid = __builtin_amdgcn_readfirstlane(C.tid >> 6); C.bid = blockIdx.x; C.G = 256;
    volatile LAS unsigned* MISC = (volatile LAS unsigned*)(lds + MISC_OFF);
    if (C.tid < 4) MISC[C.tid] = 0u;
    __syncthreads();
    unsigned char* ws = args.ws;
    const int lo = args.ph_lo, hi = args.ph_hi;
    const bool multi = (hi - lo) > 1;
    if (multi) (void)xcd_barrier_post((unsigned*)(ws + WS_CTL), MISC, C.tid == 0);
#define GRID_BARRIER() do { XcdBarrier b_; b_.bar = (unsigned*)(args.ws + WS_CTL); b_.x = xb_xcc_id(); b_.st = (volatile LAS unsigned*)(lds + MISC_OFF); \
    b_.leader = (C.wid == 0) && (__builtin_amdgcn_mbcnt_hi(~0u, __builtin_amdgcn_mbcnt_lo(~0u, 0u)) == 0u); xcd_barrier(b_); } while (0)
#if PROBE_PHASE >= 0
    volatile LAS unsigned long long* ts_l = (volatile LAS unsigned long long*)(lds + MISC_OFF + 128);
#define STAMP(k) do { if ((k) == PROBE_PHASE || (k) == PROBE_PHASE + 1) { if (C.wid == 0) ts_l[(k) - PROBE_PHASE] = __builtin_amdgcn_s_memrealtime(); } } while (0)
#else
#define STAMP(k) do { } while (0)
#endif
    int ph = 0;
#define PHASE(...) do { STAMP(ph); if (lo <= ph && ph < hi) { \
    { int l_ = (int)__builtin_amdgcn_mbcnt_hi(~0u, __builtin_amdgcn_mbcnt_lo(~0u, 0u)); asm volatile("" : "+v"(l_)); C.lane = l_; C.tid = C.wid * 64 + l_; \
      CArgs* ap_ = (CArgs*)__builtin_amdgcn_kernarg_segment_ptr(); asm volatile("" : "+s"(ap_)); C.a = ap_; } __VA_ARGS__ } if (lo <= ph && ph + 1 < hi) GRID_BARRIER(); ++ph; } while (0)
    using namespace pg8;
    const bf16_t* Abuf = (const bf16_t*)(ws + WS_A);
    const bf16_t* A8buf = (const bf16_t*)(ws + WS_A8);
    const float* modf = (const float*)(ws + WS_MODF);

    PHASE( phaseA(C); );
    PHASE( phaseB(C); );
    PHASE(
        Gemm g{A8buf, (const bf16_t*)(ws + WS_W1T), MA, 2560, 512}; Order1 S; S.init(C.G, C.bid);
        Epi1 E{(bf16_t*)(ws + WS_GLU), ws};
        gemm_phase<Epi1, Order1, true>(lds, g, S, E, C.tid, C.wid);
        ctx_kv_tile(C); );
    PHASE(
        const int vcu = (C.bid & 7) * (C.G >> 3) + (C.bid >> 3);
        for (int t = vcu; t < 512; t += C.G) conv_tile(C, t);
        __syncthreads();
        { int tt = C.wid * C.G + C.bid;
          if (C.wid >= 4) { for (int q = 0; q < 2 && tt < 8192; ++q, tt += C.G * 8) table_task(C, tt); }
          for (int t = vcu * 8 + C.wid; t < NBATCH * 64 * 8; t += C.G * 8) { attn_task(C, t);
              for (int q = 0; q < 2 && tt < 8192; ++q, tt += C.G * 8) table_task(C, tt); }
          for (; tt < 8192; tt += C.G * 8) table_task(C, tt); } );
    PHASE(
        Gemm g{A8buf, (const bf16_t*)(ws + WS_W2T), M, 1024, 512}; StaticOrder S; S.init(M, 1024, C.G, C.bid);
        EpiRes<false> E{args.in[I_X], (bf16_t*)(ws + WS_H), modf + 2 * 1024};
        gemm_phase<EpiRes<false>, StaticOrder, true>(lds, g, S, E, C.tid, C.wid); );
    PHASE( phaseNorm2(C, 0); );
    PHASE(
        Gemm g{Abuf, (const bf16_t*)(ws + WS_WQ), M, 2048, 1024}; StaticOrder S; S.init(M, 2048, C.G, C.bid);
        EpiBf16<0> E{(bf16_t*)(ws + WS_QP), (bf16_t*)(ws + WS_QP), 8, 2048};
        gemm_phase<EpiBf16<0>, StaticOrder>(lds, g, S, E, C.tid, C.wid); );
    PHASE( phaseTopk(C, 0); );
    PHASE( phasePeerSliced<0>(C, 0); );
    PHASE( phasePeerCombine(C); );
    PHASE( phasePeerSliced<1>(C, 0); );
    PHASE( phasePeerNorm(C, 0); );
    PHASE(
        Gemm g{A8buf, (const bf16_t*)(ws + WS_WSI), M, 2048, 512}; StaticOrder S; S.init(M, 2048, C.G, C.bid);
        EpiBf16<1> E{(bf16_t*)(ws + WS_U), (bf16_t*)(ws + WS_VV), 4, 1024};
        gemm_phase<EpiBf16<1>, StaticOrder, true>(lds, g, S, E, C.tid, C.wid); );
    PHASE( phaseSgu(C); );
    PHASE(
        Gemm g{A8buf, (const bf16_t*)(ws + WS_WSO), M, 1024, 512}; StaticOrder S; S.init(M, 1024, C.G, C.bid);
        EpiRes<true> E{ws + WS_H, (bf16_t*)(ws + WS_H), modf + 9 * 6144 + 2 * 1024};
        gemm_phase<EpiRes<true>, StaticOrder, true>(lds, g, S, E, C.tid, C.wid); );
    PHASE( phaseNorm2(C, 1); );
    PHASE(
        Gemm g{Abuf, (const bf16_t*)(ws + WS_WQ) + (size_t)2048 * 1024, M, 2048, 1024}; StaticOrder S; S.init(M, 2048, C.G, C.bid);
        EpiBf16<0> E{(bf16_t*)(ws + WS_QP), (bf16_t*)(ws + WS_QP), 8, 2048};
        gemm_phase<EpiBf16<0>, StaticOrder>(lds, g, S, E, C.tid, C.wid); );
    PHASE( phaseTopk(C, 1); );
    PHASE( phasePeerSliced<0>(C, 1); );
    PHASE( phasePeerCombine(C); );
    PHASE( phasePeerSliced<1>(C, 1); );
    PHASE( phasePeerNorm(C, 1); );
#if PROBE_PHASE >= 0
    if (C.bid == 0 && C.wid == 0 && multi) { const unsigned long long dt = (ts_l[1] - ts_l[0]) * PROBE_MULT, t0 = __builtin_amdgcn_s_memrealtime();
        while (__builtin_amdgcn_s_memrealtime() - t0 < dt) __builtin_amdgcn_s_sleep(8); }
#endif
#undef PHASE
#undef GRID_BARRIER
#undef STAMP
}

extern "C" void kernel_launch(void* const* d_in, const int* in_sizes, int n_in, void* d_out, int out_size, void* d_ws, size_t ws_size, hipStream_t stream) {
    static int grid = 0;
    if (grid == 0) {
        if (n_in != N_IN || out_size != M * D || ws_size < WS_END) { fprintf(stderr, "kernel_launch: unexpected shapes (n_in %d out %d ws %zu need %zu)\n", n_in, out_size, ws_size, (size_t)WS_END); grid = -1; return; }
        int dev = 0, cus = 0, per_cu = 0;
        if (hipGetDevice(&dev) != hipSuccess || hipDeviceGetAttribute(&cus, hipDeviceAttributeMultiprocessorCount, dev) != hipSuccess) { grid = -1; return; }
        if (hipFuncSetAttribute((const void*)fwd_megakernel, hipFuncAttributeMaxDynamicSharedMemorySize, LDS_BYTES) != hipSuccess) { fprintf(stderr, "kernel_launch: hipFuncSetAttribute failed\n"); grid = -1; return; }
        if (hipOccupancyMaxActiveBlocksPerMultiprocessor(&per_cu, (const void*)fwd_megakernel, 512, LDS_BYTES) != hipSuccess || per_cu < 1) { fprintf(stderr, "kernel_launch: occupancy query says %d blocks per CU\n", per_cu); (void)hipGetLastError(); grid = -1; return; }
        grid = cus;
        if (grid != 256) fprintf(stderr, "kernel_launch: note: %d CUs (the phase tilings assume 256)\n", grid);
        if (grid > 256) grid = 256;
    }
    if (grid < 0) return;
    (void)hipMemsetAsync((char*)d_ws + WS_CTL, 0, CTL_BYTES, stream);
    Args a{};
    for (int i = 0; i < N_IN; ++i) a.in[i] = (const float*)d_in[i];
    a.out = (float*)d_out; a.ws = (unsigned char*)d_ws;
#if ONE_LAUNCH
    a.ph_lo = 0; a.ph_hi = NPHASES; hipLaunchKernelGGL(fwd_megakernel, dim3(grid), dim3(512), LDS_BYTES, stream, a);
#else
    for (int i = 0; i < NPHASES; ++i) { a.ph_lo = i; a.ph_hi = i + 1; hipLaunchKernelGGL(fwd_megakernel, dim3(grid), dim3(512), LDS_BYTES, stream, a); }
#endif
}
```

```cpp
#include <hip/hip_runtime.h>
#include <cstdio>
#include <cstdint>

#ifndef PROBE_PHASE
#define PROBE_PHASE -1
#endif
#define PROBE_MULT 8
#ifndef WQ_FP8
#define WQ_FP8 1
#endif
#ifndef ONE_LAUNCH
#define ONE_LAUNCH 1
#endif

#define LAS __attribute__((address_space(3)))
typedef unsigned short bf16_t;
typedef short bf16x8 __attribute__((ext_vector_type(8)));
typedef float f32x4 __attribute__((ext_vector_type(4)));
typedef float f32x16 __attribute__((ext_vector_type(16)));
typedef float f32x2 __attribute__((ext_vector_type(2)));
typedef unsigned u32x4 __attribute__((ext_vector_type(4)));
typedef unsigned u32x2 __attribute__((ext_vector_type(2)));
typedef __bf16 bf2v __attribute__((ext_vector_type(2)));
typedef int v4i __attribute__((ext_vector_type(4)));
typedef int v8i __attribute__((ext_vector_type(8)));

constexpr int D = 1024, NBATCH = 8, SEQ = 4096, M = NBATCH * SEQ, CTXL = 256, MC = NBATCH * CTXL, MA = M + MC;
constexpr int NEXP = 16384;
constexpr float EPS = 1e-6f;
enum { I_X = 0, I_C, I_CTX, I_CCTX, I_N1G, I_N2G, I_ADAW, I_ADAB, I_WIN, I_CONVW, I_CONVB, I_GNG, I_GNB, I_RPB, I_WOUT, I_SGUIN, I_LNG, I_LNB, I_WS, I_BS, I_SGUOUT,
       I_WQ, I_KEYS, I_PU, I_PV, I_NFG, N_IN };

constexpr size_t WS_CTL  = 0;
constexpr size_t CTL_BYTES = 65536;
constexpr size_t WS_MODP = WS_CTL + CTL_BYTES;
constexpr size_t WS_MODF = WS_MODP + (size_t)2 * 8 * 9 * 6144 * 4;
constexpr size_t WS_W1T  = WS_MODF + (size_t)2 * 9 * 6144 * 4;
constexpr size_t WS_W2T  = WS_W1T + (size_t)2560 * 1024 * 2;
constexpr size_t WS_WSI  = WS_W2T + (size_t)1024 * 1024 * 2;
constexpr size_t WS_WSO  = WS_WSI + (size_t)2048 * 1024 * 2;
constexpr size_t WS_WQ   = WS_WSO + (size_t)1024 * 1024 * 2;
constexpr size_t WS_KEYS = WS_WQ + (size_t)2 * 2048 * 1024 * 2;
constexpr size_t WS_WSP  = WS_KEYS + (size_t)2 * 8 * 2 * 128 * 128 * 2;
constexpr size_t WS_TU   = WS_WSP + (size_t)8 * 128 * 128 * 2;
constexpr size_t WS_TV   = WS_TU + (size_t)2 * NEXP * 1024;
constexpr size_t WS_SIU  = WS_TV + (size_t)2 * NEXP * 1024;
constexpr size_t WS_SIV  = WS_SIU + (size_t)2 * NEXP * 4;
constexpr size_t WS_A    = WS_SIV + (size_t)2 * NEXP * 4;
constexpr size_t WS_B    = WS_A + (size_t)MA * 1024 * 2;
constexpr size_t WS_GLU  = WS_B;
constexpr size_t WS_Q    = WS_GLU + (size_t)M * 512 * 2;
constexpr size_t WS_K    = WS_Q + (size_t)M * 512 * 2;
constexpr size_t WS_V    = WS_K + (size_t)MA * 512 * 2;
constexpr size_t WS_QP   = WS_B;
constexpr size_t WS_PD   = WS_B;
constexpr size_t WS_U    = WS_B;
constexpr size_t WS_VV   = WS_B + (size_t)M * 1024 * 2;
constexpr size_t WS_IDX  = WS_V + (size_t)MA * 512 * 2;
constexpr size_t WS_WT   = WS_IDX + (size_t)M * 128 * 2;
constexpr size_t WS_SU   = WS_WT + (size_t)M * 128 * 4;
constexpr size_t WS_A8   = WS_SU + (size_t)M * 128 * 4;
constexpr size_t WS_H    = WS_A8 + (size_t)MA * 1024;
constexpr size_t WS_REF  = WS_H + (size_t)M * 1024 * 2;
constexpr size_t WS_END  = WS_REF + (size_t)256 * 1024 * 4;

constexpr int LDS_BYTES = 147456;
constexpr int MISC_OFF = 147200;

__device__ __forceinline__ float bf_lo(unsigned u) { return __uint_as_float(u << 16); }
__device__ __forceinline__ float bf_hi(unsigned u) { return __uint_as_float(u & 0xffff0000u); }
__device__ __forceinline__ unsigned pk2(float lo, float hi) { bf2v r = {(__bf16)lo, (__bf16)hi}; return __builtin_bit_cast(unsigned, r); }
template <int CTRL> __device__ __forceinline__ float dpp_f(float v) { return __builtin_bit_cast(float, __builtin_amdgcn_update_dpp(0, __builtin_bit_cast(int, v), CTRL, 0xF, 0xF, true)); }
__device__ __forceinline__ float sum8(float v) { v += dpp_f<0xB1>(v); v += dpp_f<0x4E>(v); v += dpp_f<0x141>(v); return v; }
__device__ __forceinline__ float sum16(float v) { v = sum8(v); v += dpp_f<0x140>(v); return v; }
__device__ __forceinline__ float sum32(float v) { v = sum16(v); v += __shfl_xor(v, 16); return v; }
__device__ __forceinline__ float clamp448(float v) { return fminf(fmaxf(v, -448.f), 448.f); }
__device__ __forceinline__ unsigned pk4_fp8(float a, float b, float c, float d) { int p = 0;
    p = __builtin_amdgcn_cvt_pk_fp8_f32(clamp448(a), clamp448(b), p, false); p = __builtin_amdgcn_cvt_pk_fp8_f32(clamp448(c), clamp448(d), p, true); return (unsigned)p; }
__device__ __forceinline__ float wave_sum(float v) { v = sum32(v); v += __shfl_xor(v, 32); return v; }
__device__ __forceinline__ float dot2bf(unsigned a, unsigned b, float c) { return __builtin_amdgcn_fdot2_f32_bf16(__builtin_bit_cast(bf2v, a), __builtin_bit_cast(bf2v, b), c, false); }
__device__ __forceinline__ float sigmoidf_(float x) { return __builtin_amdgcn_rcpf(1.f + __expf(-x)); }
__device__ __forceinline__ float gelu_erf(float v) { return 0.5f * v * (1.f + erff(v * 0.70710678f)); }

namespace pg8 {
constexpr int BM = 256, BK = 64, HALF = 128, HTB = HALF * BK * 2, STAGE_BYTES = 8 * HTB, NXCD = 8, WGM = 8;
__host__ __device__ __forceinline__ int lds_byte(int r, int c) { const int st = (r >> 4) * 2 + (c >> 5), rr = r & 15, cc = c & 31, ob = rr * 64 + cc * 2; return st * 1024 + (ob ^ (((ob >> 9) & 1) << 5)); }
__host__ __device__ __forceinline__ void stage_rc(int b, int& R, int& C) { const int st = b / 1024, sb = b % 1024, swz = sb ^ (((sb >> 9) & 1) << 5); R = (st >> 1) * 16 + swz / 64; C = (st & 1) * 32 + (swz % 64) / 2; }
__host__ __device__ __forceinline__ int perm32(int rho) { const int n = rho >> 4, i = rho & 15; return 8 * (i >> 2) + 4 * n + (i & 3); }
struct Unit { int pm, pn; };
struct Gemm { const bf16_t* A; const bf16_t* Bt; int M, N, K; };
struct StaticOrder {
    int nM, nN, nwg, G, c;
    __host__ __device__ void init(int M_, int N_, int G_, int c_) { nM = M_ / BM; nN = N_ / BM; nwg = nM * nN; G = G_; c = c_; }
    __host__ __device__ bool next(int i, Unit& u) const {
        const long L = (long)i * G + c; if (L >= nwg) return false;
        int wgid = (int)L; { const int q = nwg / NXCD, r = nwg % NXCD, xcd = wgid % NXCD, off = wgid / NXCD; wgid = (xcd < r ? xcd * (q + 1) : r * (q + 1) + (xcd - r) * q) + off; }
        const int nig = WGM * nN, gid = wgid / nig, fm = gid * WGM, gsz = (nM - fm) < WGM ? (nM - fm) : WGM;
        u.pm = fm + ((wgid % nig) % gsz); u.pn = (wgid % nig) / gsz; return true;
    }
    __device__ __forceinline__ void a_ready(const Unit&) const {}
    __device__ __forceinline__ void done(const Unit&) const {}
};
struct Order1 {
    StaticOrder so; int G, c;
    __device__ void init(int G_, int c_) { so.init(M, 2560, G_, c_); G = G_; c = c_; }
    __device__ bool next(int i, Unit& u) const {
        const long L = (long)i * G + c;
        if (L < so.nwg) return so.next(i, u);
        return false;
    }
    __device__ __forceinline__ void a_ready(const Unit&) const {}
    __device__ __forceinline__ void done(const Unit&) const {}
};
__device__ __forceinline__ f32x2 gelu_pk(f32x2 v) {
    const f32x2 av = __builtin_elementwise_abs(v), d = av * 0.2316418882f + 1.0f;
    f32x2 t; t.x = __builtin_amdgcn_rcpf(d.x); t.y = __builtin_amdgcn_rcpf(d.y);
    f32x2 q = t * 0.5307027145f + (-0.7265760135f); q = q * t + 0.7107068705f; q = q * t + (-0.142248368f); q = q * t + 0.127414796f; q = q * t;
    const f32x2 s = (v * v) * (-0.72134752044f);
    f32x2 e; e.x = __builtin_amdgcn_exp2f(s.x); e.y = __builtin_amdgcn_exp2f(s.y);
    const f32x2 m = v * (q * e), r = v - m;
    f32x2 o; o.x = v.x < 0.f ? m.x : r.x; o.y = v.y < 0.f ? m.y : r.y; return o;
}
__device__ __forceinline__ void mfma_fp8_acc(f32x4& acc, const v8i& a, const v8i& b, int sa, int sb) {
    asm volatile("s_nop 1\n\tv_mfma_scale_f32_16x16x128_f8f6f4 %0, %1, %2, %0, %3, %4 op_sel_hi:[0,0,0]" : "+v"(acc) : "v"(a), "v"(b), "v"(sa), "v"(sb));
}
template <class Epi, class Sched, bool FP8 = false>
__device__ __forceinline__ void gemm_phase(LAS unsigned char* lds, const Gemm g, const Sched& S, const Epi& E, const int tid, const int wid) {
    const int lane = tid & 63, wr = wid >> 2, wc = wid & 3, fr = lane & 15, fq = lane >> 4;
    const int K = g.K, nt = K / BK;
    const int sc_w = 0x7A7A7A7A, sc_x = 0x7F7F7F7F;
    unsigned voffA[2], voffB[2];
#pragma unroll
    for (int i = 0; i < 2; ++i) { int R, C; stage_rc(tid * 16 + i * 8192, R, C); const int Rb = Epi::PERM ? ((R & ~31) + perm32(R & 31)) : R;
        voffA[i] = (unsigned)(R * K + C) * 2u; voffB[i] = (unsigned)(Rb * K + C) * 2u; }
    const size_t kstep = (size_t)(BK * 2);
    const size_t hstep = (size_t)HALF * K * 2;
    const size_t tstep = 2 * hstep;
    const unsigned ldsw = (unsigned)wid * 1024u;
    const int aoff = lds_byte(wr * 64 + fr, fq * 8), boff = lds_byte(wc * 32 + fr, fq * 8);
#define PG8_SA(b, h) (((b) * 2 + (h)) * HTB)
#define PG8_SB(b, h) ((4 + (b) * 2 + (h)) * HTB)
#define PG8_STAGE(bufoff, gbase, voff) do { _Pragma("unroll") for (int _i = 0; _i < 2; ++_i) \
        __builtin_amdgcn_global_load_lds((const unsigned*)((const char*)(gbase) + (voff)[_i]), (LAS unsigned*)(lds + (bufoff) + ldsw + _i * 8192), 16, 0, 0); } while (0)
#define PG8_LD16(off) (*(const LAS v4i*)(lds + (off)))
#define PG8_LDA(dst, b, h) do { _Pragma("unroll") for (int m = 0; m < 4; ++m) { const int o_ = PG8_SA(b, h) + aoff + m * 2048; \
        if (FP8) dst##8[m] = __builtin_shufflevector(PG8_LD16(o_), PG8_LD16(o_ + 1024), 0, 1, 2, 3, 4, 5, 6, 7); \
        else { dst[m][0] = __builtin_bit_cast(bf16x8, PG8_LD16(o_)); dst[m][1] = __builtin_bit_cast(bf16x8, PG8_LD16(o_ + 1024)); } } } while (0)
#define PG8_LDB(dst, b, h) do { _Pragma("unroll") for (int n = 0; n < 2; ++n) { const int o_ = PG8_SB(b, h) + boff + n * 2048; \
        if (FP8) dst##8[n] = __builtin_shufflevector(PG8_LD16(o_), PG8_LD16(o_ + 1024), 0, 1, 2, 3, 4, 5, 6, 7); \
        else { dst[n][0] = __builtin_bit_cast(bf16x8, PG8_LD16(o_)); dst[n][1] = __builtin_bit_cast(bf16x8, PG8_LD16(o_ + 1024)); } } } while (0)
#define PG8_MMA(ai, bj, At, Bt) do { __builtin_amdgcn_s_setprio(1); _Pragma("unroll") for (int m = 0; m < 4; ++m) _Pragma("unroll") for (int n = 0; n < 2; ++n) { \
        if (FP8) mfma_fp8_acc(acc[ai][bj][m][n], Bt##8[n], At##8[m], sc_w, sc_x); \
        else { _Pragma("unroll") for (int k = 0; k < 2; ++k) acc[ai][bj][m][n] = __builtin_amdgcn_mfma_f32_16x16x32_bf16(Bt[n][k], At[m][k], acc[ai][bj][m][n], 0, 0, 0); } } \
        __builtin_amdgcn_s_setprio(0); } while (0)
#define PG8_WAIT_V(n) asm volatile("s_waitcnt vmcnt(" #n ")" ::: "memory")
#define PG8_WAIT_L(n) asm volatile("s_waitcnt lgkmcnt(" #n ")" ::: "memory")
#define PG8_BAR __builtin_amdgcn_s_barrier()
#define PG8_SCHED __builtin_amdgcn_sched_barrier(0)
    Unit cur, nxt; int ui = 0;
    if (!S.next(0, cur)) return;
    f32x4 acc[2][2][4][2];
#pragma unroll
    for (int a = 0; a < 2; ++a)
#pragma unroll
        for (int b = 0; b < 2; ++b)
#pragma unroll
            for (int m = 0; m < 4; ++m)
#pragma unroll
                for (int n = 0; n < 2; ++n) acc[a][b][m][n] = (f32x4){0.f, 0.f, 0.f, 0.f};
    const char* cA = (const char*)g.A + (size_t)cur.pm * tstep; const char* cB = (const char*)g.Bt + (size_t)cur.pn * tstep;
    S.a_ready(cur);
    PG8_STAGE(PG8_SB(0, 0), cB, voffB); PG8_STAGE(PG8_SA(0, 0), cA, voffA); PG8_STAGE(PG8_SB(0, 1), cB + hstep, voffB); PG8_STAGE(PG8_SA(0, 1), cA + hstep, voffA);
    if (wr == 1) PG8_BAR;
    PG8_WAIT_V(4); PG8_BAR;
    PG8_STAGE(PG8_SB(1, 0), cB + kstep, voffB); PG8_STAGE(PG8_SA(1, 0), cA + kstep, voffA); PG8_STAGE(PG8_SB(1, 1), cB + hstep + kstep, voffB);
    PG8_WAIT_V(6); PG8_BAR;
    for (;;) {
        const bool has_next = S.next(ui + 1, nxt);
        const char* nA = has_next ? (const char*)g.A + (size_t)nxt.pm * tstep : cA; const char* nB = has_next ? (const char*)g.Bt + (size_t)nxt.pn * tstep : cB;
#pragma unroll 1
        for (int t = 0; t < nt; t += 2) {
            const bool last = (t == nt - 2);
            bf16x8 At[4][2], B0[2][2], B1[2][2]; v8i At8[4], B08[2], B18[2];
            const char* a1 = cA + (size_t)(t + 1) * kstep;
            const char* a2 = last ? nA : cA + (size_t)(t + 2) * kstep; const char* b2 = last ? nB : cB + (size_t)(t + 2) * kstep;
            const char* a3 = a2 + kstep; const char* b3 = b2 + kstep;
            if (last && has_next) S.a_ready(nxt);
            PG8_LDB(B0, 0, 0); PG8_SCHED; PG8_LDA(At, 0, 0); PG8_STAGE(PG8_SA(1, 1), a1 + hstep, voffA);
            PG8_WAIT_L(8); PG8_BAR; PG8_WAIT_L(0); PG8_MMA(0, 0, At, B0); PG8_BAR; PG8_SCHED;
            PG8_LDB(B1, 0, 1); PG8_STAGE(PG8_SB(0, 0), b2, voffB);
            PG8_BAR; PG8_WAIT_L(0); PG8_MMA(0, 1, At, B1); PG8_BAR;
            PG8_LDA(At, 0, 1); PG8_STAGE(PG8_SA(0, 0), a2, voffA);
            PG8_BAR; PG8_WAIT_L(0); PG8_MMA(1, 0, At, B0); PG8_BAR; PG8_SCHED;
            PG8_STAGE(PG8_SB(0, 1), b2 + hstep, voffB);
            PG8_WAIT_V(6); PG8_BAR; PG8_MMA(1, 1, At, B1); PG8_BAR;
            PG8_LDB(B0, 1, 0); PG8_SCHED; PG8_LDA(At, 1, 0); PG8_STAGE(PG8_SA(0, 1), a2 + hstep, voffA);
            PG8_WAIT_L(8); PG8_BAR; PG8_WAIT_L(0); PG8_MMA(0, 0, At, B0); PG8_BAR; PG8_SCHED;
            PG8_LDB(B1, 1, 1); PG8_STAGE(PG8_SB(1, 0), b3, voffB);
            PG8_BAR; PG8_WAIT_L(0); PG8_MMA(0, 1, At, B1); PG8_BAR;
            PG8_LDA(At, 1, 1); PG8_STAGE(PG8_SA(1, 0), a3, voffA);
            PG8_BAR; PG8_WAIT_L(0); PG8_MMA(1, 0, At, B0); PG8_BAR; PG8_SCHED;
            PG8_STAGE(PG8_SB(1, 1), b3 + hstep, voffB);
            PG8_WAIT_V(6); PG8_BAR; PG8_MMA(1, 1, At, B1); PG8_BAR;
        }
        { Unit ue = cur; int wr_ = wr, wc_ = wc, fr_ = fr, fq_ = fq;
          asm volatile("" : "+s"(ue.pm), "+s"(ue.pn), "+s"(wr_), "+s"(wc_), "+v"(fr_), "+v"(fq_));
          E(acc, ue, wr_, wc_, fr_, fq_); }
        S.done(cur);
        if (!has_next) break;
#pragma unroll
        for (int a = 0; a < 2; ++a)
#pragma unroll
            for (int b = 0; b < 2; ++b)
#pragma unroll
                for (int m = 0; m < 4; ++m)
#pragma unroll
                    for (int n = 0; n < 2; ++n) acc[a][b][m][n] = (f32x4){0.f, 0.f, 0.f, 0.f};
        cur = nxt; cA = nA; cB = nB; ++ui;
    }
    PG8_WAIT_V(0);
    if (wr == 0) PG8_BAR;
    PG8_BAR;
#undef PG8_SA
#undef PG8_SB
#undef PG8_STAGE
#undef PG8_LDA
#undef PG8_LD16
#undef PG8_LDB
#undef PG8_MMA
#undef PG8_WAIT_V
#undef PG8_WAIT_L
#undef PG8_BAR
#undef PG8_SCHED
}

struct Epi1 {
    static constexpr bool PERM = true;
    bf16_t *GLU; unsigned char* wsb;
    __device__ __forceinline__ void operator()(const f32x4 (&acc)[2][2][4][2], const Unit& u, int wr, int wc, int fr, int fq) const {
        const int row0 = u.pm * BM + wr * 64 + fr;
        if (u.pn < 4) {
            const int ch0 = u.pn * 128 + wc * 32 + 8 * fq;
#pragma unroll
            for (int ai = 0; ai < 2; ++ai)
#pragma unroll
                for (int m = 0; m < 4; ++m) {
                    const f32x4 a0 = acc[ai][0][m][0], a1 = acc[ai][0][m][1], g0 = acc[ai][1][m][0], g1 = acc[ai][1][m][1];
                    u32x4 w;
                    w.x = pk2(a0[0] * sigmoidf_(g0[0]), a0[1] * sigmoidf_(g0[1])); w.y = pk2(a0[2] * sigmoidf_(g0[2]), a0[3] * sigmoidf_(g0[3]));
                    w.z = pk2(a1[0] * sigmoidf_(g1[0]), a1[1] * sigmoidf_(g1[1])); w.w = pk2(a1[2] * sigmoidf_(g1[2]), a1[3] * sigmoidf_(g1[3]));
                    *(u32x4*)(GLU + (size_t)(row0 + ai * HALF + m * 16) * 512 + ch0) = w;
                }
        } else {
            const int t = (u.pn - 4) >> 1;
            const size_t boff = WS_Q + (t >= 1 ? (size_t)M * 1024 : (size_t)0) + (t >= 2 ? (size_t)MA * 1024 : (size_t)0);
            bf16_t* base = (bf16_t*)(wsb + boff);
            const float sc = t == 0 ? 0.125f * 1.44269504f : 1.f;
            const int col0 = ((u.pn - 4) & 1) * 256 + wc * 32 + 8 * fq;
#pragma unroll
            for (int ai = 0; ai < 2; ++ai)
#pragma unroll
                for (int m = 0; m < 4; ++m) { bf16_t* rowp = base + (size_t)(row0 + ai * HALF + m * 16) * 512 + col0;
#pragma unroll
                    for (int bj = 0; bj < 2; ++bj) { const f32x4 v0 = acc[ai][bj][m][0] * sc, v1 = acc[ai][bj][m][1] * sc;
                        u32x4 w; w.x = pk2(v0[0], v0[1]); w.y = pk2(v0[2], v0[3]); w.z = pk2(v1[0], v1[1]); w.w = pk2(v1[2], v1[3]);
                        *(u32x4*)(rowp + bj * HALF) = w; } }
        }
    }
};
template <bool BF16_BASE> struct EpiRes {
    static constexpr bool PERM = true;
    const void* base; bf16_t* H; const float* gate;
    __device__ __forceinline__ void operator()(const f32x4 (&acc)[2][2][4][2], const Unit& u, int wr, int wc, int fr, int fq) const {
        const int row0 = u.pm * BM + wr * 64 + fr, col0 = u.pn * BM + wc * 32 + 8 * fq;
        const int b = (u.pm * BM) / SEQ;
        f32x4 gv[2][2];
#pragma unroll
        for (int bj = 0; bj < 2; ++bj)
#pragma unroll
            for (int n = 0; n < 2; ++n) gv[bj][n] = *(const f32x4*)(gate + (size_t)b * 6144 + col0 + bj * HALF + 4 * n);
#pragma unroll
        for (int ai = 0; ai < 2; ++ai) {
            f32x4 bb[4][2][2]; u32x4 hb[4][2];
#pragma unroll
            for (int m = 0; m < 4; ++m) { const size_t off = (size_t)(row0 + ai * HALF + m * 16) * D + col0;
#pragma unroll
                for (int bj = 0; bj < 2; ++bj) {
                    if (BF16_BASE) hb[m][bj] = *(const u32x4*)((const bf16_t*)base + off + bj * HALF);
                    else { bb[m][bj][0] = *(const f32x4*)((const float*)base + off + bj * HALF); bb[m][bj][1] = *(const f32x4*)((const float*)base + off + bj * HALF + 4); } } }
#pragma unroll
            for (int m = 0; m < 4; ++m) { const size_t off = (size_t)(row0 + ai * HALF + m * 16) * D + col0;
#pragma unroll
                for (int bj = 0; bj < 2; ++bj) {
                    f32x4 b0, b1;
                    if (BF16_BASE) { const u32x4 h4 = hb[m][bj];
                        b0 = (f32x4){bf_lo(h4.x), bf_hi(h4.x), bf_lo(h4.y), bf_hi(h4.y)}; b1 = (f32x4){bf_lo(h4.z), bf_hi(h4.z), bf_lo(h4.w), bf_hi(h4.w)}; }
                    else { b0 = bb[m][bj][0]; b1 = bb[m][bj][1]; }
                    const f32x4 v0 = b0 + gv[bj][0] * acc[ai][bj][m][0], v1 = b1 + gv[bj][1] * acc[ai][bj][m][1];
                    u32x4 w; w.x = pk2(v0[0], v0[1]); w.y = pk2(v0[2], v0[3]); w.z = pk2(v1[0], v1[1]); w.w = pk2(v1[2], v1[3]);
                    *(u32x4*)(H + off + bj * HALF) = w; } }
        }
    }
};
template <int ACT> struct EpiBf16 {
    static constexpr bool PERM = true;
    bf16_t *O0, *O1; int split_tiles, ld;
    __device__ __forceinline__ void operator()(const f32x4 (&acc)[2][2][4][2], const Unit& u, int wr, int wc, int fr, int fq) const {
        const int row0 = u.pm * BM + wr * 64 + fr;
        bf16_t* base = u.pn < split_tiles ? O0 : O1;
        const int col0 = (u.pn < split_tiles ? u.pn : u.pn - split_tiles) * BM + wc * 32 + 8 * fq;
#pragma unroll
        for (int ai = 0; ai < 2; ++ai)
#pragma unroll
            for (int m = 0; m < 4; ++m) { bf16_t* rowp = base + (size_t)(row0 + ai * HALF + m * 16) * ld + col0;
#pragma unroll
                for (int bj = 0; bj < 2; ++bj) { f32x4 v0 = acc[ai][bj][m][0], v1 = acc[ai][bj][m][1];
                    if (ACT == 1) { f32x2 a = gelu_pk((f32x2){v0[0], v0[1]}), b = gelu_pk((f32x2){v0[2], v0[3]}), c = gelu_pk((f32x2){v1[0], v1[1]}), d = gelu_pk((f32x2){v1[2], v1[3]});
                        v0 = (f32x4){a.x, a.y, b.x, b.y}; v1 = (f32x4){c.x, c.y, d.x, d.y}; }
                    u32x4 w; w.x = pk2(v0[0], v0[1]); w.y = pk2(v0[2], v0[3]); w.z = pk2(v1[0], v1[1]); w.w = pk2(v1[2], v1[3]);
                    *(u32x4*)(rowp + bj * HALF) = w; } }
    }
};
}

#define XB_TMO      128
#define XB_XCNT(j)  (256  + 64 * (j))
#define XB_XSUB(j)  (1280 + 64 * (j))
#define XB_XGEN(j)  (2304 + 64 * (j))
#define XB_TOP      3328
#define XB_TOPGEN   3392
#define XCD_BAR_WORDS 3456
#define XB_SPIN_CAP (1u << 22)
__device__ __forceinline__ unsigned xb_ld(unsigned* p)              { return __hip_atomic_load(p, __ATOMIC_RELAXED, __HIP_MEMORY_SCOPE_AGENT); }
__device__ __forceinline__ unsigned xb_add(unsigned* p, unsigned v) { return __hip_atomic_fetch_add(p, v, __ATOMIC_RELAXED, __HIP_MEMORY_SCOPE_AGENT); }
__device__ __forceinline__ unsigned xb_xcc_id() { return (unsigned)__builtin_amdgcn_s_getreg((3 << 11) | 20) & 0xFu; }
#define XB_SPIN(cond, bar) do { unsigned _sp = 0; while (cond) { __builtin_amdgcn_s_sleep(1); \
    if ((++_sp & 255u) == 0u) { if (xb_ld(&(bar)[XB_TMO])) break; if (_sp > XB_SPIN_CAP) { atomicAdd(&(bar)[XB_TMO], 1u); break; } } } } while (0)
struct XcdBarrier { unsigned* bar; unsigned x; volatile LAS unsigned* st; bool leader; };
__device__ __forceinline__ XcdBarrier xcd_barrier_post(unsigned* bar, volatile LAS unsigned* st, bool leader) {
    XcdBarrier b; b.bar = bar; b.x = xb_xcc_id(); b.st = st; b.leader = leader;
    if (leader) (void)xb_add(&bar[XB_XCNT(b.x)], 1u);
    return b;
}
__device__ __forceinline__ void xcd_barrier_complete(unsigned* bar, unsigned x, unsigned& nloc, unsigned& nx) {
    const unsigned G = gridDim.x * gridDim.y * gridDim.z;
    unsigned sum, cnt, mine, sp = 0u;
    for (;;) {
        sum = 0u; cnt = 0u; mine = 0u;
#pragma unroll
        for (unsigned j = 0; j < 16; ++j) { const unsigned c = xb_ld(&bar[XB_XCNT(j)]); sum += c; cnt += (c > 0u) ? 1u : 0u; mine = (j == x) ? c : mine; }
        if (sum == G) break;
        __builtin_amdgcn_s_sleep(1);
        if ((++sp & 255u) == 0u) { if (xb_ld(&bar[XB_TMO])) break; if (sp > XB_SPIN_CAP) { atomicAdd(&bar[XB_TMO], 1u); break; } }
    }
    nloc = mine > 0u ? mine : 1u; nx = cnt > 0u ? cnt : 1u;
}
__device__ __forceinline__ void xcd_barrier(const XcdBarrier& b) {
    asm volatile("s_waitcnt vmcnt(0)" ::: "memory");
    __syncthreads();
    if (b.leader) {
        unsigned* bar = b.bar;
        __builtin_amdgcn_s_waitcnt(0);
        unsigned nloc = b.st[0], nx = b.st[1];
        if (nloc == 0u) { xcd_barrier_complete(bar, b.x, nloc, nx); b.st[0] = nloc; b.st[1] = nx; }
        const unsigned old = xb_add(&bar[XB_XSUB(b.x)], 1u);
        const unsigned gen = old / nloc;
        if (old + 1u == (gen + 1u) * nloc) {
            __builtin_amdgcn_fence(__ATOMIC_RELEASE, "agent");
            asm volatile("s_waitcnt vmcnt(0)" ::: "memory");
            const unsigned og = xb_add(&bar[XB_TOP], 1u);
            const unsigned tg = og / nx;
            if (og + 1u == (tg + 1u) * nx) xb_add(&bar[XB_TOPGEN], 1u);
            else XB_SPIN(xb_ld(&bar[XB_TOPGEN]) == tg, bar);
            __builtin_amdgcn_fence(__ATOMIC_ACQUIRE, "agent");
            xb_add(&bar[XB_XGEN(b.x)], 1u);
            asm volatile("s_waitcnt vmcnt(0)" ::: "memory");
        } else {
            XB_SPIN(xb_ld(&bar[XB_XGEN(b.x)]) == gen, bar);
            __builtin_amdgcn_fence(__ATOMIC_ACQUIRE, "agent");
            asm volatile("s_waitcnt vmcnt(0)" ::: "memory");
        }
    }
    __syncthreads();
}

struct Args { const float* in[N_IN]; float* out; unsigned char* ws; int ph_lo, ph_hi; };
static_assert(sizeof(Args) == (N_IN + 2) * 8 + 8, "Args has padding");

typedef const __attribute__((address_space(4))) Args CArgs;
struct Ctx {
    CArgs* a; LAS unsigned char* lds; int tid, lane, wid, bid, G;
};

__device__ __forceinline__ void ctx_kv_tile(const Ctx& C) {
    CArgs& a = *C.a; unsigned char* ws = a.ws;
    const int lane = C.lane, fr = lane & 15, fq = lane >> 4;
    const int r0 = (C.bid >> 4) * 128 + C.wid * 16, c0 = (C.bid & 15) * 64;
    const unsigned char* xa = ws + WS_A8 + (size_t)(M + r0 + fr) * 1024 + 32 * fq;
    const unsigned char* wb = ws + WS_W1T + (size_t)(1536 + c0 + fr) * 1024 + 32 * fq;
    f32x4 acc[4];
#pragma unroll
    for (int nb = 0; nb < 4; ++nb) acc[nb] = (f32x4){0.f, 0.f, 0.f, 0.f};
#pragma unroll 2
    for (int ks = 0; ks < 8; ++ks) {
        const v8i xv = __builtin_shufflevector(*(const v4i*)(xa + 128 * ks), *(const v4i*)(xa + 128 * ks + 16), 0, 1, 2, 3, 4, 5, 6, 7);
        v8i wv[4];
#pragma unroll
        for (int nb = 0; nb < 4; ++nb) wv[nb] = __builtin_shufflevector(*(const v4i*)(wb + (size_t)nb * 16384 + 128 * ks), *(const v4i*)(wb + (size_t)nb * 16384 + 128 * ks + 16), 0, 1, 2, 3, 4, 5, 6, 7);
#pragma unroll
        for (int nb = 0; nb < 4; ++nb) pg8::mfma_fp8_acc(acc[nb], wv[nb], xv, 0x7A7A7A7A, 0x7F7F7F7F);
    }
    asm volatile("s_nop 15\n\ts_nop 15" ::: "memory");
#pragma unroll
    for (int nb = 0; nb < 4; ++nb) asm volatile("" : "+v"(acc[nb]));
#pragma unroll
    for (int nb = 0; nb < 4; ++nb) { const int col = c0 + 16 * nb + 4 * fq;
        bf16_t* dst = (bf16_t*)(ws + (col < 512 ? WS_K : WS_V)) + (size_t)(M + r0 + fr) * 512 + (col & 511);
        u32x2 o; o.x = pk2(acc[nb][0], acc[nb][1]); o.y = pk2(acc[nb][2], acc[nb][3]); *(u32x2*)dst = o; }
}

__device__ __forceinline__ int w1_dest_row(int n) {
    if (n < 512) return (n >> 7) * 256 + (n & 127);
    if (n < 1024) { const int q = n - 512; return (q >> 7) * 256 + 128 + (q & 127); }
    return n;
}
__device__ __forceinline__ void transpose_item(const float* W, int K, int N, bf16_t* WT, int item, LAS float* scr, int lane, int mode) {
    const int nblk = N / 32, kb = item / nblk, nb = item % nblk, k0 = 64 * kb, n0 = 32 * nb;
    { f32x4 w[8];
#pragma unroll
      for (int i = 0; i < 8; ++i) w[i] = *(const f32x4*)(W + (size_t)(k0 + 8 * i + (lane >> 3)) * N + n0 + 4 * (lane & 7));
#pragma unroll
      for (int i = 0; i < 8; ++i) { LAS float* d = scr + (8 * i + (lane >> 3)) * 33 + 4 * (lane & 7); d[0] = w[i].x; d[1] = w[i].y; d[2] = w[i].z; d[3] = w[i].w; } }
    asm volatile("s_waitcnt lgkmcnt(0)" ::: "memory"); __builtin_amdgcn_wave_barrier();
    const int c = lane & 7;
#pragma unroll
    for (int j = 0; j < 4; ++j) { const int n = (lane >> 3) + 8 * j; const LAS float* s = scr + (8 * c) * 33 + n;
        const int dr = (mode & 1) ? w1_dest_row(n0 + n) : (n0 + n);
        if (mode & 2) {
            u32x2 o; o.x = pk4_fp8(s[0 * 33] * 32.f, s[1 * 33] * 32.f, s[2 * 33] * 32.f, s[3 * 33] * 32.f); o.y = pk4_fp8(s[4 * 33] * 32.f, s[5 * 33] * 32.f, s[6 * 33] * 32.f, s[7 * 33] * 32.f);
            *(u32x2*)((unsigned char*)WT + (size_t)dr * K + k0 + 8 * c) = o;
        } else {
            u32x4 o; o.x = pk2(s[0 * 33], s[1 * 33]); o.y = pk2(s[2 * 33], s[3 * 33]); o.z = pk2(s[4 * 33], s[5 * 33]); o.w = pk2(s[6 * 33], s[7 * 33]);
            *(u32x4*)(WT + (size_t)dr * K + k0 + 8 * c) = o; } }
    asm volatile("s_waitcnt lgkmcnt(0)" ::: "memory"); __builtin_amdgcn_wave_barrier();
}
__device__ __forceinline__ void convert_task(const float* src, bf16_t* dst, size_t base, int lane) {
#pragma unroll
    for (int it = 0; it < 8; ++it) { const size_t i = base + (size_t)it * 512 + lane * 8;
        const f32x4 a = *(const f32x4*)(src + i), b = *(const f32x4*)(src + i + 4);
        u32x4 o; o.x = pk2(a[0], a[1]); o.y = pk2(a[2], a[3]); o.z = pk2(b[0], b[1]); o.w = pk2(b[2], b[3]);
        *(u32x4*)(dst + i) = o; }
}
__device__ __forceinline__ void fp8_rows_task(const float* src, unsigned char* dst, unsigned char* sinv, size_t row0, int lane) {
#pragma unroll 2
    for (int r = 0; r < 8; ++r) { const size_t row = row0 + r;
        f32x4 v[4]; float am = 0.f;
#pragma unroll
        for (int j = 0; j < 4; ++j) { v[j] = *(const f32x4*)(src + row * 1024 + 16 * lane + 4 * j);
            am = fmaxf(am, fmaxf(fmaxf(fabsf(v[j].x), fabsf(v[j].y)), fmaxf(fabsf(v[j].z), fabsf(v[j].w)))); }
#pragma unroll
        for (int o = 1; o < 64; o <<= 1) am = fmaxf(am, __shfl_xor(am, o));
        unsigned be = (__float_as_uint(am) >> 23) & 0xffu; be = be < 8u ? 8u : be;
        const float sc = __uint_as_float((261u - be) << 23);
        u32x4 w;
#pragma unroll
        for (int j = 0; j < 4; ++j) { int pk = 0;
            pk = __builtin_amdgcn_cvt_pk_fp8_f32(v[j].x * sc, v[j].y * sc, pk, false);
            pk = __builtin_amdgcn_cvt_pk_fp8_f32(v[j].z * sc, v[j].w * sc, pk, true);
            w[j] = (unsigned)pk; }
        const size_t l = row / NEXP, e = row % NEXP;
        *(u32x4*)(dst + (((l * 8 + (size_t)(lane >> 3)) * NEXP + e) * 128) + 16 * (lane & 7)) = w;
        if (lane == 0) sinv[row] = (unsigned char)(be - 7u); }
}
__device__ __forceinline__ void table_task(const Ctx& C, int t) {
    CArgs& a = *C.a; unsigned char* ws = a.ws;
    if (t < 4096) fp8_rows_task(a.in[I_PU], ws + WS_TU, ws + WS_SIU, (size_t)t * 8, C.lane);
    else fp8_rows_task(a.in[I_PV], ws + WS_TV, ws + WS_SIV, (size_t)(t - 4096) * 8, C.lane);
}
__device__ __forceinline__ void phaseA(const Ctx& C) {
    CArgs& a = *C.a; unsigned char* ws = a.ws;
    LAS float* S = (LAS float*)C.lds;
    for (int i = C.tid; i < 9 * 1024; i += 512) { const int row = i >> 10, k = i & 1023; const float c = row < 8 ? a.in[I_C][row * 1024 + k] : a.in[I_CCTX][k]; S[i] = c / (1.f + __expf(-c)); }
    __syncthreads();
    LAS float* scr = (LAS float*)(C.lds + 40960 + C.wid * 8448);
    const int gw = C.wid * C.G + C.bid, NGW = C.G * 8;
    constexpr int T_ADA = 1536, T_W1 = 16 * 80, T_W2 = 16 * 32, T_SI = 16 * 64, T_SO = 16 * 32, T_WQ = 2 * 16 * 64;
    constexpr int T_KEYS = 2 * 8 * 2 * 128 * 128 / 4096, T_WSP = 8 * 128 * 128 / 4096;
    constexpr int NT = T_ADA + T_W1 + T_W2 + T_SI + T_SO + T_WQ + T_KEYS + T_WSP;
    float* modp = (float*)(ws + WS_MODP);
    for (int T = gw; T < NT; T += NGW) {
        int t = T;
        if (t < T_ADA) {
            const int l = t / 768, r = t % 768, cb = r >> 3, ks = r & 7;
            const int kg = C.lane >> 4, c4 = 4 * (C.lane & 15);
            const float* W = a.in[I_ADAW] + (size_t)l * 1024 * 6144 + (size_t)(ks * 128 + kg) * 6144 + cb * 64 + c4;
            f32x4 acc[9];
#pragma unroll
            for (int q = 0; q < 9; ++q) acc[q] = (f32x4){0.f, 0.f, 0.f, 0.f};
#pragma unroll 1
            for (int k0 = 0; k0 < 128; k0 += 32) {
                f32x4 w[8];
#pragma unroll
                for (int i = 0; i < 8; ++i) w[i] = *(const f32x4*)(W + (size_t)(k0 + 4 * i) * 6144);
#pragma unroll
                for (int i = 0; i < 8; ++i)
#pragma unroll
                    for (int q = 0; q < 9; ++q) acc[q] += S[q * 1024 + ks * 128 + k0 + 4 * i + kg] * w[i];
            }
#pragma unroll
            for (int q = 0; q < 9; ++q)
#pragma unroll
                for (int e = 0; e < 4; ++e) { float v = acc[q][e]; v += __shfl_xor(v, 16); v += __shfl_xor(v, 32); acc[q][e] = v; }
            if (C.lane < 16) { float* P = modp + ((size_t)(l * 8 + ks) * 9) * 6144 + cb * 64 + c4;
#pragma unroll
                for (int q = 0; q < 9; ++q) *(f32x4*)(P + (size_t)q * 6144) = acc[q]; }
            continue;
        }
        t -= T_ADA;
        if (t < T_W1) { transpose_item(a.in[I_WIN], 1024, 2560, (bf16_t*)(ws + WS_W1T), t, scr, C.lane, 3); continue; } t -= T_W1;
        if (t < T_W2) { transpose_item(a.in[I_WOUT], 1024, 1024, (bf16_t*)(ws + WS_W2T), t, scr, C.lane, 2); continue; } t -= T_W2;
        if (t < T_SI) { transpose_item(a.in[I_SGUIN], 1024, 2048, (bf16_t*)(ws + WS_WSI), t, scr, C.lane, 2); continue; } t -= T_SI;
        if (t < T_SO) { transpose_item(a.in[I_SGUOUT], 1024, 1024, (bf16_t*)(ws + WS_WSO), t, scr, C.lane, 2); continue; } t -= T_SO;
        if (t < T_WQ) { const int l = t / 1024; transpose_item(a.in[I_WQ] + (size_t)l * 1024 * 2048, 1024, 2048, (bf16_t*)(ws + WS_WQ + (size_t)l * 2048 * 1024 * (WQ_FP8 ? 1 : 2)), t % 1024, scr, C.lane, WQ_FP8 ? 2 : 0); continue; } t -= T_WQ;
        if (t < T_KEYS) { convert_task(a.in[I_KEYS], (bf16_t*)(ws + WS_KEYS), (size_t)t * 4096, C.lane); continue; } t -= T_KEYS;
        convert_task(a.in[I_WS], (bf16_t*)(ws + WS_WSP), (size_t)t * 4096, C.lane);
    }
}

template <int NR>
__device__ __forceinline__ void rows_load(f32x4 (&v)[NR][4], const float* xrow0, int lane) {
#pragma unroll
    for (int r = 0; r < NR; ++r)
#pragma unroll
        for (int j = 0; j < 4; ++j) v[r][j] = *((const f32x4*)(xrow0 + (size_t)r * D) + lane + 64 * j);
}
template <int NR>
__device__ __forceinline__ void rows_finish(const f32x4 (&v)[NR][4], bf16_t* orow0, const LAS float* GS, const LAS float* SH, int lane) {
#pragma unroll
    for (int r = 0; r < NR; ++r) {
        float s = 0.f;
#pragma unroll
        for (int j = 0; j < 4; ++j) s += (v[r][j].x * v[r][j].x + v[r][j].y * v[r][j].y) + (v[r][j].z * v[r][j].z + v[r][j].w * v[r][j].w);
        const float rinv = rsqrtf(wave_sum(s) * (1.f / D) + EPS);
        unsigned* o8 = (unsigned*)((unsigned char*)orow0 + (size_t)r * D) + lane;
#pragma unroll
        for (int j = 0; j < 4; ++j) { const f32x4 g = *(const LAS f32x4*)(GS + 4 * lane + 256 * j), h = *(const LAS f32x4*)(SH + 4 * lane + 256 * j);
            const f32x4 y = v[r][j] * rinv * g + h;
            o8[64 * j] = pk4_fp8(y.x, y.y, y.z, y.w); }
    }
}
template <int NR>
__device__ __forceinline__ void modulate_rows(const float* xrow0, bf16_t* orow0, const LAS float* GS, const LAS float* SH, int lane) {
    f32x4 v[NR][4];
    rows_load<NR>(v, xrow0, lane);
    rows_finish<NR>(v, orow0, GS, SH, lane);
}

template <int NR, bool OUT8, bool ALSO8 = false>
__device__ __forceinline__ void modulate_rows_h(const bf16_t* hrow0, void* orow0v, const LAS float* GS, const LAS float* SH, int lane, unsigned char* also8 = nullptr) {
    u32x4 v[NR][2];
#pragma unroll
    for (int r = 0; r < NR; ++r)
#pragma unroll
        for (int j = 0; j < 2; ++j) v[r][j] = *(const u32x4*)(hrow0 + (size_t)r * D + 512 * j + 8 * lane);
#pragma unroll
    for (int r = 0; r < NR; ++r) {
        float x[16]; float s = 0.f;
#pragma unroll
        for (int j = 0; j < 2; ++j)
#pragma unroll
            for (int e = 0; e < 4; ++e) { x[8 * j + 2 * e] = bf_lo(v[r][j][e]); x[8 * j + 2 * e + 1] = bf_hi(v[r][j][e]); }
#pragma unroll
        for (int e = 0; e < 16; ++e) s += x[e] * x[e];
        const float rinv = rsqrtf(wave_sum(s) * (1.f / D) + EPS);
#pragma unroll
        for (int j = 0; j < 2; ++j) { float y[8];
#pragma unroll
            for (int q = 0; q < 2; ++q) { const f32x4 g = *(const LAS f32x4*)(GS + 512 * j + 8 * lane + 4 * q), h = *(const LAS f32x4*)(SH + 512 * j + 8 * lane + 4 * q);
#pragma unroll
                for (int e = 0; e < 4; ++e) y[4 * q + e] = x[8 * j + 4 * q + e] * rinv * g[e] + h[e]; }
            if (OUT8) { u32x2 w; w.x = pk4_fp8(y[0], y[1], y[2], y[3]); w.y = pk4_fp8(y[4], y[5], y[6], y[7]);
                *(u32x2*)((unsigned char*)orow0v + (size_t)r * D + 512 * j + 8 * lane) = w; }
            else { u32x4 w; w.x = pk2(y[0], y[1]); w.y = pk2(y[2], y[3]); w.z = pk2(y[4], y[5]); w.w = pk2(y[6], y[7]);
                *(u32x4*)((bf16_t*)orow0v + (size_t)r * D + 512 * j + 8 * lane) = w; }
            if (ALSO8) { u32x2 w; w.x = pk4_fp8(y[0], y[1], y[2], y[3]); w.y = pk4_fp8(y[4], y[5], y[6], y[7]);
                *(u32x2*)(also8 + (size_t)r * D + 512 * j + 8 * lane) = w; } }
    }
}

__device__ __forceinline__ void phaseB(const Ctx& C) {
    CArgs& a = *C.a; unsigned char* ws = a.ws;
    const float* modp = (const float*)(ws + WS_MODP); float* modf = (float*)(ws + WS_MODF);
    {
        const int e = C.bid * 512 + C.tid;
        if (e < 2 * 9 * 6144) { const int l = e / (9 * 6144), rem = e % (9 * 6144), row = rem / 6144, j = rem % 6144;
            float v = a.in[I_ADAB][l * 6144 + j];
#pragma unroll
            for (int ks = 0; ks < 8; ++ks) v += modp[((size_t)(l * 8 + ks) * 9 + row) * 6144 + j];
            modf[e] = v; }
    }
    LAS float* GS = (LAS float*)C.lds; LAS float* SH = GS + 1024;
    bf16_t* A = (bf16_t*)(ws + WS_A);
    for (int part = 0; part < 2; ++part) {
        const int rb = part == 0 ? (C.bid * 128) / SEQ : 8;
        __syncthreads();
        for (int c = C.tid; c < 1024; c += 512) {
            float sh = a.in[I_ADAB][c], sc = a.in[I_ADAB][1024 + c];
#pragma unroll
            for (int ks = 0; ks < 8; ++ks) { sh += modp[((size_t)(0 * 8 + ks) * 9 + rb) * 6144 + c]; sc += modp[((size_t)(0 * 8 + ks) * 9 + rb) * 6144 + 1024 + c]; }
            GS[c] = a.in[I_N1G][c] * (1.f + sc); SH[c] = sh;
        }
        __syncthreads();
        unsigned char* A8 = ws + WS_A8;
        if (part == 0) {
            const int r0 = C.bid * 128 + C.wid * 16; const float* X = a.in[I_X] + (size_t)r0 * D; unsigned char* O = A8 + (size_t)r0 * D;
            f32x4 va[4][4], vb[4][4];
            rows_load<4>(va, X, C.lane);
            rows_load<4>(vb, X + 4 * D, C.lane);   rows_finish<4>(va, (bf16_t*)O, GS, SH, C.lane);
            rows_load<4>(va, X + 8 * D, C.lane);   rows_finish<4>(vb, (bf16_t*)(O + 4 * D), GS, SH, C.lane);
            rows_load<4>(vb, X + 12 * D, C.lane);  rows_finish<4>(va, (bf16_t*)(O + 8 * D), GS, SH, C.lane);
            rows_finish<4>(vb, (bf16_t*)(O + 12 * D), GS, SH, C.lane); }
        else { const int r = C.bid * 8 + C.wid; modulate_rows<1>(a.in[I_CTX] + (size_t)r * D, (bf16_t*)(A8 + (size_t)(M + r) * D), GS, SH, C.lane); }
    }
}

__device__ __forceinline__ void conv_tile(const Ctx& C, int tile) {
    CArgs& a = *C.a; unsigned char* ws = a.ws;
    const bf16_t* GLU = (const bf16_t*)(ws + WS_GLU); unsigned char* Y8 = ws + WS_A8;
    const int b = tile >> 6, t0 = (tile & 63) * 64;
    __syncthreads();
    for (int i = C.tid; i < 94 * 64; i += 512) { const int row = i >> 6, ch = i & 63, t = t0 - 15 + row;
        u32x4 v = (u32x4){0u, 0u, 0u, 0u};
        if (t >= 0 && t < SEQ) v = *(const u32x4*)(GLU + ((size_t)(b * SEQ + t)) * 512 + ch * 8);
        *(LAS u32x4*)(C.lds + (size_t)i * 16) = v; }
    __syncthreads();
    const int half = C.tid >> 8, cp = C.tid & 255;
    float w0[31], w1[31];
#pragma unroll
    for (int j = 0; j < 31; ++j) { const f32x2 w = *(const f32x2*)(a.in[I_CONVW] + j * 512 + 2 * cp); w0[j] = w.x; w1[j] = w.y; }
    const f32x2 cb = *(const f32x2*)(a.in[I_CONVB] + 2 * cp), gg = *(const f32x2*)(a.in[I_GNG] + 2 * cp), gb = *(const f32x2*)(a.in[I_GNB] + 2 * cp);
    const LAS unsigned* L = (const LAS unsigned*)C.lds;
#pragma unroll 1
    for (int sb = 0; sb < 4; ++sb) {
        const int ob = 32 * half + 8 * sb;
        float a0[8], a1[8], x0[38], x1[38];
#pragma unroll
        for (int i = 0; i < 38; ++i) { const unsigned u = L[(ob + i) * 256 + cp]; x0[i] = bf_lo(u); x1[i] = bf_hi(u); }
#pragma unroll
        for (int o = 0; o < 8; ++o) { float s0 = cb.x, s1 = cb.y;
#pragma unroll
            for (int j = 0; j < 31; ++j) { s0 += w0[j] * x0[o + j]; s1 += w1[j] * x1[o + j]; }
            a0[o] = s0; a1[o] = s1; }
#pragma unroll
        for (int o = 0; o < 8; ++o) {
            const float s = sum32(a0[o] + a1[o]);
            const float mu = s * (1.f / 64.f), d0 = a0[o] - mu, d1 = a1[o] - mu;
            const float q = sum32(d0 * d0 + d1 * d1);
            const float rstd = rsqrtf(q * (1.f / 64.f) + EPS);
            const float y0 = d0 * rstd * gg.x + gb.x, y1 = d1 * rstd * gg.y + gb.y;
            *(unsigned short*)(Y8 + ((size_t)(b * SEQ + t0 + ob + o)) * D + 2 * cp) = (unsigned short)(pk4_fp8(y0 * sigmoidf_(y0), y1 * sigmoidf_(y1), 0.f, 0.f) & 0xffffu);
        }
    }
}

template <bool WIN>
__device__ __forceinline__ void att_softmax(f32x16& S, float& mrun, float& lrun, f32x16& O0, f32x16& O1, bf16x8 (&pb)[2], int W, const LAS float* bp) {
    if (WIN) {
        float bias[16];
#pragma unroll
        for (int e = 0; e < 16; ++e) bias[e] = bp[(e & 3) + 8 * (e >> 2)];
#pragma unroll
        for (int e = 0; e < 16; ++e) asm volatile("" : "+v"(bias[e]));
#pragma unroll
        for (int e = 0; e < 16; ++e) { const int m = __builtin_amdgcn_sbfe(W, (e & 3) + 8 * (e >> 2), 1);
            S[e] = __int_as_float((__float_as_int(S[e] + bias[e]) & m) | (__float_as_int(-1e30f) & ~m)); }
    }
    float mt = S[0];
#pragma unroll
    for (int e = 1; e < 16; ++e) mt = fmaxf(mt, S[e]);
    mt = fmaxf(mt, __shfl_xor(mt, 32));
    const float mn = fmaxf(mrun, mt), alpha = __builtin_amdgcn_exp2f(mrun - mn);
    mrun = mn;
    float ps = 0.f; float p[16];
#pragma unroll
    for (int e = 0; e < 16; ++e) { p[e] = __builtin_amdgcn_exp2f(S[e] - mn); ps += p[e]; }
    lrun = lrun * alpha + ps;
    if (!__all(alpha == 1.f)) {
#pragma unroll
        for (int e = 0; e < 16; ++e) { O0[e] *= alpha; O1[e] *= alpha; }
    }
#pragma unroll
    for (int s2 = 0; s2 < 2; ++s2) { u32x4 w; w.x = pk2(p[8 * s2 + 0], p[8 * s2 + 1]); w.y = pk2(p[8 * s2 + 2], p[8 * s2 + 3]); w.z = pk2(p[8 * s2 + 4], p[8 * s2 + 5]); w.w = pk2(p[8 * s2 + 6], p[8 * s2 + 7]);
        pb[s2] = __builtin_bit_cast(bf16x8, w); }
}
__device__ __forceinline__ void attn_task(const Ctx& C, int task) {
    CArgs& a = *C.a; unsigned char* ws = a.ws;
    const bf16_t* Qb = (const bf16_t*)(ws + WS_Q); const bf16_t* Kb = (const bf16_t*)(ws + WS_K); const bf16_t* Vb = (const bf16_t*)(ws + WS_V);
    unsigned char* Y8 = ws + WS_A8;
    const int h = task & 7, ch = (task >> 3) & 1, rp = (task >> 4) & 31, b = task >> 9;
    const int lane = C.lane, n = lane & 31, hh = lane >> 5;
    const int krA = 2 * rp - 4 < 0 ? 0 : (2 * rp - 4 > 56 ? 56 : 2 * rp - 4), krB = 2 * rp - 3 < 0 ? 0 : (2 * rp - 3 > 56 ? 56 : 2 * rp - 3);
    const int nr = krB + 8 - krA;
    LAS unsigned char* lw = C.lds + C.wid * 14592;
    LAS unsigned char* KT = lw; LAS unsigned char* VT = lw + 5760;
    LAS float* RP = (LAS float*)(lw + 11520);
    for (int i = lane; i < 465; i += 64) RP[64 + i] = a.in[I_RPB][h * 465 + i] * 1.44269504f;
    const int rq = 2 * rp + (n >> 4), kr0q = rq - 4 < 0 ? 0 : (rq - 4 > 56 ? 56 : rq - 4);
    int qtok[2], bs[2], Wq[2]; const LAS float* bp0[2];
#pragma unroll
    for (int qb = 0; qb < 2; ++qb) {
        const int j = 2 * ch + qb, qc = 16 * j + (n & 15);
        qtok[qb] = b * SEQ + rq * 64 + qc;
        bs[qb] = 16 * j - 8 < 0 ? 0 : (16 * j - 8 > 32 ? 32 : 16 * j - 8);
        const int cs = qc - 8 < 0 ? 0 : (qc - 8 > 48 ? 48 : qc - 8);
        int tq = bs[qb] + 4 * hh - cs; tq = tq < -32 ? -32 : (tq > 31 ? 31 : tq);
        Wq[qb] = (int)(unsigned)((0xFFFFull << 32) >> (32 + tq));
        bp0[qb] = RP + 64 + (krA - rq + 7) * 31 + bs[qb] + 4 * hh - qc + 15;
    }
    bf16x8 bq[2][4];
#pragma unroll
    for (int qb = 0; qb < 2; ++qb)
#pragma unroll
        for (int s = 0; s < 4; ++s) bq[qb][s] = *(const bf16x8*)(Qb + (size_t)qtok[qb] * 512 + h * 64 + 16 * s + 8 * hh);
    f32x16 O[2][2];
#pragma unroll
    for (int i = 0; i < 2; ++i)
#pragma unroll
        for (int j = 0; j < 2; ++j)
#pragma unroll
            for (int e = 0; e < 16; ++e) O[i][j][e] = 0.f;
    float mrun[2] = {-1e30f, -1e30f}, lrun[2] = {0.f, 0.f};
    const int lk = lane >> 3, lc = lane & 7;
    const int ub = 24 * ch;
    u32x4 kq[5], vq[5];
#define ATT_FETCH(NI_, tok_) do { const size_t tb_ = (size_t)(tok_) + lk; _Pragma("unroll") for (int i = 0; i < NI_; ++i) { \
        kq[i] = *(const u32x4*)(Kb + (tb_ + 8 * i) * 512 + h * 64 + lc * 8); vq[i] = *(const u32x4*)(Vb + (tb_ + 8 * i) * 512 + h * 64 + lc * 8); } } while (0)
#define ATT_STAGE(NI_) do { _Pragma("unroll") for (int i = 0; i < NI_; ++i) { *(LAS u32x4*)(KT + (8 * i + lk) * 144 + lc * 16) = kq[i]; *(LAS u32x4*)(VT + (8 * i + lk) * 144 + lc * 16) = vq[i]; } } while (0)
    typedef short s4v __attribute__((ext_vector_type(4)));
    const LAS unsigned char* vp0 = VT + (4 * hh + ((lane & 15) >> 2)) * 144 + (16 * ((lane >> 4) & 1) + 4 * (lane & 3)) * 2;
#define ATT_VA(db_, s2_, k0_) ({ const LAS unsigned char* vp_ = vp0 + (16 * (s2_) + (k0_)) * 144 + 64 * (db_); \
        const s4v lo_ = __builtin_amdgcn_ds_read_tr16_b64_v4i16((LAS s4v*)vp_), hi_ = __builtin_amdgcn_ds_read_tr16_b64_v4i16((LAS s4v*)(vp_ + 8 * 144)); \
        (bf16x8)__builtin_shufflevector(lo_, hi_, 0, 1, 2, 3, 4, 5, 6, 7); })
    ATT_FETCH(4, M + b * CTXL);
#pragma unroll 1
    for (int kt = 0; kt < 8; ++kt) {
        ATT_STAGE(4);
        if (kt < 7) ATT_FETCH(4, M + b * CTXL + 32 * (kt + 1)); else ATT_FETCH(5, b * SEQ + krA * 64 + ub);
        bf16x8 kf[4];
#pragma unroll
        for (int s = 0; s < 4; ++s) kf[s] = *(const LAS bf16x8*)(KT + n * 144 + 32 * s + 16 * hh);
        bf16x8 pb[2][2];
#pragma unroll
        for (int qb = 0; qb < 2; ++qb) {
            f32x16 S;
#pragma unroll
            for (int e = 0; e < 16; ++e) S[e] = 0.f;
#pragma unroll
            for (int s = 0; s < 4; ++s) S = __builtin_amdgcn_mfma_f32_32x32x16_bf16(kf[s], bq[qb][s], S, 0, 0, 0);
            att_softmax<false>(S, mrun[qb], lrun[qb], O[0][qb], O[1][qb], pb[qb], 0, RP);
        }
#pragma unroll
        for (int db = 0; db < 2; ++db)
#pragma unroll
            for (int s2 = 0; s2 < 2; ++s2) { const bf16x8 va = ATT_VA(db, s2, 0);
#pragma unroll
                for (int qb = 0; qb < 2; ++qb) O[db][qb] = __builtin_amdgcn_mfma_f32_32x32x16_bf16(va, pb[qb][s2], O[db][qb], 0, 0, 0); }
    }
#pragma unroll 1
    for (int i = 0; i < nr; ++i) {
        const int W = ((unsigned)(krA + i - kr0q) < 8u) ? -1 : 0;
        ATT_STAGE(5);
        ATT_FETCH(5, b * SEQ + (krA + (i + 1 < nr ? i + 1 : i)) * 64 + ub);
#pragma unroll
        for (int qb = 0; qb < 2; ++qb) {
            bf16x8 kf[4];
#pragma unroll
            for (int s = 0; s < 4; ++s) kf[s] = *(const LAS bf16x8*)(KT + (n + 8 * qb) * 144 + 32 * s + 16 * hh);
            f32x16 S;
#pragma unroll
            for (int e = 0; e < 16; ++e) S[e] = 0.f;
#pragma unroll
            for (int s = 0; s < 4; ++s) S = __builtin_amdgcn_mfma_f32_32x32x16_bf16(kf[s], bq[qb][s], S, 0, 0, 0);
            bf16x8 pb[2];
            att_softmax<true>(S, mrun[qb], lrun[qb], O[0][qb], O[1][qb], pb, Wq[qb] & W, bp0[qb] + 31 * i);
#pragma unroll
            for (int db = 0; db < 2; ++db)
#pragma unroll
                for (int s2 = 0; s2 < 2; ++s2) { const bf16x8 va = ATT_VA(db, s2, 8 * qb); O[db][qb] = __builtin_amdgcn_mfma_f32_32x32x16_bf16(va, pb[s2], O[db][qb], 0, 0, 0); }
        }
    }
#undef ATT_FETCH
#undef ATT_STAGE
#undef ATT_VA
#pragma unroll
    for (int qb = 0; qb < 2; ++qb) {
        const float lt = lrun[qb] + __shfl_xor(lrun[qb], 32), inv = 1.f / lt;
        unsigned char* yrow = Y8 + (size_t)qtok[qb] * D + 512 + h * 64;
#pragma unroll
        for (int db = 0; db < 2; ++db)
#pragma unroll
            for (int g = 0; g < 4; ++g)
                *(unsigned*)(yrow + 32 * db + 8 * g + 4 * hh) = pk4_fp8(O[db][qb][4 * g] * inv, O[db][qb][4 * g + 1] * inv, O[db][qb][4 * g + 2] * inv, O[db][qb][4 * g + 3] * inv);
    }
}

__device__ __forceinline__ void phaseNorm2(const Ctx& C, int l) {
    CArgs& a = *C.a; unsigned char* ws = a.ws;
    const float* modf = (const float*)(ws + WS_MODF) + (size_t)l * 9 * 6144;
    LAS float* GS = (LAS float*)C.lds; LAS float* SH = GS + 1024;
    const int b = (C.bid * 128) / SEQ;
    for (int c = C.tid; c < 1024; c += 512) { GS[c] = a.in[I_N2G][l * 1024 + c] * (1.f + modf[b * 6144 + 4 * 1024 + c]); SH[c] = modf[b * 6144 + 3 * 1024 + c]; }
    __syncthreads();
    bf16_t* A = (bf16_t*)(ws + WS_A);
    const bf16_t* Hb = (const bf16_t*)(ws + WS_H);
    { const int r = C.bid * 128 + C.wid * 16; modulate_rows_h<16, false, WQ_FP8 != 0>(Hb + (size_t)r * D, A + (size_t)r * D, GS, SH, C.lane, ws + WS_A8 + (size_t)r * D); }
}

__device__ __forceinline__ void ce_desc(float& x, float& y) { const float hi = fmaxf(x, y), lo = fminf(x, y); x = hi; y = lo; }
__device__ __forceinline__ void ce_asc(float& x, float& y) { const float hi = fmaxf(x, y), lo = fminf(x, y); x = lo; y = hi; }
__device__ __forceinline__ void sort16_desc(float (&v)[16]) {
#define CE(a_, b_) ce_desc(v[a_], v[b_]);
    CE(0,13) CE(1,12) CE(2,15) CE(3,14) CE(4,8) CE(5,6) CE(7,11) CE(9,10)
    CE(0,5) CE(1,7) CE(2,9) CE(3,4) CE(6,13) CE(8,14) CE(10,15) CE(11,12)
    CE(0,1) CE(2,3) CE(4,5) CE(6,8) CE(7,9) CE(10,11) CE(12,13) CE(14,15)
    CE(0,2) CE(1,3) CE(4,10) CE(5,11) CE(6,7) CE(8,9) CE(12,14) CE(13,15)
    CE(1,2) CE(3,12) CE(4,6) CE(5,7) CE(8,10) CE(9,11) CE(13,14)
    CE(1,4) CE(2,6) CE(5,8) CE(7,10) CE(9,13) CE(11,14)
    CE(2,4) CE(3,6) CE(9,12) CE(11,13)
    CE(3,5) CE(6,8) CE(7,9) CE(10,12)
    CE(3,4) CE(5,6) CE(7,8) CE(9,10) CE(11,12)
    CE(6,7) CE(8,9)
#undef CE
}
__device__ __forceinline__ void merge16_desc(float (&A)[16], const float (&B)[16]) {
#pragma unroll
    for (int i = 0; i < 16; ++i) A[i] = fmaxf(A[i], B[15 - i]);
#pragma unroll
    for (int j = 8; j > 0; j >>= 1)
#pragma unroll
        for (int i = 0; i < 16; ++i) { const int l = i ^ j; if (l > i) ce_desc(A[i], A[l]); }
}
__device__ __forceinline__ bf16x8 topk_qfrag(const bf16_t* QP, int tok, int h, int p, int hh, int s) { return *(const bf16x8*)(QP + (size_t)tok * 2048 + h * 256 + p * 128 + 64 * hh + 8 * s); }
__device__ __forceinline__ void topk_task(const Ctx& C, int l, int tok0, int ntok0, int h, const LAS unsigned char* KL, bf16x8 (&bq)[2][8]) {
    CArgs& a = *C.a; unsigned char* ws = a.ws;
    const bf16_t* QP = (const bf16_t*)(ws + WS_QP);
    unsigned short* IDX = (unsigned short*)(ws + WS_IDX); float* WT = (float*)(ws + WS_WT);
    const int lane = C.lane, n = lane & 31, hh = lane >> 5;
    const int tok = tok0 + n;
    float sp[2][16];
#pragma unroll
    for (int p = 0; p < 2; ++p) {
        float top[16];
#pragma unroll
        for (int kb = 0; kb < 4; ++kb) {
            f32x16 S;
#pragma unroll
            for (int e = 0; e < 16; ++e) S[e] = 0.f;
#pragma unroll
            for (int s = 0; s < 8; ++s) { const bf16x8 kf = *(const LAS bf16x8*)(KL + (p * 128 + 32 * kb + n) * 272 + 128 * hh + 16 * s);
                S = __builtin_amdgcn_mfma_f32_32x32x16_bf16(kf, bq[p][s], S, 0, 0, 0); }
            if (kb == 3) {
#pragma unroll
                for (int s = 0; s < 8; ++s) bq[p][s] = topk_qfrag(QP, ntok0 + n, h, p, hh, s); }
            float ch[16];
#pragma unroll
            for (int e = 0; e < 16; ++e) { const unsigned key = 32 * kb + (e & 3) + 8 * (e >> 2) + 4 * hh; ch[e] = __uint_as_float((__float_as_uint(S[e]) & ~0x7Fu) | key); }
            sort16_desc(ch);
            if (kb == 0) {
#pragma unroll
                for (int e = 0; e < 16; ++e) top[e] = ch[e];
            } else merge16_desc(top, ch);
        }
        float oth[16];
#pragma unroll
        for (int e = 0; e < 16; ++e) oth[e] = __shfl_xor(top[e], 32);
        merge16_desc(top, oth);
#pragma unroll
        for (int e = 0; e < 16; ++e) sp[p][e] = top[e];
    }
    const float NEG = -3.0e38f;
    auto cand = [&](int ia, int ib) -> float { const float s = sp[0][ia] + sp[1][ib]; return __uint_as_float((__float_as_uint(s) & ~0xFFu) | (unsigned)((ia << 4) | ib)); };
    float L1[16], L2[16], L3[16], L4[16];
#pragma unroll
    for (int i = 0; i < 16; ++i) { L1[i] = cand(0, i); L2[i] = i < 15 ? cand(i + 1, 0) : NEG; L4[i] = NEG; }
#pragma unroll
    for (int i = 0; i < 7; ++i) L3[i] = cand(1, i + 1);
#pragma unroll
    for (int i = 0; i < 6; ++i) L3[7 + i] = cand(i + 2, 1);
#pragma unroll
    for (int i = 0; i < 3; ++i) L3[13 + i] = cand(2, i + 2);
    L4[0] = cand(3, 2); L4[1] = cand(4, 2); L4[2] = cand(3, 3);
    sort16_desc(L3);
    ce_desc(L4[0], L4[1]); ce_desc(L4[1], L4[2]); ce_desc(L4[0], L4[1]);
    merge16_desc(L1, L2); merge16_desc(L3, L4); merge16_desc(L1, L3);
    if (hh == 0) {
        float e16[16], se = 0.f;
#pragma unroll
        for (int i = 0; i < 16; ++i) { e16[i] = __expf(L1[i] - L1[0]); se += e16[i]; }
        const float inv = 1.f / se;
        LAS unsigned* tb = (LAS unsigned*)(C.lds + 69632 + C.wid * 4224) + n * 33;
#pragma unroll
        for (int i = 0; i < 16; ++i) { tb[i] = __float_as_uint(sp[0][i]) & 0x7Fu; tb[16 + i] = __float_as_uint(sp[1][i]) & 0x7Fu; }
        unsigned ids[16];
#pragma unroll
        for (int i = 0; i < 16; ++i) { const unsigned code = __float_as_uint(L1[i]) & 0xFFu; ids[i] = tb[code >> 4] * 128u + tb[16 + (code & 15u)]; }
        float su[16], sv[16];
        { const LAS unsigned char* SEU = C.lds + 103424; const LAS unsigned char* SEV = SEU + NEXP;
#pragma unroll
          for (int i = 0; i < 16; ++i) { su[i] = __uint_as_float((unsigned)SEU[ids[i]] << 23); sv[i] = __uint_as_float((unsigned)SEV[ids[i]] << 23); } }
        u32x4 w0, w1;
        w0.x = ids[0] | (ids[1] << 16); w0.y = ids[2] | (ids[3] << 16); w0.z = ids[4] | (ids[5] << 16); w0.w = ids[6] | (ids[7] << 16);
        w1.x = ids[8] | (ids[9] << 16); w1.y = ids[10] | (ids[11] << 16); w1.z = ids[12] | (ids[13] << 16); w1.w = ids[14] | (ids[15] << 16);
        u32x4* ip = (u32x4*)(IDX + (size_t)tok * 128 + h * 16); ip[0] = w0; ip[1] = w1;
        f32x4* wp = (f32x4*)(WT + (size_t)tok * 128 + h * 16);
        f32x4* sp4 = (f32x4*)((float*)(ws + WS_SU) + (size_t)tok * 128 + h * 16);
#pragma unroll
        for (int i = 0; i < 4; ++i) { wp[i] = (f32x4){e16[4 * i] * inv * sv[4 * i], e16[4 * i + 1] * inv * sv[4 * i + 1], e16[4 * i + 2] * inv * sv[4 * i + 2], e16[4 * i + 3] * inv * sv[4 * i + 3]};
            sp4[i] = (f32x4){su[4 * i], su[4 * i + 1], su[4 * i + 2], su[4 * i + 3]}; }
    }
}
__device__ __forceinline__ void phaseTopk(const Ctx& C, int l) {
    CArgs& a = *C.a; unsigned char* ws = a.ws;
    const int h = C.bid & 7, grp = C.bid >> 3;
    const bf16_t* src = (const bf16_t*)(ws + WS_KEYS) + (size_t)((l * 8 + h) * 2) * 128 * 128;
    for (int i = C.tid; i < 2 * 128 * 16; i += 512) { const int row = i >> 4, chunk = i & 15; *(LAS u32x4*)(C.lds + row * 272 + chunk * 16) = *(const u32x4*)(src + (size_t)row * 128 + chunk * 8); }
    for (int i = C.tid; i < 2048; i += 512) *(LAS u32x4*)(C.lds + 103424 + i * 16) = *(const u32x4*)(ws + (i < 1024 ? WS_SIU : WS_SIV) + (size_t)l * NEXP + (size_t)(i & 1023) * 16);
    __syncthreads();
    bf16x8 bq[2][8];
    { const bf16_t* QP = (const bf16_t*)(ws + WS_QP); const int n = C.lane & 31, hh = C.lane >> 5;
#pragma unroll
      for (int p = 0; p < 2; ++p)
#pragma unroll
          for (int s = 0; s < 8; ++s) bq[p][s] = topk_qfrag(QP, grp * 1024 + C.wid * 32 + n, h, p, hh, s); }
#pragma unroll 1
    for (int t = C.wid; t < 32; t += 8) topk_task(C, l, grp * 1024 + t * 32, grp * 1024 + (t + 8 < 32 ? t + 8 : t) * 32, h, C.lds, bq);
}

__device__ __forceinline__ int peer_dequeue(const Ctx& C, unsigned* q, int js) {
    volatile LAS unsigned* slot = (volatile LAS unsigned*)(C.lds + MISC_OFF + 64);
    __syncthreads();
    if (C.tid == 0) *slot = __hip_atomic_fetch_add(q + js, 1u, __ATOMIC_RELAXED, __HIP_MEMORY_SCOPE_AGENT);
    __syncthreads();
    return (int)*slot;
}
__device__ __forceinline__ float dot16_fp8(const u32x4 (&xf)[2], const u32x4 uw) {
    float d = 0.f;
#pragma unroll
    for (int q = 0; q < 4; ++q) { const unsigned w = uw[q];
        const bf2v lo = __builtin_amdgcn_cvt_scalef32_pk_bf16_fp8(w, 1.0f, false), hi = __builtin_amdgcn_cvt_scalef32_pk_bf16_fp8(w, 1.0f, true);
        const unsigned x0 = xf[q >> 1][2 * (q & 1)], x1 = xf[q >> 1][2 * (q & 1) + 1];
        d = __builtin_amdgcn_fdot2_f32_bf16(__builtin_bit_cast(bf2v, x0), lo, d, false);
        d = __builtin_amdgcn_fdot2_f32_bf16(__builtin_bit_cast(bf2v, x1), hi, d, false); }
    return d;
}
__device__ __forceinline__ void peerU_item(const Ctx& C, int l, int js, int tile) {
    CArgs& a = *C.a; unsigned char* ws = a.ws;
    const bf16_t* A = (const bf16_t*)(ws + WS_A); const unsigned short* IDX = (const unsigned short*)(ws + WS_IDX);
    const unsigned char* TUs = ws + WS_TU + ((size_t)(l * 8 + js) * NEXP) * 128;
    bf16_t* PD = (bf16_t*)(ws + WS_PD) + (size_t)js * M * 128;
    const int lane = C.lane, g = lane >> 3, c = lane & 7;
    LAS unsigned char* lw = C.lds + C.wid * 6144;
#pragma unroll 1
    for (int half = 0; half < 2; ++half) {
        const int tok0 = tile * 128 + C.wid * 16 + half * 8;
        { const u32x4 t0 = *(const u32x4*)((const unsigned char*)(IDX + (size_t)tok0 * 128) + lane * 16), t1 = *(const u32x4*)((const unsigned char*)(IDX + (size_t)tok0 * 128) + (lane + 64) * 16);
          *(LAS u32x4*)(lw + lane * 16) = t0; *(LAS u32x4*)(lw + (lane + 64) * 16) = t1; }
        u32x4 xf[2];
#pragma unroll
        for (int j = 0; j < 2; ++j) xf[j] = *(const u32x4*)(A + (size_t)(tok0 + g) * D + 128 * js + 16 * c + 8 * j);
        bf16_t* prow = PD + (size_t)(tok0 + g) * 128 + 2 * c;
#pragma unroll 1
        for (int kk = 0; kk < 8; ++kk) {
            const u32x4 i0 = *(const LAS u32x4*)(lw + g * 256 + kk * 32), i1 = *(const LAS u32x4*)(lw + g * 256 + kk * 32 + 16);
            u32x4 uf[16];
#pragma unroll
            for (int b = 0; b < 16; ++b) { const unsigned w = b < 8 ? i0[b >> 1] : i1[(b - 8) >> 1]; const unsigned e = (b & 1) ? (w >> 16) : (w & 0xffffu);
                uf[b] = *(const u32x4*)(TUs + (e * 128u + 16u * (unsigned)c)); }
            float v0 = 0.f, v1 = 0.f;
#pragma unroll
            for (int b = 0; b < 16; ++b) { const float d = sum8(dot16_fp8(xf, uf[b]));
                if (b & 1) v1 = (c == (b >> 1)) ? d : v1; else v0 = (c == (b >> 1)) ? d : v0; }
            *(unsigned*)(prow + 16 * kk) = pk2(v0, v1);
        }
    }
}
__device__ __forceinline__ void phasePeerCombine(const Ctx& C) {
    CArgs& a = *C.a; unsigned char* ws = a.ws;
    const u32x2* PD = (const u32x2*)(ws + WS_PD); f32x4* WT = (f32x4*)(ws + WS_WT); const f32x4* SU = (const f32x4*)(ws + WS_SU);
    const size_t n4 = (size_t)M * 128 / 4;
    const size_t stride = (size_t)C.G * 512;
#pragma unroll 1
    for (size_t i = (size_t)C.bid * 512 + C.tid; i < n4; i += 4 * stride) {
        u32x2 w[4][8]; f32x4 su[4], wt[4];
#pragma unroll
        for (int t = 0; t < 4; ++t) {
#pragma unroll
            for (int j = 0; j < 8; ++j) w[t][j] = PD[(size_t)j * n4 + i + t * stride];
            su[t] = SU[i + t * stride]; wt[t] = WT[i + t * stride]; }
#pragma unroll
        for (int t = 0; t < 4; ++t) {
            f32x4 d = (f32x4){0.f, 0.f, 0.f, 0.f};
#pragma unroll
            for (int j = 0; j < 8; ++j) d += (f32x4){bf_lo(w[t][j].x), bf_hi(w[t][j].x), bf_lo(w[t][j].y), bf_hi(w[t][j].y)};
            f32x4 o;
#pragma unroll
            for (int e = 0; e < 4; ++e) o[e] = gelu_erf(d[e] * su[t][e]) * wt[t][e];
            WT[i + t * stride] = o; }
    }
}
__device__ __forceinline__ void peerV_item(const Ctx& C, int l, int js, int tile) {
    CArgs& a = *C.a; unsigned char* ws = a.ws;
    const unsigned short* IDX = (const unsigned short*)(ws + WS_IDX); const float* CF = (const float*)(ws + WS_WT);
    const unsigned char* TVs = ws + WS_TV + ((size_t)(l * 8 + js) * NEXP) * 128;
    const int lane = C.lane, g = lane >> 3, c = lane & 7;
    const int bt = (tile * 128) / SEQ;
    const float* g5p = (const float*)(ws + WS_MODF) + (size_t)l * 9 * 6144 + bt * 6144 + 5 * 1024 + 128 * js + 16 * c;
    f32x4 g5[4];
#pragma unroll
    for (int q = 0; q < 4; ++q) g5[q] = *(const f32x4*)(g5p + 4 * q);
    LAS unsigned char* lw = C.lds + C.wid * 6144;
#pragma unroll 1
    for (int half = 0; half < 2; ++half) {
        const int tok0 = tile * 128 + C.wid * 16 + half * 8;
        { const u32x4 t0 = *(const u32x4*)((const unsigned char*)(IDX + (size_t)tok0 * 128) + lane * 16), t1 = *(const u32x4*)((const unsigned char*)(IDX + (size_t)tok0 * 128) + (lane + 64) * 16);
          u32x4 cfv[4];
#pragma unroll
          for (int j = 0; j < 4; ++j) cfv[j] = *(const u32x4*)((const unsigned char*)(CF + (size_t)tok0 * 128) + (lane + 64 * j) * 16);
          *(LAS u32x4*)(lw + lane * 16) = t0; *(LAS u32x4*)(lw + (lane + 64) * 16) = t1;
#pragma unroll
          for (int j = 0; j < 4; ++j) *(LAS u32x4*)(lw + 2048 + (lane + 64 * j) * 16) = cfv[j]; }
        float acc[16];
#pragma unroll
        for (int e = 0; e < 16; ++e) acc[e] = 0.f;
#pragma unroll 1
        for (int kk = 0; kk < 8; ++kk) {
            const u32x4 i0 = *(const LAS u32x4*)(lw + g * 256 + kk * 32), i1 = *(const LAS u32x4*)(lw + g * 256 + kk * 32 + 16);
            u32x4 vf[16];
#pragma unroll
            for (int b = 0; b < 16; ++b) { const unsigned w = b < 8 ? i0[b >> 1] : i1[(b - 8) >> 1]; const unsigned e = (b & 1) ? (w >> 16) : (w & 0xffffu);
                vf[b] = *(const u32x4*)(TVs + (e * 128u + 16u * (unsigned)c)); }
            f32x4 cf[4];
#pragma unroll
            for (int q = 0; q < 4; ++q) cf[q] = *(const LAS f32x4*)(lw + 2048 + g * 512 + kk * 64 + 16 * q);
#pragma unroll
            for (int b = 0; b < 16; ++b) { const float ck = cf[b >> 2][b & 3];
#pragma unroll
                for (int q = 0; q < 4; ++q) { const unsigned vw = vf[b][q];
                    const f32x2 lo = __builtin_amdgcn_cvt_pk_f32_fp8(vw, false), hi = __builtin_amdgcn_cvt_pk_f32_fp8(vw, true);
                    acc[4 * q] += ck * lo.x; acc[4 * q + 1] += ck * lo.y; acc[4 * q + 2] += ck * hi.x; acc[4 * q + 3] += ck * hi.y; } }
        }
        bf16_t* hp = (bf16_t*)(ws + WS_H) + (size_t)(tok0 + g) * D + 128 * js + 16 * c;
        const u32x4 h0 = *(const u32x4*)hp, h1 = *(const u32x4*)(hp + 8);
        u32x4 o0, o1;
#pragma unroll
        for (int e = 0; e < 4; ++e) { o0[e] = pk2(bf_lo(h0[e]) + g5[e >> 1][2 * (e & 1)] * acc[2 * e], bf_hi(h0[e]) + g5[e >> 1][2 * (e & 1) + 1] * acc[2 * e + 1]);
                                      o1[e] = pk2(bf_lo(h1[e]) + g5[2 + (e >> 1)][2 * (e & 1)] * acc[8 + 2 * e], bf_hi(h1[e]) + g5[2 + (e >> 1)][2 * (e & 1) + 1] * acc[8 + 2 * e + 1]); }
        *(u32x4*)hp = o0; *(u32x4*)(hp + 8) = o1;
    }
}
template <int WHICH> __device__ __forceinline__ void phasePeerSliced(const Ctx& C, int l) {
    const int xcc = (int)(xb_xcc_id() & 7u);
    unsigned* q = (unsigned*)(C.a->ws + WS_CTL) + 8192 + 16 * (2 * l + WHICH);
    volatile LAS unsigned* slot = (volatile LAS unsigned*)(C.lds + MISC_OFF + 64);
#pragma unroll 1
    for (int at = 0; at < 8; ++at) { const int js = (xcc + at) & 7;
        int tile = peer_dequeue(C, q, js);
#pragma unroll 1
        while (tile < M / 128) {
            unsigned nxt = 0u;
            if (C.tid == 0) nxt = __hip_atomic_fetch_add(q + js, 1u, __ATOMIC_RELAXED, __HIP_MEMORY_SCOPE_AGENT);
            if (WHICH == 0) peerU_item(C, l, js, tile); else peerV_item(C, l, js, tile);
            __syncthreads();
            if (C.tid == 0) *slot = nxt;
            __syncthreads();
            tile = (int)*slot;
        } }
}
__device__ __forceinline__ void phasePeerNorm(const Ctx& C, int l) {
    CArgs& a = *C.a; unsigned char* ws = a.ws;
    if (l == 0) {
        const float* modf = (const float*)(ws + WS_MODF) + (size_t)9 * 6144;
        LAS float* GS = (LAS float*)C.lds; LAS float* SH = GS + 1024;
        const int b = (C.bid * 128) / SEQ;
        for (int c = C.tid; c < 1024; c += 512) { GS[c] = a.in[I_N1G][1024 + c] * (1.f + modf[b * 6144 + 1024 + c]); SH[c] = modf[b * 6144 + c]; }
        __syncthreads();
        unsigned char* A8 = ws + WS_A8;
        const bf16_t* Hb = (const bf16_t*)(ws + WS_H);
        { const int r = C.bid * 128 + C.wid * 16; modulate_rows_h<16, true>(Hb + (size_t)r * D, A8 + (size_t)r * D, GS, SH, C.lane); }
    } else {
        const bf16_t* Hb = (const bf16_t*)(ws + WS_H);
        { const int r0 = C.bid * 128 + C.wid * 16;
            u32x4 v[16][2];
#pragma unroll
            for (int r = 0; r < 16; ++r)
#pragma unroll
                for (int j = 0; j < 2; ++j) v[r][j] = *(const u32x4*)(Hb + (size_t)(r0 + r) * D + 512 * j + 8 * C.lane);
#pragma unroll
            for (int r = 0; r < 16; ++r) { float x[16]; float s = 0.f;
#pragma unroll
                for (int j = 0; j < 2; ++j)
#pragma unroll
                    for (int e = 0; e < 4; ++e) { x[8 * j + 2 * e] = bf_lo(v[r][j][e]); x[8 * j + 2 * e + 1] = bf_hi(v[r][j][e]); }
#pragma unroll
                for (int e = 0; e < 16; ++e) s += x[e] * x[e];
                const float rinv = rsqrtf(wave_sum(s) * (1.f / D) + EPS);
#pragma unroll
                for (int j = 0; j < 2; ++j)
#pragma unroll
                    for (int q = 0; q < 2; ++q) { const f32x4 gg = *(const f32x4*)(a.in[I_NFG] + 512 * j + 8 * C.lane + 4 * q);
                        *(f32x4*)(a.out + (size_t)(r0 + r) * D + 512 * j + 8 * C.lane + 4 * q) = (f32x4){x[8 * j + 4 * q] * rinv * gg[0], x[8 * j + 4 * q + 1] * rinv * gg[1], x[8 * j + 4 * q + 2] * rinv * gg[2], x[8 * j + 4 * q + 3] * rinv * gg[3]}; } } }
    }
}

__device__ __forceinline__ void phaseSgu(const Ctx& C) {
    CArgs& a = *C.a; unsigned char* ws = a.ws;
    const bf16_t* U = (const bf16_t*)(ws + WS_U); const bf16_t* VV = (const bf16_t*)(ws + WS_VV); const bf16_t* WSP = (const bf16_t*)(ws + WS_WSP);
    unsigned char* A8 = ws + WS_A8;
    LAS float* ST = (LAS float*)(C.lds + 69632);
    LAS bf16_t* VT = (LAS bf16_t*)C.lds;
    const int lane = C.lane, n = lane & 31, hh = lane >> 5;
    LAS float* LG = (LAS float*)(C.lds + 70656); LAS float* LB = LG + 1024;
    LAS unsigned char* WL = C.lds + 78848;
    for (int c = C.tid; c < 1024; c += 512) { LG[c] = a.in[I_LNG][c]; LB[c] = a.in[I_LNB][c]; }
    for (int chunk = C.bid; chunk < M / 128; chunk += C.G) {
        const int tok0 = chunk * 128;
        __syncthreads();
        for (int ib = 0; ib < 16; ib += 8) {
            u32x4 vv0[8], vv1[8];
#pragma unroll
            for (int i = 0; i < 8; ++i) { const int q = C.wid * 16 + ib + i;
                vv0[i] = *(const u32x4*)(VV + (size_t)(tok0 + q) * D + 8 * lane); vv1[i] = *(const u32x4*)(VV + (size_t)(tok0 + q) * D + 512 + 8 * lane); }
#pragma unroll
            for (int i = 0; i < 8; ++i) { const int q = C.wid * 16 + ib + i;
                float x[16];
#pragma unroll
                for (int e = 0; e < 4; ++e) { x[2 * e] = bf_lo(vv0[i][e]); x[2 * e + 1] = bf_hi(vv0[i][e]); x[8 + 2 * e] = bf_lo(vv1[i][e]); x[8 + 2 * e + 1] = bf_hi(vv1[i][e]); }
                float s = 0.f;
#pragma unroll
                for (int e = 0; e < 16; ++e) s += x[e];
                const float mu = wave_sum(s) * (1.f / D); float qq = 0.f;
#pragma unroll
                for (int e = 0; e < 16; ++e) { const float d = x[e] - mu; qq += d * d; }
                const float rstd = rsqrtf(wave_sum(qq) * (1.f / D) + EPS);
                if (lane == 0) { ST[2 * q] = mu; ST[2 * q + 1] = rstd; } }
        }
        __syncthreads();
#pragma unroll 1
        for (int g = 0; g < 8; ++g) {
            LAS bf16_t* VTg = VT + (g & 1) * (128 * 136);
            const int cb = C.tid & 15, q0 = C.tid >> 4;
            const int cbk = C.wid & 3;
            u32x4 vreg[4], ureg[4]; float bsr[4];
#pragma unroll
            for (int i = 0; i < 4; ++i) vreg[i] = *(const u32x4*)(VV + (size_t)(tok0 + q0 + 32 * i) * D + g * 128 + cb * 8);
#pragma unroll
            for (int i = 0; i < 4; ++i) { ureg[i] = *(const u32x4*)(U + (size_t)(tok0 + q0 + 32 * i) * D + g * 128 + cb * 8); bsr[i] = a.in[I_BS][g * 128 + q0 + 32 * i]; }
            u32x4 wreg[4];
#pragma unroll
            for (int i = 0; i < 4; ++i) { const int id = C.tid + 512 * i; wreg[i] = *(const u32x4*)(WSP + ((size_t)g * 128 + (id >> 4)) * 128 + (id & 15) * 8); }
            f32x4 lg0 = *(const LAS f32x4*)(LG + g * 128 + cb * 8), lg1 = *(const LAS f32x4*)(LG + g * 128 + cb * 8 + 4), lb0 = *(const LAS f32x4*)(LB + g * 128 + cb * 8), lb1 = *(const LAS f32x4*)(LB + g * 128 + cb * 8 + 4);
#pragma unroll
            for (int i = 0; i < 4; ++i) { const int q = q0 + 32 * i; const float mu = ST[2 * q], rstd = ST[2 * q + 1];
                const int col = ((((q >> 3) ^ cb) & 15) << 3) | (q & 7);
#pragma unroll
                for (int e = 0; e < 4; ++e) { const int c = cb * 8 + 2 * e;
                    const float ga = e < 2 ? lg0[2 * e] : lg1[2 * e - 4], gb = e < 2 ? lg0[2 * e + 1] : lg1[2 * e - 3];
                    const float ba = e < 2 ? lb0[2 * e] : lb1[2 * e - 4], bb = e < 2 ? lb0[2 * e + 1] : lb1[2 * e - 3];
                    const float y0 = (bf_lo(vreg[i][e]) - mu) * rstd * ga + ba;
                    const float y1 = (bf_hi(vreg[i][e]) - mu) * rstd * gb + bb;
                    const unsigned w = pk2(y0, y1);
                    VTg[c * 136 + col] = (bf16_t)(w & 0xffffu); VTg[(c + 1) * 136 + col] = (bf16_t)(w >> 16); } }
#pragma unroll
            for (int i = 0; i < 4; ++i) { const int id = C.tid + 512 * i; *(LAS u32x4*)(WL + (id >> 4) * 272 + (id & 15) * 16) = wreg[i]; }
            __syncthreads();
            bf16x8 bfr[8];
#pragma unroll
            for (int s8 = 0; s8 < 8; ++s8) bfr[s8] = *(const LAS bf16x8*)(VTg + (32 * cbk + n) * 136 + ((((2 * s8 + hh) ^ ((32 * cbk + n) >> 3)) & 15) << 3));
            f32x16 S2[2];
#pragma unroll
            for (int pi = 0; pi < 2; ++pi) {
#pragma unroll
                for (int e = 0; e < 16; ++e) S2[pi][e] = 0.f;
#pragma unroll
                for (int s8 = 0; s8 < 8; ++s8) { const bf16x8 wfr = *(const LAS bf16x8*)(WL + (32 * (2 * (C.wid >> 2) + pi) + n) * 272 + 32 * s8 + 16 * hh);
                    S2[pi] = __builtin_amdgcn_mfma_f32_32x32x16_bf16(wfr, bfr[s8], S2[pi], 0, 0, 0); }
            }
            LAS unsigned char* MX = (LAS unsigned char*)(VT + ((g + 1) & 1) * (128 * 136));
#pragma unroll
            for (int pi = 0; pi < 2; ++pi) {
                const int pb = 2 * (C.wid >> 2) + pi;
#pragma unroll
                for (int e = 0; e < 16; e += 2) { const int p = 32 * pb + (e & 3) + 8 * (e >> 2) + 4 * hh;
                    const unsigned w = pk2(S2[pi][e], S2[pi][e + 1]);
                    *(LAS bf16_t*)(MX + p * 272 + (32 * cbk + n) * 2) = (bf16_t)(w & 0xffffu); *(LAS bf16_t*)(MX + (p + 1) * 272 + (32 * cbk + n) * 2) = (bf16_t)(w >> 16); }
            }
            __syncthreads();
#pragma unroll
            for (int i = 0; i < 4; ++i) { const int q = q0 + 32 * i;
                const u32x4 mx = *(const LAS u32x4*)(MX + q * 272 + cb * 16);
                float r[8];
#pragma unroll
                for (int e = 0; e < 4; ++e) { r[2 * e] = bf_lo(ureg[i][e]) * (bf_lo(mx[e]) + bsr[i]); r[2 * e + 1] = bf_hi(ureg[i][e]) * (bf_hi(mx[e]) + bsr[i]); }
                u32x2 o; o.x = pk4_fp8(r[0], r[1], r[2], r[3]); o.y = pk4_fp8(r[4], r[5], r[6], r[7]);
                *(u32x2*)(A8 + (size_t)(tok0 + q) * D + g * 128 + cb * 8) = o; }
            __syncthreads();
        }
    }
}

constexpr int NPHASES = 22;
__global__ void __launch_bounds__(512, 2) fwd_megakernel(Args args) {
    extern __shared__ __attribute__((aligned(16))) unsigned char lds_raw[];
    LAS unsigned char* lds = (LAS unsigned char*)lds_raw;
    Ctx C; C.a = (CArgs*)__builtin_amdgcn_kernarg_segment_ptr(); C.lds = lds; C.tid = threadIdx.x; C.lane = C.tid & 63; C.wid = __builtin_amdgcn_readfirstlane(C.tid >> 6); C.bid = blockIdx.x; C.G = 256;
    volatile LAS unsigned* MISC = (volatile LAS unsigned*)(lds + MISC_OFF);
    if (C.tid < 4) MISC[C.tid] = 0u;
    __syncthreads();
    unsigned char* ws = args.ws;
    const int lo = args.ph_lo, hi = args.ph_hi;
    const bool multi = (hi - lo) > 1;
    if (multi) (void)xcd_barrier_post((unsigned*)(ws + WS_CTL), MISC, C.tid == 0);
#define GRID_BARRIER() do { XcdBarrier b_; b_.bar = (unsigned*)(args.ws + WS_CTL); b_.x = xb_xcc_id(); b_.st = (volatile LAS unsigned*)(lds + MISC_OFF); \
    b_.leader = (C.wid == 0) && (__builtin_amdgcn_mbcnt_hi(~0u, __builtin_amdgcn_mbcnt_lo(~0u, 0u)) == 0u); xcd_barrier(b_); } while (0)
#if PROBE_PHASE >= 0
    volatile LAS unsigned long long* ts_l = (volatile LAS unsigned long long*)(lds + MISC_OFF + 128);
#define STAMP(k) do { if ((k) == PROBE_PHASE || (k) == PROBE_PHASE + 1) { if (C.wid == 0) ts_l[(k) - PROBE_PHASE] = __builtin_amdgcn_s_memrealtime(); } } while (0)
#else
#define STAMP(k) do { } while (0)
#endif
    int ph = 0;
#define PHASE(...) do { STAMP(ph); if (lo <= ph && ph < hi) { \
    { int l_ = (int)__builtin_amdgcn_mbcnt_hi(~0u, __builtin_amdgcn_mbcnt_lo(~0u, 0u)); asm volatile("" : "+v"(l_)); C.lane = l_; C.tid = C.wid * 64 + l_; \
      CArgs* ap_ = (CArgs*)__builtin_amdgcn_kernarg_segment_ptr(); asm volatile("" : "+s"(ap_)); C.a = ap_; } __VA_ARGS__ } if (lo <= ph && ph + 1 < hi) GRID_BARRIER(); ++ph; } while (0)
    using namespace pg8;
    const bf16_t* Abuf = (const bf16_t*)(ws + WS_A);
    const bf16_t* A8buf = (const bf16_t*)(ws + WS_A8);
    const float* modf = (const float*)(ws + WS_MODF);

    PHASE( phaseA(C); );
    PHASE( phaseB(C); );
    PHASE(
        Gemm g{A8buf, (const bf16_t*)(ws + WS_W1T), MA, 2560, 512}; Order1 S; S.init(C.G, C.bid);
        Epi1 E{(bf16_t*)(ws + WS_GLU), ws};
        gemm_phase<Epi1, Order1, true>(lds, g, S, E, C.tid, C.wid);
        ctx_kv_tile(C); );
    PHASE(
        const int vcu = (C.bid & 7) * (C.G >> 3) + (C.bid >> 3);
        for (int t = vcu; t < 512; t += C.G) conv_tile(C, t);
        __syncthreads();
        { int tt = C.wid * C.G + C.bid;
          if (C.wid >= 4) { for (int q = 0; q < 2 && tt < 8192; ++q, tt += C.G * 8) table_task(C, tt); }
          for (int t = vcu * 8 + C.wid; t < NBATCH * 64 * 8; t += C.G * 8) { attn_task(C, t);
              for (int q = 0; q < 2 && tt < 8192; ++q, tt += C.G * 8) table_task(C, tt); }
          for (; tt < 8192; tt += C.G * 8) table_task(C, tt); } );
    PHASE(
        Gemm g{A8buf, (const bf16_t*)(ws + WS_W2T), M, 1024, 512}; StaticOrder S; S.init(M, 1024, C.G, C.bid);
        EpiRes<false> E{args.in[I_X], (bf16_t*)(ws + WS_H), modf + 2 * 1024};
        gemm_phase<EpiRes<false>, StaticOrder, true>(lds, g, S, E, C.tid, C.wid); );
    PHASE( phaseNorm2(C, 0); );
    PHASE(
        Gemm g{WQ_FP8 ? A8buf : Abuf, (const bf16_t*)(ws + WS_WQ), M, 2048, WQ_FP8 ? 512 : 1024}; StaticOrder S; S.init(M, 2048, C.G, C.bid);
        EpiBf16<0> E{(bf16_t*)(ws + WS_QP), (bf16_t*)(ws + WS_QP), 8, 2048};
        gemm_phase<EpiBf16<0>, StaticOrder, WQ_FP8 != 0>(lds, g, S, E, C.tid, C.wid); );
    PHASE( phaseTopk(C, 0); );
    PHASE( phasePeerSliced<0>(C, 0); );
    PHASE( phasePeerCombine(C); );
    PHASE( phasePeerSliced<1>(C, 0); );
    PHASE( phasePeerNorm(C, 0); );
    PHASE(
        Gemm g{A8buf, (const bf16_t*)(ws + WS_WSI), M, 2048, 512}; StaticOrder S; S.init(M, 2048, C.G, C.bid);
        EpiBf16<1> E{(bf16_t*)(ws + WS_U), (bf16_t*)(ws + WS_VV), 4, 1024};
        gemm_phase<EpiBf16<1>, StaticOrder, true>(lds, g, S, E, C.tid, C.wid); );
    PHASE( phaseSgu(C); );
    PHASE(
        Gemm g{A8buf, (const bf16_t*)(ws + WS_WSO), M, 1024, 512}; StaticOrder S; S.init(M, 1024, C.G, C.bid);
        EpiRes<true> E{ws + WS_H, (bf16_t*)(ws + WS_H), modf + 9 * 6144 + 2 * 1024};
        gemm_phase<EpiRes<true>, StaticOrder, true>(lds, g, S, E, C.tid, C.wid); );
    PHASE( phaseNorm2(C, 1); );
    PHASE(
        Gemm g{WQ_FP8 ? A8buf : Abuf, (const bf16_t*)(ws + WS_WQ + (size_t)2048 * 1024 * (WQ_FP8 ? 1 : 2)), M, 2048, WQ_FP8 ? 512 : 1024}; StaticOrder S; S.init(M, 2048, C.G, C.bid);
        EpiBf16<0> E{(bf16_t*)(ws + WS_QP), (bf16_t*)(ws + WS_QP), 8, 2048};
        gemm_phase<EpiBf16<0>, StaticOrder, WQ_FP8 != 0>(lds, g, S, E, C.tid, C.wid); );
    PHASE( phaseTopk(C, 1); );
    PHASE( phasePeerSliced<0>(C, 1); );
    PHASE( phasePeerCombine(C); );
    PHASE( phasePeerSliced<1>(C, 1); );
    PHASE( phasePeerNorm(C, 1); );
#if PROBE_PHASE >= 0
    if (C.bid == 0 && C.wid == 0 && multi) { const unsigned long long dt = (ts_l[1] - ts_l[0]) * PROBE_MULT, t0 = __builtin_amdgcn_s_memrealtime();
        while (__builtin_amdgcn_s_memrealtime() - t0 < dt) __builtin_amdgcn_s_sleep(8); }
#endif
#undef PHASE
#undef GRID_BARRIER
#undef STAMP
}

extern "C" void kernel_launch(void* const* d_in, const int* in_sizes, int n_in, void* d_out, int out_size, void* d_ws, size_t ws_size, hipStream_t stream) {
    static int grid = 0;
    if (grid == 0) {
        if (n_in != N_IN || out_size != M * D || ws_size < WS_END) { fprintf(stderr, "kernel_launch: unexpected shapes (n_in %d out %d ws %zu need %zu)\n", n_in, out_size, ws_size, (size_t)WS_END); grid = -1; return; }
        int dev = 0, cus = 0, per_cu = 0;
        if (hipGetDevice(&dev) != hipSuccess || hipDeviceGetAttribute(&cus, hipDeviceAttributeMultiprocessorCount, dev) != hipSuccess) { grid = -1; return; }
        if (hipFuncSetAttribute((const void*)fwd_megakernel, hipFuncAttributeMaxDynamicSharedMemorySize, LDS_BYTES) != hipSuccess) { fprintf(stderr, "kernel_launch: hipFuncSetAttribute failed\n"); grid = -1; return; }
        if (hipOccupancyMaxActiveBlocksPerMultiprocessor(&per_cu, (const void*)fwd_megakernel, 512, LDS_BYTES) != hipSuccess || per_cu < 1) { fprintf(stderr, "kernel_launch: occupancy query says %d blocks per CU\n", per_cu); (void)hipGetLastError(); grid = -1; return; }
        grid = cus;
        if (grid != 256) fprintf(stderr, "kernel_launch: note: %d CUs (the phase tilings assume 256)\n", grid);
        if (grid > 256) grid = 256;
    }
    if (grid < 0) return;
    (void)hipMemsetAsync((char*)d_ws + WS_CTL, 0, CTL_BYTES, stream);
    Args a{};
    for (int i = 0; i < N_IN; ++i) a.in[i] = (const float*)d_in[i];
    a.out = (float*)d_out; a.ws = (unsigned char*)d_ws;
#if ONE_LAUNCH
    a.ph_lo = 0; a.ph_hi = NPHASES; hipLaunchKernelGGL(fwd_megakernel, dim3(grid), dim3(512), LDS_BYTES, stream, a);
#else
    for (int i = 0; i < NPHASES; ++i) { a.ph_lo = i; a.ph_hi = i + 1; hipLaunchKernelGGL(fwd_megakernel, dim3(grid), dim3(512), LDS_BYTES, stream, a); }
#endif
}
```

```cpp
#include <hip/hip_runtime.h>
#include <cstdio>
#include <cstdint>

#ifndef PROBE_PHASE
#define PROBE_PHASE -1
#endif
#define PROBE_MULT 8
#ifndef WQ_FP8
#define WQ_FP8 1
#endif
#ifndef ONE_LAUNCH
#define ONE_LAUNCH 1
#endif

#define LAS __attribute__((address_space(3)))
typedef unsigned short bf16_t;
typedef short bf16x8 __attribute__((ext_vector_type(8)));
typedef float f32x4 __attribute__((ext_vector_type(4)));
typedef float f32x16 __attribute__((ext_vector_type(16)));
typedef float f32x2 __attribute__((ext_vector_type(2)));
typedef unsigned u32x4 __attribute__((ext_vector_type(4)));
typedef unsigned u32x2 __attribute__((ext_vector_type(2)));
typedef __bf16 bf2v __attribute__((ext_vector_type(2)));
typedef int v4i __attribute__((ext_vector_type(4)));
typedef int v8i __attribute__((ext_vector_type(8)));

constexpr int D = 1024, NBATCH = 8, SEQ = 4096, M = NBATCH * SEQ, CTXL = 256, MC = NBATCH * CTXL, MA = M + MC;
constexpr int NEXP = 16384;
constexpr float EPS = 1e-6f;
enum { I_X = 0, I_C, I_CTX, I_CCTX, I_N1G, I_N2G, I_ADAW, I_ADAB, I_WIN, I_CONVW, I_CONVB, I_GNG, I_GNB, I_RPB, I_WOUT, I_SGUIN, I_LNG, I_LNB, I_WS, I_BS, I_SGUOUT,
       I_WQ, I_KEYS, I_PU, I_PV, I_NFG, N_IN };

constexpr size_t WS_CTL  = 0;
constexpr size_t CTL_BYTES = 65536;
constexpr size_t WS_MODP = WS_CTL + CTL_BYTES;
constexpr size_t WS_MODF = WS_MODP + (size_t)2 * 8 * 9 * 6144 * 4;
constexpr size_t WS_W1T  = WS_MODF + (size_t)2 * 9 * 6144 * 4;
constexpr size_t WS_W2T  = WS_W1T + (size_t)2560 * 1024 * 2;
constexpr size_t WS_WSI  = WS_W2T + (size_t)1024 * 1024 * 2;
constexpr size_t WS_WSO  = WS_WSI + (size_t)2048 * 1024 * 2;
constexpr size_t WS_WQ   = WS_WSO + (size_t)1024 * 1024 * 2;
constexpr size_t WS_KEYS = WS_WQ + (size_t)2 * 2048 * 1024 * 2;
constexpr size_t WS_WSP  = WS_KEYS + (size_t)2 * 8 * 2 * 128 * 128 * 2;
constexpr size_t WS_TU   = WS_WSP + (size_t)8 * 128 * 128 * 2;
constexpr size_t WS_TV   = WS_TU + (size_t)2 * NEXP * 1024;
constexpr size_t WS_SIU  = WS_TV + (size_t)2 * NEXP * 1024;
constexpr size_t WS_SIV  = WS_SIU + (size_t)2 * NEXP * 4;
constexpr size_t WS_A    = WS_SIV + (size_t)2 * NEXP * 4;
constexpr size_t WS_B    = WS_A + (size_t)MA * 1024 * 2;
constexpr size_t WS_GLU  = WS_B;
constexpr size_t WS_Q    = WS_GLU + (size_t)M * 512 * 2;
constexpr size_t WS_K    = WS_Q + (size_t)M * 512 * 2;
constexpr size_t WS_V    = WS_K + (size_t)MA * 512 * 2;
constexpr size_t WS_QP   = WS_B;
constexpr size_t WS_PD   = WS_B;
constexpr size_t WS_U    = WS_B;
constexpr size_t WS_VV   = WS_B + (size_t)M * 1024 * 2;
constexpr size_t WS_IDX  = WS_V + (size_t)MA * 512 * 2;
constexpr size_t WS_WT   = WS_IDX + (size_t)M * 128 * 2;
constexpr size_t WS_SU   = WS_WT + (size_t)M * 128 * 4;
constexpr size_t WS_A8   = WS_SU + (size_t)M * 128 * 4;
constexpr size_t WS_H    = WS_A8 + (size_t)MA * 1024;
constexpr size_t WS_REF  = WS_H + (size_t)M * 1024 * 2;
constexpr size_t WS_END  = WS_REF + (size_t)256 * 1024 * 4;

constexpr int LDS_BYTES = 147456;
constexpr int MISC_OFF = 147200;

__device__ __forceinline__ float bf_lo(unsigned u) { return __uint_as_float(u << 16); }
__device__ __forceinline__ float bf_hi(unsigned u) { return __uint_as_float(u & 0xffff0000u); }
__device__ __forceinline__ unsigned pk2(float lo, float hi) { bf2v r = {(__bf16)lo, (__bf16)hi}; return __builtin_bit_cast(unsigned, r); }
template <int CTRL> __device__ __forceinline__ float dpp_f(float v) { return __builtin_bit_cast(float, __builtin_amdgcn_update_dpp(0, __builtin_bit_cast(int, v), CTRL, 0xF, 0xF, true)); }
__device__ __forceinline__ float sum8(float v) { v += dpp_f<0xB1>(v); v += dpp_f<0x4E>(v); v += dpp_f<0x141>(v); return v; }
__device__ __forceinline__ float sum16(float v) { v = sum8(v); v += dpp_f<0x140>(v); return v; }
__device__ __forceinline__ float sum32(float v) { v = sum16(v); v += __shfl_xor(v, 16); return v; }
__device__ __forceinline__ float clamp448(float v) { return fminf(fmaxf(v, -448.f), 448.f); }
__device__ __forceinline__ unsigned pk4_fp8(float a, float b, float c, float d) { int p = 0;
    p = __builtin_amdgcn_cvt_pk_fp8_f32(clamp448(a), clamp448(b), p, false); p = __builtin_amdgcn_cvt_pk_fp8_f32(clamp448(c), clamp448(d), p, true); return (unsigned)p; }
__device__ __forceinline__ float wave_sum(float v) { v = sum32(v); v += __shfl_xor(v, 32); return v; }
__device__ __forceinline__ float dot2bf(unsigned a, unsigned b, float c) { return __builtin_amdgcn_fdot2_f32_bf16(__builtin_bit_cast(bf2v, a), __builtin_bit_cast(bf2v, b), c, false); }
__device__ __forceinline__ float sigmoidf_(float x) { return __builtin_amdgcn_rcpf(1.f + __expf(-x)); }
__device__ __forceinline__ float gelu_erf(float v) { return 0.5f * v * (1.f + erff(v * 0.70710678f)); }

namespace pg8 {
constexpr int BM = 256, BK = 64, HALF = 128, HTB = HALF * BK * 2, STAGE_BYTES = 8 * HTB, NXCD = 8, WGM = 8;
__host__ __device__ __forceinline__ int lds_byte(int r, int c) { const int st = (r >> 4) * 2 + (c >> 5), rr = r & 15, cc = c & 31, ob = rr * 64 + cc * 2; return st * 1024 + (ob ^ (((ob >> 9) & 1) << 5)); }
__host__ __device__ __forceinline__ void stage_rc(int b, int& R, int& C) { const int st = b / 1024, sb = b % 1024, swz = sb ^ (((sb >> 9) & 1) << 5); R = (st >> 1) * 16 + swz / 64; C = (st & 1) * 32 + (swz % 64) / 2; }
__host__ __device__ __forceinline__ int perm32(int rho) { const int n = rho >> 4, i = rho & 15; return 8 * (i >> 2) + 4 * n + (i & 3); }
struct Unit { int pm, pn; };
struct Gemm { const bf16_t* A; const bf16_t* Bt; int M, N, K; };
struct StaticOrder {
    int nM, nN, nwg, G, c;
    __host__ __device__ void init(int M_, int N_, int G_, int c_) { nM = M_ / BM; nN = N_ / BM; nwg = nM * nN; G = G_; c = c_; }
    __host__ __device__ bool next(int i, Unit& u) const {
        const long L = (long)i * G + c; if (L >= nwg) return false;
        int wgid = (int)L; { const int q = nwg / NXCD, r = nwg % NXCD, xcd = wgid % NXCD, off = wgid / NXCD; wgid = (xcd < r ? xcd * (q + 1) : r * (q + 1) + (xcd - r) * q) + off; }
        const int nig = WGM * nN, gid = wgid / nig, fm = gid * WGM, gsz = (nM - fm) < WGM ? (nM - fm) : WGM;
        u.pm = fm + ((wgid % nig) % gsz); u.pn = (wgid % nig) / gsz; return true;
    }
    __device__ __forceinline__ void a_ready(const Unit&) const {}
    __device__ __forceinline__ void done(const Unit&) const {}
};
struct Order1 {
    StaticOrder so; int G, c;
    __device__ void init(int G_, int c_) { so.init(M, 2560, G_, c_); G = G_; c = c_; }
    __device__ bool next(int i, Unit& u) const {
        const long L = (long)i * G + c;
        if (L < so.nwg) return so.next(i, u);
        return false;
    }
    __device__ __forceinline__ void a_ready(const Unit&) const {}
    __device__ __forceinline__ void done(const Unit&) const {}
};
__device__ __forceinline__ f32x2 gelu_pk(f32x2 v) {
    const f32x2 av = __builtin_elementwise_abs(v), d = av * 0.2316418882f + 1.0f;
    f32x2 t; t.x = __builtin_amdgcn_rcpf(d.x); t.y = __builtin_amdgcn_rcpf(d.y);
    f32x2 q = t * 0.5307027145f + (-0.7265760135f); q = q * t + 0.7107068705f; q = q * t + (-0.142248368f); q = q * t + 0.127414796f; q = q * t;
    const f32x2 s = (v * v) * (-0.72134752044f);
    f32x2 e; e.x = __builtin_amdgcn_exp2f(s.x); e.y = __builtin_amdgcn_exp2f(s.y);
    const f32x2 m = v * (q * e), r = v - m;
    f32x2 o; o.x = v.x < 0.f ? m.x : r.x; o.y = v.y < 0.f ? m.y : r.y; return o;
}
__device__ __forceinline__ void mfma_fp8_acc(f32x4& acc, const v8i& a, const v8i& b, int sa, int sb) {
    asm volatile("s_nop 1\n\tv_mfma_scale_f32_16x16x128_f8f6f4 %0, %1, %2, %0, %3, %4 op_sel_hi:[0,0,0]" : "+v"(acc) : "v"(a), "v"(b), "v"(sa), "v"(sb));
}
template <class Epi, class Sched, bool FP8 = false>
__device__ __forceinline__ void gemm_phase(LAS unsigned char* lds, const Gemm g, const Sched& S, const Epi& E, const int tid, const int wid) {
    const int lane = tid & 63, wr = wid >> 2, wc = wid & 3, fr = lane & 15, fq = lane >> 4;
    const int K = g.K, nt = K / BK;
    const int sc_w = 0x7A7A7A7A, sc_x = 0x7F7F7F7F;
    unsigned voffA[2], voffB[2];
#pragma unroll
    for (int i = 0; i < 2; ++i) { int R, C; stage_rc(tid * 16 + i * 8192, R, C); const int Rb = Epi::PERM ? ((R & ~31) + perm32(R & 31)) : R;
        voffA[i] = (unsigned)(R * K + C) * 2u; voffB[i] = (unsigned)(Rb * K + C) * 2u; }
    const size_t kstep = (size_t)(BK * 2);
    const size_t hstep = (size_t)HALF * K * 2;
    const size_t tstep = 2 * hstep;
    const unsigned ldsw = (unsigned)wid * 1024u;
    const int aoff = lds_byte(wr * 64 + fr, fq * 8), boff = lds_byte(wc * 32 + fr, fq * 8);
#define PG8_SA(b, h) (((b) * 2 + (h)) * HTB)
#define PG8_SB(b, h) ((4 + (b) * 2 + (h)) * HTB)
#define PG8_STAGE(bufoff, gbase, voff) do { _Pragma("unroll") for (int _i = 0; _i < 2; ++_i) \
        __builtin_amdgcn_global_load_lds((const unsigned*)((const char*)(gbase) + (voff)[_i]), (LAS unsigned*)(lds + (bufoff) + ldsw + _i * 8192), 16, 0, 0); } while (0)
#define PG8_LD16(off) (*(const LAS v4i*)(lds + (off)))
#define PG8_LDA(dst, b, h) do { _Pragma("unroll") for (int m = 0; m < 4; ++m) { const int o_ = PG8_SA(b, h) + aoff + m * 2048; \
        if (FP8) dst##8[m] = __builtin_shufflevector(PG8_LD16(o_), PG8_LD16(o_ + 1024), 0, 1, 2, 3, 4, 5, 6, 7); \
        else { dst[m][0] = __builtin_bit_cast(bf16x8, PG8_LD16(o_)); dst[m][1] = __builtin_bit_cast(bf16x8, PG8_LD16(o_ + 1024)); } } } while (0)
#define PG8_LDB(dst, b, h) do { _Pragma("unroll") for (int n = 0; n < 2; ++n) { const int o_ = PG8_SB(b, h) + boff + n * 2048; \
        if (FP8) dst##8[n] = __builtin_shufflevector(PG8_LD16(o_), PG8_LD16(o_ + 1024), 0, 1, 2, 3, 4, 5, 6, 7); \
        else { dst[n][0] = __builtin_bit_cast(bf16x8, PG8_LD16(o_)); dst[n][1] = __builtin_bit_cast(bf16x8, PG8_LD16(o_ + 1024)); } } } while (0)
#define PG8_MMA(ai, bj, At, Bt) do { __builtin_amdgcn_s_setprio(1); _Pragma("unroll") for (int m = 0; m < 4; ++m) _Pragma("unroll") for (int n = 0; n < 2; ++n) { \
        if (FP8) mfma_fp8_acc(acc[ai][bj][m][n], Bt##8[n], At##8[m], sc_w, sc_x); \
        else { _Pragma("unroll") for (int k = 0; k < 2; ++k) acc[ai][bj][m][n] = __builtin_amdgcn_mfma_f32_16x16x32_bf16(Bt[n][k], At[m][k], acc[ai][bj][m][n], 0, 0, 0); } } \
        __builtin_amdgcn_s_setprio(0); } while (0)
#define PG8_WAIT_V(n) asm volatile("s_waitcnt vmcnt(" #n ")" ::: "memory")
#define PG8_WAIT_L(n) asm volatile("s_waitcnt lgkmcnt(" #n ")" ::: "memory")
#define PG8_BAR __builtin_amdgcn_s_barrier()
#define PG8_SCHED __builtin_amdgcn_sched_barrier(0)
    Unit cur, nxt; int ui = 0;
    if (!S.next(0, cur)) return;
    f32x4 acc[2][2][4][2];
#pragma unroll
    for (int a = 0; a < 2; ++a)
#pragma unroll
        for (int b = 0; b < 2; ++b)
#pragma unroll
            for (int m = 0; m < 4; ++m)
#pragma unroll
                for (int n = 0; n < 2; ++n) acc[a][b][m][n] = (f32x4){0.f, 0.f, 0.f, 0.f};
    const char* cA = (const char*)g.A + (size_t)cur.pm * tstep; const char* cB = (const char*)g.Bt + (size_t)cur.pn * tstep;
    S.a_ready(cur);
    PG8_STAGE(PG8_SB(0, 0), cB, voffB); PG8_STAGE(PG8_SA(0, 0), cA, voffA); PG8_STAGE(PG8_SB(0, 1), cB + hstep, voffB); PG8_STAGE(PG8_SA(0, 1), cA + hstep, voffA);
    if (wr == 1) PG8_BAR;
    PG8_WAIT_V(4); PG8_BAR;
    PG8_STAGE(PG8_SB(1, 0), cB + kstep, voffB); PG8_STAGE(PG8_SA(1, 0), cA + kstep, voffA); PG8_STAGE(PG8_SB(1, 1), cB + hstep + kstep, voffB);
    PG8_WAIT_V(6); PG8_BAR;
    for (;;) {
        const bool has_next = S.next(ui + 1, nxt);
        const char* nA = has_next ? (const char*)g.A + (size_t)nxt.pm * tstep : cA; const char* nB = has_next ? (const char*)g.Bt + (size_t)nxt.pn * tstep : cB;
#pragma unroll 1
        for (int t = 0; t < nt; t += 2) {
            const bool last = (t == nt - 2);
            bf16x8 At[4][2], B0[2][2], B1[2][2]; v8i At8[4], B08[2], B18[2];
            const char* a1 = cA + (size_t)(t + 1) * kstep;
            const char* a2 = last ? nA : cA + (size_t)(t + 2) * kstep; const char* b2 = last ? nB : cB + (size_t)(t + 2) * kstep;
            const char* a3 = a2 + kstep; const char* b3 = b2 + kstep;
            if (last && has_next) S.a_ready(nxt);
            PG8_LDB(B0, 0, 0); PG8_SCHED; PG8_LDA(At, 0, 0); PG8_STAGE(PG8_SA(1, 1), a1 + hstep, voffA);
            PG8_WAIT_L(8); PG8_BAR; PG8_WAIT_L(0); PG8_MMA(0, 0, At, B0); PG8_BAR; PG8_SCHED;
            PG8_LDB(B1, 0, 1); PG8_STAGE(PG8_SB(0, 0), b2, voffB);
            PG8_BAR; PG8_WAIT_L(0); PG8_MMA(0, 1, At, B1); PG8_BAR;
            PG8_LDA(At, 0, 1); PG8_STAGE(PG8_SA(0, 0), a2, voffA);
            PG8_BAR; PG8_WAIT_L(0); PG8_MMA(1, 0, At, B0); PG8_BAR; PG8_SCHED;
            PG8_STAGE(PG8_SB(0, 1), b2 + hstep, voffB);
            PG8_WAIT_V(6); PG8_BAR; PG8_MMA(1, 1, At, B1); PG8_BAR;
            PG8_LDB(B0, 1, 0); PG8_SCHED; PG8_LDA(At, 1, 0); PG8_STAGE(PG8_SA(0, 1), a2 + hstep, voffA);
            PG8_WAIT_L(8); PG8_BAR; PG8_WAIT_L(0); PG8_MMA(0, 0, At, B0); PG8_BAR; PG8_SCHED;
            PG8_LDB(B1, 1, 1); PG8_STAGE(PG8_SB(1, 0), b3, voffB);
            PG8_BAR; PG8_WAIT_L(0); PG8_MMA(0, 1, At, B1); PG8_BAR;
            PG8_LDA(At, 1, 1); PG8_STAGE(PG8_SA(1, 0), a3, voffA);
            PG8_BAR; PG8_WAIT_L(0); PG8_MMA(1, 0, At, B0); PG8_BAR; PG8_SCHED;
            PG8_STAGE(PG8_SB(1, 1), b3 + hstep, voffB);
            PG8_WAIT_V(6); PG8_BAR; PG8_MMA(1, 1, At, B1); PG8_BAR;
        }
        { Unit ue = cur; int wr_ = wr, wc_ = wc, fr_ = fr, fq_ = fq;
          asm volatile("" : "+s"(ue.pm), "+s"(ue.pn), "+s"(wr_), "+s"(wc_), "+v"(fr_), "+v"(fq_));
          E(acc, ue, wr_, wc_, fr_, fq_); }
        S.done(cur);
        if (!has_next) break;
#pragma unroll
        for (int a = 0; a < 2; ++a)
#pragma unroll
            for (int b = 0; b < 2; ++b)
#pragma unroll
                for (int m = 0; m < 4; ++m)
#pragma unroll
                    for (int n = 0; n < 2; ++n) acc[a][b][m][n] = (f32x4){0.f, 0.f, 0.f, 0.f};
        cur = nxt; cA = nA; cB = nB; ++ui;
    }
    PG8_WAIT_V(0);
    if (wr == 0) PG8_BAR;
    PG8_BAR;
#undef PG8_SA
#undef PG8_SB
#undef PG8_STAGE
#undef PG8_LDA
#undef PG8_LD16
#undef PG8_LDB
#undef PG8_MMA
#undef PG8_WAIT_V
#undef PG8_WAIT_L
#undef PG8_BAR
#undef PG8_SCHED
}

struct Epi1 {
    static constexpr bool PERM = true;
    bf16_t *GLU; unsigned char* wsb;
    __device__ __forceinline__ void operator()(const f32x4 (&acc)[2][2][4][2], const Unit& u, int wr, int wc, int fr, int fq) const {
        const int row0 = u.pm * BM + wr * 64 + fr;
        if (u.pn < 4) {
            const int ch0 = u.pn * 128 + wc * 32 + 8 * fq;
#pragma unroll
            for (int ai = 0; ai < 2; ++ai)
#pragma unroll
                for (int m = 0; m < 4; ++m) {
                    const f32x4 a0 = acc[ai][0][m][0], a1 = acc[ai][0][m][1], g0 = acc[ai][1][m][0], g1 = acc[ai][1][m][1];
                    u32x4 w;
                    w.x = pk2(a0[0] * sigmoidf_(g0[0]), a0[1] * sigmoidf_(g0[1])); w.y = pk2(a0[2] * sigmoidf_(g0[2]), a0[3] * sigmoidf_(g0[3]));
                    w.z = pk2(a1[0] * sigmoidf_(g1[0]), a1[1] * sigmoidf_(g1[1])); w.w = pk2(a1[2] * sigmoidf_(g1[2]), a1[3] * sigmoidf_(g1[3]));
                    *(u32x4*)(GLU + (size_t)(row0 + ai * HALF + m * 16) * 512 + ch0) = w;
                }
        } else {
            const int t = (u.pn - 4) >> 1;
            const size_t boff = WS_Q + (t >= 1 ? (size_t)M * 1024 : (size_t)0) + (t >= 2 ? (size_t)MA * 1024 : (size_t)0);
            bf16_t* base = (bf16_t*)(wsb + boff);
            const float sc = t == 0 ? 0.125f * 1.44269504f : 1.f;
            const int col0 = ((u.pn - 4) & 1) * 256 + wc * 32 + 8 * fq;
#pragma unroll
            for (int ai = 0; ai < 2; ++ai)
#pragma unroll
                for (int m = 0; m < 4; ++m) { bf16_t* rowp = base + (size_t)(row0 + ai * HALF + m * 16) * 512 + col0;
#pragma unroll
                    for (int bj = 0; bj < 2; ++bj) { const f32x4 v0 = acc[ai][bj][m][0] * sc, v1 = acc[ai][bj][m][1] * sc;
                        u32x4 w; w.x = pk2(v0[0], v0[1]); w.y = pk2(v0[2], v0[3]); w.z = pk2(v1[0], v1[1]); w.w = pk2(v1[2], v1[3]);
                        *(u32x4*)(rowp + bj * HALF) = w; } }
        }
    }
};
template <bool BF16_BASE> struct EpiRes {
    static constexpr bool PERM = true;
    const void* base; bf16_t* H; const float* gate;
    __device__ __forceinline__ void operator()(const f32x4 (&acc)[2][2][4][2], const Unit& u, int wr, int wc, int fr, int fq) const {
        const int row0 = u.pm * BM + wr * 64 + fr, col0 = u.pn * BM + wc * 32 + 8 * fq;
        const int b = (u.pm * BM) / SEQ;
        f32x4 gv[2][2];
#pragma unroll
        for (int bj = 0; bj < 2; ++bj)
#pragma unroll
            for (int n = 0; n < 2; ++n) gv[bj][n] = *(const f32x4*)(gate + (size_t)b * 6144 + col0 + bj * HALF + 4 * n);
#pragma unroll
        for (int ai = 0; ai < 2; ++ai) {
            f32x4 bb[4][2][2]; u32x4 hb[4][2];
#pragma unroll
            for (int m = 0; m < 4; ++m) { const size_t off = (size_t)(row0 + ai * HALF + m * 16) * D + col0;
#pragma unroll
                for (int bj = 0; bj < 2; ++bj) {
                    if (BF16_BASE) hb[m][bj] = *(const u32x4*)((const bf16_t*)base + off + bj * HALF);
                    else { bb[m][bj][0] = *(const f32x4*)((const float*)base + off + bj * HALF); bb[m][bj][1] = *(const f32x4*)((const float*)base + off + bj * HALF + 4); } } }
#pragma unroll
            for (int m = 0; m < 4; ++m) { const size_t off = (size_t)(row0 + ai * HALF + m * 16) * D + col0;
#pragma unroll
                for (int bj = 0; bj < 2; ++bj) {
                    f32x4 b0, b1;
                    if (BF16_BASE) { const u32x4 h4 = hb[m][bj];
                        b0 = (f32x4){bf_lo(h4.x), bf_hi(h4.x), bf_lo(h4.y), bf_hi(h4.y)}; b1 = (f32x4){bf_lo(h4.z), bf_hi(h4.z), bf_lo(h4.w), bf_hi(h4.w)}; }
                    else { b0 = bb[m][bj][0]; b1 = bb[m][bj][1]; }
                    const f32x4 v0 = b0 + gv[bj][0] * acc[ai][bj][m][0], v1 = b1 + gv[bj][1] * acc[ai][bj][m][1];
                    u32x4 w; w.x = pk2(v0[0], v0[1]); w.y = pk2(v0[2], v0[3]); w.z = pk2(v1[0], v1[1]); w.w = pk2(v1[2], v1[3]);
                    *(u32x4*)(H + off + bj * HALF) = w; } }
        }
    }
};
template <int ACT> struct EpiBf16 {
    static constexpr bool PERM = true;
    bf16_t *O0, *O1; int split_tiles, ld;
    __device__ __forceinline__ void operator()(const f32x4 (&acc)[2][2][4][2], const Unit& u, int wr, int wc, int fr, int fq) const {
        const int row0 = u.pm * BM + wr * 64 + fr;
        bf16_t* base = u.pn < split_tiles ? O0 : O1;
        const int col0 = (u.pn < split_tiles ? u.pn : u.pn - split_tiles) * BM + wc * 32 + 8 * fq;
#pragma unroll
        for (int ai = 0; ai < 2; ++ai)
#pragma unroll
            for (int m = 0; m < 4; ++m) { bf16_t* rowp = base + (size_t)(row0 + ai * HALF + m * 16) * ld + col0;
#pragma unroll
                for (int bj = 0; bj < 2; ++bj) { f32x4 v0 = acc[ai][bj][m][0], v1 = acc[ai][bj][m][1];
                    if (ACT == 1) { f32x2 a = gelu_pk((f32x2){v0[0], v0[1]}), b = gelu_pk((f32x2){v0[2], v0[3]}), c = gelu_pk((f32x2){v1[0], v1[1]}), d = gelu_pk((f32x2){v1[2], v1[3]});
                        v0 = (f32x4){a.x, a.y, b.x, b.y}; v1 = (f32x4){c.x, c.y, d.x, d.y}; }
                    u32x4 w; w.x = pk2(v0[0], v0[1]); w.y = pk2(v0[2], v0[3]); w.z = pk2(v1[0], v1[1]); w.w = pk2(v1[2], v1[3]);
                    *(u32x4*)(rowp + bj * HALF) = w; } }
    }
};
}

#define XB_TMO      128
#define XB_XCNT(j)  (256  + 64 * (j))
#define XB_XSUB(j)  (1280 + 64 * (j))
#define XB_XGEN(j)  (2304 + 64 * (j))
#define XB_TOP      3328
#define XB_TOPGEN   3392
#define XCD_BAR_WORDS 3456
#define XB_SPIN_CAP (1u << 22)
__device__ __forceinline__ unsigned xb_ld(unsigned* p)              { return __hip_atomic_load(p, __ATOMIC_RELAXED, __HIP_MEMORY_SCOPE_AGENT); }
__device__ __forceinline__ unsigned xb_add(unsigned* p, unsigned v) { return __hip_atomic_fetch_add(p, v, __ATOMIC_RELAXED, __HIP_MEMORY_SCOPE_AGENT); }
__device__ __forceinline__ unsigned xb_xcc_id() { return (unsigned)__builtin_amdgcn_s_getreg((3 << 11) | 20) & 0xFu; }
#define XB_SPIN(cond, bar) do { unsigned _sp = 0; while (cond) { __builtin_amdgcn_s_sleep(1); \
    if ((++_sp & 255u) == 0u) { if (xb_ld(&(bar)[XB_TMO])) break; if (_sp > XB_SPIN_CAP) { atomicAdd(&(bar)[XB_TMO], 1u); break; } } } } while (0)
struct XcdBarrier { unsigned* bar; unsigned x; volatile LAS unsigned* st; bool leader; };
__device__ __forceinline__ XcdBarrier xcd_barrier_post(unsigned* bar, volatile LAS unsigned* st, bool leader) {
    XcdBarrier b; b.bar = bar; b.x = xb_xcc_id(); b.st = st; b.leader = leader;
    if (leader) (void)xb_add(&bar[XB_XCNT(b.x)], 1u);
    return b;
}
__device__ __forceinline__ void xcd_barrier_complete(unsigned* bar, unsigned x, unsigned& nloc, unsigned& nx) {
    const unsigned G = gridDim.x * gridDim.y * gridDim.z;
    unsigned sum, cnt, mine, sp = 0u;
    for (;;) {
        sum = 0u; cnt = 0u; mine = 0u;
#pragma unroll
        for (unsigned j = 0; j < 16; ++j) { const unsigned c = xb_ld(&bar[XB_XCNT(j)]); sum += c; cnt += (c > 0u) ? 1u : 0u; mine = (j == x) ? c : mine; }
        if (sum == G) break;
        __builtin_amdgcn_s_sleep(1);
        if ((++sp & 255u) == 0u) { if (xb_ld(&bar[XB_TMO])) break; if (sp > XB_SPIN_CAP) { atomicAdd(&bar[XB_TMO], 1u); break; } }
    }
    nloc = mine > 0u ? mine : 1u; nx = cnt > 0u ? cnt : 1u;
}
__device__ __forceinline__ void xcd_barrier(const XcdBarrier& b) {
    asm volatile("s_waitcnt vmcnt(0)" ::: "memory");
    __syncthreads();
    if (b.leader) {
        unsigned* bar = b.bar;
        __builtin_amdgcn_s_waitcnt(0);
        unsigned nloc = b.st[0], nx = b.st[1];
        if (nloc == 0u) { xcd_barrier_complete(bar, b.x, nloc, nx); b.st[0] = nloc; b.st[1] = nx; }
        const unsigned old = xb_add(&bar[XB_XSUB(b.x)], 1u);
        const unsigned gen = old / nloc;
        if (old + 1u == (gen + 1u) * nloc) {
            __builtin_amdgcn_fence(__ATOMIC_RELEASE, "agent");
            asm volatile("s_waitcnt vmcnt(0)" ::: "memory");
            const unsigned og = xb_add(&bar[XB_TOP], 1u);
            const unsigned tg = og / nx;
            if (og + 1u == (tg + 1u) * nx) xb_add(&bar[XB_TOPGEN], 1u);
            else XB_SPIN(xb_ld(&bar[XB_TOPGEN]) == tg, bar);
            __builtin_amdgcn_fence(__ATOMIC_ACQUIRE, "agent");
            xb_add(&bar[XB_XGEN(b.x)], 1u);
            asm volatile("s_waitcnt vmcnt(0)" ::: "memory");
        } else {
            XB_SPIN(xb_ld(&bar[XB_XGEN(b.x)]) == gen, bar);
            __builtin_amdgcn_fence(__ATOMIC_ACQUIRE, "agent");
            asm volatile("s_waitcnt vmcnt(0)" ::: "memory");
        }
    }
    __syncthreads();
}

struct Args { const float* in[N_IN]; float* out; unsigned char* ws; int ph_lo, ph_hi; };
static_assert(sizeof(Args) == (N_IN + 2) * 8 + 8, "Args has padding");

typedef const __attribute__((address_space(4))) Args CArgs;
struct Ctx {
    CArgs* a; LAS unsigned char* lds; int tid, lane, wid, bid, G;
};

__device__ __forceinline__ void ctx_kv_tile(const Ctx& C) {
    CArgs& a = *C.a; unsigned char* ws = a.ws;
    const int lane = C.lane, fr = lane & 15, fq = lane >> 4;
    const int r0 = (C.bid >> 4) * 128 + C.wid * 16, c0 = (C.bid & 15) * 64;
    const unsigned char* xa = ws + WS_A8 + (size_t)(M + r0 + fr) * 1024 + 32 * fq;
    const unsigned char* wb = ws + WS_W1T + (size_t)(1536 + c0 + fr) * 1024 + 32 * fq;
    f32x4 acc[4];
#pragma unroll
    for (int nb = 0; nb < 4; ++nb) acc[nb] = (f32x4){0.f, 0.f, 0.f, 0.f};
#pragma unroll 2
    for (int ks = 0; ks < 8; ++ks) {
        const v8i xv = __builtin_shufflevector(*(const v4i*)(xa + 128 * ks), *(const v4i*)(xa + 128 * ks + 16), 0, 1, 2, 3, 4, 5, 6, 7);
        v8i wv[4];
#pragma unroll
        for (int nb = 0; nb < 4; ++nb) wv[nb] = __builtin_shufflevector(*(const v4i*)(wb + (size_t)nb * 16384 + 128 * ks), *(const v4i*)(wb + (size_t)nb * 16384 + 128 * ks + 16), 0, 1, 2, 3, 4, 5, 6, 7);
#pragma unroll
        for (int nb = 0; nb < 4; ++nb) pg8::mfma_fp8_acc(acc[nb], wv[nb], xv, 0x7A7A7A7A, 0x7F7F7F7F);
    }
    asm volatile("s_nop 15\n\ts_nop 15" ::: "memory");
#pragma unroll
    for (int nb = 0; nb < 4; ++nb) asm volatile("" : "+v"(acc[nb]));
#pragma unroll
    for (int nb = 0; nb < 4; ++nb) { const int col = c0 + 16 * nb + 4 * fq;
        bf16_t* dst = (bf16_t*)(ws + (col < 512 ? WS_K : WS_V)) + (size_t)(M + r0 + fr) * 512 + (col & 511);
        u32x2 o; o.x = pk2(acc[nb][0], acc[nb][1]); o.y = pk2(acc[nb][2], acc[nb][3]); *(u32x2*)dst = o; }
}

__device__ __forceinline__ int w1_dest_row(int n) {
    if (n < 512) return (n >> 7) * 256 + (n & 127);
    if (n < 1024) { const int q = n - 512; return (q >> 7) * 256 + 128 + (q & 127); }
    return n;
}
__device__ __forceinline__ void transpose_item(const float* W, int K, int N, bf16_t* WT, int item, LAS float* scr, int lane, int mode) {
    const int nblk = N / 32, kb = item / nblk, nb = item % nblk, k0 = 64 * kb, n0 = 32 * nb;
    { f32x4 w[8];
#pragma unroll
      for (int i = 0; i < 8; ++i) w[i] = *(const f32x4*)(W + (size_t)(k0 + 8 * i + (lane >> 3)) * N + n0 + 4 * (lane & 7));
#pragma unroll
      for (int i = 0; i < 8; ++i) { LAS float* d = scr + (8 * i + (lane >> 3)) * 33 + 4 * (lane & 7); d[0] = w[i].x; d[1] = w[i].y; d[2] = w[i].z; d[3] = w[i].w; } }
    asm volatile("s_waitcnt lgkmcnt(0)" ::: "memory"); __builtin_amdgcn_wave_barrier();
    const int c = lane & 7;
#pragma unroll
    for (int j = 0; j < 4; ++j) { const int n = (lane >> 3) + 8 * j; const LAS float* s = scr + (8 * c) * 33 + n;
        const int dr = (mode & 1) ? w1_dest_row(n0 + n) : (n0 + n);
        if (mode & 2) {
            u32x2 o; o.x = pk4_fp8(s[0 * 33] * 32.f, s[1 * 33] * 32.f, s[2 * 33] * 32.f, s[3 * 33] * 32.f); o.y = pk4_fp8(s[4 * 33] * 32.f, s[5 * 33] * 32.f, s[6 * 33] * 32.f, s[7 * 33] * 32.f);
            *(u32x2*)((unsigned char*)WT + (size_t)dr * K + k0 + 8 * c) = o;
        } else {
            u32x4 o; o.x = pk2(s[0 * 33], s[1 * 33]); o.y = pk2(s[2 * 33], s[3 * 33]); o.z = pk2(s[4 * 33], s[5 * 33]); o.w = pk2(s[6 * 33], s[7 * 33]);
            *(u32x4*)(WT + (size_t)dr * K + k0 + 8 * c) = o; } }
    asm volatile("s_waitcnt lgkmcnt(0)" ::: "memory"); __builtin_amdgcn_wave_barrier();
}
__device__ __forceinline__ void convert_task(const float* src, bf16_t* dst, size_t base, int lane) {
#pragma unroll
    for (int it = 0; it < 8; ++it) { const size_t i = base + (size_t)it * 512 + lane * 8;
        const f32x4 a = *(const f32x4*)(src + i), b = *(const f32x4*)(src + i + 4);
        u32x4 o; o.x = pk2(a[0], a[1]); o.y = pk2(a[2], a[3]); o.z = pk2(b[0], b[1]); o.w = pk2(b[2], b[3]);
        *(u32x4*)(dst + i) = o; }
}
__device__ __forceinline__ void fp8_rows_task(const float* src, unsigned char* dst, unsigned char* sinv, size_t row0, int lane) {
#pragma unroll 2
    for (int r = 0; r < 8; ++r) { const size_t row = row0 + r;
        f32x4 v[4]; float am = 0.f;
#pragma unroll
        for (int j = 0; j < 4; ++j) { v[j] = *(const f32x4*)(src + row * 1024 + 16 * lane + 4 * j);
            am = fmaxf(am, fmaxf(fmaxf(fabsf(v[j].x), fabsf(v[j].y)), fmaxf(fabsf(v[j].z), fabsf(v[j].w)))); }
#pragma unroll
        for (int o = 1; o < 64; o <<= 1) am = fmaxf(am, __shfl_xor(am, o));
        unsigned be = (__float_as_uint(am) >> 23) & 0xffu; be = be < 8u ? 8u : be;
        const float sc = __uint_as_float((261u - be) << 23);
        u32x4 w;
#pragma unroll
        for (int j = 0; j < 4; ++j) { int pk = 0;
            pk = __builtin_amdgcn_cvt_pk_fp8_f32(v[j].x * sc, v[j].y * sc, pk, false);
            pk = __builtin_amdgcn_cvt_pk_fp8_f32(v[j].z * sc, v[j].w * sc, pk, true);
            w[j] = (unsigned)pk; }
        const size_t l = row / NEXP, e = row % NEXP;
        *(u32x4*)(dst + (((l * 8 + (size_t)(lane >> 3)) * NEXP + e) * 128) + 16 * (lane & 7)) = w;
        if (lane == 0) sinv[row] = (unsigned char)(be - 7u); }
}
__device__ __forceinline__ void table_task(const Ctx& C, int t) {
    CArgs& a = *C.a; unsigned char* ws = a.ws;
    if (t < 4096) fp8_rows_task(a.in[I_PU], ws + WS_TU, ws + WS_SIU, (size_t)t * 8, C.lane);
    else fp8_rows_task(a.in[I_PV], ws + WS_TV, ws + WS_SIV, (size_t)(t - 4096) * 8, C.lane);
}
__device__ __forceinline__ void phaseA(const Ctx& C) {
    CArgs& a = *C.a; unsigned char* ws = a.ws;
    LAS float* S = (LAS float*)C.lds;
    for (int i = C.tid; i < 9 * 1024; i += 512) { const int row = i >> 10, k = i & 1023; const float c = row < 8 ? a.in[I_C][row * 1024 + k] : a.in[I_CCTX][k]; S[i] = c / (1.f + __expf(-c)); }
    __syncthreads();
    LAS float* scr = (LAS float*)(C.lds + 40960 + C.wid * 8448);
    const int gw = C.wid * C.G + C.bid, NGW = C.G * 8;
    constexpr int T_ADA = 1536, T_W1 = 16 * 80, T_W2 = 16 * 32, T_SI = 16 * 64, T_SO = 16 * 32, T_WQ = 2 * 16 * 64;
    constexpr int T_KEYS = 2 * 8 * 2 * 128 * 128 / 4096, T_WSP = 8 * 128 * 128 / 4096;
    constexpr int NT = T_ADA + T_W1 + T_W2 + T_SI + T_SO + T_WQ + T_KEYS + T_WSP;
    float* modp = (float*)(ws + WS_MODP);
    for (int T = gw; T < NT; T += NGW) {
        int t = T;
        if (t < T_ADA) {
            const int l = t / 768, r = t % 768, cb = r >> 3, ks = r & 7;
            const int kg = C.lane >> 4, c4 = 4 * (C.lane & 15);
            const float* W = a.in[I_ADAW] + (size_t)l * 1024 * 6144 + (size_t)(ks * 128 + kg) * 6144 + cb * 64 + c4;
            f32x4 acc[9];
#pragma unroll
            for (int q = 0; q < 9; ++q) acc[q] = (f32x4){0.f, 0.f, 0.f, 0.f};
#pragma unroll 1
            for (int k0 = 0; k0 < 128; k0 += 32) {
                f32x4 w[8];
#pragma unroll
                for (int i = 0; i < 8; ++i) w[i] = *(const f32x4*)(W + (size_t)(k0 + 4 * i) * 6144);
#pragma unroll
                for (int i = 0; i < 8; ++i)
#pragma unroll
                    for (int q = 0; q < 9; ++q) acc[q] += S[q * 1024 + ks * 128 + k0 + 4 * i + kg] * w[i];
            }
#pragma unroll
            for (int q = 0; q < 9; ++q)
#pragma unroll
                for (int e = 0; e < 4; ++e) { float v = acc[q][e]; v += __shfl_xor(v, 16); v += __shfl_xor(v, 32); acc[q][e] = v; }
            if (C.lane < 16) { float* P = modp + ((size_t)(l * 8 + ks) * 9) * 6144 + cb * 64 + c4;
#pragma unroll
                for (int q = 0; q < 9; ++q) *(f32x4*)(P + (size_t)q * 6144) = acc[q]; }
            continue;
        }
        t -= T_ADA;
        if (t < T_W1) { transpose_item(a.in[I_WIN], 1024, 2560, (bf16_t*)(ws + WS_W1T), t, scr, C.lane, 3); continue; } t -= T_W1;
        if (t < T_W2) { transpose_item(a.in[I_WOUT], 1024, 1024, (bf16_t*)(ws + WS_W2T), t, scr, C.lane, 2); continue; } t -= T_W2;
        if (t < T_SI) { transpose_item(a.in[I_SGUIN], 1024, 2048, (bf16_t*)(ws + WS_WSI), t, scr, C.lane, 2); continue; } t -= T_SI;
        if (t < T_SO) { transpose_item(a.in[I_SGUOUT], 1024, 1024, (bf16_t*)(ws + WS_WSO), t, scr, C.lane, 2); continue; } t -= T_SO;
        if (t < T_WQ) { const int l = t / 1024; transpose_item(a.in[I_WQ] + (size_t)l * 1024 * 2048, 1024, 2048, (bf16_t*)(ws + WS_WQ + (size_t)l * 2048 * 1024 * (WQ_FP8 ? 1 : 2)), t % 1024, scr, C.lane, WQ_FP8 ? 2 : 0); continue; } t -= T_WQ;
        if (t < T_KEYS) { convert_task(a.in[I_KEYS], (bf16_t*)(ws + WS_KEYS), (size_t)t * 4096, C.lane); continue; } t -= T_KEYS;
        convert_task(a.in[I_WS], (bf16_t*)(ws + WS_WSP), (size_t)t * 4096, C.lane);
    }
}

template <int NR>
__device__ __forceinline__ void rows_load(f32x4 (&v)[NR][4], const float* xrow0, int lane) {
#pragma unroll
    for (int r = 0; r < NR; ++r)
#pragma unroll
        for (int j = 0; j < 4; ++j) v[r][j] = *((const f32x4*)(xrow0 + (size_t)r * D) + lane + 64 * j);
}
template <int NR>
__device__ __forceinline__ void rows_finish(const f32x4 (&v)[NR][4], bf16_t* orow0, const LAS float* GS, const LAS float* SH, int lane) {
#pragma unroll
    for (int r = 0; r < NR; ++r) {
        float s = 0.f;
#pragma unroll
        for (int j = 0; j < 4; ++j) s += (v[r][j].x * v[r][j].x + v[r][j].y * v[r][j].y) + (v[r][j].z * v[r][j].z + v[r][j].w * v[r][j].w);
        const float rinv = rsqrtf(wave_sum(s) * (1.f / D) + EPS);
        unsigned* o8 = (unsigned*)((unsigned char*)orow0 + (size_t)r * D) + lane;
#pragma unroll
        for (int j = 0; j < 4; ++j) { const f32x4 g = *(const LAS f32x4*)(GS + 4 * lane + 256 * j), h = *(const LAS f32x4*)(SH + 4 * lane + 256 * j);
            const f32x4 y = v[r][j] * rinv * g + h;
            o8[64 * j] = pk4_fp8(y.x, y.y, y.z, y.w); }
    }
}
template <int NR>
__device__ __forceinline__ void modulate_rows(const float* xrow0, bf16_t* orow0, const LAS float* GS, const LAS float* SH, int lane) {
    f32x4 v[NR][4];
    rows_load<NR>(v, xrow0, lane);
    rows_finish<NR>(v, orow0, GS, SH, lane);
}

template <int NR, bool OUT8, bool ALSO8 = false>
__device__ __forceinline__ void modulate_rows_h(const bf16_t* hrow0, void* orow0v, const LAS float* GS, const LAS float* SH, int lane, unsigned char* also8 = nullptr) {
    u32x4 v[NR][2];
#pragma unroll
    for (int r = 0; r < NR; ++r)
#pragma unroll
        for (int j = 0; j < 2; ++j) v[r][j] = *(const u32x4*)(hrow0 + (size_t)r * D + 512 * j + 8 * lane);
#pragma unroll
    for (int r = 0; r < NR; ++r) {
        float x[16]; float s = 0.f;
#pragma unroll
        for (int j = 0; j < 2; ++j)
#pragma unroll
            for (int e = 0; e < 4; ++e) { x[8 * j + 2 * e] = bf_lo(v[r][j][e]); x[8 * j + 2 * e + 1] = bf_hi(v[r][j][e]); }
#pragma unroll
        for (int e = 0; e < 16; ++e) s += x[e] * x[e];
        const float rinv = rsqrtf(wave_sum(s) * (1.f / D) + EPS);
#pragma unroll
        for (int j = 0; j < 2; ++j) { float y[8];
#pragma unroll
            for (int q = 0; q < 2; ++q) { const f32x4 g = *(const LAS f32x4*)(GS + 512 * j + 8 * lane + 4 * q), h = *(const LAS f32x4*)(SH + 512 * j + 8 * lane + 4 * q);
#pragma unroll
                for (int e = 0; e < 4; ++e) y[4 * q + e] = x[8 * j + 4 * q + e] * rinv * g[e] + h[e]; }
            if (OUT8) { u32x2 w; w.x = pk4_fp8(y[0], y[1], y[2], y[3]); w.y = pk4_fp8(y[4], y[5], y[6], y[7]);
                *(u32x2*)((unsigned char*)orow0v + (size_t)r * D + 512 * j + 8 * lane) = w; }
            else { u32x4 w; w.x = pk2(y[0], y[1]); w.y = pk2(y[2], y[3]); w.z = pk2(y[4], y[5]); w.w = pk2(y[6], y[7]);
                *(u32x4*)((bf16_t*)orow0v + (size_t)r * D + 512 * j + 8 * lane) = w; }
            if (ALSO8) { u32x2 w; w.x = pk4_fp8(y[0], y[1], y[2], y[3]); w.y = pk4_fp8(y[4], y[5], y[6], y[7]);
                *(u32x2*)(also8 + (size_t)r * D + 512 * j + 8 * lane) = w; } }
    }
}

__device__ __forceinline__ void phaseB(const Ctx& C) {
    CArgs& a = *C.a; unsigned char* ws = a.ws;
    const float* modp = (const float*)(ws + WS_MODP); float* modf = (float*)(ws + WS_MODF);
    {
        const int e = C.bid * 512 + C.tid;
        if (e < 2 * 9 * 6144) { const int l = e / (9 * 6144), rem = e % (9 * 6144), row = rem / 6144, j = rem % 6144;
            float v = a.in[I_ADAB][l * 6144 + j];
#pragma unroll
            for (int ks = 0; ks < 8; ++ks) v += modp[((size_t)(l * 8 + ks) * 9 + row) * 6144 + j];
            modf[e] = v; }
    }
    LAS float* GS = (LAS float*)C.lds; LAS float* SH = GS + 1024;
    bf16_t* A = (bf16_t*)(ws + WS_A);
    for (int part = 0; part < 2; ++part) {
        const int rb = part == 0 ? (C.bid * 128) / SEQ : 8;
        __syncthreads();
        for (int c = C.tid; c < 1024; c += 512) {
            float sh = a.in[I_ADAB][c], sc = a.in[I_ADAB][1024 + c];
#pragma unroll
            for (int ks = 0; ks < 8; ++ks) { sh += modp[((size_t)(0 * 8 + ks) * 9 + rb) * 6144 + c]; sc += modp[((size_t)(0 * 8 + ks) * 9 + rb) * 6144 + 1024 + c]; }
            GS[c] = a.in[I_N1G][c] * (1.f + sc); SH[c] = sh;
        }
        __syncthreads();
        unsigned char* A8 = ws + WS_A8;
        if (part == 0) {
            const int r0 = C.bid * 128 + C.wid * 16; const float* X = a.in[I_X] + (size_t)r0 * D; unsigned char* O = A8 + (size_t)r0 * D;
            f32x4 va[4][4], vb[4][4];
            rows_load<4>(va, X, C.lane);
            rows_load<4>(vb, X + 4 * D, C.lane);   rows_finish<4>(va, (bf16_t*)O, GS, SH, C.lane);
            rows_load<4>(va, X + 8 * D, C.lane);   rows_finish<4>(vb, (bf16_t*)(O + 4 * D), GS, SH, C.lane);
            rows_load<4>(vb, X + 12 * D, C.lane);  rows_finish<4>(va, (bf16_t*)(O + 8 * D), GS, SH, C.lane);
            rows_finish<4>(vb, (bf16_t*)(O + 12 * D), GS, SH, C.lane); }
        else { const int r = C.bid * 8 + C.wid; modulate_rows<1>(a.in[I_CTX] + (size_t)r * D, (bf16_t*)(A8 + (size_t)(M + r) * D), GS, SH, C.lane); }
    }
}

__device__ __forceinline__ void conv_tile(const Ctx& C, int tile) {
    CArgs& a = *C.a; unsigned char* ws = a.ws;
    const bf16_t* GLU = (const bf16_t*)(ws + WS_GLU); unsigned char* Y8 = ws + WS_A8;
    const int b = tile >> 6, t0 = (tile & 63) * 64;
    __syncthreads();
    for (int i = C.tid; i < 94 * 64; i += 512) { const int row = i >> 6, ch = i & 63, t = t0 - 15 + row;
        u32x4 v = (u32x4){0u, 0u, 0u, 0u};
        if (t >= 0 && t < SEQ) v = *(const u32x4*)(GLU + ((size_t)(b * SEQ + t)) * 512 + ch * 8);
        *(LAS u32x4*)(C.lds + (size_t)i * 16) = v; }
    __syncthreads();
    const int half = C.tid >> 8, cp = C.tid & 255;
    float w0[31], w1[31];
#pragma unroll
    for (int j = 0; j < 31; ++j) { const f32x2 w = *(const f32x2*)(a.in[I_CONVW] + j * 512 + 2 * cp); w0[j] = w.x; w1[j] = w.y; }
    const f32x2 cb = *(const f32x2*)(a.in[I_CONVB] + 2 * cp), gg = *(const f32x2*)(a.in[I_GNG] + 2 * cp), gb = *(const f32x2*)(a.in[I_GNB] + 2 * cp);
    const LAS unsigned* L = (const LAS unsigned*)C.lds;
#pragma unroll 1
    for (int sb = 0; sb < 4; ++sb) {
        const int ob = 32 * half + 8 * sb;
        float a0[8], a1[8], x0[38], x1[38];
#pragma unroll
        for (int i = 0; i < 38; ++i) { const unsigned u = L[(ob + i) * 256 + cp]; x0[i] = bf_lo(u); x1[i] = bf_hi(u); }
#pragma unroll
        for (int o = 0; o < 8; ++o) { float s0 = cb.x, s1 = cb.y;
#pragma unroll
            for (int j = 0; j < 31; ++j) { s0 += w0[j] * x0[o + j]; s1 += w1[j] * x1[o + j]; }
            a0[o] = s0; a1[o] = s1; }
#pragma unroll
        for (int o = 0; o < 8; ++o) {
            const float s = sum32(a0[o] + a1[o]);
            const float mu = s * (1.f / 64.f), d0 = a0[o] - mu, d1 = a1[o] - mu;
            const float q = sum32(d0 * d0 + d1 * d1);
            const float rstd = rsqrtf(q * (1.f / 64.f) + EPS);
            const float y0 = d0 * rstd * gg.x + gb.x, y1 = d1 * rstd * gg.y + gb.y;
            *(unsigned short*)(Y8 + ((size_t)(b * SEQ + t0 + ob + o)) * D + 2 * cp) = (unsigned short)(pk4_fp8(y0 * sigmoidf_(y0), y1 * sigmoidf_(y1), 0.f, 0.f) & 0xffffu);
        }
    }
}

template <bool WIN>
__device__ __forceinline__ void att_softmax(f32x16& S, float& mrun, float& lrun, f32x16& O0, f32x16& O1, bf16x8 (&pb)[2], int W, const LAS float* bp) {
    if (WIN) {
        float bias[16];
#pragma unroll
        for (int e = 0; e < 16; ++e) bias[e] = bp[(e & 3) + 8 * (e >> 2)];
#pragma unroll
        for (int e = 0; e < 16; ++e) asm volatile("" : "+v"(bias[e]));
#pragma unroll
        for (int e = 0; e < 16; ++e) { const int m = __builtin_amdgcn_sbfe(W, (e & 3) + 8 * (e >> 2), 1);
            S[e] = __int_as_float((__float_as_int(S[e] + bias[e]) & m) | (__float_as_int(-1e30f) & ~m)); }
    }
    float mt = S[0];
#pragma unroll
    for (int e = 1; e < 16; ++e) mt = fmaxf(mt, S[e]);
    mt = fmaxf(mt, __shfl_xor(mt, 32));
    const float mn = fmaxf(mrun, mt), alpha = __builtin_amdgcn_exp2f(mrun - mn);
    mrun = mn;
    float ps = 0.f; float p[16];
#pragma unroll
    for (int e = 0; e < 16; ++e) { p[e] = __builtin_amdgcn_exp2f(S[e] - mn); ps += p[e]; }
    lrun = lrun * alpha + ps;
    if (!__all(alpha == 1.f)) {
#pragma unroll
        for (int e = 0; e < 16; ++e) { O0[e] *= alpha; O1[e] *= alpha; }
    }
#pragma unroll
    for (int s2 = 0; s2 < 2; ++s2) { u32x4 w; w.x = pk2(p[8 * s2 + 0], p[8 * s2 + 1]); w.y = pk2(p[8 * s2 + 2], p[8 * s2 + 3]); w.z = pk2(p[8 * s2 + 4], p[8 * s2 + 5]); w.w = pk2(p[8 * s2 + 6], p[8 * s2 + 7]);
        pb[s2] = __builtin_bit_cast(bf16x8, w); }
}
__device__ __forceinline__ void attn_task(const Ctx& C, int task) {
    CArgs& a = *C.a; unsigned char* ws = a.ws;
    const bf16_t* Qb = (const bf16_t*)(ws + WS_Q); const bf16_t* Kb = (const bf16_t*)(ws + WS_K); const bf16_t* Vb = (const bf16_t*)(ws + WS_V);
    unsigned char* Y8 = ws + WS_A8;
    const int h = task & 7, ch = (task >> 3) & 1, rp = (task >> 4) & 31, b = task >> 9;
    const int lane = C.lane, n = lane & 31, hh = lane >> 5;
    const int krA = 2 * rp - 4 < 0 ? 0 : (2 * rp - 4 > 56 ? 56 : 2 * rp - 4), krB = 2 * rp - 3 < 0 ? 0 : (2 * rp - 3 > 56 ? 56 : 2 * rp - 3);
    const int nr = krB + 8 - krA;
    LAS unsigned char* lw = C.lds + C.wid * 14592;
    LAS unsigned char* KT = lw; LAS unsigned char* VT = lw + 5760;
    LAS float* RP = (LAS float*)(lw + 11520);
    for (int i = lane; i < 465; i += 64) RP[64 + i] = a.in[I_RPB][h * 465 + i] * 1.44269504f;
    const int rq = 2 * rp + (n >> 4), kr0q = rq - 4 < 0 ? 0 : (rq - 4 > 56 ? 56 : rq - 4);
    int qtok[2], bs[2], Wq[2]; const LAS float* bp0[2];
#pragma unroll
    for (int qb = 0; qb < 2; ++qb) {
        const int j = 2 * ch + qb, qc = 16 * j + (n & 15);
        qtok[qb] = b * SEQ + rq * 64 + qc;
        bs[qb] = 16 * j - 8 < 0 ? 0 : (16 * j - 8 > 32 ? 32 : 16 * j - 8);
        const int cs = qc - 8 < 0 ? 0 : (qc - 8 > 48 ? 48 : qc - 8);
        int tq = bs[qb] + 4 * hh - cs; tq = tq < -32 ? -32 : (tq > 31 ? 31 : tq);
        Wq[qb] = (int)(unsigned)((0xFFFFull << 32) >> (32 + tq));
        bp0[qb] = RP + 64 + (krA - rq + 7) * 31 + bs[qb] + 4 * hh - qc + 15;
    }
    bf16x8 bq[2][4];
#pragma unroll
    for (int qb = 0; qb < 2; ++qb)
#pragma unroll
        for (int s = 0; s < 4; ++s) bq[qb][s] = *(const bf16x8*)(Qb + (size_t)qtok[qb] * 512 + h * 64 + 16 * s + 8 * hh);
    f32x16 O[2][2];
#pragma unroll
    for (int i = 0; i < 2; ++i)
#pragma unroll
        for (int j = 0; j < 2; ++j)
#pragma unroll
            for (int e = 0; e < 16; ++e) O[i][j][e] = 0.f;
    float mrun[2] = {-1e30f, -1e30f}, lrun[2] = {0.f, 0.f};
    const int lk = lane >> 3, lc = lane & 7;
    const int ub = 24 * ch;
    u32x4 kq[5], vq[5];
#define ATT_FETCH(NI_, tok_) do { const size_t tb_ = (size_t)(tok_) + lk; _Pragma("unroll") for (int i = 0; i < NI_; ++i) { \
        kq[i] = *(const u32x4*)(Kb + (tb_ + 8 * i) * 512 + h * 64 + lc * 8); vq[i] = *(const u32x4*)(Vb + (tb_ + 8 * i) * 512 + h * 64 + lc * 8); } } while (0)
#define ATT_STAGE(NI_) do { _Pragma("unroll") for (int i = 0; i < NI_; ++i) { *(LAS u32x4*)(KT + (8 * i + lk) * 144 + lc * 16) = kq[i]; *(LAS u32x4*)(VT + (8 * i + lk) * 144 + lc * 16) = vq[i]; } } while (0)
    typedef short s4v __attribute__((ext_vector_type(4)));
    const LAS unsigned char* vp0 = VT + (4 * hh + ((lane & 15) >> 2)) * 144 + (16 * ((lane >> 4) & 1) + 4 * (lane & 3)) * 2;
#define ATT_VA(db_, s2_, k0_) ({ const LAS unsigned char* vp_ = vp0 + (16 * (s2_) + (k0_)) * 144 + 64 * (db_); \
        const s4v lo_ = __builtin_amdgcn_ds_read_tr16_b64_v4i16((LAS s4v*)vp_), hi_ = __builtin_amdgcn_ds_read_tr16_b64_v4i16((LAS s4v*)(vp_ + 8 * 144)); \
        (bf16x8)__builtin_shufflevector(lo_, hi_, 0, 1, 2, 3, 4, 5, 6, 7); })
    ATT_FETCH(4, M + b * CTXL);
#pragma unroll 1
    for (int kt = 0; kt < 8; ++kt) {
        ATT_STAGE(4);
        if (kt < 7) ATT_FETCH(4, M + b * CTXL + 32 * (kt + 1)); else ATT_FETCH(5, b * SEQ + krA * 64 + ub);
        bf16x8 kf[4];
#pragma unroll
        for (int s = 0; s < 4; ++s) kf[s] = *(const LAS bf16x8*)(KT + n * 144 + 32 * s + 16 * hh);
        bf16x8 pb[2][2];
#pragma unroll
        for (int qb = 0; qb < 2; ++qb) {
            f32x16 S;
#pragma unroll
            for (int e = 0; e < 16; ++e) S[e] = 0.f;
#pragma unroll
            for (int s = 0; s < 4; ++s) S = __builtin_amdgcn_mfma_f32_32x32x16_bf16(kf[s], bq[qb][s], S, 0, 0, 0);
            att_softmax<false>(S, mrun[qb], lrun[qb], O[0][qb], O[1][qb], pb[qb], 0, RP);
        }
#pragma unroll
        for (int db = 0; db < 2; ++db)
#pragma unroll
            for (int s2 = 0; s2 < 2; ++s2) { const bf16x8 va = ATT_VA(db, s2, 0);
#pragma unroll
                for (int qb = 0; qb < 2; ++qb) O[db][qb] = __builtin_amdgcn_mfma_f32_32x32x16_bf16(va, pb[qb][s2], O[db][qb], 0, 0, 0); }
    }
#pragma unroll 1
    for (int i = 0; i < nr; ++i) {
        const int W = ((unsigned)(krA + i - kr0q) < 8u) ? -1 : 0;
        ATT_STAGE(5);
        ATT_FETCH(5, b * SEQ + (krA + (i + 1 < nr ? i + 1 : i)) * 64 + ub);
#pragma unroll
        for (int qb = 0; qb < 2; ++qb) {
            bf16x8 kf[4];
#pragma unroll
            for (int s = 0; s < 4; ++s) kf[s] = *(const LAS bf16x8*)(KT + (n + 8 * qb) * 144 + 32 * s + 16 * hh);
            f32x16 S;
#pragma unroll
            for (int e = 0; e < 16; ++e) S[e] = 0.f;
#pragma unroll
            for (int s = 0; s < 4; ++s) S = __builtin_amdgcn_mfma_f32_32x32x16_bf16(kf[s], bq[qb][s], S, 0, 0, 0);
            bf16x8 pb[2];
            att_softmax<true>(S, mrun[qb], lrun[qb], O[0][qb], O[1][qb], pb, Wq[qb] & W, bp0[qb] + 31 * i);
#pragma unroll
            for (int db = 0; db < 2; ++db)
#pragma unroll
                for (int s2 = 0; s2 < 2; ++s2) { const bf16x8 va = ATT_VA(db, s2, 8 * qb); O[db][qb] = __builtin_amdgcn_mfma_f32_32x32x16_bf16(va, pb[s2], O[db][qb], 0, 0, 0); }
        }
    }
#undef ATT_FETCH
#undef ATT_STAGE
#undef ATT_VA
#pragma unroll
    for (int qb = 0; qb < 2; ++qb) {
        const float lt = lrun[qb] + __shfl_xor(lrun[qb], 32), inv = 1.f / lt;
        unsigned char* yrow = Y8 + (size_t)qtok[qb] * D + 512 + h * 64;
#pragma unroll
        for (int db = 0; db < 2; ++db)
#pragma unroll
            for (int g = 0; g < 4; ++g)
                *(unsigned*)(yrow + 32 * db + 8 * g + 4 * hh) = pk4_fp8(O[db][qb][4 * g] * inv, O[db][qb][4 * g + 1] * inv, O[db][qb][4 * g + 2] * inv, O[db][qb][4 * g + 3] * inv);
    }
}

__device__ __forceinline__ void phaseNorm2(const Ctx& C, int l) {
    CArgs& a = *C.a; unsigned char* ws = a.ws;
    const float* modf = (const float*)(ws + WS_MODF) + (size_t)l * 9 * 6144;
    LAS float* GS = (LAS float*)C.lds; LAS float* SH = GS + 1024;
    const int b = (C.bid * 128) / SEQ;
    for (int c = C.tid; c < 1024; c += 512) { GS[c] = a.in[I_N2G][l * 1024 + c] * (1.f + modf[b * 6144 + 4 * 1024 + c]); SH[c] = modf[b * 6144 + 3 * 1024 + c]; }
    __syncthreads();
    bf16_t* A = (bf16_t*)(ws + WS_A);
    const bf16_t* Hb = (const bf16_t*)(ws + WS_H);
    { const int r = C.bid * 128 + C.wid * 16; modulate_rows_h<16, false, WQ_FP8 != 0>(Hb + (size_t)r * D, A + (size_t)r * D, GS, SH, C.lane, ws + WS_A8 + (size_t)r * D); }
}

__device__ __forceinline__ void ce_desc(float& x, float& y) { const float hi = fmaxf(x, y), lo = fminf(x, y); x = hi; y = lo; }
__device__ __forceinline__ void ce_asc(float& x, float& y) { const float hi = fmaxf(x, y), lo = fminf(x, y); x = lo; y = hi; }
__device__ __forceinline__ void sort16_desc(float (&v)[16]) {
#define CE(a_, b_) ce_desc(v[a_], v[b_]);
    CE(0,13) CE(1,12) CE(2,15) CE(3,14) CE(4,8) CE(5,6) CE(7,11) CE(9,10)
    CE(0,5) CE(1,7) CE(2,9) CE(3,4) CE(6,13) CE(8,14) CE(10,15) CE(11,12)
    CE(0,1) CE(2,3) CE(4,5) CE(6,8) CE(7,9) CE(10,11) CE(12,13) CE(14,15)
    CE(0,2) CE(1,3) CE(4,10) CE(5,11) CE(6,7) CE(8,9) CE(12,14) CE(13,15)
    CE(1,2) CE(3,12) CE(4,6) CE(5,7) CE(8,10) CE(9,11) CE(13,14)
    CE(1,4) CE(2,6) CE(5,8) CE(7,10) CE(9,13) CE(11,14)
    CE(2,4) CE(3,6) CE(9,12) CE(11,13)
    CE(3,5) CE(6,8) CE(7,9) CE(10,12)
    CE(3,4) CE(5,6) CE(7,8) CE(9,10) CE(11,12)
    CE(6,7) CE(8,9)
#undef CE
}
__device__ __forceinline__ void merge16_desc(float (&A)[16], const float (&B)[16]) {
#pragma unroll
    for (int i = 0; i < 16; ++i) A[i] = fmaxf(A[i], B[15 - i]);
#pragma unroll
    for (int j = 8; j > 0; j >>= 1)
#pragma unroll
        for (int i = 0; i < 16; ++i) { const int l = i ^ j; if (l > i) ce_desc(A[i], A[l]); }
}
__device__ __forceinline__ bf16x8 topk_qfrag(const bf16_t* QP, int tok, int h, int p, int hh, int s) { return *(const bf16x8*)(QP + (size_t)tok * 2048 + h * 256 + p * 128 + 64 * hh + 8 * s); }
__device__ __forceinline__ void topk_task(const Ctx& C, int l, int tok0, int ntok0, int h, const LAS unsigned char* KL, bf16x8 (&bq)[2][8]) {
    CArgs& a = *C.a; unsigned char* ws = a.ws;
    const bf16_t* QP = (const bf16_t*)(ws + WS_QP);
    unsigned short* IDX = (unsigned short*)(ws + WS_IDX); float* WT = (float*)(ws + WS_WT);
    const int lane = C.lane, n = lane & 31, hh = lane >> 5;
    const int tok = tok0 + n;
    float sp[2][16];
#pragma unroll
    for (int p = 0; p < 2; ++p) {
        float top[16];
#pragma unroll
        for (int kb = 0; kb < 4; ++kb) {
            f32x16 S;
#pragma unroll
            for (int e = 0; e < 16; ++e) S[e] = 0.f;
#pragma unroll
            for (int s = 0; s < 8; ++s) { const bf16x8 kf = *(const LAS bf16x8*)(KL + (p * 128 + 32 * kb + n) * 272 + 128 * hh + 16 * s);
                S = __builtin_amdgcn_mfma_f32_32x32x16_bf16(kf, bq[p][s], S, 0, 0, 0); }
            if (kb == 3) {
#pragma unroll
                for (int s = 0; s < 8; ++s) bq[p][s] = topk_qfrag(QP, ntok0 + n, h, p, hh, s); }
            float ch[16];
#pragma unroll
            for (int e = 0; e < 16; ++e) { const unsigned key = 32 * kb + (e & 3) + 8 * (e >> 2) + 4 * hh; ch[e] = __uint_as_float((__float_as_uint(S[e]) & ~0x7Fu) | key); }
            sort16_desc(ch);
            if (kb == 0) {
#pragma unroll
                for (int e = 0; e < 16; ++e) top[e] = ch[e];
            } else merge16_desc(top, ch);
        }
        float oth[16];
#pragma unroll
        for (int e = 0; e < 16; ++e) oth[e] = __shfl_xor(top[e], 32);
        merge16_desc(top, oth);
#pragma unroll
        for (int e = 0; e < 16; ++e) sp[p][e] = top[e];
    }
    const float NEG = -3.0e38f;
    auto cand = [&](int ia, int ib) -> float { const float s = sp[0][ia] + sp[1][ib]; return __uint_as_float((__float_as_uint(s) & ~0xFFu) | (unsigned)((ia << 4) | ib)); };
    float L1[16], L2[16], L3[16], L4[16];
#pragma unroll
    for (int i = 0; i < 16; ++i) { L1[i] = cand(0, i); L2[i] = i < 15 ? cand(i + 1, 0) : NEG; L4[i] = NEG; }
#pragma unroll
    for (int i = 0; i < 7; ++i) L3[i] = cand(1, i + 1);
#pragma unroll
    for (int i = 0; i < 6; ++i) L3[7 + i] = cand(i + 2, 1);
#pragma unroll
    for (int i = 0; i < 3; ++i) L3[13 + i] = cand(2, i + 2);
    L4[0] = cand(3, 2); L4[1] = cand(4, 2); L4[2] = cand(3, 3);
    sort16_desc(L3);
    ce_desc(L4[0], L4[1]); ce_desc(L4[1], L4[2]); ce_desc(L4[0], L4[1]);
    merge16_desc(L1, L2); merge16_desc(L3, L4); merge16_desc(L1, L3);
    if (hh == 0) {
        float e16[16], se = 0.f;
#pragma unroll
        for (int i = 0; i < 16; ++i) { e16[i] = __expf(L1[i] - L1[0]); se += e16[i]; }
        const float inv = 1.f / se;
        LAS unsigned* tb = (LAS unsigned*)(C.lds + 69632 + C.wid * 4224) + n * 33;
#pragma unroll
        for (int i = 0; i < 16; ++i) { tb[i] = __float_as_uint(sp[0][i]) & 0x7Fu; tb[16 + i] = __float_as_uint(sp[1][i]) & 0x7Fu; }
        unsigned ids[16];
#pragma unroll
        for (int i = 0; i < 16; ++i) { const unsigned code = __float_as_uint(L1[i]) & 0xFFu; ids[i] = tb[code >> 4] * 128u + tb[16 + (code & 15u)]; }
        float su[16], sv[16];
        { const LAS unsigned char* SEU = C.lds + 103424; const LAS unsigned char* SEV = SEU + NEXP;
#pragma unroll
          for (int i = 0; i < 16; ++i) { su[i] = __uint_as_float((unsigned)SEU[ids[i]] << 23); sv[i] = __uint_as_float((unsigned)SEV[ids[i]] << 23); } }
        u32x4 w0, w1;
        w0.x = ids[0] | (ids[1] << 16); w0.y = ids[2] | (ids[3] << 16); w0.z = ids[4] | (ids[5] << 16); w0.w = ids[6] | (ids[7] << 16);
        w1.x = ids[8] | (ids[9] << 16); w1.y = ids[10] | (ids[11] << 16); w1.z = ids[12] | (ids[13] << 16); w1.w = ids[14] | (ids[15] << 16);
        u32x4* ip = (u32x4*)(IDX + (size_t)tok * 128 + h * 16); ip[0] = w0; ip[1] = w1;
        f32x4* wp = (f32x4*)(WT + (size_t)tok * 128 + h * 16);
        f32x4* sp4 = (f32x4*)((float*)(ws + WS_SU) + (size_t)tok * 128 + h * 16);
#pragma unroll
        for (int i = 0; i < 4; ++i) { wp[i] = (f32x4){e16[4 * i] * inv * sv[4 * i], e16[4 * i + 1] * inv * sv[4 * i + 1], e16[4 * i + 2] * inv * sv[4 * i + 2], e16[4 * i + 3] * inv * sv[4 * i + 3]};
            sp4[i] = (f32x4){su[4 * i], su[4 * i + 1], su[4 * i + 2], su[4 * i + 3]}; }
    }
}
__device__ __forceinline__ void phaseTopk(const Ctx& C, int l) {
    CArgs& a = *C.a; unsigned char* ws = a.ws;
    const int h = C.bid & 7, grp = C.bid >> 3;
    const bf16_t* src = (const bf16_t*)(ws + WS_KEYS) + (size_t)((l * 8 + h) * 2) * 128 * 128;
    for (int i = C.tid; i < 2 * 128 * 16; i += 512) { const int row = i >> 4, chunk = i & 15; *(LAS u32x4*)(C.lds + row * 272 + chunk * 16) = *(const u32x4*)(src + (size_t)row * 128 + chunk * 8); }
    for (int i = C.tid; i < 2048; i += 512) *(LAS u32x4*)(C.lds + 103424 + i * 16) = *(const u32x4*)(ws + (i < 1024 ? WS_SIU : WS_SIV) + (size_t)l * NEXP + (size_t)(i & 1023) * 16);
    __syncthreads();
    bf16x8 bq[2][8];
    { const bf16_t* QP = (const bf16_t*)(ws + WS_QP); const int n = C.lane & 31, hh = C.lane >> 5;
#pragma unroll
      for (int p = 0; p < 2; ++p)
#pragma unroll
          for (int s = 0; s < 8; ++s) bq[p][s] = topk_qfrag(QP, grp * 1024 + C.wid * 32 + n, h, p, hh, s); }
#pragma unroll 1
    for (int t = C.wid; t < 32; t += 8) topk_task(C, l, grp * 1024 + t * 32, grp * 1024 + (t + 8 < 32 ? t + 8 : t) * 32, h, C.lds, bq);
}

__device__ __forceinline__ int peer_dequeue(const Ctx& C, unsigned* q, int js) {
    volatile LAS unsigned* slot = (volatile LAS unsigned*)(C.lds + MISC_OFF + 64);
    __syncthreads();
    if (C.tid == 0) *slot = __hip_atomic_fetch_add(q + js, 1u, __ATOMIC_RELAXED, __HIP_MEMORY_SCOPE_AGENT);
    __syncthreads();
    return (int)*slot;
}
__device__ __forceinline__ float dot16_fp8(const u32x4 (&xf)[2], const u32x4 uw) {
    float d = 0.f;
#pragma unroll
    for (int q = 0; q < 4; ++q) { const unsigned w = uw[q];
        const bf2v lo = __builtin_amdgcn_cvt_scalef32_pk_bf16_fp8(w, 1.0f, false), hi = __builtin_amdgcn_cvt_scalef32_pk_bf16_fp8(w, 1.0f, true);
        const unsigned x0 = xf[q >> 1][2 * (q & 1)], x1 = xf[q >> 1][2 * (q & 1) + 1];
        d = __builtin_amdgcn_fdot2_f32_bf16(__builtin_bit_cast(bf2v, x0), lo, d, false);
        d = __builtin_amdgcn_fdot2_f32_bf16(__builtin_bit_cast(bf2v, x1), hi, d, false); }
    return d;
}
__device__ __forceinline__ void peerU_item(const Ctx& C, int l, int js, int tile) {
    CArgs& a = *C.a; unsigned char* ws = a.ws;
    const bf16_t* A = (const bf16_t*)(ws + WS_A); const unsigned short* IDX = (const unsigned short*)(ws + WS_IDX);
    const unsigned char* TUs = ws + WS_TU + ((size_t)(l * 8 + js) * NEXP) * 128;
    bf16_t* PD = (bf16_t*)(ws + WS_PD) + (size_t)js * M * 128;
    const int lane = C.lane, g = lane >> 3, c = lane & 7;
    LAS unsigned char* lw = C.lds + C.wid * 6144;
#pragma unroll 1
    for (int half = 0; half < 2; ++half) {
        const int tok0 = tile * 128 + C.wid * 16 + half * 8;
        { const u32x4 t0 = *(const u32x4*)((const unsigned char*)(IDX + (size_t)tok0 * 128) + lane * 16), t1 = *(const u32x4*)((const unsigned char*)(IDX + (size_t)tok0 * 128) + (lane + 64) * 16);
          *(LAS u32x4*)(lw + lane * 16) = t0; *(LAS u32x4*)(lw + (lane + 64) * 16) = t1; }
        u32x4 xf[2];
#pragma unroll
        for (int j = 0; j < 2; ++j) xf[j] = *(const u32x4*)(A + (size_t)(tok0 + g) * D + 128 * js + 16 * c + 8 * j);
        bf16_t* prow = PD + (size_t)(tok0 + g) * 128 + 2 * c;
#pragma unroll 1
        for (int kk = 0; kk < 8; ++kk) {
            const u32x4 i0 = *(const LAS u32x4*)(lw + g * 256 + kk * 32), i1 = *(const LAS u32x4*)(lw + g * 256 + kk * 32 + 16);
            u32x4 uf[16];
#pragma unroll
            for (int b = 0; b < 16; ++b) { const unsigned w = b < 8 ? i0[b >> 1] : i1[(b - 8) >> 1]; const unsigned e = (b & 1) ? (w >> 16) : (w & 0xffffu);
                uf[b] = *(const u32x4*)(TUs + (e * 128u + 16u * (unsigned)c)); }
            float v0 = 0.f, v1 = 0.f;
#pragma unroll
            for (int b = 0; b < 16; ++b) { const float d = sum8(dot16_fp8(xf, uf[b]));
                if (b & 1) v1 = (c == (b >> 1)) ? d : v1; else v0 = (c == (b >> 1)) ? d : v0; }
            *(unsigned*)(prow + 16 * kk) = pk2(v0, v1);
        }
    }
}
__device__ __forceinline__ void phasePeerCombine(const Ctx& C) {
    CArgs& a = *C.a; unsigned char* ws = a.ws;
    const u32x2* PD = (const u32x2*)(ws + WS_PD); f32x4* WT = (f32x4*)(ws + WS_WT); const f32x4* SU = (const f32x4*)(ws + WS_SU);
    const size_t n4 = (size_t)M * 128 / 4;
    const size_t stride = (size_t)C.G * 512;
#pragma unroll 1
    for (size_t i = (size_t)C.bid * 512 + C.tid; i < n4; i += 4 * stride) {
        u32x2 w[4][8]; f32x4 su[4], wt[4];
#pragma unroll
        for (int t = 0; t < 4; ++t) {
#pragma unroll
            for (int j = 0; j < 8; ++j) w[t][j] = PD[(size_t)j * n4 + i + t * stride];
            su[t] = SU[i + t * stride]; wt[t] = WT[i + t * stride]; }
#pragma unroll
        for (int t = 0; t < 4; ++t) {
            f32x4 d = (f32x4){0.f, 0.f, 0.f, 0.f};
#pragma unroll
            for (int j = 0; j < 8; ++j) d += (f32x4){bf_lo(w[t][j].x), bf_hi(w[t][j].x), bf_lo(w[t][j].y), bf_hi(w[t][j].y)};
            f32x4 o;
#pragma unroll
            for (int e = 0; e < 4; ++e) o[e] = gelu_erf(d[e] * su[t][e]) * wt[t][e];
            WT[i + t * stride] = o; }
    }
}
__device__ __forceinline__ void peerV_item(const Ctx& C, int l, int js, int tile) {
    CArgs& a = *C.a; unsigned char* ws = a.ws;
    const unsigned short* IDX = (const unsigned short*)(ws + WS_IDX); const float* CF = (const float*)(ws + WS_WT);
    const unsigned char* TVs = ws + WS_TV + ((size_t)(l * 8 + js) * NEXP) * 128;
    const int lane = C.lane, g = lane >> 3, c = lane & 7;
    const int bt = (tile * 128) / SEQ;
    const float* g5p = (const float*)(ws + WS_MODF) + (size_t)l * 9 * 6144 + bt * 6144 + 5 * 1024 + 128 * js + 16 * c;
    f32x4 g5[4];
#pragma unroll
    for (int q = 0; q < 4; ++q) g5[q] = *(const f32x4*)(g5p + 4 * q);
    LAS unsigned char* lw = C.lds + C.wid * 6144;
#pragma unroll 1
    for (int half = 0; half < 2; ++half) {
        const int tok0 = tile * 128 + C.wid * 16 + half * 8;
        { const u32x4 t0 = *(const u32x4*)((const unsigned char*)(IDX + (size_t)tok0 * 128) + lane * 16), t1 = *(const u32x4*)((const unsigned char*)(IDX + (size_t)tok0 * 128) + (lane + 64) * 16);
          u32x4 cfv[4];
#pragma unroll
          for (int j = 0; j < 4; ++j) cfv[j] = *(const u32x4*)((const unsigned char*)(CF + (size_t)tok0 * 128) + (lane + 64 * j) * 16);
          *(LAS u32x4*)(lw + lane * 16) = t0; *(LAS u32x4*)(lw + (lane + 64) * 16) = t1;
#pragma unroll
          for (int j = 0; j < 4; ++j) *(LAS u32x4*)(lw + 2048 + (lane + 64 * j) * 16) = cfv[j]; }
        float acc[16];
#pragma unroll
        for (int e = 0; e < 16; ++e) acc[e] = 0.f;
#pragma unroll 1
        for (int kk = 0; kk < 8; ++kk) {
            const u32x4 i0 = *(const LAS u32x4*)(lw + g * 256 + kk * 32), i1 = *(const LAS u32x4*)(lw + g * 256 + kk * 32 + 16);
            u32x4 vf[16];
#pragma unroll
            for (int b = 0; b < 16; ++b) { const unsigned w = b < 8 ? i0[b >> 1] : i1[(b - 8) >> 1]; const unsigned e = (b & 1) ? (w >> 16) : (w & 0xffffu);
                vf[b] = *(const u32x4*)(TVs + (e * 128u + 16u * (unsigned)c)); }
            f32x4 cf[4];
#pragma unroll
            for (int q = 0; q < 4; ++q) cf[q] = *(const LAS f32x4*)(lw + 2048 + g * 512 + kk * 64 + 16 * q);
#pragma unroll
            for (int b = 0; b < 16; ++b) { const float ck = cf[b >> 2][b & 3];
#pragma unroll
                for (int q = 0; q < 4; ++q) { const unsigned vw = vf[b][q];
                    const f32x2 lo = __builtin_amdgcn_cvt_pk_f32_fp8(vw, false), hi = __builtin_amdgcn_cvt_pk_f32_fp8(vw, true);
                    acc[4 * q] += ck * lo.x; acc[4 * q + 1] += ck * lo.y; acc[4 * q + 2] += ck * hi.x; acc[4 * q + 3] += ck * hi.y; } }
        }
        bf16_t* hp = (bf16_t*)(ws + WS_H) + (size_t)(tok0 + g) * D + 128 * js + 16 * c;
        const u32x4 h0 = *(const u32x4*)hp, h1 = *(const u32x4*)(hp + 8);
        u32x4 o0, o1;
#pragma unroll
        for (int e = 0; e < 4; ++e) { o0[e] = pk2(bf_lo(h0[e]) + g5[e >> 1][2 * (e & 1)] * acc[2 * e], bf_hi(h0[e]) + g5[e >> 1][2 * (e & 1) + 1] * acc[2 * e + 1]);
                                      o1[e] = pk2(bf_lo(h1[e]) + g5[2 + (e >> 1)][2 * (e & 1)] * acc[8 + 2 * e], bf_hi(h1[e]) + g5[2 + (e >> 1)][2 * (e & 1) + 1] * acc[8 + 2 * e + 1]); }
        *(u32x4*)hp = o0; *(u32x4*)(hp + 8) = o1;
    }
}
template <int WHICH> __device__ __forceinline__ void phasePeerSliced(const Ctx& C, int l) {
    const int xcc = (int)(xb_xcc_id() & 7u);
    unsigned* q = (unsigned*)(C.a->ws + WS_CTL) + 8192 + 16 * (2 * l + WHICH);
    volatile LAS unsigned* slot = (volatile LAS unsigned*)(C.lds + MISC_OFF + 64);
#pragma unroll 1
    for (int at = 0; at < 8; ++at) { const int js = (xcc + at) & 7;
        int tile = peer_dequeue(C, q, js);
#pragma unroll 1
        while (tile < M / 128) {
            unsigned nxt = 0u;
            if (C.tid == 0) nxt = __hip_atomic_fetch_add(q + js, 1u, __ATOMIC_RELAXED, __HIP_MEMORY_SCOPE_AGENT);
            if (WHICH == 0) peerU_item(C, l, js, tile); else peerV_item(C, l, js, tile);
            __syncthreads();
            if (C.tid == 0) *slot = nxt;
            __syncthreads();
            tile = (int)*slot;
        } }
}
__device__ __forceinline__ void phasePeerNorm(const Ctx& C, int l) {
    CArgs& a = *C.a; unsigned char* ws = a.ws;
    if (l == 0) {
        const float* modf = (const float*)(ws + WS_MODF) + (size_t)9 * 6144;
        LAS float* GS = (LAS float*)C.lds; LAS float* SH = GS + 1024;
        const int b = (C.bid * 128) / SEQ;
        for (int c = C.tid; c < 1024; c += 512) { GS[c] = a.in[I_N1G][1024 + c] * (1.f + modf[b * 6144 + 1024 + c]); SH[c] = modf[b * 6144 + c]; }
        __syncthreads();
        unsigned char* A8 = ws + WS_A8;
        const bf16_t* Hb = (const bf16_t*)(ws + WS_H);
        { const int r = C.bid * 128 + C.wid * 16; modulate_rows_h<16, true>(Hb + (size_t)r * D, A8 + (size_t)r * D, GS, SH, C.lane); }
    } else {
        const bf16_t* Hb = (const bf16_t*)(ws + WS_H);
        { const int r0 = C.bid * 128 + C.wid * 16;
            u32x4 v[16][2];
#pragma unroll
            for (int r = 0; r < 16; ++r)
#pragma unroll
                for (int j = 0; j < 2; ++j) v[r][j] = *(const u32x4*)(Hb + (size_t)(r0 + r) * D + 512 * j + 8 * C.lane);
#pragma unroll
            for (int r = 0; r < 16; ++r) { float x[16]; float s = 0.f;
#pragma unroll
                for (int j = 0; j < 2; ++j)
#pragma unroll
                    for (int e = 0; e < 4; ++e) { x[8 * j + 2 * e] = bf_lo(v[r][j][e]); x[8 * j + 2 * e + 1] = bf_hi(v[r][j][e]); }
#pragma unroll
                for (int e = 0; e < 16; ++e) s += x[e] * x[e];
                const float rinv = rsqrtf(wave_sum(s) * (1.f / D) + EPS);
#pragma unroll
                for (int j = 0; j < 2; ++j)
#pragma unroll
                    for (int q = 0; q < 2; ++q) { const f32x4 gg = *(const f32x4*)(a.in[I_NFG] + 512 * j + 8 * C.lane + 4 * q);
                        *(f32x4*)(a.out + (size_t)(r0 + r) * D + 512 * j + 8 * C.lane + 4 * q) = (f32x4){x[8 * j + 4 * q] * rinv * gg[0], x[8 * j + 4 * q + 1] * rinv * gg[1], x[8 * j + 4 * q + 2] * rinv * gg[2], x[8 * j + 4 * q + 3] * rinv * gg[3]}; } } }
    }
}

__device__ __forceinline__ void phaseSgu(const Ctx& C) {
    CArgs& a = *C.a; unsigned char* ws = a.ws;
    const bf16_t* U = (const bf16_t*)(ws + WS_U); const bf16_t* VV = (const bf16_t*)(ws + WS_VV); const bf16_t* WSP = (const bf16_t*)(ws + WS_WSP);
    unsigned char* A8 = ws + WS_A8;
    LAS float* ST = (LAS float*)(C.lds + 69632);
    LAS bf16_t* VT = (LAS bf16_t*)C.lds;
    const int lane = C.lane, n = lane & 31, hh = lane >> 5;
    LAS float* LG = (LAS float*)(C.lds + 70656); LAS float* LB = LG + 1024;
    LAS unsigned char* WL = C.lds + 78848;
    for (int c = C.tid; c < 1024; c += 512) { LG[c] = a.in[I_LNG][c]; LB[c] = a.in[I_LNB][c]; }
    for (int chunk = C.bid; chunk < M / 128; chunk += C.G) {
        const int tok0 = chunk * 128;
        __syncthreads();
        for (int ib = 0; ib < 16; ib += 8) {
            u32x4 vv0[8], vv1[8];
#pragma unroll
            for (int i = 0; i < 8; ++i) { const int q = C.wid * 16 + ib + i;
                vv0[i] = *(const u32x4*)(VV + (size_t)(tok0 + q) * D + 8 * lane); vv1[i] = *(const u32x4*)(VV + (size_t)(tok0 + q) * D + 512 + 8 * lane); }
#pragma unroll
            for (int i = 0; i < 8; ++i) { const int q = C.wid * 16 + ib + i;
                float x[16];
#pragma unroll
                for (int e = 0; e < 4; ++e) { x[2 * e] = bf_lo(vv0[i][e]); x[2 * e + 1] = bf_hi(vv0[i][e]); x[8 + 2 * e] = bf_lo(vv1[i][e]); x[8 + 2 * e + 1] = bf_hi(vv1[i][e]); }
                float s = 0.f;
#pragma unroll
                for (int e = 0; e < 16; ++e) s += x[e];
                const float mu = wave_sum(s) * (1.f / D); float qq = 0.f;
#pragma unroll
                for (int e = 0; e < 16; ++e) { const float d = x[e] - mu; qq += d * d; }
                const float rstd = rsqrtf(wave_sum(qq) * (1.f / D) + EPS);
                if (lane == 0) { ST[2 * q] = mu; ST[2 * q + 1] = rstd; } }
        }
        __syncthreads();
        const int cb = C.tid & 15, q0 = C.tid >> 4;
        const int cbk = C.wid & 3;
        u32x4 vreg[4], wreg[4], unext[4]; float bnext[4];
#define SGU_LOADS(g_) do { _Pragma("unroll") for (int i = 0; i < 4; ++i) vreg[i] = *(const u32x4*)(VV + (size_t)(tok0 + q0 + 32 * i) * D + (g_) * 128 + cb * 8); \
            _Pragma("unroll") for (int i = 0; i < 4; ++i) { unext[i] = *(const u32x4*)(U + (size_t)(tok0 + q0 + 32 * i) * D + (g_) * 128 + cb * 8); bnext[i] = a.in[I_BS][(g_) * 128 + q0 + 32 * i]; } \
            _Pragma("unroll") for (int i = 0; i < 4; ++i) { const int id = C.tid + 512 * i; wreg[i] = *(const u32x4*)(WSP + ((size_t)(g_) * 128 + (id >> 4)) * 128 + (id & 15) * 8); } } while (0)
        SGU_LOADS(0);
#pragma unroll 1
        for (int g = 0; g < 8; ++g) {
            LAS bf16_t* VTg = VT + (g & 1) * (128 * 136);
            u32x4 ureg[4]; float bsr[4];
#pragma unroll
            for (int i = 0; i < 4; ++i) { ureg[i] = unext[i]; bsr[i] = bnext[i]; }
            f32x4 lg0 = *(const LAS f32x4*)(LG + g * 128 + cb * 8), lg1 = *(const LAS f32x4*)(LG + g * 128 + cb * 8 + 4), lb0 = *(const LAS f32x4*)(LB + g * 128 + cb * 8), lb1 = *(const LAS f32x4*)(LB + g * 128 + cb * 8 + 4);
#pragma unroll
            for (int i = 0; i < 4; ++i) { const int q = q0 + 32 * i; const float mu = ST[2 * q], rstd = ST[2 * q + 1];
                const int col = ((((q >> 3) ^ cb) & 15) << 3) | (q & 7);
#pragma unroll
                for (int e = 0; e < 4; ++e) { const int c = cb * 8 + 2 * e;
                    const float ga = e < 2 ? lg0[2 * e] : lg1[2 * e - 4], gb = e < 2 ? lg0[2 * e + 1] : lg1[2 * e - 3];
                    const float ba = e < 2 ? lb0[2 * e] : lb1[2 * e - 4], bb = e < 2 ? lb0[2 * e + 1] : lb1[2 * e - 3];
                    const float y0 = (bf_lo(vreg[i][e]) - mu) * rstd * ga + ba;
                    const float y1 = (bf_hi(vreg[i][e]) - mu) * rstd * gb + bb;
                    const unsigned w = pk2(y0, y1);
                    VTg[c * 136 + col] = (bf16_t)(w & 0xffffu); VTg[(c + 1) * 136 + col] = (bf16_t)(w >> 16); } }
#pragma unroll
            for (int i = 0; i < 4; ++i) { const int id = C.tid + 512 * i; *(LAS u32x4*)(WL + (id >> 4) * 272 + (id & 15) * 16) = wreg[i]; }
            __syncthreads();
            if (g < 7) SGU_LOADS(g + 1);
            bf16x8 bfr[8];
#pragma unroll
            for (int s8 = 0; s8 < 8; ++s8) bfr[s8] = *(const LAS bf16x8*)(VTg + (32 * cbk + n) * 136 + ((((2 * s8 + hh) ^ ((32 * cbk + n) >> 3)) & 15) << 3));
            f32x16 S2[2];
#pragma unroll
            for (int pi = 0; pi < 2; ++pi) {
#pragma unroll
                for (int e = 0; e < 16; ++e) S2[pi][e] = 0.f;
#pragma unroll
                for (int s8 = 0; s8 < 8; ++s8) { const bf16x8 wfr = *(const LAS bf16x8*)(WL + (32 * (2 * (C.wid >> 2) + pi) + n) * 272 + 32 * s8 + 16 * hh);
                    S2[pi] = __builtin_amdgcn_mfma_f32_32x32x16_bf16(wfr, bfr[s8], S2[pi], 0, 0, 0); }
            }
            LAS unsigned char* MX = (LAS unsigned char*)(VT + ((g + 1) & 1) * (128 * 136));
#pragma unroll
            for (int pi = 0; pi < 2; ++pi) {
                const int pb = 2 * (C.wid >> 2) + pi;
#pragma unroll
                for (int e = 0; e < 16; e += 2) { const int p = 32 * pb + (e & 3) + 8 * (e >> 2) + 4 * hh;
                    const unsigned w = pk2(S2[pi][e], S2[pi][e + 1]);
                    *(LAS bf16_t*)(MX + p * 272 + (32 * cbk + n) * 2) = (bf16_t)(w & 0xffffu); *(LAS bf16_t*)(MX + (p + 1) * 272 + (32 * cbk + n) * 2) = (bf16_t)(w >> 16); }
            }
            __syncthreads();
#pragma unroll
            for (int i = 0; i < 4; ++i) { const int q = q0 + 32 * i;
                const u32x4 mx = *(const LAS u32x4*)(MX + q * 272 + cb * 16);
                float r[8];
#pragma unroll
                for (int e = 0; e < 4; ++e) { r[2 * e] = bf_lo(ureg[i][e]) * (bf_lo(mx[e]) + bsr[i]); r[2 * e + 1] = bf_hi(ureg[i][e]) * (bf_hi(mx[e]) + bsr[i]); }
                u32x2 o; o.x = pk4_fp8(r[0], r[1], r[2], r[3]); o.y = pk4_fp8(r[4], r[5], r[6], r[7]);
                *(u32x2*)(A8 + (size_t)(tok0 + q) * D + g * 128 + cb * 8) = o; }
            __syncthreads();
        }
    }
}

constexpr int NPHASES = 22;
__global__ void __launch_bounds__(512, 2) fwd_megakernel(Args args) {
    extern __shared__ __attribute__((aligned(16))) unsigned char lds_raw[];
    LAS unsigned char* lds = (LAS unsigned char*)lds_raw;
    Ctx C; C.a = (CArgs*)__builtin_amdgcn_kernarg_segment_ptr(); C.lds = lds; C.tid = threadIdx.x; C.lane = C.tid & 63; C.wid = __builtin_amdgcn_readfirstlane(C.tid >> 6); C.bid = blockIdx.x; C.G = 256;
    volatile LAS unsigned* MISC = (volatile LAS unsigned*)(lds + MISC_OFF);
    if (C.tid < 4) MISC[C.tid] = 0u;
    __syncthreads();
    unsigned char* ws = args.ws;
    const int lo = args.ph_lo, hi = args.ph_hi;
    const bool multi = (hi - lo) > 1;
    if (multi) (void)xcd_barrier_post((unsigned*)(ws + WS_CTL), MISC, C.tid == 0);
#define GRID_BARRIER() do { XcdBarrier b_; b_.bar = (unsigned*)(args.ws + WS_CTL); b_.x = xb_xcc_id(); b_.st = (volatile LAS unsigned*)(lds + MISC_OFF); \
    b_.leader = (C.wid == 0) && (__builtin_amdgcn_mbcnt_hi(~0u, __builtin_amdgcn_mbcnt_lo(~0u, 0u)) == 0u); xcd_barrier(b_); } while (0)
#if PROBE_PHASE >= 0
    volatile LAS unsigned long long* ts_l = (volatile LAS unsigned long long*)(lds + MISC_OFF + 128);
#define STAMP(k) do { if ((k) == PROBE_PHASE || (k) == PROBE_PHASE + 1) { if (C.wid == 0) ts_l[(k) - PROBE_PHASE] = __builtin_amdgcn_s_memrealtime(); } } while (0)
#else
#define STAMP(k) do { } while (0)
#endif
    int ph = 0;
#define PHASE(...) do { STAMP(ph); if (lo <= ph && ph < hi) { \
    { int l_ = (int)__builtin_amdgcn_mbcnt_hi(~0u, __builtin_amdgcn_mbcnt_lo(~0u, 0u)); asm volatile("" : "+v"(l_)); C.lane = l_; C.tid = C.wid * 64 + l_; \
      CArgs* ap_ = (CArgs*)__builtin_amdgcn_kernarg_segment_ptr(); asm volatile("" : "+s"(ap_)); C.a = ap_; } __VA_ARGS__ } if (lo <= ph && ph + 1 < hi) GRID_BARRIER(); ++ph; } while (0)
    using namespace pg8;
    const bf16_t* Abuf = (const bf16_t*)(ws + WS_A);
    const bf16_t* A8buf = (const bf16_t*)(ws + WS_A8);
    const float* modf = (const float*)(ws + WS_MODF);

    PHASE( phaseA(C); );
    PHASE( phaseB(C); );
    PHASE(
        Gemm g{A8buf, (const bf16_t*)(ws + WS_W1T), MA, 2560, 512}; Order1 S; S.init(C.G, C.bid);
        Epi1 E{(bf16_t*)(ws + WS_GLU), ws};
        gemm_phase<Epi1, Order1, true>(lds, g, S, E, C.tid, C.wid);
        ctx_kv_tile(C); );
    PHASE(
        const int vcu = (C.bid & 7) * (C.G >> 3) + (C.bid >> 3);
        for (int t = vcu; t < 512; t += C.G) conv_tile(C, t);
        __syncthreads();
        { int tt = C.wid * C.G + C.bid;
          if (C.wid >= 4) { for (int q = 0; q < 2 && tt < 8192; ++q, tt += C.G * 8) table_task(C, tt); }
          for (int t = vcu * 8 + C.wid; t < NBATCH * 64 * 8; t += C.G * 8) { attn_task(C, t);
              for (int q = 0; q < 2 && tt < 8192; ++q, tt += C.G * 8) table_task(C, tt); }
          for (; tt < 8192; tt += C.G * 8) table_task(C, tt); } );
    PHASE(
        Gemm g{A8buf, (const bf16_t*)(ws + WS_W2T), M, 1024, 512}; StaticOrder S; S.init(M, 1024, C.G, C.bid);
        EpiRes<false> E{args.in[I_X], (bf16_t*)(ws + WS_H), modf + 2 * 1024};
        gemm_phase<EpiRes<false>, StaticOrder, true>(lds, g, S, E, C.tid, C.wid); );
    PHASE( phaseNorm2(C, 0); );
    PHASE(
        Gemm g{WQ_FP8 ? A8buf : Abuf, (const bf16_t*)(ws + WS_WQ), M, 2048, WQ_FP8 ? 512 : 1024}; StaticOrder S; S.init(M, 2048, C.G, C.bid);
        EpiBf16<0> E{(bf16_t*)(ws + WS_QP), (bf16_t*)(ws + WS_QP), 8, 2048};
        gemm_phase<EpiBf16<0>, StaticOrder, WQ_FP8 != 0>(lds, g, S, E, C.tid, C.wid); );
    PHASE( phaseTopk(C, 0); );
    PHASE( phasePeerSliced<0>(C, 0); );
    PHASE( phasePeerCombine(C); );
    PHASE( phasePeerSliced<1>(C, 0); );
    PHASE( phasePeerNorm(C, 0); );
    PHASE(
        Gemm g{A8buf, (const bf16_t*)(ws + WS_WSI), M, 2048, 512}; StaticOrder S; S.init(M, 2048, C.G, C.bid);
        EpiBf16<1> E{(bf16_t*)(ws + WS_U), (bf16_t*)(ws + WS_VV), 4, 1024};
        gemm_phase<EpiBf16<1>, StaticOrder, true>(lds, g, S, E, C.tid, C.wid); );
    PHASE( phaseSgu(C); );
    PHASE(
        Gemm g{A8buf, (const bf16_t*)(ws + WS_WSO), M, 1024, 512}; StaticOrder S; S.init(M, 1024, C.G, C.bid);
        EpiRes<true> E{ws + WS_H, (bf16_t*)(ws + WS_H), modf + 9 * 6144 + 2 * 1024};
        gemm_phase<EpiRes<true>, StaticOrder, true>(lds, g, S, E, C.tid, C.wid); );
    PHASE( phaseNorm2(C, 1); );
    PHASE(
        Gemm g{WQ_FP8 ? A8buf : Abuf, (const bf16_t*)(ws + WS_WQ + (size_t)2048 * 1024 * (WQ_FP8 ? 1 : 2)), M, 2048, WQ_FP8 ? 512 : 1024}; StaticOrder S; S.init(M, 2048, C.G, C.bid);
        EpiBf16<0> E{(bf16_t*)(ws + WS_QP), (bf16_t*)(ws + WS_QP), 8, 2048};
        gemm_phase<EpiBf16<0>, StaticOrder, WQ_FP8 != 0>(lds, g, S, E, C.tid, C.wid); );
    PHASE( phaseTopk(C, 1); );
    PHASE( phasePeerSliced<0>(C, 1); );
    PHASE( phasePeerCombine(C); );
    PHASE( phasePeerSliced<1>(C, 1); );
    PHASE( phasePeerNorm(C, 1); );
#if PROBE_PHASE >= 0
    if (C.bid == 0 && C.wid == 0 && multi) { const unsigned long long dt = (ts_l[1] - ts_l[0]) * PROBE_MULT, t0 = __builtin_amdgcn_s_memrealtime();
        while (__builtin_amdgcn_s_memrealtime() - t0 < dt) __builtin_amdgcn_s_sleep(8); }
#endif
#undef PHASE
#undef GRID_BARRIER
#undef STAMP
}

extern "C" void kernel_launch(void* const* d_in, const int* in_sizes, int n_in, void* d_out, int out_size, void* d_ws, size_t ws_size, hipStream_t stream) {
    static int grid = 0;
    if (grid == 0) {
        if (n_in != N_IN || out_size != M * D || ws_size < WS_END) { fprintf(stderr, "kernel_launch: unexpected shapes (n_in %d out %d ws %zu need %zu)\n", n_in, out_size, ws_size, (size_t)WS_END); grid = -1; return; }
        int dev = 0, cus = 0, per_cu = 0;
        if (hipGetDevice(&dev) != hipSuccess || hipDeviceGetAttribute(&cus, hipDeviceAttributeMultiprocessorCount, dev) != hipSuccess) { grid = -1; return; }
        if (hipFuncSetAttribute((const void*)fwd_megakernel, hipFuncAttributeMaxDynamicSharedMemorySize, LDS_BYTES) != hipSuccess) { fprintf(stderr, "kernel_launch: hipFuncSetAttribute failed\n"); grid = -1; return; }
        if (hipOccupancyMaxActiveBlocksPerMultiprocessor(&per_cu, (const void*)fwd_megakernel, 512, LDS_BYTES) != hipSuccess || per_cu < 1) { fprintf(stderr, "kernel_launch: occupancy query says %d blocks per CU\n", per_cu); (void)hipGetLastError(); grid = -1; return; }
        grid = cus;
        if (grid != 256) fprintf(stderr, "kernel_launch: note: %d CUs (the phase tilings assume 256)\n", grid);
        if (grid > 256) grid = 256;
    }
    if (grid < 0) return;
    (void)hipMemsetAsync((char*)d_ws + WS_CTL, 0, CTL_BYTES, stream);
    Args a{};
    for (int i = 0; i < N_IN; ++i) a.in[i] = (const float*)d_in[i];
    a.out = (float*)d_out; a.ws = (unsigned char*)d_ws;
#if ONE_LAUNCH
    a.ph_lo = 0; a.ph_hi = NPHASES; hipLaunchKernelGGL(fwd_megakernel, dim3(grid), dim3(512), LDS_BYTES, stream, a);
#else
    for (int i = 0; i < NPHASES; ++i) { a.ph_lo = i; a.ph_hi = i + 1; hipLaunchKernelGGL(fwd_megakernel, dim3(grid), dim3(512), LDS_BYTES, stream, a); }
#endif
}
```

```cpp
#include <hip/hip_runtime.h>
#include <cstdio>
#include <cstdint>

#ifndef PROBE_PHASE
#define PROBE_PHASE -1
#endif
#define PROBE_MULT 8
#ifndef WQ_FP8
#define WQ_FP8 1
#endif
#ifndef ONE_LAUNCH
#define ONE_LAUNCH 1
#endif

#define LAS __attribute__((address_space(3)))
typedef unsigned short bf16_t;
typedef short bf16x8 __attribute__((ext_vector_type(8)));
typedef float f32x4 __attribute__((ext_vector_type(4)));
typedef float f32x16 __attribute__((ext_vector_type(16)));
typedef float f32x2 __attribute__((ext_vector_type(2)));
typedef unsigned u32x4 __attribute__((ext_vector_type(4)));
typedef unsigned u32x2 __attribute__((ext_vector_type(2)));
typedef __bf16 bf2v __attribute__((ext_vector_type(2)));
typedef int v4i __attribute__((ext_vector_type(4)));
typedef int v8i __attribute__((ext_vector_type(8)));

constexpr int D = 1024, NBATCH = 8, SEQ = 4096, M = NBATCH * SEQ, CTXL = 256, MC = NBATCH * CTXL, MA = M + MC;
constexpr int NEXP = 16384;
constexpr float EPS = 1e-6f;
enum { I_X = 0, I_C, I_CTX, I_CCTX, I_N1G, I_N2G, I_ADAW, I_ADAB, I_WIN, I_CONVW, I_CONVB, I_GNG, I_GNB, I_RPB, I_WOUT, I_SGUIN, I_LNG, I_LNB, I_WS, I_BS, I_SGUOUT,
       I_WQ, I_KEYS, I_PU, I_PV, I_NFG, N_IN };

constexpr size_t WS_CTL  = 0;
constexpr size_t CTL_BYTES = 65536;
constexpr size_t WS_MODP = WS_CTL + CTL_BYTES;
constexpr size_t WS_MODF = WS_MODP + (size_t)2 * 8 * 9 * 6144 * 4;
constexpr size_t WS_W1T  = WS_MODF + (size_t)2 * 9 * 6144 * 4;
constexpr size_t WS_W2T  = WS_W1T + (size_t)2560 * 1024 * 2;
constexpr size_t WS_WSI  = WS_W2T + (size_t)1024 * 1024 * 2;
constexpr size_t WS_WSO  = WS_WSI + (size_t)2048 * 1024 * 2;
constexpr size_t WS_WQ   = WS_WSO + (size_t)1024 * 1024 * 2;
constexpr size_t WS_KEYS = WS_WQ + (size_t)2 * 2048 * 1024 * 2;
constexpr size_t WS_WSP  = WS_KEYS + (size_t)2 * 8 * 2 * 128 * 128 * 2;
constexpr size_t WS_TU   = WS_WSP + (size_t)8 * 128 * 128 * 2;
constexpr size_t WS_TV   = WS_TU + (size_t)2 * NEXP * 1024;
constexpr size_t WS_SIU  = WS_TV + (size_t)2 * NEXP * 1024;
constexpr size_t WS_SIV  = WS_SIU + (size_t)2 * NEXP * 4;
constexpr size_t WS_A    = WS_SIV + (size_t)2 * NEXP * 4;
constexpr size_t WS_B    = WS_A + (size_t)MA * 1024 * 2;
constexpr size_t WS_GLU  = WS_B;
constexpr size_t WS_Q    = WS_GLU + (size_t)M * 512 * 2;
constexpr size_t WS_K    = WS_Q + (size_t)M * 512 * 2;
constexpr size_t WS_V    = WS_K + (size_t)MA * 512 * 2;
constexpr size_t WS_QP   = WS_B;
constexpr size_t WS_PD   = WS_B;
constexpr size_t WS_U    = WS_B;
constexpr size_t WS_VV   = WS_B + (size_t)M * 1024 * 2;
constexpr size_t WS_IDX  = WS_V + (size_t)MA * 512 * 2;
constexpr size_t WS_WT   = WS_IDX + (size_t)M * 128 * 2;
constexpr size_t WS_SU   = WS_WT + (size_t)M * 128 * 4;
constexpr size_t WS_A8   = WS_SU + (size_t)M * 128 * 4;
constexpr size_t WS_H    = WS_A8 + (size_t)MA * 1024;
constexpr size_t WS_REF  = WS_H + (size_t)M * 1024 * 2;
constexpr size_t WS_GS2  = WS_REF;
constexpr size_t WS_RSTD = WS_REF + (size_t)65536;
constexpr size_t WS_END  = WS_REF + (size_t)256 * 1024 * 4;

constexpr int LDS_BYTES = 147456;
constexpr int MISC_OFF = 147200;

__device__ __forceinline__ float bf_lo(unsigned u) { return __uint_as_float(u << 16); }
__device__ __forceinline__ float bf_hi(unsigned u) { return __uint_as_float(u & 0xffff0000u); }
__device__ __forceinline__ unsigned pk2(float lo, float hi) { bf2v r = {(__bf16)lo, (__bf16)hi}; return __builtin_bit_cast(unsigned, r); }
template <int CTRL> __device__ __forceinline__ float dpp_f(float v) { return __builtin_bit_cast(float, __builtin_amdgcn_update_dpp(0, __builtin_bit_cast(int, v), CTRL, 0xF, 0xF, true)); }
__device__ __forceinline__ float sum8(float v) { v += dpp_f<0xB1>(v); v += dpp_f<0x4E>(v); v += dpp_f<0x141>(v); return v; }
__device__ __forceinline__ float sum8s(float v) { v += dpp_f<0xB1>(v); asm volatile("" : "+v"(v)); v += dpp_f<0x4E>(v); asm volatile("" : "+v"(v)); v += dpp_f<0x141>(v); asm volatile("" : "+v"(v)); return v; }
__device__ __forceinline__ float sum16(float v) { v = sum8(v); v += dpp_f<0x140>(v); return v; }
__device__ __forceinline__ float sum32(float v) { v = sum16(v); v += __shfl_xor(v, 16); return v; }
__device__ __forceinline__ float clamp448(float v) { return fminf(fmaxf(v, -448.f), 448.f); }
__device__ __forceinline__ unsigned pk4_fp8(float a, float b, float c, float d) { int p = 0;
    p = __builtin_amdgcn_cvt_pk_fp8_f32(clamp448(a), clamp448(b), p, false); p = __builtin_amdgcn_cvt_pk_fp8_f32(clamp448(c), clamp448(d), p, true); return (unsigned)p; }
__device__ __forceinline__ float wave_sum(float v) { v = sum32(v); v += __shfl_xor(v, 32); return v; }
__device__ __forceinline__ float dot2bf(unsigned a, unsigned b, float c) { return __builtin_amdgcn_fdot2_f32_bf16(__builtin_bit_cast(bf2v, a), __builtin_bit_cast(bf2v, b), c, false); }
__device__ __forceinline__ float sigmoidf_(float x) { return __builtin_amdgcn_rcpf(1.f + __expf(-x)); }
__device__ __forceinline__ float gelu_erf(float v) {
    const float xc = __builtin_amdgcn_fmed3f(v, -4.f, 4.f), u = xc * xc;
    float q = u * 8.06671040634712e-11f + (-7.005557176931155e-09f);
    q = q * u + 2.7166984266122897e-07f; q = q * u + (-6.295738382956848e-06f); q = q * u + 9.89137423718144e-05f; q = q * u + (-0.001133946358259485f);
    q = q * u + 0.009877530791576584f; q = q * u + (-0.06641064740001598f); q = q * u + 0.3989227237481351f;
    return v * (xc * q + 0.5f);
}

namespace pg8 {
constexpr int BM = 256, BK = 64, HALF = 128, HTB = HALF * BK * 2, STAGE_BYTES = 8 * HTB, NXCD = 8, WGM = 8;
__host__ __device__ __forceinline__ int lds_byte(int r, int c) { const int st = (r >> 4) * 2 + (c >> 5), rr = r & 15, cc = c & 31, ob = rr * 64 + cc * 2; return st * 1024 + (ob ^ (((ob >> 9) & 1) << 5)); }
__host__ __device__ __forceinline__ void stage_rc(int b, int& R, int& C) { const int st = b / 1024, sb = b % 1024, swz = sb ^ (((sb >> 9) & 1) << 5); R = (st >> 1) * 16 + swz / 64; C = (st & 1) * 32 + (swz % 64) / 2; }
__host__ __device__ __forceinline__ int perm32(int rho) { const int n = rho >> 4, i = rho & 15; return 8 * (i >> 2) + 4 * n + (i & 3); }
struct Unit { int pm, pn; };
struct Gemm { const bf16_t* A; const bf16_t* Bt; int M, N, K; };
struct StaticOrder {
    int nM, nN, nwg, G, c;
    __host__ __device__ void init(int M_, int N_, int G_, int c_) { nM = M_ / BM; nN = N_ / BM; nwg = nM * nN; G = G_; c = c_; }
    __host__ __device__ bool next(int i, Unit& u) const {
        const long L = (long)i * G + c; if (L >= nwg) return false;
        int wgid = (int)L; { const int q = nwg / NXCD, r = nwg % NXCD, xcd = wgid % NXCD, off = wgid / NXCD; wgid = (xcd < r ? xcd * (q + 1) : r * (q + 1) + (xcd - r) * q) + off; }
        const int nig = WGM * nN, gid = wgid / nig, fm = gid * WGM, gsz = (nM - fm) < WGM ? (nM - fm) : WGM;
        u.pm = fm + ((wgid % nig) % gsz); u.pn = (wgid % nig) / gsz; return true;
    }
    __device__ __forceinline__ void a_ready(const Unit&) const {}
    __device__ __forceinline__ void done(const Unit&) const {}
};
struct Order1 {
    StaticOrder so; int G, c;
    __device__ void init(int G_, int c_) { so.init(M, 2560, G_, c_); G = G_; c = c_; }
    __device__ bool next(int i, Unit& u) const {
        const long L = (long)i * G + c;
        if (L < so.nwg) return so.next(i, u);
        return false;
    }
    __device__ __forceinline__ void a_ready(const Unit&) const {}
    __device__ __forceinline__ void done(const Unit&) const {}
};
__device__ __forceinline__ f32x2 gelu_pk(f32x2 v) {
    f32x2 xc; xc.x = __builtin_amdgcn_fmed3f(v.x, -4.f, 4.f); xc.y = __builtin_amdgcn_fmed3f(v.y, -4.f, 4.f);
    const f32x2 u = xc * xc;
    f32x2 q = u * 8.06671040634712e-11f + (-7.005557176931155e-09f);
    q = q * u + 2.7166984266122897e-07f; q = q * u + (-6.295738382956848e-06f); q = q * u + 9.89137423718144e-05f; q = q * u + (-0.001133946358259485f);
    q = q * u + 0.009877530791576584f; q = q * u + (-0.06641064740001598f); q = q * u + 0.3989227237481351f;
    const f32x2 phi = xc * q + 0.5f;
    return v * phi;
}
__device__ __forceinline__ void mfma_fp8_acc(f32x4& acc, const v8i& a, const v8i& b, int sa, int sb) {
    asm volatile("s_nop 1\n\tv_mfma_scale_f32_16x16x128_f8f6f4 %0, %1, %2, %0, %3, %4 op_sel_hi:[0,0,0]" : "+v"(acc) : "v"(a), "v"(b), "v"(sa), "v"(sb));
}
template <class Epi, class Sched, bool FP8 = false>
__device__ __forceinline__ void gemm_phase(LAS unsigned char* lds, const Gemm g, const Sched& S, const Epi& E, const int tid, const int wid) {
    const int lane = tid & 63, wr = wid >> 2, wc = wid & 3, fr = lane & 15, fq = lane >> 4;
    const int K = g.K, nt = K / BK;
    const int sc_w = 0x7A7A7A7A, sc_x = 0x7F7F7F7F;
    unsigned voffA[2], voffB[2];
#pragma unroll
    for (int i = 0; i < 2; ++i) { int R, C; stage_rc(tid * 16 + i * 8192, R, C); const int Rb = Epi::PERM ? ((R & ~31) + perm32(R & 31)) : R;
        voffA[i] = (unsigned)(R * K + C) * 2u; voffB[i] = (unsigned)(Rb * K + C) * 2u; }
    const size_t kstep = (size_t)(BK * 2);
    const size_t hstep = (size_t)HALF * K * 2;
    const size_t tstep = 2 * hstep;
    const unsigned ldsw = (unsigned)wid * 1024u;
    const int aoff = lds_byte(wr * 64 + fr, fq * 8), boff = lds_byte(wc * 32 + fr, fq * 8);
#define PG8_SA(b, h) (((b) * 2 + (h)) * HTB)
#define PG8_SB(b, h) ((4 + (b) * 2 + (h)) * HTB)
#define PG8_STAGE(bufoff, gbase, voff) do { _Pragma("unroll") for (int _i = 0; _i < 2; ++_i) \
        __builtin_amdgcn_global_load_lds((const unsigned*)((const char*)(gbase) + (voff)[_i]), (LAS unsigned*)(lds + (bufoff) + ldsw + _i * 8192), 16, 0, 0); } while (0)
#define PG8_LD16(off) (*(const LAS v4i*)(lds + (off)))
#define PG8_LDA(dst, b, h) do { _Pragma("unroll") for (int m = 0; m < 4; ++m) { const int o_ = PG8_SA(b, h) + aoff + m * 2048; \
        if (FP8) dst##8[m] = __builtin_shufflevector(PG8_LD16(o_), PG8_LD16(o_ + 1024), 0, 1, 2, 3, 4, 5, 6, 7); \
        else { dst[m][0] = __builtin_bit_cast(bf16x8, PG8_LD16(o_)); dst[m][1] = __builtin_bit_cast(bf16x8, PG8_LD16(o_ + 1024)); } } } while (0)
#define PG8_LDB(dst, b, h) do { _Pragma("unroll") for (int n = 0; n < 2; ++n) { const int o_ = PG8_SB(b, h) + boff + n * 2048; \
        if (FP8) dst##8[n] = __builtin_shufflevector(PG8_LD16(o_), PG8_LD16(o_ + 1024), 0, 1, 2, 3, 4, 5, 6, 7); \
        else { dst[n][0] = __builtin_bit_cast(bf16x8, PG8_LD16(o_)); dst[n][1] = __builtin_bit_cast(bf16x8, PG8_LD16(o_ + 1024)); } } } while (0)
#define PG8_MMA(ai, bj, At, Bt) do { __builtin_amdgcn_s_setprio(1); _Pragma("unroll") for (int m = 0; m < 4; ++m) _Pragma("unroll") for (int n = 0; n < 2; ++n) { \
        if (FP8) mfma_fp8_acc(acc[ai][bj][m][n], Bt##8[n], At##8[m], sc_w, sc_x); \
        else { _Pragma("unroll") for (int k = 0; k < 2; ++k) acc[ai][bj][m][n] = __builtin_amdgcn_mfma_f32_16x16x32_bf16(Bt[n][k], At[m][k], acc[ai][bj][m][n], 0, 0, 0); } } \
        __builtin_amdgcn_s_setprio(0); } while (0)
#define PG8_WAIT_V(n) asm volatile("s_waitcnt vmcnt(" #n ")" ::: "memory")
#define PG8_WAIT_L(n) asm volatile("s_waitcnt lgkmcnt(" #n ")" ::: "memory")
#define PG8_BAR __builtin_amdgcn_s_barrier()
#define PG8_SCHED __builtin_amdgcn_sched_barrier(0)
    Unit cur, nxt; int ui = 0;
    if (!S.next(0, cur)) return;
    f32x4 acc[2][2][4][2];
#pragma unroll
    for (int a = 0; a < 2; ++a)
#pragma unroll
        for (int b = 0; b < 2; ++b)
#pragma unroll
            for (int m = 0; m < 4; ++m)
#pragma unroll
                for (int n = 0; n < 2; ++n) acc[a][b][m][n] = (f32x4){0.f, 0.f, 0.f, 0.f};
    const char* cA = (const char*)g.A + (size_t)cur.pm * tstep; const char* cB = (const char*)g.Bt + (size_t)cur.pn * tstep;
    S.a_ready(cur);
    PG8_STAGE(PG8_SB(0, 0), cB, voffB); PG8_STAGE(PG8_SA(0, 0), cA, voffA); PG8_STAGE(PG8_SB(0, 1), cB + hstep, voffB); PG8_STAGE(PG8_SA(0, 1), cA + hstep, voffA);
    if (wr == 1) PG8_BAR;
    PG8_WAIT_V(4); PG8_BAR;
    PG8_STAGE(PG8_SB(1, 0), cB + kstep, voffB); PG8_STAGE(PG8_SA(1, 0), cA + kstep, voffA); PG8_STAGE(PG8_SB(1, 1), cB + hstep + kstep, voffB);
    PG8_WAIT_V(6); PG8_BAR;
    for (;;) {
        const bool has_next = S.next(ui + 1, nxt);
        const char* nA = has_next ? (const char*)g.A + (size_t)nxt.pm * tstep : cA; const char* nB = has_next ? (const char*)g.Bt + (size_t)nxt.pn * tstep : cB;
#pragma unroll 1
        for (int t = 0; t < nt; t += 2) {
            const bool last = (t == nt - 2);
            bf16x8 At[4][2], B0[2][2], B1[2][2]; v8i At8[4], B08[2], B18[2];
            const char* a1 = cA + (size_t)(t + 1) * kstep;
            const char* a2 = last ? nA : cA + (size_t)(t + 2) * kstep; const char* b2 = last ? nB : cB + (size_t)(t + 2) * kstep;
            const char* a3 = a2 + kstep; const char* b3 = b2 + kstep;
            if (last && has_next) S.a_ready(nxt);
            PG8_LDB(B0, 0, 0); PG8_SCHED; PG8_LDA(At, 0, 0); PG8_STAGE(PG8_SA(1, 1), a1 + hstep, voffA);
            PG8_WAIT_L(8); PG8_BAR; PG8_WAIT_L(0); PG8_MMA(0, 0, At, B0); PG8_BAR; PG8_SCHED;
            PG8_LDB(B1, 0, 1); PG8_STAGE(PG8_SB(0, 0), b2, voffB);
            PG8_BAR; PG8_WAIT_L(0); PG8_MMA(0, 1, At, B1); PG8_BAR;
            PG8_LDA(At, 0, 1); PG8_STAGE(PG8_SA(0, 0), a2, voffA);
            PG8_BAR; PG8_WAIT_L(0); PG8_MMA(1, 0, At, B0); PG8_BAR; PG8_SCHED;
            PG8_STAGE(PG8_SB(0, 1), b2 + hstep, voffB);
            PG8_WAIT_V(6); PG8_BAR; PG8_MMA(1, 1, At, B1); PG8_BAR;
            PG8_LDB(B0, 1, 0); PG8_SCHED; PG8_LDA(At, 1, 0); PG8_STAGE(PG8_SA(0, 1), a2 + hstep, voffA);
            PG8_WAIT_L(8); PG8_BAR; PG8_WAIT_L(0); PG8_MMA(0, 0, At, B0); PG8_BAR; PG8_SCHED;
            PG8_LDB(B1, 1, 1); PG8_STAGE(PG8_SB(1, 0), b3, voffB);
            PG8_BAR; PG8_WAIT_L(0); PG8_MMA(0, 1, At, B1); PG8_BAR;
            PG8_LDA(At, 1, 1); PG8_STAGE(PG8_SA(1, 0), a3, voffA);
            PG8_BAR; PG8_WAIT_L(0); PG8_MMA(1, 0, At, B0); PG8_BAR; PG8_SCHED;
            PG8_STAGE(PG8_SB(1, 1), b3 + hstep, voffB);
            PG8_WAIT_V(6); PG8_BAR; PG8_MMA(1, 1, At, B1); PG8_BAR;
        }
        { Unit ue = cur; int wr_ = wr, wc_ = wc, fr_ = fr, fq_ = fq;
          asm volatile("" : "+s"(ue.pm), "+s"(ue.pn), "+s"(wr_), "+s"(wc_), "+v"(fr_), "+v"(fq_));
          E(acc, ue, wr_, wc_, fr_, fq_); }
        S.done(cur);
        if (!has_next) break;
#pragma unroll
        for (int a = 0; a < 2; ++a)
#pragma unroll
            for (int b = 0; b < 2; ++b)
#pragma unroll
                for (int m = 0; m < 4; ++m)
#pragma unroll
                    for (int n = 0; n < 2; ++n) acc[a][b][m][n] = (f32x4){0.f, 0.f, 0.f, 0.f};
        cur = nxt; cA = nA; cB = nB; ++ui;
    }
    PG8_WAIT_V(0);
    if (wr == 0) PG8_BAR;
    PG8_BAR;
#undef PG8_SA
#undef PG8_SB
#undef PG8_STAGE
#undef PG8_LDA
#undef PG8_LD16
#undef PG8_LDB
#undef PG8_MMA
#undef PG8_WAIT_V
#undef PG8_WAIT_L
#undef PG8_BAR
#undef PG8_SCHED
}

struct Epi1 {
    static constexpr bool PERM = true;
    bf16_t *GLU; unsigned char* wsb;
    __device__ __forceinline__ void operator()(const f32x4 (&acc)[2][2][4][2], const Unit& u, int wr, int wc, int fr, int fq) const {
        const int row0 = u.pm * BM + wr * 64 + fr;
        if (u.pn < 4) {
            const int ch0 = u.pn * 128 + wc * 32 + 8 * fq;
#pragma unroll
            for (int ai = 0; ai < 2; ++ai)
#pragma unroll
                for (int m = 0; m < 4; ++m) {
                    const f32x4 a0 = acc[ai][0][m][0], a1 = acc[ai][0][m][1], g0 = acc[ai][1][m][0], g1 = acc[ai][1][m][1];
                    u32x4 w;
                    w.x = pk2(a0[0] * sigmoidf_(g0[0]), a0[1] * sigmoidf_(g0[1])); w.y = pk2(a0[2] * sigmoidf_(g0[2]), a0[3] * sigmoidf_(g0[3]));
                    w.z = pk2(a1[0] * sigmoidf_(g1[0]), a1[1] * sigmoidf_(g1[1])); w.w = pk2(a1[2] * sigmoidf_(g1[2]), a1[3] * sigmoidf_(g1[3]));
                    *(u32x4*)(GLU + (size_t)(row0 + ai * HALF + m * 16) * 512 + ch0) = w;
                }
        } else {
            const int t = (u.pn - 4) >> 1;
            const size_t boff = WS_Q + (t >= 1 ? (size_t)M * 1024 : (size_t)0) + (t >= 2 ? (size_t)MA * 1024 : (size_t)0);
            bf16_t* base = (bf16_t*)(wsb + boff);
            const float sc = t == 0 ? 0.125f * 1.44269504f : 1.f;
            const int col0 = ((u.pn - 4) & 1) * 256 + wc * 32 + 8 * fq;
#pragma unroll
            for (int ai = 0; ai < 2; ++ai)
#pragma unroll
                for (int m = 0; m < 4; ++m) { bf16_t* rowp = base + (size_t)(row0 + ai * HALF + m * 16) * 512 + col0;
#pragma unroll
                    for (int bj = 0; bj < 2; ++bj) { const f32x4 v0 = acc[ai][bj][m][0] * sc, v1 = acc[ai][bj][m][1] * sc;
                        u32x4 w; w.x = pk2(v0[0], v0[1]); w.y = pk2(v0[2], v0[3]); w.z = pk2(v1[0], v1[1]); w.w = pk2(v1[2], v1[3]);
                        *(u32x4*)(rowp + bj * HALF) = w; } }
        }
    }
};
template <bool BF16_BASE> struct EpiRes {
    static constexpr bool PERM = true;
    const void* base; bf16_t* H; const float* gate;
    __device__ __forceinline__ void operator()(const f32x4 (&acc)[2][2][4][2], const Unit& u, int wr, int wc, int fr, int fq) const {
        const int row0 = u.pm * BM + wr * 64 + fr, col0 = u.pn * BM + wc * 32 + 8 * fq;
        const int b = (u.pm * BM) / SEQ;
        const float* gp = gate + (size_t)b * 6144 + col0;
        if (BF16_BASE) {
            u32x4 hb[2][4][2];
#pragma unroll
            for (int ai = 0; ai < 2; ++ai)
#pragma unroll
                for (int m = 0; m < 4; ++m)
#pragma unroll
                    for (int bj = 0; bj < 2; ++bj) hb[ai][m][bj] = *(const u32x4*)((const bf16_t*)base + (size_t)(row0 + ai * HALF + m * 16) * D + col0 + bj * HALF);
#pragma unroll
            for (int bj = 0; bj < 2; ++bj) { const f32x4 g0 = *(const f32x4*)(gp + bj * HALF), g1 = *(const f32x4*)(gp + bj * HALF + 4);
#pragma unroll
                for (int ai = 0; ai < 2; ++ai)
#pragma unroll
                    for (int m = 0; m < 4; ++m) { const size_t off = (size_t)(row0 + ai * HALF + m * 16) * D + col0 + bj * HALF;
                        const u32x4 h4 = hb[ai][m][bj];
                        const f32x4 b0 = (f32x4){bf_lo(h4.x), bf_hi(h4.x), bf_lo(h4.y), bf_hi(h4.y)}, b1 = (f32x4){bf_lo(h4.z), bf_hi(h4.z), bf_lo(h4.w), bf_hi(h4.w)};
                        const f32x4 v0 = b0 + g0 * acc[ai][bj][m][0], v1 = b1 + g1 * acc[ai][bj][m][1];
                        u32x4 w; w.x = pk2(v0[0], v0[1]); w.y = pk2(v0[2], v0[3]); w.z = pk2(v1[0], v1[1]); w.w = pk2(v1[2], v1[3]);
                        *(u32x4*)(H + off) = w; } }
        } else {
            f32x4 gv[2][2];
#pragma unroll
            for (int bj = 0; bj < 2; ++bj)
#pragma unroll
                for (int n = 0; n < 2; ++n) gv[bj][n] = *(const f32x4*)(gp + bj * HALF + 4 * n);
#pragma unroll
            for (int ai = 0; ai < 2; ++ai) {
                f32x4 bb[4][2][2];
#pragma unroll
                for (int m = 0; m < 4; ++m) { const size_t off = (size_t)(row0 + ai * HALF + m * 16) * D + col0;
#pragma unroll
                    for (int bj = 0; bj < 2; ++bj) { bb[m][bj][0] = *(const f32x4*)((const float*)base + off + bj * HALF); bb[m][bj][1] = *(const f32x4*)((const float*)base + off + bj * HALF + 4); } }
#pragma unroll
                for (int m = 0; m < 4; ++m) { const size_t off = (size_t)(row0 + ai * HALF + m * 16) * D + col0;
#pragma unroll
                    for (int bj = 0; bj < 2; ++bj) {
                        const f32x4 v0 = bb[m][bj][0] + gv[bj][0] * acc[ai][bj][m][0], v1 = bb[m][bj][1] + gv[bj][1] * acc[ai][bj][m][1];
                        u32x4 w; w.x = pk2(v0[0], v0[1]); w.y = pk2(v0[2], v0[3]); w.z = pk2(v1[0], v1[1]); w.w = pk2(v1[2], v1[3]);
                        *(u32x4*)(H + off + bj * HALF) = w; } }
            }
        }
    }
};
template <int ACT> struct EpiBf16 {
    static constexpr bool PERM = true;
    bf16_t *O0, *O1; int split_tiles, ld;
    __device__ __forceinline__ void operator()(const f32x4 (&acc)[2][2][4][2], const Unit& u, int wr, int wc, int fr, int fq) const {
        const int row0 = u.pm * BM + wr * 64 + fr;
        bf16_t* base = u.pn < split_tiles ? O0 : O1;
        const int col0 = (u.pn < split_tiles ? u.pn : u.pn - split_tiles) * BM + wc * 32 + 8 * fq;
#pragma unroll
        for (int ai = 0; ai < 2; ++ai)
#pragma unroll
            for (int m = 0; m < 4; ++m) { bf16_t* rowp = base + (size_t)(row0 + ai * HALF + m * 16) * ld + col0;
#pragma unroll
                for (int bj = 0; bj < 2; ++bj) { f32x4 v0 = acc[ai][bj][m][0], v1 = acc[ai][bj][m][1];
                    if (ACT == 1) { f32x2 a = gelu_pk((f32x2){v0[0], v0[1]}), b = gelu_pk((f32x2){v0[2], v0[3]}), c = gelu_pk((f32x2){v1[0], v1[1]}), d = gelu_pk((f32x2){v1[2], v1[3]});
                        v0 = (f32x4){a.x, a.y, b.x, b.y}; v1 = (f32x4){c.x, c.y, d.x, d.y}; }
                    u32x4 w; w.x = pk2(v0[0], v0[1]); w.y = pk2(v0[2], v0[3]); w.z = pk2(v1[0], v1[1]); w.w = pk2(v1[2], v1[3]);
                    *(u32x4*)(rowp + bj * HALF) = w; } }
    }
};
struct EpiQFrag {
    static constexpr bool PERM = true;
    bf16_t* O;
    __device__ __forceinline__ void operator()(const f32x4 (&acc)[2][2][4][2], const Unit& u, int wr, int wc, int fr, int fq) const {
        const int row0 = u.pm * BM + wr * 64 + fr;
        const int hh = wc >> 1, sidx = 4 * (wc & 1) + fq;
#pragma unroll
        for (int ai = 0; ai < 2; ++ai)
#pragma unroll
            for (int m = 0; m < 4; ++m) { const int r = row0 + ai * HALF + m * 16;
#pragma unroll
                for (int bj = 0; bj < 2; ++bj) { const f32x4 v0 = acc[ai][bj][m][0], v1 = acc[ai][bj][m][1];
                    u32x4 w; w.x = pk2(v0[0], v0[1]); w.y = pk2(v0[2], v0[3]); w.z = pk2(v1[0], v1[1]); w.w = pk2(v1[2], v1[3]);
                    const size_t unit = ((((size_t)(r >> 5) * 8 + u.pn) * 2 + bj) * 8 + sidx) * 64 + 32 * hh + (r & 31);
                    *(u32x4*)(O + unit * 8) = w; } }
    }
};
}

#define XB_TMO      128
#define XB_XCNT(j)  (256  + 64 * (j))
#define XB_XSUB(j)  (1280 + 64 * (j))
#define XB_XGEN(j)  (2304 + 64 * (j))
#define XB_TOP      3328
#define XB_TOPGEN   3392
#define XCD_BAR_WORDS 3456
#define XB_SPIN_CAP (1u << 22)
__device__ __forceinline__ unsigned xb_ld(unsigned* p)              { return __hip_atomic_load(p, __ATOMIC_RELAXED, __HIP_MEMORY_SCOPE_AGENT); }
__device__ __forceinline__ unsigned xb_add(unsigned* p, unsigned v) { return __hip_atomic_fetch_add(p, v, __ATOMIC_RELAXED, __HIP_MEMORY_SCOPE_AGENT); }
__device__ __forceinline__ unsigned xb_xcc_id() { return (unsigned)__builtin_amdgcn_s_getreg((3 << 11) | 20) & 0xFu; }
#define XB_SPIN(cond, bar) do { unsigned _sp = 0; while (cond) { __builtin_amdgcn_s_sleep(1); \
    if ((++_sp & 255u) == 0u) { if (xb_ld(&(bar)[XB_TMO])) break; if (_sp > XB_SPIN_CAP) { atomicAdd(&(bar)[XB_TMO], 1u); break; } } } } while (0)
struct XcdBarrier { unsigned* bar; unsigned x; volatile LAS unsigned* st; bool leader; };
__device__ __forceinline__ XcdBarrier xcd_barrier_post(unsigned* bar, volatile LAS unsigned* st, bool leader) {
    XcdBarrier b; b.bar = bar; b.x = xb_xcc_id(); b.st = st; b.leader = leader;
    if (leader) (void)xb_add(&bar[XB_XCNT(b.x)], 1u);
    return b;
}
__device__ __forceinline__ void xcd_barrier_complete(unsigned* bar, unsigned x, unsigned& nloc, unsigned& nx) {
    const unsigned G = gridDim.x * gridDim.y * gridDim.z;
    unsigned sum, cnt, mine, sp = 0u;
    for (;;) {
        sum = 0u; cnt = 0u; mine = 0u;
#pragma unroll
        for (unsigned j = 0; j < 16; ++j) { const unsigned c = xb_ld(&bar[XB_XCNT(j)]); sum += c; cnt += (c > 0u) ? 1u : 0u; mine = (j == x) ? c : mine; }
        if (sum == G) break;
        __builtin_amdgcn_s_sleep(1);
        if ((++sp & 255u) == 0u) { if (xb_ld(&bar[XB_TMO])) break; if (sp > XB_SPIN_CAP) { atomicAdd(&bar[XB_TMO], 1u); break; } }
    }
    nloc = mine > 0u ? mine : 1u; nx = cnt > 0u ? cnt : 1u;
}
__device__ __forceinline__ void xcd_barrier(const XcdBarrier& b) {
    asm volatile("s_waitcnt vmcnt(0)" ::: "memory");
    __syncthreads();
    if (b.leader) {
        unsigned* bar = b.bar;
        __builtin_amdgcn_s_waitcnt(0);
        unsigned nloc = b.st[0], nx = b.st[1];
        if (nloc == 0u) { xcd_barrier_complete(bar, b.x, nloc, nx); b.st[0] = nloc; b.st[1] = nx; }
        const unsigned old = xb_add(&bar[XB_XSUB(b.x)], 1u);
        const unsigned gen = old / nloc;
        if (old + 1u == (gen + 1u) * nloc) {
            __builtin_amdgcn_fence(__ATOMIC_RELEASE, "agent");
            asm volatile("s_waitcnt vmcnt(0)" ::: "memory");
            const unsigned og = xb_add(&bar[XB_TOP], 1u);
            const unsigned tg = og / nx;
            if (og + 1u == (tg + 1u) * nx) xb_add(&bar[XB_TOPGEN], 1u);
            else XB_SPIN(xb_ld(&bar[XB_TOPGEN]) == tg, bar);
            __builtin_amdgcn_fence(__ATOMIC_ACQUIRE, "agent");
            xb_add(&bar[XB_XGEN(b.x)], 1u);
            asm volatile("s_waitcnt vmcnt(0)" ::: "memory");
        } else {
            XB_SPIN(xb_ld(&bar[XB_XGEN(b.x)]) == gen, bar);
            __builtin_amdgcn_fence(__ATOMIC_ACQUIRE, "agent");
            asm volatile("s_waitcnt vmcnt(0)" ::: "memory");
        }
    }
    __syncthreads();
}

struct Args { const float* in[N_IN]; float* out; unsigned char* ws; int ph_lo, ph_hi; };
static_assert(sizeof(Args) == (N_IN + 2) * 8 + 8, "Args has padding");

typedef const __attribute__((address_space(4))) Args CArgs;
struct Ctx {
    CArgs* a; LAS unsigned char* lds; int tid, lane, wid, bid, G;
};

__device__ __forceinline__ void ctx_kv_tile(const Ctx& C) {
    CArgs& a = *C.a; unsigned char* ws = a.ws;
    const int lane = C.lane, fr = lane & 15, fq = lane >> 4;
    const int r0 = (C.bid >> 4) * 128 + C.wid * 16, c0 = (C.bid & 15) * 64;
    const unsigned char* xa = ws + WS_A8 + (size_t)(M + r0 + fr) * 1024 + 32 * fq;
    const unsigned char* wb = ws + WS_W1T + (size_t)(1536 + c0 + fr) * 1024 + 32 * fq;
    f32x4 acc[4];
#pragma unroll
    for (int nb = 0; nb < 4; ++nb) acc[nb] = (f32x4){0.f, 0.f, 0.f, 0.f};
#pragma unroll 4
    for (int ks = 0; ks < 8; ++ks) {
        const v8i xv = __builtin_shufflevector(*(const v4i*)(xa + 128 * ks), *(const v4i*)(xa + 128 * ks + 16), 0, 1, 2, 3, 4, 5, 6, 7);
        v8i wv[4];
#pragma unroll
        for (int nb = 0; nb < 4; ++nb) wv[nb] = __builtin_shufflevector(*(const v4i*)(wb + (size_t)nb * 16384 + 128 * ks), *(const v4i*)(wb + (size_t)nb * 16384 + 128 * ks + 16), 0, 1, 2, 3, 4, 5, 6, 7);
#pragma unroll
        for (int nb = 0; nb < 4; ++nb) pg8::mfma_fp8_acc(acc[nb], wv[nb], xv, 0x7A7A7A7A, 0x7F7F7F7F);
    }
    asm volatile("s_nop 15\n\ts_nop 15" ::: "memory");
#pragma unroll
    for (int nb = 0; nb < 4; ++nb) asm volatile("" : "+v"(acc[nb]));
#pragma unroll
    for (int nb = 0; nb < 4; ++nb) { const int col = c0 + 16 * nb + 4 * fq;
        bf16_t* dst = (bf16_t*)(ws + (col < 512 ? WS_K : WS_V)) + (size_t)(M + r0 + fr) * 512 + (col & 511);
        u32x2 o; o.x = pk2(acc[nb][0], acc[nb][1]); o.y = pk2(acc[nb][2], acc[nb][3]); *(u32x2*)dst = o; }
}

__device__ __forceinline__ int w1_dest_row(int n) {
    if (n < 512) return (n >> 7) * 256 + (n & 127);
    if (n < 1024) { const int q = n - 512; return (q >> 7) * 256 + 128 + (q & 127); }
    return n;
}
__device__ __forceinline__ void transpose_item(const float* W, int K, int N, bf16_t* WT, int item, LAS float* scr, int lane, int mode) {
    const int nblk = N / 32, kb = item / nblk, nb = item % nblk, k0 = 64 * kb, n0 = 32 * nb;
    { f32x4 w[8];
#pragma unroll
      for (int i = 0; i < 8; ++i) w[i] = *(const f32x4*)(W + (size_t)(k0 + 8 * i + (lane >> 3)) * N + n0 + 4 * (lane & 7));
#pragma unroll
      for (int i = 0; i < 8; ++i) { LAS float* d = scr + (8 * i + (lane >> 3)) * 33 + 4 * (lane & 7); d[0] = w[i].x; d[1] = w[i].y; d[2] = w[i].z; d[3] = w[i].w; } }
    asm volatile("s_waitcnt lgkmcnt(0)" ::: "memory"); __builtin_amdgcn_wave_barrier();
    const int c = lane & 7;
#pragma unroll
    for (int j = 0; j < 4; ++j) { const int n = (lane >> 3) + 8 * j; const LAS float* s = scr + (8 * c) * 33 + n;
        const int dr = (mode & 1) ? w1_dest_row(n0 + n) : (n0 + n);
        if (mode & 2) {
            u32x2 o; o.x = pk4_fp8(s[0 * 33] * 32.f, s[1 * 33] * 32.f, s[2 * 33] * 32.f, s[3 * 33] * 32.f); o.y = pk4_fp8(s[4 * 33] * 32.f, s[5 * 33] * 32.f, s[6 * 33] * 32.f, s[7 * 33] * 32.f);
            *(u32x2*)((unsigned char*)WT + (size_t)dr * K + k0 + 8 * c) = o;
        } else {
            u32x4 o; o.x = pk2(s[0 * 33], s[1 * 33]); o.y = pk2(s[2 * 33], s[3 * 33]); o.z = pk2(s[4 * 33], s[5 * 33]); o.w = pk2(s[6 * 33], s[7 * 33]);
            *(u32x4*)(WT + (size_t)dr * K + k0 + 8 * c) = o; } }
    asm volatile("s_waitcnt lgkmcnt(0)" ::: "memory"); __builtin_amdgcn_wave_barrier();
}
__device__ __forceinline__ void convert_task(const float* src, bf16_t* dst, size_t base, int lane) {
#pragma unroll
    for (int it = 0; it < 8; ++it) { const size_t i = base + (size_t)it * 512 + lane * 8;
        const f32x4 a = *(const f32x4*)(src + i), b = *(const f32x4*)(src + i + 4);
        u32x4 o; o.x = pk2(a[0], a[1]); o.y = pk2(a[2], a[3]); o.z = pk2(b[0], b[1]); o.w = pk2(b[2], b[3]);
        *(u32x4*)(dst + i) = o; }
}
__device__ __forceinline__ void fp8_rows_task(const float* src, unsigned char* dst, unsigned char* sinv, size_t row0, int lane) {
#pragma unroll 2
    for (int r = 0; r < 8; ++r) { const size_t row = row0 + r;
        f32x4 v[4]; float am = 0.f;
#pragma unroll
        for (int j = 0; j < 4; ++j) { v[j] = *(const f32x4*)(src + row * 1024 + 16 * lane + 4 * j);
            am = fmaxf(am, fmaxf(fmaxf(fabsf(v[j].x), fabsf(v[j].y)), fmaxf(fabsf(v[j].z), fabsf(v[j].w)))); }
#pragma unroll
        for (int o = 1; o < 64; o <<= 1) am = fmaxf(am, __shfl_xor(am, o));
        unsigned be = (__float_as_uint(am) >> 23) & 0xffu; be = be < 8u ? 8u : be;
        const float sc = __uint_as_float((261u - be) << 23);
        u32x4 w;
#pragma unroll
        for (int j = 0; j < 4; ++j) { int pk = 0;
            pk = __builtin_amdgcn_cvt_pk_fp8_f32(v[j].x * sc, v[j].y * sc, pk, false);
            pk = __builtin_amdgcn_cvt_pk_fp8_f32(v[j].z * sc, v[j].w * sc, pk, true);
            w[j] = (unsigned)pk; }
        const size_t l = row / NEXP, e = row % NEXP;
        *(u32x4*)(dst + (((l * 8 + (size_t)(lane >> 3)) * NEXP + e) * 128) + 16 * (lane & 7)) = w;
        if (lane == 0) sinv[row] = (unsigned char)(be - 7u); }
}
__device__ __forceinline__ void fp4_rows_task(const float* src, unsigned char* dst, unsigned char* sinv, size_t row0, int lane) {
#pragma unroll 2
    for (int r = 0; r < 8; ++r) { const size_t row = row0 + r;
        f32x4 v[4]; float am = 0.f;
#pragma unroll
        for (int j = 0; j < 4; ++j) { v[j] = *(const f32x4*)(src + row * 1024 + 16 * lane + 4 * j);
            am = fmaxf(am, fmaxf(fmaxf(fabsf(v[j].x), fabsf(v[j].y)), fmaxf(fabsf(v[j].z), fabsf(v[j].w)))); }
#pragma unroll
        for (int o = 1; o < 64; o <<= 1) am = fmaxf(am, __shfl_xor(am, o));
        unsigned be = (__float_as_uint(am) >> 23) & 0xffu; be = be < 8u ? 8u : be;
        const float sc = __uint_as_float((256u - be) << 23);
        unsigned w0 = 0u, w1 = 0u;
#pragma unroll
        for (int j = 0; j < 4; ++j) {
            const unsigned lo = (unsigned)__builtin_amdgcn_cvt_scalef32_pk_fp4_f32(0u, v[j].x * sc, v[j].y * sc, 1.0f, 0) & 0xffu;
            const unsigned hi = (unsigned)__builtin_amdgcn_cvt_scalef32_pk_fp4_f32(0u, v[j].z * sc, v[j].w * sc, 1.0f, 0) & 0xffu;
            const unsigned hw = lo | (hi << 8);
            if (j == 0) w0 = hw; else if (j == 1) w0 |= hw << 16; else if (j == 2) w1 = hw; else w1 |= hw << 16; }
        const size_t l = row / NEXP, e = row % NEXP;
        u32x2 w; w.x = w0; w.y = w1;
        *(u32x2*)(dst + (((l * 4 + (size_t)(lane >> 4)) * NEXP + e) * 128) + 8 * (lane & 15)) = w;
        if (lane == 0) sinv[row] = (unsigned char)(be - 2u); }
}
__device__ __forceinline__ void table_task(const Ctx& C, int t) {
    CArgs& a = *C.a; unsigned char* ws = a.ws;
    if (t < 4096) fp4_rows_task(a.in[I_PU], ws + WS_TU, ws + WS_SIU, (size_t)t * 8, C.lane);
    else fp4_rows_task(a.in[I_PV], ws + WS_TV, ws + WS_SIV, (size_t)(t - 4096) * 8, C.lane);
}
__device__ __forceinline__ void phaseA(const Ctx& C) {
    CArgs& a = *C.a; unsigned char* ws = a.ws;
    LAS float* S = (LAS float*)C.lds;
    {   float cv[18];
#pragma unroll
        for (int it = 0; it < 18; ++it) { const int row = it >> 1, k = C.tid + 512 * (it & 1); cv[it] = row < 8 ? a.in[I_C][row * 1024 + k] : a.in[I_CCTX][k]; }
#pragma unroll
        for (int it = 0; it < 18; ++it) { const int row = it >> 1, k = C.tid + 512 * (it & 1); S[row * 1024 + k] = cv[it] / (1.f + __expf(-cv[it])); } }
    __syncthreads();
    LAS float* scr = (LAS float*)(C.lds + 40960 + C.wid * 8448);
    const int gw = C.wid * C.G + C.bid, NGW = C.G * 8;
    constexpr int T_ADA = 1536, T_W1 = 16 * 80, T_W2 = 16 * 32, T_SI = 16 * 64, T_SO = 16 * 32, T_WQ = 2 * 16 * 64;
    constexpr int T_KEYS = 2 * 8 * 2 * 128 * 128 / 4096, T_WSP = 8 * 128 * 128 / 4096;
    constexpr int NT = T_ADA + T_W1;
    float* modp = (float*)(ws + WS_MODP);
    for (int T = gw; T < NT; T += NGW) {
        int t = T;
        if (t < T_ADA) {
            const int l = t / 768, r = t % 768, cb = r >> 3, ks = r & 7;
            const int kg = C.lane >> 4, c4 = 4 * (C.lane & 15);
            const float* W = a.in[I_ADAW] + (size_t)l * 1024 * 6144 + (size_t)(ks * 128 + kg) * 6144 + cb * 64 + c4;
            f32x4 acc[9];
#pragma unroll
            for (int q = 0; q < 9; ++q) acc[q] = (f32x4){0.f, 0.f, 0.f, 0.f};
#pragma unroll 1
            for (int k0 = 0; k0 < 128; k0 += 32) {
                f32x4 w[8];
#pragma unroll
                for (int i = 0; i < 8; ++i) w[i] = *(const f32x4*)(W + (size_t)(k0 + 4 * i) * 6144);
#pragma unroll
                for (int i = 0; i < 8; ++i)
#pragma unroll
                    for (int q = 0; q < 9; ++q) acc[q] += S[q * 1024 + ks * 128 + k0 + 4 * i + kg] * w[i];
            }
#pragma unroll
            for (int q = 0; q < 9; ++q)
#pragma unroll
                for (int e = 0; e < 4; ++e) { float v = acc[q][e]; v += __shfl_xor(v, 16); v += __shfl_xor(v, 32); acc[q][e] = v; }
            if (C.lane < 16) { float* P = modp + ((size_t)(l * 8 + ks) * 9) * 6144 + cb * 64 + c4;
#pragma unroll
                for (int q = 0; q < 9; ++q) *(f32x4*)(P + (size_t)q * 6144) = acc[q]; }
            continue;
        }
        t -= T_ADA;
        transpose_item(a.in[I_WIN], 1024, 2560, (bf16_t*)(ws + WS_W1T), t, scr, C.lane, 3);
    }
}
constexpr int T_LATE = 16 * 32 + 16 * 64 + 16 * 32 + 2 * 16 * 64 + 2 * 8 * 2 * 128 * 128 / 4096 + 8 * 128 * 128 / 4096;
__device__ __forceinline__ void late_prep_task(const Ctx& C, int t, LAS float* scr) {
    CArgs& a = *C.a; unsigned char* ws = a.ws;
    constexpr int T_W2 = 16 * 32, T_SI = 16 * 64, T_SO = 16 * 32, T_WQ = 2 * 16 * 64, T_KEYS = 2 * 8 * 2 * 128 * 128 / 4096;
    if (t < T_W2) { transpose_item(a.in[I_WOUT], 1024, 1024, (bf16_t*)(ws + WS_W2T), t, scr, C.lane, 2); return; } t -= T_W2;
    if (t < T_SI) { transpose_item(a.in[I_SGUIN], 1024, 2048, (bf16_t*)(ws + WS_WSI), t, scr, C.lane, 2); return; } t -= T_SI;
    if (t < T_SO) { transpose_item(a.in[I_SGUOUT], 1024, 1024, (bf16_t*)(ws + WS_WSO), t, scr, C.lane, 2); return; } t -= T_SO;
    if (t < T_WQ) { const int l = t / 1024; transpose_item(a.in[I_WQ] + (size_t)l * 1024 * 2048, 1024, 2048, (bf16_t*)(ws + WS_WQ + (size_t)l * 2048 * 1024 * (WQ_FP8 ? 1 : 2)), t % 1024, scr, C.lane, WQ_FP8 ? 2 : 0); return; } t -= T_WQ;
    if (t < T_KEYS) { convert_task(a.in[I_KEYS], (bf16_t*)(ws + WS_KEYS), (size_t)t * 4096, C.lane); return; } t -= T_KEYS;
    convert_task(a.in[I_WS], (bf16_t*)(ws + WS_WSP), (size_t)t * 4096, C.lane);
}

template <int NR>
__device__ __forceinline__ void rows_load(f32x4 (&v)[NR][4], const float* xrow0, int lane) {
#pragma unroll
    for (int r = 0; r < NR; ++r)
#pragma unroll
        for (int j = 0; j < 4; ++j) v[r][j] = *((const f32x4*)(xrow0 + (size_t)r * D) + lane + 64 * j);
}
template <int NR>
__device__ __forceinline__ void rows_finish(const f32x4 (&v)[NR][4], bf16_t* orow0, const LAS float* GS, const LAS float* SH, int lane) {
#pragma unroll
    for (int r = 0; r < NR; ++r) {
        float s = 0.f;
#pragma unroll
        for (int j = 0; j < 4; ++j) s += (v[r][j].x * v[r][j].x + v[r][j].y * v[r][j].y) + (v[r][j].z * v[r][j].z + v[r][j].w * v[r][j].w);
        const float rinv = rsqrtf(wave_sum(s) * (1.f / D) + EPS);
        unsigned* o8 = (unsigned*)((unsigned char*)orow0 + (size_t)r * D) + lane;
#pragma unroll
        for (int j = 0; j < 4; ++j) { const f32x4 g = *(const LAS f32x4*)(GS + 4 * lane + 256 * j), h = *(const LAS f32x4*)(SH + 4 * lane + 256 * j);
            const f32x4 y = v[r][j] * rinv * g + h;
            o8[64 * j] = pk4_fp8(y.x, y.y, y.z, y.w); }
    }
}
template <int NR>
__device__ __forceinline__ void modulate_rows(const float* xrow0, bf16_t* orow0, const LAS float* GS, const LAS float* SH, int lane) {
    f32x4 v[NR][4];
    rows_load<NR>(v, xrow0, lane);
    rows_finish<NR>(v, orow0, GS, SH, lane);
}

template <int NR, bool OUT8, bool ALSO8 = false>
__device__ __forceinline__ void modulate_rows_h(const bf16_t* hrow0, void* orow0v, const LAS float* GS, const LAS float* SH, int lane, unsigned char* also8 = nullptr, float* rstd_out = nullptr) {
    u32x4 v[NR][2];
#pragma unroll
    for (int r = 0; r < NR; ++r)
#pragma unroll
        for (int j = 0; j < 2; ++j) v[r][j] = *(const u32x4*)(hrow0 + (size_t)r * D + 512 * j + 8 * lane);
#pragma unroll
    for (int r = 0; r < NR; ++r) {
        float x[16]; float s = 0.f;
#pragma unroll
        for (int j = 0; j < 2; ++j)
#pragma unroll
            for (int e = 0; e < 4; ++e) { x[8 * j + 2 * e] = bf_lo(v[r][j][e]); x[8 * j + 2 * e + 1] = bf_hi(v[r][j][e]); }
#pragma unroll
        for (int e = 0; e < 16; ++e) s += x[e] * x[e];
        const float rinv = rsqrtf(wave_sum(s) * (1.f / D) + EPS);
        if (rstd_out != nullptr && lane == 0) rstd_out[r] = rinv;
#pragma unroll
        for (int j = 0; j < 2; ++j) { float y[8];
#pragma unroll
            for (int q = 0; q < 2; ++q) { const f32x4 g = *(const LAS f32x4*)(GS + 512 * j + 8 * lane + 4 * q), h = *(const LAS f32x4*)(SH + 512 * j + 8 * lane + 4 * q);
#pragma unroll
                for (int e = 0; e < 4; ++e) y[4 * q + e] = x[8 * j + 4 * q + e] * rinv * g[e] + h[e]; }
            if (OUT8) { u32x2 w; w.x = pk4_fp8(y[0], y[1], y[2], y[3]); w.y = pk4_fp8(y[4], y[5], y[6], y[7]);
                *(u32x2*)((unsigned char*)orow0v + (size_t)r * D + 512 * j + 8 * lane) = w; }
            else { u32x4 w; w.x = pk2(y[0], y[1]); w.y = pk2(y[2], y[3]); w.z = pk2(y[4], y[5]); w.w = pk2(y[6], y[7]);
                *(u32x4*)((bf16_t*)orow0v + (size_t)r * D + 512 * j + 8 * lane) = w; }
            if (ALSO8) { u32x2 w; w.x = pk4_fp8(y[0], y[1], y[2], y[3]); w.y = pk4_fp8(y[4], y[5], y[6], y[7]);
                *(u32x2*)(also8 + (size_t)r * D + 512 * j + 8 * lane) = w; } }
    }
}

__device__ __forceinline__ void phaseB(const Ctx& C) {
    CArgs& a = *C.a; unsigned char* ws = a.ws;
    const float* modp = (const float*)(ws + WS_MODP); float* modf = (float*)(ws + WS_MODF);
    {
        const int e = C.bid * 512 + C.tid;
        if (e < 2 * 9 * 6144) { const int l = e / (9 * 6144), rem = e % (9 * 6144), row = rem / 6144, j = rem % 6144;
            float v = a.in[I_ADAB][l * 6144 + j];
#pragma unroll
            for (int ks = 0; ks < 8; ++ks) v += modp[((size_t)(l * 8 + ks) * 9 + row) * 6144 + j];
            modf[e] = v;
            if (row < 8 && j >= 4 * 1024 && j < 5 * 1024) ((float*)(ws + WS_GS2))[(l * 8 + row) * 1024 + (j - 4 * 1024)] = a.in[I_N2G][l * 1024 + (j - 4 * 1024)] * (1.f + v); }
    }
    LAS float* GS = (LAS float*)C.lds; LAS float* SH = GS + 1024;
    bf16_t* A = (bf16_t*)(ws + WS_A);
    for (int part = 0; part < 2; ++part) {
        const int rb = part == 0 ? (C.bid * 128) / SEQ : 8;
        __syncthreads();
        { float shv[2], scv[2], gv[2];
#pragma unroll
          for (int k = 0; k < 2; ++k) { const int c = C.tid + 512 * k;
            float sh = a.in[I_ADAB][c], sc = a.in[I_ADAB][1024 + c];
#pragma unroll
            for (int ks = 0; ks < 8; ++ks) { sh += modp[((size_t)(0 * 8 + ks) * 9 + rb) * 6144 + c]; sc += modp[((size_t)(0 * 8 + ks) * 9 + rb) * 6144 + 1024 + c]; }
            shv[k] = sh; scv[k] = sc; gv[k] = a.in[I_N1G][c]; }
#pragma unroll
          for (int k = 0; k < 2; ++k) { const int c = C.tid + 512 * k; GS[c] = gv[k] * (1.f + scv[k]); SH[c] = shv[k]; } }
        __syncthreads();
        unsigned char* A8 = ws + WS_A8;
        if (part == 0) {
            const int r0 = C.bid * 128 + C.wid * 16; const float* X = a.in[I_X] + (size_t)r0 * D; unsigned char* O = A8 + (size_t)r0 * D;
            f32x4 va[4][4], vb[4][4];
            rows_load<4>(va, X, C.lane);
            rows_load<4>(vb, X + 4 * D, C.lane);   rows_finish<4>(va, (bf16_t*)O, GS, SH, C.lane);
            rows_load<4>(va, X + 8 * D, C.lane);   rows_finish<4>(vb, (bf16_t*)(O + 4 * D), GS, SH, C.lane);
            rows_load<4>(vb, X + 12 * D, C.lane);  rows_finish<4>(va, (bf16_t*)(O + 8 * D), GS, SH, C.lane);
            rows_finish<4>(vb, (bf16_t*)(O + 12 * D), GS, SH, C.lane); }
        else { const int r = C.bid * 8 + C.wid; modulate_rows<1>(a.in[I_CTX] + (size_t)r * D, (bf16_t*)(A8 + (size_t)(M + r) * D), GS, SH, C.lane); }
    }
}

__device__ __forceinline__ void conv_tile(const Ctx& C, int tile) {
    CArgs& a = *C.a; unsigned char* ws = a.ws;
    const bf16_t* GLU = (const bf16_t*)(ws + WS_GLU); unsigned char* Y8 = ws + WS_A8;
    const int b = tile >> 6, t0 = (tile & 63) * 64;
    __syncthreads();
#pragma unroll 1
    for (int hb = 0; hb < 12; hb += 6) {   u32x4 v[6];
#pragma unroll
        for (int it = 0; it < 6; ++it) { const int i = C.tid + 512 * (hb + it), t = t0 - 15 + (i >> 6), tc = t < 0 ? 0 : (t >= SEQ ? SEQ - 1 : t);
            v[it] = *(const u32x4*)(GLU + ((size_t)(b * SEQ + tc)) * 512 + (i & 63) * 8); }
#pragma unroll
        for (int it = 0; it < 6; ++it) { const int i = C.tid + 512 * (hb + it), t = t0 - 15 + (i >> 6);
            const unsigned m = (t >= 0 && t < SEQ) ? 0xffffffffu : 0u;
            *(LAS u32x4*)(C.lds + (size_t)i * 16) = v[it] & (u32x4){m, m, m, m}; } }
    __syncthreads();
    const int half = C.tid >> 8, cp = C.tid & 255;
    float w0[31], w1[31];
#pragma unroll
    for (int j = 0; j < 31; ++j) { const f32x2 w = *(const f32x2*)(a.in[I_CONVW] + j * 512 + 2 * cp); w0[j] = w.x; w1[j] = w.y; }
    const f32x2 cb = *(const f32x2*)(a.in[I_CONVB] + 2 * cp), gg = *(const f32x2*)(a.in[I_GNG] + 2 * cp), gb = *(const f32x2*)(a.in[I_GNB] + 2 * cp);
    const LAS unsigned* L = (const LAS unsigned*)C.lds;
#pragma unroll 1
    for (int sb = 0; sb < 4; ++sb) {
        const int ob = 32 * half + 8 * sb;
        float a0[8], a1[8], x0[38], x1[38];
#pragma unroll
        for (int i = 0; i < 38; ++i) { const unsigned u = L[(ob + i) * 256 + cp]; x0[i] = bf_lo(u); x1[i] = bf_hi(u); }
#pragma unroll
        for (int o = 0; o < 8; ++o) { float s0 = cb.x, s1 = cb.y;
#pragma unroll
            for (int j = 0; j < 31; ++j) { s0 += w0[j] * x0[o + j]; s1 += w1[j] * x1[o + j]; }
            a0[o] = s0; a1[o] = s1; }
#pragma unroll
        for (int o = 0; o < 8; ++o) {
            const float s = sum32(a0[o] + a1[o]);
            const float mu = s * (1.f / 64.f), d0 = a0[o] - mu, d1 = a1[o] - mu;
            const float q = sum32(d0 * d0 + d1 * d1);
            const float rstd = rsqrtf(q * (1.f / 64.f) + EPS);
            const float y0 = d0 * rstd * gg.x + gb.x, y1 = d1 * rstd * gg.y + gb.y;
            *(unsigned short*)(Y8 + ((size_t)(b * SEQ + t0 + ob + o)) * D + 2 * cp) = (unsigned short)(pk4_fp8(y0 * sigmoidf_(y0), y1 * sigmoidf_(y1), 0.f, 0.f) & 0xffffu);
        }
    }
}

template <bool WIN>
__device__ __forceinline__ void att_softmax(f32x16& S, float& mrun, float& lrun, f32x16& O0, f32x16& O1, bf16x8 (&pb)[2], int W, const LAS float* bp, bool first) {
    if (WIN) {
        float bias[16];
#pragma unroll
        for (int e = 0; e < 16; ++e) bias[e] = bp[(e & 3) + 8 * (e >> 2)];
#pragma unroll
        for (int e = 0; e < 16; ++e) asm volatile("" : "+v"(bias[e]));
#pragma unroll
        for (int e = 0; e < 16; ++e) { const int m = __builtin_amdgcn_sbfe(W, (e & 3) + 8 * (e >> 2), 1);
            S[e] = __int_as_float((__float_as_int(S[e] + bias[e]) & m) | (__float_as_int(-1e30f) & ~m)); }
    }
    float mt = S[0];
#pragma unroll
    for (int e = 1; e < 16; ++e) mt = fmaxf(mt, S[e]);
    mt = fmaxf(mt, __shfl_xor(mt, 32));
    const bool jump = first | (mt > 8.f);
    const float delta = jump ? mt : 0.f;
    if (__any(jump)) {
#pragma unroll
        for (int e = 0; e < 16; ++e) S[e] -= delta;
    }
    const float alpha = first ? 1.f : __builtin_amdgcn_exp2f(-delta);
    mrun += delta;
    float ps = 0.f; float p[16];
#pragma unroll
    for (int e = 0; e < 16; ++e) { p[e] = __builtin_amdgcn_exp2f(S[e]); ps += p[e]; }
    lrun = lrun * alpha + ps;
    if (!__all(alpha == 1.f)) {
#pragma unroll
        for (int e = 0; e < 16; ++e) { O0[e] *= alpha; O1[e] *= alpha; }
    }
#pragma unroll
    for (int s2 = 0; s2 < 2; ++s2) { u32x4 w; w.x = pk2(p[8 * s2 + 0], p[8 * s2 + 1]); w.y = pk2(p[8 * s2 + 2], p[8 * s2 + 3]); w.z = pk2(p[8 * s2 + 4], p[8 * s2 + 5]); w.w = pk2(p[8 * s2 + 6], p[8 * s2 + 7]);
        pb[s2] = __builtin_bit_cast(bf16x8, w); }
}
__device__ __forceinline__ void attn_task(const Ctx& C, int task) {
    CArgs& a = *C.a; unsigned char* ws = a.ws;
    const bf16_t* Qb = (const bf16_t*)(ws + WS_Q); const bf16_t* Kb = (const bf16_t*)(ws + WS_K); const bf16_t* Vb = (const bf16_t*)(ws + WS_V);
    unsigned char* Y8 = ws + WS_A8;
    const int h = task & 7, ch = (task >> 3) & 1, rp = (task >> 4) & 31, b = task >> 9;
    const int lane = C.lane, n = lane & 31, hh = lane >> 5;
    const int krA = 2 * rp - 4 < 0 ? 0 : (2 * rp - 4 > 56 ? 56 : 2 * rp - 4), krB = 2 * rp - 3 < 0 ? 0 : (2 * rp - 3 > 56 ? 56 : 2 * rp - 3);
    const int nr = krB + 8 - krA;
    LAS unsigned char* lw = C.lds + C.wid * 14592;
    LAS unsigned char* KT = lw; LAS unsigned char* VT = lw + 5760;
    LAS float* RP = (LAS float*)(lw + 11520);
    const int rq = 2 * rp + (n >> 4), kr0q = rq - 4 < 0 ? 0 : (rq - 4 > 56 ? 56 : rq - 4);
    int qtok[2], bs[2], Wq[2]; const LAS float* bp0[2];
#pragma unroll
    for (int qb = 0; qb < 2; ++qb) {
        const int j = 2 * ch + qb, qc = 16 * j + (n & 15);
        qtok[qb] = b * SEQ + rq * 64 + qc;
        bs[qb] = 16 * j - 8 < 0 ? 0 : (16 * j - 8 > 32 ? 32 : 16 * j - 8);
        const int cs = qc - 8 < 0 ? 0 : (qc - 8 > 48 ? 48 : qc - 8);
        int tq = bs[qb] + 4 * hh - cs; tq = tq < -32 ? -32 : (tq > 31 ? 31 : tq);
        Wq[qb] = (int)(unsigned)((0xFFFFull << 32) >> (32 + tq));
        bp0[qb] = RP + 64 + (krA - rq + 7) * 31 + bs[qb] + 4 * hh - qc + 15;
    }
    bf16x8 bq[2][4];
#pragma unroll
    for (int qb = 0; qb < 2; ++qb)
#pragma unroll
        for (int s = 0; s < 4; ++s) bq[qb][s] = *(const bf16x8*)(Qb + (size_t)qtok[qb] * 512 + h * 64 + 16 * s + 8 * hh);
    f32x16 O[2][2];
#pragma unroll
    for (int i = 0; i < 2; ++i)
#pragma unroll
        for (int j = 0; j < 2; ++j)
#pragma unroll
            for (int e = 0; e < 16; ++e) O[i][j][e] = 0.f;
    float mrun[2] = {0.f, 0.f}, lrun[2] = {0.f, 0.f};
    const int lk = lane >> 3, lc = lane & 7;
    const int ub = 24 * ch;
    u32x4 kq[5], vq[5];
#define ATT_FETCH(NI_, tok_) do { const size_t tb_ = (size_t)(tok_) + lk; _Pragma("unroll") for (int i = 0; i < NI_; ++i) { \
        kq[i] = *(const u32x4*)(Kb + (tb_ + 8 * i) * 512 + h * 64 + lc * 8); vq[i] = *(const u32x4*)(Vb + (tb_ + 8 * i) * 512 + h * 64 + lc * 8); } } while (0)
#define ATT_STAGE(NI_) do { _Pragma("unroll") for (int i = 0; i < NI_; ++i) { *(LAS u32x4*)(KT + (8 * i + lk) * 144 + lc * 16) = kq[i]; *(LAS u32x4*)(VT + (8 * i + lk) * 144 + lc * 16) = vq[i]; } } while (0)
    typedef short s4v __attribute__((ext_vector_type(4)));
    const LAS unsigned char* vp0 = VT + (4 * hh + ((lane & 15) >> 2)) * 144 + (16 * ((lane >> 4) & 1) + 4 * (lane & 3)) * 2;
#define ATT_VA(db_, s2_, k0_) ({ const LAS unsigned char* vp_ = vp0 + (16 * (s2_) + (k0_)) * 144 + 64 * (db_); \
        const s4v lo_ = __builtin_amdgcn_ds_read_tr16_b64_v4i16((LAS s4v*)vp_), hi_ = __builtin_amdgcn_ds_read_tr16_b64_v4i16((LAS s4v*)(vp_ + 8 * 144)); \
        (bf16x8)__builtin_shufflevector(lo_, hi_, 0, 1, 2, 3, 4, 5, 6, 7); })
    ATT_FETCH(4, M + b * CTXL);
#pragma unroll 1
    for (int kt = 0; kt < 8; ++kt) {
        ATT_STAGE(4);
        if (kt < 7) ATT_FETCH(4, M + b * CTXL + 32 * (kt + 1)); else ATT_FETCH(5, b * SEQ + krA * 64 + ub);
        bf16x8 kf[4];
#pragma unroll
        for (int s = 0; s < 4; ++s) kf[s] = *(const LAS bf16x8*)(KT + n * 144 + 32 * s + 16 * hh);
        bf16x8 pb[2][2];
#pragma unroll
        for (int qb = 0; qb < 2; ++qb) {
            f32x16 S;
#pragma unroll
            for (int e = 0; e < 16; ++e) S[e] = -mrun[qb];
#pragma unroll
            for (int s = 0; s < 4; ++s) S = __builtin_amdgcn_mfma_f32_32x32x16_bf16(kf[s], bq[qb][s], S, 0, 0, 0);
            att_softmax<false>(S, mrun[qb], lrun[qb], O[0][qb], O[1][qb], pb[qb], 0, RP, kt == 0);
        }
#pragma unroll
        for (int db = 0; db < 2; ++db)
#pragma unroll
            for (int s2 = 0; s2 < 2; ++s2) { const bf16x8 va = ATT_VA(db, s2, 0);
#pragma unroll
                for (int qb = 0; qb < 2; ++qb) O[db][qb] = __builtin_amdgcn_mfma_f32_32x32x16_bf16(va, pb[qb][s2], O[db][qb], 0, 0, 0); }
    }
#pragma unroll 1
    for (int i = 0; i < nr; ++i) {
        const int W = ((unsigned)(krA + i - kr0q) < 8u) ? -1 : 0;
        ATT_STAGE(5);
        ATT_FETCH(5, b * SEQ + (krA + (i + 1 < nr ? i + 1 : i)) * 64 + ub);
#pragma unroll
        for (int qb = 0; qb < 2; ++qb) {
            bf16x8 kf[4];
#pragma unroll
            for (int s = 0; s < 4; ++s) kf[s] = *(const LAS bf16x8*)(KT + (n + 8 * qb) * 144 + 32 * s + 16 * hh);
            f32x16 S;
#pragma unroll
            for (int e = 0; e < 16; ++e) S[e] = -mrun[qb];
#pragma unroll
            for (int s = 0; s < 4; ++s) S = __builtin_amdgcn_mfma_f32_32x32x16_bf16(kf[s], bq[qb][s], S, 0, 0, 0);
            bf16x8 pb[2];
            att_softmax<true>(S, mrun[qb], lrun[qb], O[0][qb], O[1][qb], pb, Wq[qb] & W, bp0[qb] + 31 * i, false);
#pragma unroll
            for (int db = 0; db < 2; ++db)
#pragma unroll
                for (int s2 = 0; s2 < 2; ++s2) { const bf16x8 va = ATT_VA(db, s2, 8 * qb); O[db][qb] = __builtin_amdgcn_mfma_f32_32x32x16_bf16(va, pb[s2], O[db][qb], 0, 0, 0); }
        }
    }
#undef ATT_FETCH
#undef ATT_STAGE
#undef ATT_VA
#pragma unroll
    for (int qb = 0; qb < 2; ++qb) {
        const float lt = lrun[qb] + __shfl_xor(lrun[qb], 32), inv = 1.f / lt;
        unsigned char* yrow = Y8 + (size_t)qtok[qb] * D + 512 + h * 64;
#pragma unroll
        for (int db = 0; db < 2; ++db)
#pragma unroll
            for (int g = 0; g < 4; ++g)
                *(unsigned*)(yrow + 32 * db + 8 * g + 4 * hh) = pk4_fp8(O[db][qb][4 * g] * inv, O[db][qb][4 * g + 1] * inv, O[db][qb][4 * g + 2] * inv, O[db][qb][4 * g + 3] * inv);
    }
}

__device__ __forceinline__ void phaseNorm2(const Ctx& C, int l) {
    CArgs& a = *C.a; unsigned char* ws = a.ws;
    const float* modf = (const float*)(ws + WS_MODF) + (size_t)l * 9 * 6144;
    LAS float* GS = (LAS float*)C.lds; LAS float* SH = GS + 1024;
    const int b = (C.bid * 128) / SEQ;
    { float g_[2], sc_[2], sh_[2];
#pragma unroll
      for (int k = 0; k < 2; ++k) { const int c = C.tid + 512 * k; g_[k] = a.in[I_N2G][l * 1024 + c]; sc_[k] = modf[b * 6144 + 4 * 1024 + c]; sh_[k] = modf[b * 6144 + 3 * 1024 + c]; }
#pragma unroll
      for (int k = 0; k < 2; ++k) { const int c = C.tid + 512 * k; GS[c] = g_[k] * (1.f + sc_[k]); SH[c] = sh_[k]; } }
    __syncthreads();
    bf16_t* A = (bf16_t*)(ws + WS_A);
    const bf16_t* Hb = (const bf16_t*)(ws + WS_H);
    { const int r = C.bid * 128 + C.wid * 16;
      modulate_rows_h<16, true>(Hb + (size_t)r * D, ws + WS_A8 + (size_t)r * D, GS, SH, C.lane, nullptr, (float*)(ws + WS_RSTD) + (size_t)l * M + r); }
}

__device__ __forceinline__ void ce_desc(float& x, float& y) { const float hi = fmaxf(x, y), lo = fminf(x, y); x = hi; y = lo; }
__device__ __forceinline__ void ce_asc(float& x, float& y) { const float hi = fmaxf(x, y), lo = fminf(x, y); x = lo; y = hi; }
__device__ __forceinline__ void sort16_desc(float (&v)[16]) {
#define CE(a_, b_) ce_desc(v[a_], v[b_]);
    CE(0,13) CE(1,12) CE(2,15) CE(3,14) CE(4,8) CE(5,6) CE(7,11) CE(9,10)
    CE(0,5) CE(1,7) CE(2,9) CE(3,4) CE(6,13) CE(8,14) CE(10,15) CE(11,12)
    CE(0,1) CE(2,3) CE(4,5) CE(6,8) CE(7,9) CE(10,11) CE(12,13) CE(14,15)
    CE(0,2) CE(1,3) CE(4,10) CE(5,11) CE(6,7) CE(8,9) CE(12,14) CE(13,15)
    CE(1,2) CE(3,12) CE(4,6) CE(5,7) CE(8,10) CE(9,11) CE(13,14)
    CE(1,4) CE(2,6) CE(5,8) CE(7,10) CE(9,13) CE(11,14)
    CE(2,4) CE(3,6) CE(9,12) CE(11,13)
    CE(3,5) CE(6,8) CE(7,9) CE(10,12)
    CE(3,4) CE(5,6) CE(7,8) CE(9,10) CE(11,12)
    CE(6,7) CE(8,9)
#undef CE
}
__device__ __forceinline__ void merge16_desc(float (&A)[16], const float (&B)[16]) {
#pragma unroll
    for (int i = 0; i < 16; ++i) A[i] = fmaxf(A[i], B[15 - i]);
#pragma unroll
    for (int j = 8; j > 0; j >>= 1)
#pragma unroll
        for (int i = 0; i < 16; ++i) { const int l = i ^ j; if (l > i) ce_desc(A[i], A[l]); }
}
__device__ __forceinline__ bf16x8 topk_qfrag(const bf16_t* QP, int tok, int h, int p, int hh, int s) { return *(const bf16x8*)(QP + ((((((size_t)(tok >> 5) * 8 + h) * 2 + p) * 8 + s) * 64 + 32 * hh + (tok & 31)) * 8)); }
__device__ __forceinline__ void topk_task(const Ctx& C, int l, int tok0, int ntok0, int h, const LAS unsigned char* KL, bf16x8 (&bq)[2][8]) {
    CArgs& a = *C.a; unsigned char* ws = a.ws;
    const bf16_t* QP = (const bf16_t*)(ws + WS_QP);
    unsigned short* IDX = (unsigned short*)(ws + WS_IDX); float* WT = (float*)(ws + WS_WT);
    const int lane = C.lane, n = lane & 31, hh = lane >> 5;
    const int tok = tok0 + n;
    float sp[2][16];
    auto scores = [&](int p_, int kb_) -> f32x16 { f32x16 S_;
#pragma unroll
        for (int e = 0; e < 16; ++e) S_[e] = 0.f;
#pragma unroll
        for (int s = 0; s < 8; ++s) { const bf16x8 kf = *(const LAS bf16x8*)(KL + (p_ * 128 + 32 * kb_ + n) * 272 + 128 * hh + 16 * s);
            S_ = __builtin_amdgcn_mfma_f32_32x32x16_bf16(kf, bq[p_][s], S_, 0, 0, 0); }
        return S_; };
    f32x16 Sn = scores(0, 0);
#pragma unroll
    for (int p = 0; p < 2; ++p) {
        float top[16];
#pragma unroll
        for (int kb = 0; kb < 4; ++kb) {
            const f32x16 S = Sn;
            if (kb < 3) Sn = scores(p, kb + 1);
            if (kb == 2) {
#pragma unroll
                for (int s = 0; s < 8; ++s) bq[p][s] = topk_qfrag(QP, ntok0 + n, h, p, hh, s); }
            if (kb == 3 && p == 0) Sn = scores(1, 0);
            __builtin_amdgcn_sched_barrier(0);
            float ch[16];
#pragma unroll
            for (int e = 0; e < 16; ++e) { const unsigned key = 32 * kb + (e & 3) + 8 * (e >> 2) + 4 * hh; ch[e] = __uint_as_float((__float_as_uint(S[e]) & ~0x7Fu) | key); }
            sort16_desc(ch);
            if (kb == 0) {
#pragma unroll
                for (int e = 0; e < 16; ++e) top[e] = ch[e];
            } else merge16_desc(top, ch);
        }
        float oth[16];
#pragma unroll
        for (int e = 0; e < 16; ++e) oth[e] = __shfl_xor(top[e], 32);
        merge16_desc(top, oth);
#pragma unroll
        for (int e = 0; e < 16; ++e) sp[p][e] = top[e];
    }
    const float NEG = -3.0e38f;
    auto cand = [&](int ia, int ib) -> float { const float s = sp[0][ia] + sp[1][ib]; return __uint_as_float((__float_as_uint(s) & ~0xFFu) | (unsigned)((ia << 4) | ib)); };
    float L1[16], L2[16], L3[16], L4[16];
#pragma unroll
    for (int i = 0; i < 16; ++i) { L1[i] = cand(0, i); L2[i] = i < 15 ? cand(i + 1, 0) : NEG; L4[i] = NEG; }
#pragma unroll
    for (int i = 0; i < 7; ++i) L3[i] = cand(1, i + 1);
#pragma unroll
    for (int i = 0; i < 6; ++i) L3[7 + i] = cand(i + 2, 1);
#pragma unroll
    for (int i = 0; i < 3; ++i) L3[13 + i] = cand(2, i + 2);
    L4[0] = cand(3, 2); L4[1] = cand(4, 2); L4[2] = cand(3, 3);
    sort16_desc(L3);
    ce_desc(L4[0], L4[1]); ce_desc(L4[1], L4[2]); ce_desc(L4[0], L4[1]);
    merge16_desc(L1, L2); merge16_desc(L3, L4); merge16_desc(L1, L3);
    if (hh == 0) {
        float e16[16], se = 0.f;
#pragma unroll
        for (int i = 0; i < 16; ++i) { e16[i] = __expf(L1[i] - L1[0]); se += e16[i]; }
        const float inv = 1.f / se;
        LAS unsigned* tb = (LAS unsigned*)(C.lds + 69632 + C.wid * 4224) + n * 33;
#pragma unroll
        for (int i = 0; i < 16; ++i) { tb[i] = __float_as_uint(sp[0][i]) & 0x7Fu; tb[16 + i] = __float_as_uint(sp[1][i]) & 0x7Fu; }
        unsigned ids[16];
#pragma unroll
        for (int i = 0; i < 16; ++i) { const unsigned code = __float_as_uint(L1[i]) & 0xFFu; ids[i] = tb[code >> 4] * 128u + tb[16 + (code & 15u)]; }
        unsigned sub[16]; float sv[16];
        { const LAS unsigned char* SEU = C.lds + 103424; const LAS unsigned char* SEV = SEU + NEXP;
#pragma unroll
          for (int i = 0; i < 16; ++i) { sub[i] = (unsigned)SEU[ids[i]]; sv[i] = __uint_as_float((unsigned)SEV[ids[i]] << 23); } }
        u32x4 w0, w1;
        w0.x = ids[0] | (ids[1] << 16); w0.y = ids[2] | (ids[3] << 16); w0.z = ids[4] | (ids[5] << 16); w0.w = ids[6] | (ids[7] << 16);
        w1.x = ids[8] | (ids[9] << 16); w1.y = ids[10] | (ids[11] << 16); w1.z = ids[12] | (ids[13] << 16); w1.w = ids[14] | (ids[15] << 16);
        u32x4* ip = (u32x4*)(IDX + (size_t)tok * 128 + h * 16); ip[0] = w0; ip[1] = w1;
        u32x4 ww[2], sw;
#pragma unroll
        for (int i = 0; i < 8; ++i) ww[i >> 2][i & 3] = pk2(e16[2 * i] * inv * sv[2 * i], e16[2 * i + 1] * inv * sv[2 * i + 1]);
#pragma unroll
        for (int i = 0; i < 4; ++i) sw[i] = sub[4 * i] | (sub[4 * i + 1] << 8) | (sub[4 * i + 2] << 16) | (sub[4 * i + 3] << 24);
        u32x4* wp = (u32x4*)((bf16_t*)WT + (size_t)tok * 128 + h * 16); wp[0] = ww[0]; wp[1] = ww[1];
        *(u32x4*)(ws + WS_SU + (size_t)tok * 128 + h * 16) = sw;
    }
}
__device__ __forceinline__ void phaseTopk(const Ctx& C, int l) {
    CArgs& a = *C.a; unsigned char* ws = a.ws;
    const int h = C.bid & 7, grp = C.bid >> 3;
    const bf16_t* src = (const bf16_t*)(ws + WS_KEYS) + (size_t)((l * 8 + h) * 2) * 128 * 128;
    {
        u32x4 kv[8], sv[4];
#pragma unroll
        for (int k = 0; k < 8; ++k) { const int i = C.tid + 512 * k, row = i >> 4, chunk = i & 15; kv[k] = *(const u32x4*)(src + (size_t)row * 128 + chunk * 8); }
#pragma unroll
        for (int k = 0; k < 4; ++k) { const int i = C.tid + 512 * k; sv[k] = *(const u32x4*)(ws + (i < 1024 ? WS_SIU : WS_SIV) + (size_t)l * NEXP + (size_t)(i & 1023) * 16); }
#pragma unroll
        for (int k = 0; k < 8; ++k) { const int i = C.tid + 512 * k, row = i >> 4, chunk = i & 15; *(LAS u32x4*)(C.lds + row * 272 + chunk * 16) = kv[k]; }
#pragma unroll
        for (int k = 0; k < 4; ++k) { const int i = C.tid + 512 * k; *(LAS u32x4*)(C.lds + 103424 + i * 16) = sv[k]; }
    }
    __syncthreads();
    bf16x8 bq[2][8];
    { const bf16_t* QP = (const bf16_t*)(ws + WS_QP); const int n = C.lane & 31, hh = C.lane >> 5;
#pragma unroll
      for (int p = 0; p < 2; ++p)
#pragma unroll
          for (int s = 0; s < 8; ++s) bq[p][s] = topk_qfrag(QP, grp * 1024 + C.wid * 32 + n, h, p, hh, s); }
#pragma unroll 1
    for (int t = C.wid; t < 32; t += 8) topk_task(C, l, grp * 1024 + t * 32, grp * 1024 + (t + 8 < 32 ? t + 8 : t) * 32, h, C.lds, bq);
}

__device__ __forceinline__ int peer_dequeue(const Ctx& C, unsigned* q, int js) {
    volatile LAS unsigned* slot = (volatile LAS unsigned*)(C.lds + MISC_OFF + 64);
    __syncthreads();
    if (C.tid == 0) *slot = __hip_atomic_fetch_add(q + js, 1u, __ATOMIC_RELAXED, __HIP_MEMORY_SCOPE_AGENT);
    __syncthreads();
    return (int)*slot;
}
__device__ __forceinline__ float dot16_fp8(const u32x4 (&xf)[2], const u32x4 uw) {
    float d = 0.f;
#pragma unroll
    for (int q = 0; q < 4; ++q) { const unsigned w = uw[q];
        const bf2v lo = __builtin_amdgcn_cvt_scalef32_pk_bf16_fp8(w, 1.0f, false), hi = __builtin_amdgcn_cvt_scalef32_pk_bf16_fp8(w, 1.0f, true);
        const unsigned x0 = xf[q >> 1][2 * (q & 1)], x1 = xf[q >> 1][2 * (q & 1) + 1];
        d = __builtin_amdgcn_fdot2_f32_bf16(__builtin_bit_cast(bf2v, x0), lo, d, false);
        d = __builtin_amdgcn_fdot2_f32_bf16(__builtin_bit_cast(bf2v, x1), hi, d, false); }
    return d;
}
__device__ __forceinline__ float dot32_fp4(const u32x4 (&xf)[4], const u32x4 uw) {
    float d = 0.f;
#pragma unroll
    for (int q = 0; q < 4; ++q) { const unsigned w = uw[q];
        const bf2v p0 = __builtin_amdgcn_cvt_scalef32_pk_bf16_fp4(w, 1.0f, 0), p1 = __builtin_amdgcn_cvt_scalef32_pk_bf16_fp4(w, 1.0f, 1);
        const bf2v p2 = __builtin_amdgcn_cvt_scalef32_pk_bf16_fp4(w, 1.0f, 2), p3 = __builtin_amdgcn_cvt_scalef32_pk_bf16_fp4(w, 1.0f, 3);
        const unsigned x0 = xf[q][0], x1 = xf[q][1], x2 = xf[q][2], x3 = xf[q][3];
        d = __builtin_amdgcn_fdot2_f32_bf16(__builtin_bit_cast(bf2v, x0), p0, d, false);
        d = __builtin_amdgcn_fdot2_f32_bf16(__builtin_bit_cast(bf2v, x1), p1, d, false);
        d = __builtin_amdgcn_fdot2_f32_bf16(__builtin_bit_cast(bf2v, x2), p2, d, false);
        d = __builtin_amdgcn_fdot2_f32_bf16(__builtin_bit_cast(bf2v, x3), p3, d, false); }
    return d;
}
__device__ __forceinline__ void peerU_item(const Ctx& C, int l, int js, int tile) {
    CArgs& a = *C.a; unsigned char* ws = a.ws;
    const bf16_t* Hb = (const bf16_t*)(ws + WS_H); const unsigned short* IDX = (const unsigned short*)(ws + WS_IDX);
    const int cs = js & 3;
    const unsigned char* TUs = ws + WS_TU + ((size_t)(l * 4 + cs) * NEXP) * 128;
    bf16_t* PD = (bf16_t*)(ws + WS_PD) + (size_t)cs * M * 128;
    const int lane = C.lane, g = lane >> 3, c = lane & 7;
    const int bt = (tile * 128) / SEQ;
    const float* rstd = (const float*)(ws + WS_RSTD) + (size_t)l * M;
    LAS unsigned char* lw = C.lds + C.wid * 6144;
    const int tok0 = tile * 128 + (js >> 2) * 64 + C.wid * 8;
    { const u32x4 t0 = *(const u32x4*)((const unsigned char*)(IDX + (size_t)tok0 * 128) + lane * 16), t1 = *(const u32x4*)((const unsigned char*)(IDX + (size_t)tok0 * 128) + (lane + 64) * 16);
      *(LAS u32x4*)(lw + lane * 16) = t0; *(LAS u32x4*)(lw + (lane + 64) * 16) = t1; }
    u32x4 xf[4];
    { u32x4 hr[4];
#pragma unroll
      for (int j = 0; j < 4; ++j) hr[j] = *(const u32x4*)(Hb + (size_t)(tok0 + g) * D + 256 * cs + 32 * c + 8 * j);
      const float rinv = rstd[tok0 + g];
      const float* gsp = (const float*)(ws + WS_GS2) + (size_t)(l * 8 + bt) * 1024 + 256 * cs + 32 * c;
      const float* shp = (const float*)(ws + WS_MODF) + (size_t)l * 9 * 6144 + (size_t)bt * 6144 + 3 * 1024 + 256 * cs + 32 * c;
#pragma unroll
      for (int j = 0; j < 4; ++j) { const f32x4 g0 = *(const f32x4*)(gsp + 8 * j), g1 = *(const f32x4*)(gsp + 8 * j + 4), s0 = *(const f32x4*)(shp + 8 * j), s1 = *(const f32x4*)(shp + 8 * j + 4);
          xf[j][0] = pk2(bf_lo(hr[j][0]) * rinv * g0[0] + s0[0], bf_hi(hr[j][0]) * rinv * g0[1] + s0[1]);
          xf[j][1] = pk2(bf_lo(hr[j][1]) * rinv * g0[2] + s0[2], bf_hi(hr[j][1]) * rinv * g0[3] + s0[3]);
          xf[j][2] = pk2(bf_lo(hr[j][2]) * rinv * g1[0] + s1[0], bf_hi(hr[j][2]) * rinv * g1[1] + s1[1]);
          xf[j][3] = pk2(bf_lo(hr[j][3]) * rinv * g1[2] + s1[2], bf_hi(hr[j][3]) * rinv * g1[3] + s1[3]); } }
    u32x4 kp0 = (u32x4){0u, 0u, 0u, 0u}, kp1 = (u32x4){0u, 0u, 0u, 0u};
#pragma unroll 1
    for (int kk = 0; kk < 8; ++kk) {
        const u32x4 i0 = *(const LAS u32x4*)(lw + g * 256 + kk * 32), i1 = *(const LAS u32x4*)(lw + g * 256 + kk * 32 + 16);
        u32x4 uf[16];
#pragma unroll
        for (int b = 0; b < 16; ++b) { const unsigned w = b < 8 ? i0[b >> 1] : i1[(b - 8) >> 1]; const unsigned e = (b & 1) ? (w >> 16) : (w & 0xffffu);
            uf[b] = *(const u32x4*)(TUs + (e * 128u + 16u * (unsigned)c)); }
        const bool mine = (c == kk);
#pragma unroll
        for (int j = 0; j < 8; ++j) { const float d0 = sum8s(dot32_fp4(xf, uf[2 * j])), d1 = sum8s(dot32_fp4(xf, uf[2 * j + 1]));
            const unsigned a = pk2(d0, d1);
            if (j < 4) kp0[j] = mine ? a : kp0[j]; else kp1[j - 4] = mine ? a : kp1[j - 4]; }
    }
    bf16_t* prow = PD + (size_t)(tok0 + g) * 128 + 16 * c;
    *(u32x4*)prow = kp0; *(u32x4*)(prow + 8) = kp1;
}
__device__ __forceinline__ void phasePeerCombine(const Ctx& C) {
    CArgs& a = *C.a; unsigned char* ws = a.ws;
    const u32x2* PD = (const u32x2*)(ws + WS_PD); const u32x2* WT = (const u32x2*)(ws + WS_WT); const unsigned* SU = (const unsigned*)(ws + WS_SU);
    const size_t n4 = (size_t)M * 128 / 4;
    const size_t stride = (size_t)C.G * 512;
#pragma unroll 1
    for (size_t i = (size_t)C.bid * 512 + C.tid; i < n4; i += 4 * stride) {
        u32x2 w[4][4]; unsigned su[4]; u32x2 wt[4];
#pragma unroll
        for (int t = 0; t < 4; ++t) {
#pragma unroll
            for (int j = 0; j < 4; ++j) w[t][j] = PD[(size_t)j * n4 + i + t * stride];
            su[t] = SU[i + t * stride]; wt[t] = WT[i + t * stride]; }
#pragma unroll
        for (int t = 0; t < 4; ++t) {
            f32x4 d = (f32x4){0.f, 0.f, 0.f, 0.f};
#pragma unroll
            for (int j = 0; j < 4; ++j) d += (f32x4){bf_lo(w[t][j].x), bf_hi(w[t][j].x), bf_lo(w[t][j].y), bf_hi(w[t][j].y)};
            f32x4 o;
#pragma unroll
            for (int e = 0; e < 4; ++e) { const unsigned ww_ = e < 2 ? wt[t].x : wt[t].y;
                o[e] = gelu_erf(d[e] * __uint_as_float(((su[t] >> (8 * e)) & 0xffu) << 23)) * ((e & 1) ? bf_hi(ww_) : bf_lo(ww_)); }
            u32x2 ob; ob.x = pk2(o[0], o[1]); ob.y = pk2(o[2], o[3]);
            ((u32x2*)(ws + WS_A))[i + t * stride] = ob; }
    }
}
__device__ __forceinline__ void peerV_item(const Ctx& C, int l, int js, int tile) {
    CArgs& a = *C.a; unsigned char* ws = a.ws;
    const unsigned short* IDX = (const unsigned short*)(ws + WS_IDX); const bf16_t* CF = (const bf16_t*)(ws + WS_A);
    const int cs = js & 3;
    const unsigned char* TVs = ws + WS_TV + ((size_t)(l * 4 + cs) * NEXP) * 128;
    int lane = C.lane; asm volatile("" : "+v"(lane));
    const int g = lane >> 3, c = lane & 7;
    const int bt = (tile * 128) / SEQ;
    LAS unsigned char* lw = C.lds + C.wid * 6144;
    const int tok0 = tile * 128 + (js >> 2) * 64 + C.wid * 8;
    { const u32x4 t0 = *(const u32x4*)((const unsigned char*)(IDX + (size_t)tok0 * 128) + lane * 16), t1 = *(const u32x4*)((const unsigned char*)(IDX + (size_t)tok0 * 128) + (lane + 64) * 16);
      u32x4 cfv[2];
#pragma unroll
      for (int j = 0; j < 2; ++j) cfv[j] = *(const u32x4*)((const unsigned char*)(CF + (size_t)tok0 * 128) + (lane + 64 * j) * 16);
      *(LAS u32x4*)(lw + lane * 16) = t0; *(LAS u32x4*)(lw + (lane + 64) * 16) = t1;
#pragma unroll
      for (int j = 0; j < 2; ++j) *(LAS u32x4*)(lw + 2048 + (lane + 64 * j) * 16) = cfv[j]; }
    f32x2 acc[16];
#pragma unroll
    for (int e = 0; e < 16; ++e) acc[e] = (f32x2){0.f, 0.f};
#pragma unroll 1
    for (int kk = 0; kk < 8; ++kk) {
        const u32x4 i0 = *(const LAS u32x4*)(lw + g * 256 + kk * 32), i1 = *(const LAS u32x4*)(lw + g * 256 + kk * 32 + 16);
        u32x4 vf[16];
#pragma unroll
        for (int b = 0; b < 16; ++b) { const unsigned w = b < 8 ? i0[b >> 1] : i1[(b - 8) >> 1]; const unsigned e = (b & 1) ? (w >> 16) : (w & 0xffffu);
            vf[b] = *(const u32x4*)(TVs + (e * 128u + 16u * (unsigned)c)); }
        u32x4 cfw[2];
#pragma unroll
        for (int q = 0; q < 2; ++q) cfw[q] = *(const LAS u32x4*)(lw + 2048 + g * 256 + kk * 32 + 16 * q);
#pragma unroll
        for (int b = 0; b < 16; ++b) { const unsigned cw = cfw[b >> 3][(b >> 1) & 3]; const float ck = (b & 1) ? bf_hi(cw) : bf_lo(cw);
            const f32x2 ck2 = (f32x2){ck, ck};
#pragma unroll
            for (int q = 0; q < 4; ++q) { const unsigned vw = vf[b][q];
                acc[4 * q] += ck2 * __builtin_amdgcn_cvt_scalef32_pk_f32_fp4(vw, 1.0f, 0);
                acc[4 * q + 1] += ck2 * __builtin_amdgcn_cvt_scalef32_pk_f32_fp4(vw, 1.0f, 1);
                acc[4 * q + 2] += ck2 * __builtin_amdgcn_cvt_scalef32_pk_f32_fp4(vw, 1.0f, 2);
                acc[4 * q + 3] += ck2 * __builtin_amdgcn_cvt_scalef32_pk_f32_fp4(vw, 1.0f, 3); }
            asm volatile("" : "+v"(acc[0]), "+v"(acc[1]), "+v"(acc[2]), "+v"(acc[3]), "+v"(acc[4]), "+v"(acc[5]), "+v"(acc[6]), "+v"(acc[7]),
                              "+v"(acc[8]), "+v"(acc[9]), "+v"(acc[10]), "+v"(acc[11]), "+v"(acc[12]), "+v"(acc[13]), "+v"(acc[14]), "+v"(acc[15])); }
    }
    bf16_t* hp = (bf16_t*)(ws + WS_H) + (size_t)(tok0 + g) * D + 256 * cs + 32 * c;
    const float* g5p = (const float*)(ws + WS_MODF) + (size_t)l * 9 * 6144 + bt * 6144 + 5 * 1024 + 256 * cs + 32 * c;
#pragma unroll
    for (int j = 0; j < 4; ++j) {
        const u32x4 h4 = *(const u32x4*)(hp + 8 * j);
        const f32x4 ga = *(const f32x4*)(g5p + 8 * j), gb = *(const f32x4*)(g5p + 8 * j + 4);
        u32x4 o;
        o[0] = pk2(bf_lo(h4[0]) + ga[0] * acc[4 * j].x, bf_hi(h4[0]) + ga[1] * acc[4 * j].y);
        o[1] = pk2(bf_lo(h4[1]) + ga[2] * acc[4 * j + 1].x, bf_hi(h4[1]) + ga[3] * acc[4 * j + 1].y);
        o[2] = pk2(bf_lo(h4[2]) + gb[0] * acc[4 * j + 2].x, bf_hi(h4[2]) + gb[1] * acc[4 * j + 2].y);
        o[3] = pk2(bf_lo(h4[3]) + gb[2] * acc[4 * j + 3].x, bf_hi(h4[3]) + gb[3] * acc[4 * j + 3].y);
        *(u32x4*)(hp + 8 * j) = o; }
}
template <int WHICH> __device__ __forceinline__ void phasePeerSliced(const Ctx& C, int l) {
    const int xcc = (int)(xb_xcc_id() & 7u);
    unsigned* q = (unsigned*)(C.a->ws + WS_CTL) + 8192 + 16 * (2 * l + WHICH);
    volatile LAS unsigned* slot = (volatile LAS unsigned*)(C.lds + MISC_OFF + 64);
#pragma unroll 1
    for (int at = 0; at < 8; ++at) {
        if (at > 0) {
            __syncthreads();
            if (C.tid == 0) { unsigned hd[8], m = 0u;
#pragma unroll
                for (int j = 0; j < 8; ++j) hd[j] = __hip_atomic_load(q + j, __ATOMIC_RELAXED, __HIP_MEMORY_SCOPE_AGENT);
#pragma unroll
                for (int j = 0; j < 8; ++j) m |= (hd[j] < (unsigned)(M / 128)) ? (1u << j) : 0u;
                *slot = m; }
            __syncthreads();
            const unsigned live = *slot;
            while (at < 8 && !((live >> ((xcc + at) & 7)) & 1u)) ++at;
            if (at >= 8) break;
        }
        const int js = (xcc + at) & 7;
        int tile = peer_dequeue(C, q, js);
#pragma unroll 1
        while (tile < M / 128) {
            unsigned nxt = 0u;
            if (C.tid == 0) nxt = __hip_atomic_fetch_add(q + js, 1u, __ATOMIC_RELAXED, __HIP_MEMORY_SCOPE_AGENT);
            if (WHICH == 0) peerU_item(C, l, js, tile); else peerV_item(C, l, js, tile);
            __syncthreads();
            if (C.tid == 0) *slot = nxt;
            __syncthreads();
            tile = (int)*slot;
        } }
}
__device__ __forceinline__ void phasePeerNorm(const Ctx& C, int l) {
    CArgs& a = *C.a; unsigned char* ws = a.ws;
    if (l == 0) {
        const float* modf = (const float*)(ws + WS_MODF) + (size_t)9 * 6144;
        LAS float* GS = (LAS float*)C.lds; LAS float* SH = GS + 1024;
        const int b = (C.bid * 128) / SEQ;
        { float g_[2], sc_[2], sh_[2];
#pragma unroll
          for (int k = 0; k < 2; ++k) { const int c = C.tid + 512 * k; g_[k] = a.in[I_N1G][1024 + c]; sc_[k] = modf[b * 6144 + 1024 + c]; sh_[k] = modf[b * 6144 + c]; }
#pragma unroll
          for (int k = 0; k < 2; ++k) { const int c = C.tid + 512 * k; GS[c] = g_[k] * (1.f + sc_[k]); SH[c] = sh_[k]; } }
        __syncthreads();
        unsigned char* A8 = ws + WS_A8;
        const bf16_t* Hb = (const bf16_t*)(ws + WS_H);
        { const int r = C.bid * 128 + C.wid * 16; modulate_rows_h<16, true>(Hb + (size_t)r * D, A8 + (size_t)r * D, GS, SH, C.lane); }
    } else {
        const bf16_t* Hb = (const bf16_t*)(ws + WS_H);
        { const int r0 = C.bid * 128 + C.wid * 16;
            u32x4 v[16][2];
#pragma unroll
            for (int r = 0; r < 16; ++r)
#pragma unroll
                for (int j = 0; j < 2; ++j) v[r][j] = *(const u32x4*)(Hb + (size_t)(r0 + r) * D + 512 * j + 8 * C.lane);
#pragma unroll
            for (int r = 0; r < 16; ++r) { float x[16]; float s = 0.f;
#pragma unroll
                for (int j = 0; j < 2; ++j)
#pragma unroll
                    for (int e = 0; e < 4; ++e) { x[8 * j + 2 * e] = bf_lo(v[r][j][e]); x[8 * j + 2 * e + 1] = bf_hi(v[r][j][e]); }
#pragma unroll
                for (int e = 0; e < 16; ++e) s += x[e] * x[e];
                const float rinv = rsqrtf(wave_sum(s) * (1.f / D) + EPS);
#pragma unroll
                for (int j = 0; j < 2; ++j)
#pragma unroll
                    for (int q = 0; q < 2; ++q) { const f32x4 gg = *(const f32x4*)(a.in[I_NFG] + 512 * j + 8 * C.lane + 4 * q);
                        *(f32x4*)(a.out + (size_t)(r0 + r) * D + 512 * j + 8 * C.lane + 4 * q) = (f32x4){x[8 * j + 4 * q] * rinv * gg[0], x[8 * j + 4 * q + 1] * rinv * gg[1], x[8 * j + 4 * q + 2] * rinv * gg[2], x[8 * j + 4 * q + 3] * rinv * gg[3]}; } } }
    }
}

__device__ __forceinline__ void phaseSgu(const Ctx& C) {
    CArgs& a = *C.a; unsigned char* ws = a.ws;
    const bf16_t* U = (const bf16_t*)(ws + WS_U); const bf16_t* VV = (const bf16_t*)(ws + WS_VV); const bf16_t* WSP = (const bf16_t*)(ws + WS_WSP);
    unsigned char* A8 = ws + WS_A8;
    LAS float* ST = (LAS float*)(C.lds + 69632);
    LAS bf16_t* VT = (LAS bf16_t*)C.lds;
    const int lane = C.lane, n = lane & 31, hh = lane >> 5;
    LAS float* LG = (LAS float*)(C.lds + 70656); LAS float* LB = LG + 1024;
    LAS unsigned char* WL = C.lds + 78848;
    { float g_[2], b_[2];
#pragma unroll
      for (int k = 0; k < 2; ++k) { const int c = C.tid + 512 * k; g_[k] = a.in[I_LNG][c]; b_[k] = a.in[I_LNB][c]; }
#pragma unroll
      for (int k = 0; k < 2; ++k) { const int c = C.tid + 512 * k; LG[c] = g_[k]; LB[c] = b_[k]; } }
    for (int chunk = C.bid; chunk < M / 128; chunk += C.G) {
        const int tok0 = chunk * 128;
        __syncthreads();
        for (int ib = 0; ib < 16; ib += 16) {
            u32x4 vv0[16], vv1[16];
#pragma unroll
            for (int i = 0; i < 16; ++i) { const int q = C.wid * 16 + ib + i;
                vv0[i] = *(const u32x4*)(VV + (size_t)(tok0 + q) * D + 8 * lane); vv1[i] = *(const u32x4*)(VV + (size_t)(tok0 + q) * D + 512 + 8 * lane); }
#pragma unroll
            for (int i = 0; i < 16; ++i) { const int q = C.wid * 16 + ib + i;
                float x[16];
#pragma unroll
                for (int e = 0; e < 4; ++e) { x[2 * e] = bf_lo(vv0[i][e]); x[2 * e + 1] = bf_hi(vv0[i][e]); x[8 + 2 * e] = bf_lo(vv1[i][e]); x[8 + 2 * e + 1] = bf_hi(vv1[i][e]); }
                float s = 0.f;
#pragma unroll
                for (int e = 0; e < 16; ++e) s += x[e];
                const float mu = wave_sum(s) * (1.f / D); float qq = 0.f;
#pragma unroll
                for (int e = 0; e < 16; ++e) { const float d = x[e] - mu; qq += d * d; }
                const float rstd = rsqrtf(wave_sum(qq) * (1.f / D) + EPS);
                if (lane == 0) { ST[2 * q] = mu; ST[2 * q + 1] = rstd; } }
        }
        __syncthreads();
        const int cb = C.tid & 15, q0 = C.tid >> 4;
        const int cbk = C.wid & 3;
        u32x4 vreg[4], wreg[4], unext[4]; float bnext[4];
#define SGU_LOADS(g_) do { _Pragma("unroll") for (int i = 0; i < 4; ++i) vreg[i] = *(const u32x4*)(VV + (size_t)(tok0 + q0 + 32 * i) * D + (g_) * 128 + cb * 8); \
            _Pragma("unroll") for (int i = 0; i < 4; ++i) { unext[i] = *(const u32x4*)(U + (size_t)(tok0 + q0 + 32 * i) * D + (g_) * 128 + cb * 8); bnext[i] = a.in[I_BS][(g_) * 128 + q0 + 32 * i]; } \
            _Pragma("unroll") for (int i = 0; i < 4; ++i) { const int id = C.tid + 512 * i; wreg[i] = *(const u32x4*)(WSP + ((size_t)(g_) * 128 + (id >> 4)) * 128 + (id & 15) * 8); } } while (0)
        SGU_LOADS(0);
#pragma unroll 1
        for (int g = 0; g < 8; ++g) {
            LAS bf16_t* VTg = VT + (g & 1) * (128 * 136);
            u32x4 ureg[4]; float bsr[4];
#pragma unroll
            for (int i = 0; i < 4; ++i) { ureg[i] = unext[i]; bsr[i] = bnext[i]; }
            f32x4 lg0 = *(const LAS f32x4*)(LG + g * 128 + cb * 8), lg1 = *(const LAS f32x4*)(LG + g * 128 + cb * 8 + 4), lb0 = *(const LAS f32x4*)(LB + g * 128 + cb * 8), lb1 = *(const LAS f32x4*)(LB + g * 128 + cb * 8 + 4);
#pragma unroll
            for (int i = 0; i < 4; ++i) { const int q = q0 + 32 * i; const float mu = ST[2 * q], rstd = ST[2 * q + 1];
                const int col = ((((q >> 3) ^ cb) & 15) << 3) | (q & 7);
#pragma unroll
                for (int e = 0; e < 4; ++e) { const int c = cb * 8 + 2 * e;
                    const float ga = e < 2 ? lg0[2 * e] : lg1[2 * e - 4], gb = e < 2 ? lg0[2 * e + 1] : lg1[2 * e - 3];
                    const float ba = e < 2 ? lb0[2 * e] : lb1[2 * e - 4], bb = e < 2 ? lb0[2 * e + 1] : lb1[2 * e - 3];
                    const float y0 = (bf_lo(vreg[i][e]) - mu) * rstd * ga + ba;
                    const float y1 = (bf_hi(vreg[i][e]) - mu) * rstd * gb + bb;
                    const unsigned w = pk2(y0, y1);
                    VTg[c * 136 + col] = (bf16_t)(w & 0xffffu); VTg[(c + 1) * 136 + col] = (bf16_t)(w >> 16); } }
#pragma unroll
            for (int i = 0; i < 4; ++i) { const int id = C.tid + 512 * i; *(LAS u32x4*)(WL + (id >> 4) * 272 + (id & 15) * 16) = wreg[i]; }
            __syncthreads();
            if (g < 7) SGU_LOADS(g + 1);
            bf16x8 bfr[8];
#pragma unroll
            for (int s8 = 0; s8 < 8; ++s8) bfr[s8] = *(const LAS bf16x8*)(VTg + (32 * cbk + n) * 136 + ((((2 * s8 + hh) ^ ((32 * cbk + n) >> 3)) & 15) << 3));
            f32x16 S2[2];
#pragma unroll
            for (int pi = 0; pi < 2; ++pi) {
#pragma unroll
                for (int e = 0; e < 16; ++e) S2[pi][e] = 0.f;
#pragma unroll
                for (int s8 = 0; s8 < 8; ++s8) { const bf16x8 wfr = *(const LAS bf16x8*)(WL + (32 * (2 * (C.wid >> 2) + pi) + n) * 272 + 32 * s8 + 16 * hh);
                    S2[pi] = __builtin_amdgcn_mfma_f32_32x32x16_bf16(wfr, bfr[s8], S2[pi], 0, 0, 0); }
            }
            LAS unsigned char* MX = (LAS unsigned char*)(VT + ((g + 1) & 1) * (128 * 136));
#pragma unroll
            for (int pi = 0; pi < 2; ++pi) {
                const int pb = 2 * (C.wid >> 2) + pi;
#pragma unroll
                for (int e = 0; e < 16; e += 2) { const int p = 32 * pb + (e & 3) + 8 * (e >> 2) + 4 * hh;
                    const unsigned w = pk2(S2[pi][e], S2[pi][e + 1]);
                    *(LAS bf16_t*)(MX + p * 272 + (32 * cbk + n) * 2) = (bf16_t)(w & 0xffffu); *(LAS bf16_t*)(MX + (p + 1) * 272 + (32 * cbk + n) * 2) = (bf16_t)(w >> 16); }
            }
            __syncthreads();
#pragma unroll
            for (int i = 0; i < 4; ++i) { const int q = q0 + 32 * i;
                const u32x4 mx = *(const LAS u32x4*)(MX + q * 272 + cb * 16);
                float r[8];
#pragma unroll
                for (int e = 0; e < 4; ++e) { r[2 * e] = bf_lo(ureg[i][e]) * (bf_lo(mx[e]) + bsr[i]); r[2 * e + 1] = bf_hi(ureg[i][e]) * (bf_hi(mx[e]) + bsr[i]); }
                u32x2 o; o.x = pk4_fp8(r[0], r[1], r[2], r[3]); o.y = pk4_fp8(r[4], r[5], r[6], r[7]);
                *(u32x2*)(A8 + (size_t)(tok0 + q) * D + g * 128 + cb * 8) = o; }
            __syncthreads();
        }
    }
}

constexpr int NPHASES = 22;
__global__ void __launch_bounds__(512, 2) fwd_megakernel(Args args) {
    extern __shared__ __attribute__((aligned(16))) unsigned char lds_raw[];
    LAS unsigned char* lds = (LAS unsigned char*)lds_raw;
    Ctx C; C.a = (CArgs*)__builtin_amdgcn_kernarg_segment_ptr(); C.lds = lds; C.tid = threadIdx.x; C.lane = C.tid & 63; C.wid = __builtin_amdgcn_readfirstlane(C.tid >> 6); C.bid = blockIdx.x; C.G = 256;
    volatile LAS unsigned* MISC = (volatile LAS unsigned*)(lds + MISC_OFF);
    if (C.tid < 4) MISC[C.tid] = 0u;
    __syncthreads();
    unsigned char* ws = args.ws;
    const int lo = args.ph_lo, hi = args.ph_hi;
    const bool multi = (hi - lo) > 1;
    if (multi) (void)xcd_barrier_post((unsigned*)(ws + WS_CTL), MISC, C.tid == 0);
#define GRID_BARRIER() do { XcdBarrier b_; b_.bar = (unsigned*)(args.ws + WS_CTL); b_.x = xb_xcc_id(); b_.st = (volatile LAS unsigned*)(lds + MISC_OFF); \
    b_.leader = (C.wid == 0) && (__builtin_amdgcn_mbcnt_hi(~0u, __builtin_amdgcn_mbcnt_lo(~0u, 0u)) == 0u); xcd_barrier(b_); } while (0)
#if PROBE_PHASE >= 0
    volatile LAS unsigned long long* ts_l = (volatile LAS unsigned long long*)(lds + MISC_OFF + 128);
#define STAMP(k) do { if ((k) == PROBE_PHASE || (k) == PROBE_PHASE + 1) { if (C.wid == 0) ts_l[(k) - PROBE_PHASE] = __builtin_amdgcn_s_memrealtime(); } } while (0)
#else
#define STAMP(k) do { } while (0)
#endif
    int ph = 0;
#define PHASE(...) do { STAMP(ph); if (lo <= ph && ph < hi) { \
    { int l_ = (int)__builtin_amdgcn_mbcnt_hi(~0u, __builtin_amdgcn_mbcnt_lo(~0u, 0u)); asm volatile("" : "+v"(l_)); C.lane = l_; C.tid = C.wid * 64 + l_; \
      CArgs* ap_ = (CArgs*)__builtin_amdgcn_kernarg_segment_ptr(); asm volatile("" : "+s"(ap_)); C.a = ap_; } __VA_ARGS__ } if (lo <= ph && ph + 1 < hi) GRID_BARRIER(); ++ph; } while (0)
    using namespace pg8;
    const bf16_t* Abuf = (const bf16_t*)(ws + WS_A);
    const bf16_t* A8buf = (const bf16_t*)(ws + WS_A8);
    const float* modf = (const float*)(ws + WS_MODF);

    PHASE( phaseA(C); );
    PHASE( phaseB(C); );
    PHASE(
        Gemm g{A8buf, (const bf16_t*)(ws + WS_W1T), MA, 2560, 512}; Order1 S; S.init(C.G, C.bid);
        Epi1 E{(bf16_t*)(ws + WS_GLU), ws};
        gemm_phase<Epi1, Order1, true>(lds, g, S, E, C.tid, C.wid);
        ctx_kv_tile(C); );
    PHASE(
        const int vcu = (C.bid & 7) * (C.G >> 3) + (C.bid >> 3);
        for (int t = vcu; t < 512; t += C.G) conv_tile(C, t);
        __syncthreads();
        {
            LAS float* RPw = (LAS float*)(C.lds + C.wid * 14592 + 11520); float t8[8];
            _Pragma("unroll") for (int k = 0; k < 8; ++k) { const int i = C.lane + 64 * k; t8[k] = args.in[I_RPB][C.wid * 465 + (i < 465 ? i : 464)] * 1.44269504f; }
            _Pragma("unroll") for (int k = 0; k < 8; ++k) RPw[64 + C.lane + 64 * k] = t8[k]; }
        { int tt = C.wid * C.G + C.bid;
          if (C.wid >= 4) { for (int q = 0; q < 2 && tt < 8192; ++q, tt += C.G * 8) table_task(C, tt); }
          int lt = C.wid * C.G + C.bid; LAS float* lscr = (LAS float*)(C.lds + C.wid * 14592);
          for (int t = vcu * 8 + C.wid; t < NBATCH * 64 * 8; t += C.G * 8) { attn_task(C, t);
              for (int q = 0; q < 2 && tt < 8192; ++q, tt += C.G * 8) table_task(C, tt); }
          for (; tt < 8192; tt += C.G * 8) table_task(C, tt);
          for (; lt < T_LATE; lt += C.G * 8) late_prep_task(C, lt, lscr); } );
    PHASE(
        Gemm g{A8buf, (const bf16_t*)(ws + WS_W2T), M, 1024, 512}; StaticOrder S; S.init(M, 1024, C.G, C.bid);
        EpiRes<false> E{args.in[I_X], (bf16_t*)(ws + WS_H), modf + 2 * 1024};
        gemm_phase<EpiRes<false>, StaticOrder, true>(lds, g, S, E, C.tid, C.wid); );
    PHASE( phaseNorm2(C, 0); );
    PHASE(
        Gemm g{WQ_FP8 ? A8buf : Abuf, (const bf16_t*)(ws + WS_WQ), M, 2048, WQ_FP8 ? 512 : 1024}; StaticOrder S; S.init(M, 2048, C.G, C.bid);
        EpiQFrag E{(bf16_t*)(ws + WS_QP)};
        gemm_phase<EpiQFrag, StaticOrder, WQ_FP8 != 0>(lds, g, S, E, C.tid, C.wid); );
    PHASE( phaseTopk(C, 0); );
    PHASE( phasePeerSliced<0>(C, 0); );
    PHASE( phasePeerCombine(C); );
    PHASE( phasePeerSliced<1>(C, 0); );
    PHASE( phasePeerNorm(C, 0); );
    PHASE(
        Gemm g{A8buf, (const bf16_t*)(ws + WS_WSI), M, 2048, 512}; StaticOrder S; S.init(M, 2048, C.G, C.bid);
        EpiBf16<1> E{(bf16_t*)(ws + WS_U), (bf16_t*)(ws + WS_VV), 4, 1024};
        gemm_phase<EpiBf16<1>, StaticOrder, true>(lds, g, S, E, C.tid, C.wid); );
    PHASE( phaseSgu(C); );
    PHASE(
        Gemm g{A8buf, (const bf16_t*)(ws + WS_WSO), M, 1024, 512}; StaticOrder S; S.init(M, 1024, C.G, C.bid);
        EpiRes<true> E{ws + WS_H, (bf16_t*)(ws + WS_H), modf + 9 * 6144 + 2 * 1024};
        gemm_phase<EpiRes<true>, StaticOrder, true>(lds, g, S, E, C.tid, C.wid); );
    PHASE( phaseNorm2(C, 1); );
    PHASE(
        Gemm g{WQ_FP8 ? A8buf : Abuf, (const bf16_t*)(ws + WS_WQ + (size_t)2048 * 1024 * (WQ_FP8 ? 1 : 2)), M, 2048, WQ_FP8 ? 512 : 1024}; StaticOrder S; S.init(M, 2048, C.G, C.bid);
        EpiQFrag E{(bf16_t*)(ws + WS_QP)};
        gemm_phase<EpiQFrag, StaticOrder, WQ_FP8 != 0>(lds, g, S, E, C.tid, C.wid); );
    PHASE( phaseTopk(C, 1); );
    PHASE( phasePeerSliced<0>(C, 1); );
    PHASE( phasePeerCombine(C); );
    PHASE( phasePeerSliced<1>(C, 1); );
    PHASE( phasePeerNorm(C, 1); );
#if PROBE_PHASE >= 0
    if (C.bid == 0 && C.wid == 0 && multi) { const unsigned long long dt = (ts_l[1] - ts_l[0]) * PROBE_MULT, t0 = __builtin_amdgcn_s_memrealtime();
        while (__builtin_amdgcn_s_memrealtime() - t0 < dt) __builtin_amdgcn_s_sleep(8); }
#endif
#undef PHASE
#undef GRID_BARRIER
#undef STAMP
}

extern "C" void kernel_launch(void* const* d_in, const int* in_sizes, int n_in, void* d_out, int out_size, void* d_ws, size_t ws_size, hipStream_t stream) {
    static int grid = 0;
    if (grid == 0) {
        if (n_in != N_IN || out_size != M * D || ws_size < WS_END) { fprintf(stderr, "kernel_launch: unexpected shapes (n_in %d out %d ws %zu need %zu)\n", n_in, out_size, ws_size, (size_t)WS_END); grid = -1; return; }
        int dev = 0, cus = 0, per_cu = 0;
        if (hipGetDevice(&dev) != hipSuccess || hipDeviceGetAttribute(&cus, hipDeviceAttributeMultiprocessorCount, dev) != hipSuccess) { grid = -1; return; }
        if (hipFuncSetAttribute((const void*)fwd_megakernel, hipFuncAttributeMaxDynamicSharedMemorySize, LDS_BYTES) != hipSuccess) { fprintf(stderr, "kernel_launch: hipFuncSetAttribute failed\n"); grid = -1; return; }
        if (hipOccupancyMaxActiveBlocksPerMultiprocessor(&per_cu, (const void*)fwd_megakernel, 512, LDS_BYTES) != hipSuccess || per_cu < 1) { fprintf(stderr, "kernel_launch: occupancy query says %d blocks per CU\n", per_cu); (void)hipGetLastError(); grid = -1; return; }
        grid = cus;
        if (grid != 256) fprintf(stderr, "kernel_launch: note: %d CUs (the phase tilings assume 256)\n", grid);
        if (grid > 256) grid = 256;
    }
    if (grid < 0) return;
    (void)hipMemsetAsync((char*)d_ws + WS_CTL, 0, CTL_BYTES, stream);
    Args a{};
    for (int i = 0; i < N_IN; ++i) a.in[i] = (const float*)d_in[i];
    a.out = (float*)d_out; a.ws = (unsigned char*)d_ws;
#if ONE_LAUNCH
    a.ph_lo = 0; a.ph_hi = NPHASES; hipLaunchKernelGGL(fwd_megakernel, dim3(grid), dim3(512), LDS_BYTES, stream, a);
#else
    for (int i = 0; i < NPHASES; ++i) { a.ph_lo = i; a.ph_hi = i + 1; hipLaunchKernelGGL(fwd_megakernel, dim3(grid), dim3(512), LDS_BYTES, stream, a); }
#endif
}
```
